# Optimizing an MI355X kernel written in HIP

```python
import jax, jax.numpy as jnp
from jax import lax
import numpy as np

D_MODEL = 1024
BATCH = 16
SEQ = 2048
DEPTH = 2
DEC_BATCH = 16
DEC_SEQ = 32
PAST_LEN = 1024

CHUNK = 64
EPS = 1e-6
CONV_WIDTH = 4
MB_INNER = 1024
MB_HEADDIM = 64
MB_HEADS = MB_INNER // MB_HEADDIM
MB_GROUPS = 4
MB_HPG = MB_HEADS // MB_GROUPS
MB_STATE = 128
MB_CONV_CH = MB_INNER + 2 * MB_GROUPS * MB_STATE
MB_NORM_GROUP = MB_INNER // MB_GROUPS
HG_WIDTH = 1024
HG_EXPAND = 128
HG_HEADS = HG_WIDTH // HG_EXPAND
HG_DK = HG_EXPAND
HG_DV = HG_WIDTH // HG_HEADS
RG_WIDTH = 1024
RG_BLOCKS = 16
RG_BLOCK = RG_WIDTH // RG_BLOCKS
RG_C = 8.0
N_BRANCH = 3
BRANCH_WIDTH = 1024
FF_HIDDEN = -(-8 * D_MODEL // (3 * 256)) * 256
IN_SIZES = (MB_INNER, MB_CONV_CH, MB_HEADS,
            HG_HEADS * HG_DK, HG_HEADS * HG_DK, HG_WIDTH, HG_WIDTH,
            RG_WIDTH, RG_WIDTH,
            N_BRANCH * D_MODEL)
IN_WIDTH = sum(IN_SIZES)

kernel_name = 'hybrid_ssd_hgrn2_rglru_stream_step'


def rmsnorm(x, w):
    xf = x.astype(jnp.float32)
    y = xf * lax.rsqrt(jnp.mean(xf * xf, axis=-1, keepdims=True) + EPS)
    return (y * w.astype(jnp.float32)).astype(x.dtype)


def causal_conv(u, hist, w, b):
    L = u.shape[1]
    up = jnp.concatenate([hist.astype(u.dtype), u], axis=1)
    y = b + up[:, 0:L] * w[0]
    for k in range(1, CONV_WIDTH):
        y = y + up[:, k:k + L] * w[k]
    return y, up[:, L:]


def chunk_len(L):
    if L % CHUNK == 0:
        return CHUNK
    assert L <= CHUNK
    return L


def to_chunks(a, q):
    b, l = a.shape[:2]
    return jnp.moveaxis(a.reshape((b, l // q, q) + a.shape[2:]), 1, 0)


def from_chunks(a):
    c, b, q = a.shape[:3]
    return jnp.moveaxis(a, 0, 1).reshape((b, c * q) + a.shape[3:])


def masked_exp(mask, v):
    return jnp.where(mask, jnp.exp(jnp.where(mask, v, 0.0)), 0.0)


def ssd_scan(xs, dt, a, bm, cm, h0):
    q = chunk_len(xs.shape[1])
    causal = jnp.tril(jnp.ones((q, q), dtype=bool))[None, :, :, None, None]

    def body(h, inp):
        xc, dtc, bc, cc = inp
        acs = jnp.cumsum(dtc * a, axis=1)
        seg = acs[:, :, None] - acs[:, None]
        lmat = masked_exp(causal, seg)
        cb = jnp.einsum('bign,bjgn->bijg', cc, bc)
        m = cb[..., None] * lmat * dtc[:, None]
        y = jnp.einsum('bijgr,bjgrp->bigrp', m, xc)
        y = y + jnp.einsum('bign,bigr,bgrpn->bigrp', cc, jnp.exp(acs), h)
        last = acs[:, -1]
        w_end = jnp.exp(last[:, None] - acs) * dtc
        h = jnp.exp(last)[..., None, None] * h + jnp.einsum('bjgn,bjgr,bjgrp->bgrpn', bc, w_end, xc)
        return h, y

    h_t, ys = lax.scan(body, h0, (to_chunks(xs, q), to_chunks(dt, q), to_chunks(bm, q), to_chunks(cm, q)))
    return from_chunks(ys), h_t


def hgrn_scan(qh, kh, log_g, vh, s0):
    q = chunk_len(qh.shape[1])
    causal = jnp.tril(jnp.ones((q, q), dtype=bool))[None, :, :, None, None]

    def body(s, inp):
        qc, kc, gc, vc = inp
        gcs = jnp.cumsum(gc, axis=1)
        dec = masked_exp(causal, gcs[:, :, None] - gcs[:, None])
        att = jnp.einsum('bihk,bijhk->bijh', qc, dec * kc[:, None])
        o = jnp.einsum('bijh,bjhv->bihv', att, vc)
        o = o + jnp.einsum('bihk,bhkv->bihv', qc * jnp.exp(gcs), s)
        last = gcs[:, -1]
        s = jnp.exp(last)[..., None] * s + jnp.einsum('bjhk,bjhv->bhkv', kc * jnp.exp(last[:, None] - gcs), vc)
        return s, o

    s_t, os_ = lax.scan(body, s0, (to_chunks(qh, q), to_chunks(kh, q), to_chunks(log_g, q), to_chunks(vh, q)))
    return from_chunks(os_), s_t


def rglru(xc, h0, w_a, b_a, w_i, b_i, lam):
    b, l, _ = xc.shape
    xb = xc.reshape(b, l, RG_BLOCKS, RG_BLOCK)
    r = jax.nn.sigmoid(jnp.einsum('blhi,hij->blhj', xb, w_a).reshape(b, l, RG_WIDTH) + b_a)
    i = jax.nn.sigmoid(jnp.einsum('blhi,hij->blhj', xb, w_i).reshape(b, l, RG_WIDTH) + b_i)
    log_a = -RG_C * jax.nn.softplus(-lam) * r
    a = jnp.exp(log_a)
    u = jnp.sqrt(-jnp.expm1(2.0 * log_a)) * (i * xc)
    u = u.at[:, 0].add(a[:, 0] * h0)

    def combine(left, right):
        a1, b1 = left
        a2, b2 = right
        return a1 * a2, a2 * b1 + b2

    _, h = lax.associative_scan(combine, (a, u), axis=1)
    return h, h[:, -1]


def zero_states(b, dtype):
    return (jnp.zeros((b, MB_HEADS, MB_HEADDIM, MB_STATE), jnp.float32),
            jnp.zeros((b, CONV_WIDTH - 1, MB_CONV_CH), dtype),
            jnp.zeros((b, HG_HEADS, HG_DK, HG_DV), jnp.float32),
            jnp.zeros((b, RG_WIDTH), jnp.float32),
            jnp.zeros((b, CONV_WIDTH - 1, RG_WIDTH), dtype))


def layer(x, st, p):
    f32 = jnp.float32
    ssm0, conv_mb0, hg0, rg0, conv_rg0 = st
    b, L, _ = x.shape
    h = rmsnorm(x, p['norm_mix'])
    proj = h @ p['w_in']
    split_pts = [int(v) for v in np.cumsum(IN_SIZES)[:-1]]
    z, xbc, dt_raw, hq, hf, hi, hgate, rgate, rx, mg = jnp.split(proj, split_pts, axis=-1)

    xbc, conv_mb_new = causal_conv(xbc, conv_mb0, p['mb_conv_w'], p['mb_conv_b'])
    xbc = jax.nn.silu(xbc.astype(f32))
    xs, bm, cm = jnp.split(xbc, [MB_INNER, MB_INNER + MB_GROUPS * MB_STATE], axis=-1)
    xs = xs.reshape(b, L, MB_GROUPS, MB_HPG, MB_HEADDIM)
    bm = bm.reshape(b, L, MB_GROUPS, MB_STATE)
    cm = cm.reshape(b, L, MB_GROUPS, MB_STATE)
    dt = jax.nn.softplus(dt_raw.astype(f32) + p['mb_dt_bias'].astype(f32)).reshape(b, L, MB_GROUPS, MB_HPG)
    a = -jnp.exp(p['mb_a_log'].astype(f32)).reshape(MB_GROUPS, MB_HPG)
    h0 = ssm0.astype(f32).reshape(b, MB_GROUPS, MB_HPG, MB_HEADDIM, MB_STATE)
    y, ssm_new = ssd_scan(xs, dt, a, bm, cm, h0)
    y = y + p['mb_d'].astype(f32).reshape(MB_GROUPS, MB_HPG)[..., None] * xs
    y = y.reshape(b, L, MB_GROUPS, MB_NORM_GROUP) * jax.nn.silu(z.astype(f32)).reshape(b, L, MB_GROUPS, MB_NORM_GROUP)
    y_mb = rmsnorm(y, p['mb_norm_w'].reshape(MB_GROUPS, MB_NORM_GROUP)).reshape(b, L, MB_INNER)
    ssm_new = ssm_new.reshape(b, MB_HEADS, MB_HEADDIM, MB_STATE)

    lb = p['hg_lb'].astype(f32).reshape(HG_HEADS, HG_DK)
    qh = jax.nn.silu(hq.astype(f32)).reshape(b, L, HG_HEADS, HG_DK)
    fh = hf.astype(f32).reshape(b, L, HG_HEADS, HG_DK)
    log_g = jnp.log(lb + (1.0 - lb) * jax.nn.sigmoid(fh))
    kh = (1.0 - lb) * jax.nn.sigmoid(-fh)
    vh = hi.astype(f32).reshape(b, L, HG_HEADS, HG_DV)
    o, hg_new = hgrn_scan(qh, kh, log_g, vh, hg0.astype(f32))
    y_hg = rmsnorm(o, p['hg_norm_w']).reshape(b, L, HG_WIDTH) * jax.nn.silu(hgate.astype(f32))

    xr, conv_rg_new = causal_conv(rx, conv_rg0, p['rg_conv_w'], p['rg_conv_b'])
    hr, rg_new = rglru(xr.astype(f32), rg0.astype(f32), p['rg_w_a'], p['rg_b_a'], p['rg_w_i'], p['rg_b_i'], p['rg_lambda'])
    y_rg = jax.nn.gelu(rgate.astype(f32)) * hr

    branches = jnp.stack([y_mb, y_hg, y_rg], axis=0).astype(x.dtype)
    pb = jnp.einsum('kblc,kcd->kbld', branches, p['w_branch'])
    gates = jax.nn.sigmoid(mg.reshape(b, L, N_BRANCH, D_MODEL))
    merged = jnp.einsum('kbld,blkd->bld', pb, gates)
    x = x + merged @ p['w_out']

    h2 = rmsnorm(x, p['norm_ffn'])
    gu = h2 @ p['w_ffn_in']
    g, u = jnp.split(gu, [FF_HIDDEN], axis=-1)
    x = x + (jax.nn.silu(g) * u) @ p['w_ffn_out']
    return x, (ssm_new, conv_mb_new, hg_new, rg_new, conv_rg_new)


def setup_inputs(seed: int = 0) -> dict:
    key = jax.random.key(seed)
    ks = iter(jax.random.split(key, 40))
    nrm = lambda shape, s=1.0: s * jax.random.normal(next(ks), shape, jnp.float32)
    dt0 = jnp.exp(jax.random.uniform(next(ks), (DEPTH, MB_HEADS), jnp.float32, np.log(1e-3), np.log(1e-1)))
    a0 = jax.random.uniform(next(ks), (DEPTH, RG_WIDTH), jnp.float32, 0.9, 0.999)
    pa = a0 ** (1.0 / RG_C)
    return {
        'x_prompt': nrm((BATCH, SEQ, D_MODEL)),
        'x_sample': nrm((DEC_BATCH, DEC_SEQ, D_MODEL)),
        'state_ssm': nrm((DEPTH, DEC_BATCH, MB_HEADS, MB_HEADDIM, MB_STATE), 0.1),
        'state_ssm_conv': nrm((DEPTH, DEC_BATCH, CONV_WIDTH - 1, MB_CONV_CH)),
        'state_hgrn': nrm((DEPTH, DEC_BATCH, HG_HEADS, HG_DK, HG_DV), 0.1),
        'state_rglru': nrm((DEPTH, DEC_BATCH, RG_WIDTH), 0.5),
        'state_rglru_conv': nrm((DEPTH, DEC_BATCH, CONV_WIDTH - 1, RG_WIDTH)),
        'norm_mix': 1.0 + nrm((DEPTH, D_MODEL), 0.05),
        'w_in': nrm((DEPTH, D_MODEL, IN_WIDTH), D_MODEL ** -0.5),
        'mb_conv_w': nrm((DEPTH, CONV_WIDTH, MB_CONV_CH), CONV_WIDTH ** -0.5),
        'mb_conv_b': nrm((DEPTH, MB_CONV_CH), 0.02),
        'mb_dt_bias': dt0 + jnp.log(-jnp.expm1(-dt0)),
        'mb_a_log': jnp.log(jax.random.uniform(next(ks), (DEPTH, MB_HEADS), jnp.float32, 1.0, 16.0)),
        'mb_d': 1.0 + nrm((DEPTH, MB_HEADS), 0.1),
        'mb_norm_w': 1.0 + nrm((DEPTH, MB_INNER), 0.05),
        'hg_lb_logits': nrm((DEPTH, HG_HEADS * HG_DK), 0.1),
        'hg_norm_w': 1.0 + nrm((DEPTH, HG_DV), 0.05),
        'rg_conv_w': nrm((DEPTH, CONV_WIDTH, RG_WIDTH), CONV_WIDTH ** -0.5),
        'rg_conv_b': nrm((DEPTH, RG_WIDTH), 0.02),
        'rg_w_a': nrm((DEPTH, RG_BLOCKS, RG_BLOCK, RG_BLOCK), RG_BLOCK ** -0.5),
        'rg_b_a': nrm((DEPTH, RG_WIDTH), 0.02),
        'rg_w_i': nrm((DEPTH, RG_BLOCKS, RG_BLOCK, RG_BLOCK), RG_BLOCK ** -0.5),
        'rg_b_i': nrm((DEPTH, RG_WIDTH), 0.02),
        'rg_lambda': jnp.log(pa) - jnp.log1p(-pa),
        'w_branch': nrm((DEPTH, N_BRANCH, BRANCH_WIDTH, D_MODEL), BRANCH_WIDTH ** -0.5),
        'w_out': nrm((DEPTH, D_MODEL, D_MODEL), D_MODEL ** -0.5),
        'norm_ffn': 1.0 + nrm((DEPTH, D_MODEL), 0.05),
        'w_ffn_in': nrm((DEPTH, D_MODEL, 2 * FF_HIDDEN), D_MODEL ** -0.5),
        'w_ffn_out': nrm((DEPTH, FF_HIDDEN, D_MODEL), FF_HIDDEN ** -0.5),
        'norm_final': 1.0 + nrm((D_MODEL,), 0.05),
    }


def reference(x_prompt, x_sample, state_ssm, state_ssm_conv, state_hgrn, state_rglru, state_rglru_conv,
              norm_mix, w_in, mb_conv_w, mb_conv_b, mb_dt_bias, mb_a_log, mb_d, mb_norm_w,
              hg_lb_logits, hg_norm_w, rg_conv_w, rg_conv_b, rg_w_a, rg_b_a, rg_w_i, rg_b_i, rg_lambda,
              w_branch, w_out, norm_ffn, w_ffn_in, w_ffn_out, norm_final):
    sm = jax.nn.softmax(hg_lb_logits.astype(jnp.float32), axis=0)
    lbs = jnp.cumsum(sm, axis=0) - sm[0]
    yp, ys = x_prompt, x_sample
    new_p = [[], [], [], [], []]
    new_s = [[], [], [], [], []]
    for l in range(DEPTH):
        p = dict(norm_mix=norm_mix[l], w_in=w_in[l], mb_conv_w=mb_conv_w[l], mb_conv_b=mb_conv_b[l],
                 mb_dt_bias=mb_dt_bias[l], mb_a_log=mb_a_log[l], mb_d=mb_d[l], mb_norm_w=mb_norm_w[l],
                 hg_lb=lbs[l], hg_norm_w=hg_norm_w[l], rg_conv_w=rg_conv_w[l], rg_conv_b=rg_conv_b[l],
                 rg_w_a=rg_w_a[l], rg_b_a=rg_b_a[l], rg_w_i=rg_w_i[l], rg_b_i=rg_b_i[l], rg_lambda=rg_lambda[l],
                 w_branch=w_branch[l], w_out=w_out[l], norm_ffn=norm_ffn[l], w_ffn_in=w_ffn_in[l],
                 w_ffn_out=w_ffn_out[l])
        yp, sp = layer(yp, zero_states(yp.shape[0], yp.dtype), p)
        ys, ss = layer(ys, (state_ssm[l], state_ssm_conv[l], state_hgrn[l], state_rglru[l], state_rglru_conv[l]), p)
        for j in range(5):
            new_p[j].append(sp[j])
            new_s[j].append(ss[j])
    y_prompt = rmsnorm(yp, norm_final)
    y_sample = rmsnorm(ys, norm_final)
    new_ssm_p = jnp.stack(new_p[0])
    new_ssm_conv_p = jnp.stack(new_p[1])
    new_hgrn_p = jnp.stack(new_p[2])
    new_rglru_p = jnp.stack(new_p[3])
    new_rglru_conv_p = jnp.stack(new_p[4])
    new_ssm_s = jnp.stack(new_s[0])
    new_ssm_conv_s = jnp.stack(new_s[1])
    new_hgrn_s = jnp.stack(new_s[2])
    new_rglru_s = jnp.stack(new_s[3])
    new_rglru_conv_s = jnp.stack(new_s[4])
    return (y_prompt, y_sample, new_ssm_p, new_ssm_conv_p, new_hgrn_p, new_rglru_p, new_rglru_conv_p,
            new_ssm_s, new_ssm_conv_s, new_hgrn_s, new_rglru_s, new_rglru_conv_s)
```

```cpp
#include <hip/hip_runtime.h>
#include <hip/hip_cooperative_groups.h>
#include <cstdio>
namespace cg = cooperative_groups;

typedef unsigned short bf16_t;
typedef short bf16x8 __attribute__((ext_vector_type(8)));
typedef float f32x4 __attribute__((ext_vector_type(4)));
typedef unsigned short us4 __attribute__((ext_vector_type(4)));
typedef unsigned short us8 __attribute__((ext_vector_type(8)));
#define DEVI __device__ __forceinline__

constexpr int D = 1024, NPROJ = 12416, SEGT = 512, NSEG = 4, ROWS_P = 8192, ROWS = 8704, FFH = 2816;
constexpr int PC_Z = 0, PC_XBC = 1024, PC_HQ = 3072, PC_HF = 4096, PC_HI = 5120, PC_HGATE = 6144, PC_RGATE = 7168, PC_RX = 8192, PC_MG = 9216, PC_DT = 12288;
constexpr size_t E_WIN = (size_t)NPROJ * 1024, E_WBR = 3u * 1024 * 1024, E_WOUT = 1024u * 1024, E_WFI = 5632u * 1024, E_WFO = 1024u * 2816;
constexpr size_t E_LAYER = E_WIN + E_WBR + E_WOUT + E_WFI + E_WFO;
constexpr size_t WS_PROJ = 2 * E_LAYER * 2;
constexpr size_t WS_DT = WS_PROJ + (size_t)ROWS * NPROJ * 2;
constexpr size_t WS_XB = WS_DT + (size_t)ROWS * 16 * 4;
constexpr size_t WS_YMB = WS_XB + (size_t)ROWS * 1024 * 2;
constexpr size_t WS_YHG = WS_YMB + (size_t)ROWS * 1024 * 2;
constexpr size_t WS_YRG = WS_YHG + (size_t)ROWS * 1024 * 2;
constexpr size_t WS_MRG = WS_YRG + (size_t)ROWS * 1024 * 2;
constexpr size_t WS_END = WS_MRG + (size_t)ROWS * 1024 * 2;
constexpr size_t O_YP = 0, O_YS = 33554432, O_SSM_P = 34078720, O_SCV_P = 38273024, O_HG_P = 38469632, O_RG_P = 42663936, O_RCV_P = 42696704,
                 O_SSM_S = 42795008, O_SCV_S = 46989312, O_HG_S = 47185920, O_RG_S = 51380224, O_RCV_S = 51412992;
constexpr int LDS_BYTES = 72 * 1024;

enum { I_XP = 0, I_XS, I_SSM, I_SCV, I_HG, I_RG, I_RCV, I_NMIX, I_WIN, I_MCW, I_MCB, I_DTB, I_ALOG, I_MBD, I_MBNW, I_LBL, I_HGNW, I_RCW, I_RCB, I_RWA, I_RBA, I_RWI, I_RBI, I_RLAM, I_WBR, I_WOUT, I_NFFN, I_WFI, I_WFO, I_NFIN };

struct Params { const float* in[30]; float* out; unsigned char* ws; };

DEVI int tidx() { int t = __builtin_amdgcn_workitem_id_x(); asm volatile("" : "+v"(t)); return t; }
DEVI bf16_t f2bf(float f) { unsigned u = __float_as_uint(f); u += 0x7fffu + ((u >> 16) & 1u); return (bf16_t)(u >> 16); }
DEVI float bf2f(bf16_t h) { return __uint_as_float(((unsigned)h) << 16); }
DEVI float sigm(float x) { return 1.f / (1.f + __expf(-x)); }
DEVI float silu(float x) { return x / (1.f + __expf(-x)); }
DEVI float softplus(float x) { return x > 20.f ? x : log1pf(__expf(x)); }
DEVI float gelu_t(float x) { float u = 0.7978845608f * (x + 0.044715f * x * x * x); return x * sigm(2.f * u); }
DEVI float cexp(float x) { return __expf(fminf(x, 80.f)); }

DEVI const float* xrow_in(const Params& p, int seg, int r) {
    if (r < ROWS_P) { int b = r >> 9, tt = r & 511; return p.in[I_XP] + ((size_t)(b * 2048 + seg * SEGT + tt)) * D; }
    return p.in[I_XS] + (size_t)(r - ROWS_P) * D;
}
DEVI float* xrow_out(const Params& p, int seg, int r) {
    if (r < ROWS_P) { int b = r >> 9, tt = r & 511; return p.out + O_YP + ((size_t)(b * 2048 + seg * SEGT + tt)) * D; }
    return p.out + O_YS + (size_t)(r - ROWS_P) * D;
}

DEVI int map_win(int n) { return n < 3072 ? n : (n < 12288 ? n + 16 : (n < 12304 ? 3072 + (n - 12288) : -1)); }
DEVI int map_wfi(int n) { int T = n >> 7, q = (n >> 5) & 3, s = (n >> 4) & 1, i = n & 15; return s * FFH + 64 * T + 16 * q + i; }

DEVI void transpose_tile(const float* src, int ldsrc, bf16_t* dst, int K, int k0, int n0, int mode, float* tile  ) {
    const int tid = tidx(), c = tid & 63, rq = tid >> 6;
    int n = n0 + c, sn = mode == 1 ? map_win(n) : (mode == 2 ? map_wfi(n) : n);
#pragma unroll 4
    for (int rr = 0; rr < 16; ++rr) { int kl = rr * 4 + rq; tile[kl * 65 + c] = sn >= 0 ? src[(size_t)(k0 + kl) * ldsrc + sn] : 0.f; }
    __syncthreads();
#pragma unroll 4
    for (int rr = 0; rr < 16; ++rr) { int nl = rr * 4 + rq; dst[(size_t)(n0 + nl) * K + k0 + c] = f2bf(tile[c * 65 + nl]); }
    __syncthreads();
}

DEVI void phase_prep(const Params& p, char* lds) {
    float* tile = (float*)lds;
    bf16_t* wsb = (bf16_t*)p.ws;
    constexpr int T_WIN = 16 * 194, T_WBR = 3 * 256, T_WOUT = 256, T_WFI = 16 * 88, T_WFO = 44 * 16, T_L = T_WIN + T_WBR + T_WOUT + T_WFI + T_WFO;
    for (int t = blockIdx.x; t < 2 * T_L; t += gridDim.x) {
        int l = t / T_L, j = t % T_L;
        bf16_t* wl = wsb + (size_t)l * E_LAYER;
        if (j < T_WIN) { int kt = j & 15, nt = j >> 4; transpose_tile(p.in[I_WIN] + (size_t)l * 1024 * 12304, 12304, wl, 1024, kt * 64, nt * 64, 1, tile); continue; }
        j -= T_WIN;
        if (j < T_WBR) { int k = j >> 8, jj = j & 255, kt = jj & 15, nt = jj >> 4;
            transpose_tile(p.in[I_WBR] + ((size_t)l * 3 + k) * 1024 * 1024, 1024, wl + E_WIN + (size_t)k * 1024 * 1024, 1024, kt * 64, nt * 64, 0, tile); continue; }
        j -= T_WBR;
        if (j < T_WOUT) { int kt = j & 15, nt = j >> 4; transpose_tile(p.in[I_WOUT] + (size_t)l * 1024 * 1024, 1024, wl + E_WIN + E_WBR, 1024, kt * 64, nt * 64, 0, tile); continue; }
        j -= T_WOUT;
        if (j < T_WFI) { int kt = j & 15, nt = j >> 4; transpose_tile(p.in[I_WFI] + (size_t)l * 1024 * 5632, 5632, wl + E_WIN + E_WBR + E_WOUT, 1024, kt * 64, nt * 64, 2, tile); continue; }
        j -= T_WFI;
        { int kt = j % 44, nt = j / 44; transpose_tile(p.in[I_WFO] + (size_t)l * 2816 * 1024, 1024, wl + E_WIN + E_WBR + E_WOUT + E_WFI, 2816, kt * 64, nt * 64, 0, tile); }
    }
}

DEVI void phase_norm(const Params& p, int seg, int nrows, const float* w, bool from_input) {
    bf16_t* xb = (bf16_t*)(p.ws + WS_XB);
    const int lane = tidx() & 63, wv = tidx() >> 6;
    for (int r = blockIdx.x * 4 + wv; r < nrows; r += gridDim.x * 4) {
        const float* x = from_input ? xrow_in(p, seg, r) : xrow_out(p, seg, r);
        f32x4 v[4]; float ss = 0.f;
#pragma unroll
        for (int i = 0; i < 4; ++i) { v[i] = *(const f32x4*)(x + i * 256 + lane * 4); ss += v[i][0] * v[i][0] + v[i][1] * v[i][1] + v[i][2] * v[i][2] + v[i][3] * v[i][3]; }
#pragma unroll
        for (int o = 32; o >= 1; o >>= 1) ss += __shfl_xor(ss, o);
        float rs = rsqrtf(ss * (1.f / 1024.f) + 1e-6f);
#pragma unroll
        for (int i = 0; i < 4; ++i) { f32x4 wv4 = *(const f32x4*)(w + i * 256 + lane * 4); us4 o;
            o[0] = f2bf(v[i][0] * rs * wv4[0]); o[1] = f2bf(v[i][1] * rs * wv4[1]); o[2] = f2bf(v[i][2] * rs * wv4[2]); o[3] = f2bf(v[i][3] * rs * wv4[3]);
            *(us4*)(xb + (size_t)r * 1024 + i * 256 + lane * 4) = o; }
    }
}
DEVI void phase_final_norm(const Params& p, int seg, int nrows) {
    const float* w = p.in[I_NFIN];
    const int lane = tidx() & 63, wv = tidx() >> 6;
    for (int r = blockIdx.x * 4 + wv; r < nrows; r += gridDim.x * 4) {
        float* x = xrow_out(p, seg, r);
        f32x4 v[4]; float ss = 0.f;
#pragma unroll
        for (int i = 0; i < 4; ++i) { v[i] = *(const f32x4*)(x + i * 256 + lane * 4); ss += v[i][0] * v[i][0] + v[i][1] * v[i][1] + v[i][2] * v[i][2] + v[i][3] * v[i][3]; }
#pragma unroll
        for (int o = 32; o >= 1; o >>= 1) ss += __shfl_xor(ss, o);
        float rs = rsqrtf(ss * (1.f / 1024.f) + 1e-6f);
#pragma unroll
        for (int i = 0; i < 4; ++i) { f32x4 wv4 = *(const f32x4*)(w + i * 256 + lane * 4); f32x4 o;
            o[0] = v[i][0] * rs * wv4[0]; o[1] = v[i][1] * rs * wv4[1]; o[2] = v[i][2] * rs * wv4[2]; o[3] = v[i][3] * rs * wv4[3];
            *(f32x4*)(x + i * 256 + lane * 4) = o; }
    }
}
DEVI void phase_mbnorm(const Params& p, int l, int nrows) {
    bf16_t* y = (bf16_t*)(p.ws + WS_YMB); const float* w = p.in[I_MBNW] + l * 1024;
    const int lane = tidx() & 63, wv = tidx() >> 6;
    for (int it = blockIdx.x * 4 + wv; it < nrows * 4; it += gridDim.x * 4) {
        int r = it >> 2, g = it & 3; bf16_t* yp = y + (size_t)r * 1024 + g * 256 + lane * 4;
        us4 v = *(const us4*)yp; float f0 = bf2f(v[0]), f1 = bf2f(v[1]), f2 = bf2f(v[2]), f3 = bf2f(v[3]);
        float ss = f0 * f0 + f1 * f1 + f2 * f2 + f3 * f3;
#pragma unroll
        for (int o = 32; o >= 1; o >>= 1) ss += __shfl_xor(ss, o);
        float rs = rsqrtf(ss * (1.f / 256.f) + 1e-6f); f32x4 wv4 = *(const f32x4*)(w + g * 256 + lane * 4);
        us4 o; o[0] = f2bf(f0 * rs * wv4[0]); o[1] = f2bf(f1 * rs * wv4[1]); o[2] = f2bf(f2 * rs * wv4[2]); o[3] = f2bf(f3 * rs * wv4[3]);
        *(us4*)yp = o;
    }
}

DEVI void gemm_kloop(f32x4 (&acc)[4][4], const bf16_t* A, int lda, const bf16_t* Bt, int ldb, int K, char* lds) {
    char* SA = lds; char* SB = lds + 8192;
    const int tid = tidx(), lane = tid & 63, wid = tid >> 6, wr = wid >> 1, wc = wid & 1, fr = lane & 15, fq = lane >> 4;
    for (int kt = 0; kt < K / 32; ++kt) {
#pragma unroll
        for (int i = 0; i < 2; ++i) { int b = tid * 16 + i * 4096, r = b >> 6, c = (b & 63) >> 1;
            __builtin_amdgcn_global_load_lds((const unsigned*)(A + (size_t)r * lda + kt * 32 + c), (unsigned*)(SA + b), 16, 0, 0);
            __builtin_amdgcn_global_load_lds((const unsigned*)(Bt + (size_t)r * ldb + kt * 32 + c), (unsigned*)(SB + b), 16, 0, 0); }
        asm volatile("s_waitcnt vmcnt(0)" ::: "memory"); __syncthreads();
        bf16x8 af[4], bfr[4];
#pragma unroll
        for (int m = 0; m < 4; ++m) af[m] = *(const bf16x8*)(SA + (wr * 64 + m * 16 + fr) * 64 + fq * 16);
#pragma unroll
        for (int n = 0; n < 4; ++n) bfr[n] = *(const bf16x8*)(SB + (wc * 64 + n * 16 + fr) * 64 + fq * 16);
#pragma unroll
        for (int m = 0; m < 4; ++m)
#pragma unroll
            for (int n = 0; n < 4; ++n) acc[m][n] = __builtin_amdgcn_mfma_f32_16x16x32_bf16(bfr[n], af[m], acc[m][n], 0, 0, 0);
        __syncthreads();
    }
}
DEVI bool next_tile(int it, int MT, int NT, int& mt, int& nt) {
    int x = blockIdx.x & 7, bl = blockIdx.x >> 3, G8 = gridDim.x >> 3;
    int nI = (MT - x + 7) >> 3; long j = (long)it * G8 + bl;
    if (j >= (long)nI * NT) return false;
    int i = (int)(j % nI); nt = (int)(j / nI); mt = x + 8 * i; return true;
}
#define ZERO_ACC(a) _Pragma("unroll") for (int m_ = 0; m_ < 4; ++m_) _Pragma("unroll") for (int n_ = 0; n_ < 4; ++n_) a[m_][n_] = (f32x4){0.f, 0.f, 0.f, 0.f}

DEVI void phase_proj(const Params& p, int l, int MT, char* lds) {
    const bf16_t* xb = (const bf16_t*)(p.ws + WS_XB); const bf16_t* wt = (const bf16_t*)p.ws + (size_t)l * E_LAYER;
    bf16_t* proj = (bf16_t*)(p.ws + WS_PROJ); float* dtb = (float*)(p.ws + WS_DT);
    const int lane = tidx() & 63, wid = tidx() >> 6, wr = wid >> 1, wc = wid & 1, fr = lane & 15, fq = lane >> 4;
    int mt, nt;
    for (int it = 0; next_tile(it, MT, 97, mt, nt); ++it) {
        f32x4 acc[4][4]; ZERO_ACC(acc);
        gemm_kloop(acc, xb + (size_t)mt * 128 * 1024, 1024, wt + (size_t)nt * 128 * 1024, 1024, 1024, lds);
        int ty = nt < 8 ? 1 : nt < 24 ? 0 : nt < 32 ? 1 : nt < 48 ? 0 : nt < 56 ? 1 : nt < 64 ? 2 : nt < 72 ? 0 : nt < 96 ? 3 : 4;
        if (ty == 4) {
            if (wc == 0 && fq < 4) {
#pragma unroll
                for (int m = 0; m < 4; ++m) { int row = mt * 128 + wr * 64 + m * 16 + fr; f32x4 v = acc[m][0]; f32x4 b = *(const f32x4*)(p.in[I_DTB] + l * 16 + fq * 4);
                    f32x4 o; o[0] = softplus(v[0] + b[0]); o[1] = softplus(v[1] + b[1]); o[2] = softplus(v[2] + b[2]); o[3] = softplus(v[3] + b[3]);
                    *(f32x4*)(dtb + (size_t)row * 16 + fq * 4) = o; }
            }
        } else {
#pragma unroll
            for (int m = 0; m < 4; ++m) { int row = mt * 128 + wr * 64 + m * 16 + fr;
#pragma unroll
                for (int n = 0; n < 4; ++n) { int col = nt * 128 + wc * 64 + n * 16 + fq * 4; f32x4 v = acc[m][n]; us4 o;
#pragma unroll
                    for (int j = 0; j < 4; ++j) { float x = v[j]; x = ty == 1 ? silu(x) : ty == 2 ? gelu_t(x) : ty == 3 ? sigm(x) : x; o[j] = f2bf(x); }
                    *(us4*)(proj + (size_t)row * NPROJ + col) = o; } }
        }
    }
}
DEVI void phase_merge(const Params& p, int l, int MT, char* lds) {
    const bf16_t* wt = (const bf16_t*)p.ws + (size_t)l * E_LAYER + E_WIN; const bf16_t* proj = (const bf16_t*)(p.ws + WS_PROJ);
    bf16_t* mrg = (bf16_t*)(p.ws + WS_MRG);
    const int lane = tidx() & 63, wid = tidx() >> 6, wr = wid >> 1, wc = wid & 1, fr = lane & 15, fq = lane >> 4;
    int mt, nt;
    for (int it = 0; next_tile(it, MT, 8, mt, nt); ++it) {
        f32x4 tot[4][4]; ZERO_ACC(tot);
#pragma unroll 1
        for (int k = 0; k < 3; ++k) {
            const bf16_t* y = (const bf16_t*)(p.ws + WS_YMB + (size_t)k * ROWS * 1024 * 2);
            f32x4 acc[4][4]; ZERO_ACC(acc);
            gemm_kloop(acc, y + (size_t)mt * 128 * 1024, 1024, wt + (size_t)k * 1024 * 1024 + (size_t)nt * 128 * 1024, 1024, 1024, lds);
#pragma unroll
            for (int m = 0; m < 4; ++m) { int row = mt * 128 + wr * 64 + m * 16 + fr; asm volatile("" ::: "memory");
#pragma unroll
                for (int n = 0; n < 4; ++n) { int col = nt * 128 + wc * 64 + n * 16 + fq * 4; us4 g = *(const us4*)(proj + (size_t)row * NPROJ + PC_MG + k * 1024 + col);
#pragma unroll
                    for (int j = 0; j < 4; ++j) tot[m][n][j] += acc[m][n][j] * bf2f(g[j]); } }
        }
#pragma unroll
        for (int m = 0; m < 4; ++m) { int row = mt * 128 + wr * 64 + m * 16 + fr;
#pragma unroll
            for (int n = 0; n < 4; ++n) { int col = nt * 128 + wc * 64 + n * 16 + fq * 4; us4 o;
#pragma unroll
                for (int j = 0; j < 4; ++j) o[j] = f2bf(tot[m][n][j]);
                *(us4*)(mrg + (size_t)row * 1024 + col) = o; } }
    }
}
DEVI void phase_resid(const Params& p, int seg, int MT, const bf16_t* A, int K, const bf16_t* Bt, bool from_input, char* lds) {
    const int lane = tidx() & 63, wid = tidx() >> 6, wr = wid >> 1, wc = wid & 1, fr = lane & 15, fq = lane >> 4;
    int mt, nt;
    for (int it = 0; next_tile(it, MT, 8, mt, nt); ++it) {
        f32x4 acc[4][4]; ZERO_ACC(acc);
        gemm_kloop(acc, A + (size_t)mt * 128 * K, K, Bt + (size_t)nt * 128 * K, K, K, lds);
#pragma unroll
        for (int m = 0; m < 4; ++m) { int row = mt * 128 + wr * 64 + m * 16 + fr;
            const float* xi = from_input ? xrow_in(p, seg, row) : xrow_out(p, seg, row); float* xo = xrow_out(p, seg, row);
#pragma unroll
            for (int n = 0; n < 4; ++n) { int col = nt * 128 + wc * 64 + n * 16 + fq * 4; f32x4 v = *(const f32x4*)(xi + col); *(f32x4*)(xo + col) = v + acc[m][n]; } }
    }
}
DEVI void phase_ffn_in(const Params& p, int l, int MT, char* lds) {
    const bf16_t* xb = (const bf16_t*)(p.ws + WS_XB); const bf16_t* wt = (const bf16_t*)p.ws + (size_t)l * E_LAYER + E_WIN + E_WBR + E_WOUT;
    bf16_t* act = (bf16_t*)(p.ws + WS_PROJ);
    const int lane = tidx() & 63, wid = tidx() >> 6, wr = wid >> 1, wc = wid & 1, fr = lane & 15, fq = lane >> 4;
    int mt, nt;
    for (int it = 0; next_tile(it, MT, 44, mt, nt); ++it) {
        f32x4 acc[4][4]; ZERO_ACC(acc);
        gemm_kloop(acc, xb + (size_t)mt * 128 * 1024, 1024, wt + (size_t)nt * 128 * 1024, 1024, 1024, lds);
#pragma unroll
        for (int m = 0; m < 4; ++m) { int row = mt * 128 + wr * 64 + m * 16 + fr;
#pragma unroll
            for (int q = 0; q < 2; ++q) { int col = nt * 64 + 16 * (2 * wc + q) + fq * 4; us4 o;
#pragma unroll
                for (int j = 0; j < 4; ++j) o[j] = f2bf(silu(acc[m][2 * q][j]) * acc[m][2 * q + 1][j]);
                *(us4*)(act + (size_t)row * FFH + col) = o; } }
    }
}

struct Seq { int row0, nchunk, Q, b, samp, seg; };
DEVI Seq make_seq(int seg, int sq) { Seq s; s.seg = seg; if (sq < 16) { s.row0 = sq * SEGT; s.nchunk = 8; s.Q = 64; s.b = sq; s.samp = 0; } else { s.b = sq - 16; s.row0 = ROWS_P + s.b * 32; s.nchunk = 1; s.Q = 32; s.samp = 1; } return s; }

template <int NF, int KS>
DEVI void lds_mma(f32x4* acc, const bf16_t* X, int ldx, int m0, const bf16_t* Y, int ldy, int n0) {
    const int lane = tidx() & 63, fr = lane & 15, fq = lane >> 4;
#pragma unroll
    for (int ks = 0; ks < KS; ++ks) {
        bf16x8 a = *(const bf16x8*)(X + (m0 + fr) * ldx + ks * 32 + fq * 8);
#pragma unroll
        for (int nf = 0; nf < NF; ++nf) { bf16x8 b = *(const bf16x8*)(Y + (n0 + nf * 16 + fr) * ldy + ks * 32 + fq * 8); acc[nf] = __builtin_amdgcn_mfma_f32_16x16x32_bf16(a, b, acc[nf], 0, 0, 0); }
    }
}

DEVI void conv8(const bf16_t* proj, int row0, int tq, int pcol, const float* hist, int histC, int hch, const float* cw, const float* cb, int C, int ch, float (&out)[8], float (&raw)[8]) {
    f32x4 b0 = *(const f32x4*)(cb + ch), b1 = *(const f32x4*)(cb + ch + 4);
    out[0] = b0[0]; out[1] = b0[1]; out[2] = b0[2]; out[3] = b0[3]; out[4] = b1[0]; out[5] = b1[1]; out[6] = b1[2]; out[7] = b1[3];
#pragma unroll
    for (int k = 0; k < 4; ++k) {
        int ts = tq - 3 + k; float v[8];
        if (ts >= 0) { us8 u = *(const us8*)(proj + (size_t)(row0 + ts) * NPROJ + pcol);
#pragma unroll
            for (int e = 0; e < 8; ++e) v[e] = bf2f(u[e]); }
        else if (hist) { f32x4 h0 = *(const f32x4*)(hist + (3 + ts) * histC + hch), h1 = *(const f32x4*)(hist + (3 + ts) * histC + hch + 4);
            v[0] = h0[0]; v[1] = h0[1]; v[2] = h0[2]; v[3] = h0[3]; v[4] = h1[0]; v[5] = h1[1]; v[6] = h1[2]; v[7] = h1[3]; }
        else {
#pragma unroll
            for (int e = 0; e < 8; ++e) v[e] = 0.f; }
        f32x4 w0 = *(const f32x4*)(cw + k * C + ch), w1 = *(const f32x4*)(cw + k * C + ch + 4);
        out[0] += v[0] * w0[0]; out[1] += v[1] * w0[1]; out[2] += v[2] * w0[2]; out[3] += v[3] * w0[3];
        out[4] += v[4] * w1[0]; out[5] += v[5] * w1[1]; out[6] += v[6] * w1[2]; out[7] += v[7] * w1[3];
        if (k == 3) {
#pragma unroll
            for (int e = 0; e < 8; ++e) raw[e] = v[e]; }
    }
}

DEVI void ssd_unit(const Params& p, int l, Seq sq, int hd, char* lds) {
    bf16_t* Bm = (bf16_t*)lds;
    bf16_t* R2 = (bf16_t*)(lds + 17408);
    bf16_t* xT = (bf16_t*)(lds + 35840);
    bf16_t* hb = (bf16_t*)(lds + 45056);
    float* fl = (float*)(lds + 62464);
    const int tid = tidx(), lane = tid & 63, w = tid >> 6, fr = lane & 15, fq = lane >> 4;
    const bf16_t* proj = (const bf16_t*)(p.ws + WS_PROJ); const float* dtb = (const float*)(p.ws + WS_DT); bf16_t* ymb = (bf16_t*)(p.ws + WS_YMB);
    const int g = hd >> 2;
    const float a = -__expf(p.in[I_ALOG][l * 16 + hd]), Dv = p.in[I_MBD][l * 16 + hd];
    const float* cw = p.in[I_MCW] + (size_t)l * 4 * 2048; const float* cbias = p.in[I_MCB] + l * 2048;
    const float* st_in; float* st_out; const float* hist; float* hist_out;
    if (sq.samp) { st_in = p.in[I_SSM] + ((size_t)(l * 16 + sq.b) * 16 + hd) * 8192; st_out = p.out + O_SSM_S + ((size_t)(l * 16 + sq.b) * 16 + hd) * 8192;
        hist = p.in[I_SCV] + (size_t)(l * 16 + sq.b) * 3 * 2048; hist_out = p.out + O_SCV_S + (size_t)(l * 16 + sq.b) * 3 * 2048; }
    else { st_out = p.out + O_SSM_P + ((size_t)(l * 16 + sq.b) * 16 + hd) * 8192; st_in = sq.seg ? st_out : nullptr;
        hist_out = p.out + O_SCV_P + (size_t)(l * 16 + sq.b) * 3 * 2048; hist = sq.seg ? hist_out : nullptr; }
    f32x4 hacc[8];
#pragma unroll
    for (int nf = 0; nf < 8; ++nf)
#pragma unroll
        for (int r = 0; r < 4; ++r) { int pp = 16 * w + 4 * fq + r, n = 16 * nf + fr; float v = st_in ? st_in[pp * 128 + n] : 0.f; hacc[nf][r] = v; hb[pp * 136 + n] = f2bf(v); }
    for (int c = 0; c < sq.nchunk; ++c) {
        const int rowc = sq.row0 + c * 64; const bool lastc = (c == sq.nchunk - 1);
        if (w == 0) {
            float dt = lane < sq.Q ? dtb[(size_t)(rowc + lane) * 16 + hd] : 0.f; float v = dt * a;
#pragma unroll
            for (int o = 1; o < 64; o <<= 1) { float t = __shfl_up(v, o); if (lane >= o) v += t; }
            float last = __shfl(v, 63);
            fl[lane] = v; fl[64 + lane] = dt; fl[128 + lane] = __expf(last - v) * dt; fl[192 + lane] = __expf(v);
        }
        __syncthreads();
        const float elast = __expf(fl[63]);
#pragma unroll 1
        for (int i = 0; i < 2; ++i) { int it = tid + 256 * i, t = it >> 3, c8 = (it & 7) * 8; float o[8], raw[8];
            int ch = hd * 64 + c8;
            if (t < sq.Q) { conv8(proj, sq.row0, c * 64 + t, PC_XBC + ch, hist, 2048, ch, cw, cbias, 2048, ch, o, raw);
#pragma unroll
                for (int e = 0; e < 8; ++e) o[e] = silu(o[e]);
                if (lastc && t >= sq.Q - 3) {
#pragma unroll
                    for (int e = 0; e < 8; ++e) hist_out[(t - (sq.Q - 3)) * 2048 + ch + e] = raw[e]; } }
            else {
#pragma unroll
                for (int e = 0; e < 8; ++e) o[e] = 0.f; }
#pragma unroll
            for (int e = 0; e < 8; ++e) xT[(c8 + e) * 72 + t] = f2bf(o[e]); }
#pragma unroll 1
        for (int i = 0; i < 4; ++i) { int it = tid + 256 * i, t = it >> 4, c8 = (it & 15) * 8; float o[8], raw[8];
            int ch = 1024 + g * 128 + c8;
            if (t < sq.Q) { conv8(proj, sq.row0, c * 64 + t, PC_XBC + ch, hist, 2048, ch, cw, cbias, 2048, ch, o, raw);
#pragma unroll
                for (int e = 0; e < 8; ++e) o[e] = silu(o[e]);
                if (lastc && (hd & 3) == 0 && t >= sq.Q - 3) {
#pragma unroll
                    for (int e = 0; e < 8; ++e) hist_out[(t - (sq.Q - 3)) * 2048 + ch + e] = raw[e]; } }
            else {
#pragma unroll
                for (int e = 0; e < 8; ++e) o[e] = 0.f; }
            us8 ov; float we = fl[128 + t];
#pragma unroll
            for (int e = 0; e < 8; ++e) { ov[e] = f2bf(o[e]); R2[(c8 + e) * 72 + t] = f2bf(o[e] * we); }
            *(us8*)(Bm + t * 136 + c8) = ov; }
        __syncthreads();
#pragma unroll
        for (int nf = 0; nf < 8; ++nf) hacc[nf] *= elast;
        lds_mma<8, 2>(hacc, xT, 72, 16 * w, R2, 72, 0);
        __syncthreads();
#pragma unroll 1
        for (int i = 0; i < 4; ++i) { int it = tid + 256 * i, t = it >> 4, c8 = (it & 15) * 8; float o[8], raw[8];
            int ch = 1536 + g * 128 + c8;
            if (t < sq.Q) { conv8(proj, sq.row0, c * 64 + t, PC_XBC + ch, hist, 2048, ch, cw, cbias, 2048, ch, o, raw);
#pragma unroll
                for (int e = 0; e < 8; ++e) o[e] = silu(o[e]);
                if (lastc && (hd & 3) == 0 && t >= sq.Q - 3) {
#pragma unroll
                    for (int e = 0; e < 8; ++e) hist_out[(t - (sq.Q - 3)) * 2048 + ch + e] = raw[e]; } }
            else {
#pragma unroll
                for (int e = 0; e < 8; ++e) o[e] = 0.f; }
            us8 ov;
#pragma unroll
            for (int e = 0; e < 8; ++e) ov[e] = f2bf(o[e]);
            *(us8*)(R2 + t * 136 + c8) = ov; }
        __syncthreads();
        f32x4 cbv[4];
#pragma unroll
        for (int nf = 0; nf < 4; ++nf) cbv[nf] = (f32x4){0.f, 0.f, 0.f, 0.f};
        lds_mma<4, 4>(cbv, Bm, 136, 16 * w, R2, 136, 0);
        __syncthreads();
#pragma unroll
        for (int nf = 0; nf < 4; ++nf) { int i = 16 * nf + fr; float ai = fl[i]; us4 o;
#pragma unroll
            for (int r = 0; r < 4; ++r) { int j = 16 * w + 4 * fq + r; float v = (j <= i) ? cbv[nf][r] * __expf(ai - fl[j]) * fl[64 + j] : 0.f; o[r] = f2bf(v); }
            *(us4*)(Bm + i * 72 + 16 * w + 4 * fq) = o; }
        __syncthreads();
        f32x4 ya[4];
#pragma unroll
        for (int nf = 0; nf < 4; ++nf) ya[nf] = (f32x4){0.f, 0.f, 0.f, 0.f};
        lds_mma<4, 4>(ya, hb, 136, 16 * w, R2, 136, 0);
#pragma unroll
        for (int nf = 0; nf < 4; ++nf) ya[nf] *= fl[192 + 16 * nf + fr];
        lds_mma<4, 2>(ya, xT, 72, 16 * w, Bm, 72, 0);
#pragma unroll
        for (int nf = 0; nf < 4; ++nf) { int i = 16 * nf + fr, p0 = 16 * w + 4 * fq;
            if (i < sq.Q) { us4 z = *(const us4*)(proj + (size_t)(rowc + i) * NPROJ + PC_Z + hd * 64 + p0); us4 o;
#pragma unroll
                for (int r = 0; r < 4; ++r) o[r] = f2bf((ya[nf][r] + Dv * bf2f(xT[(p0 + r) * 72 + i])) * bf2f(z[r]));
                *(us4*)(ymb + (size_t)(rowc + i) * 1024 + hd * 64 + p0) = o; } }
        __syncthreads();
#pragma unroll
        for (int nf = 0; nf < 8; ++nf)
#pragma unroll
            for (int r = 0; r < 4; ++r) hb[(16 * w + 4 * fq + r) * 136 + 16 * nf + fr] = f2bf(hacc[nf][r]);
    }
#pragma unroll
    for (int nf = 0; nf < 8; ++nf)
#pragma unroll
        for (int r = 0; r < 4; ++r) st_out[(16 * w + 4 * fq + r) * 128 + 16 * nf + fr] = hacc[nf][r];
    __syncthreads();
}

DEVI void hgrn_unit(const Params& p, int l, Seq sq, int h, char* lds) {
    bf16_t* sb = (bf16_t*)lds;
    bf16_t* qt = (bf16_t*)(lds + 34816);
    bf16_t* kt = (bf16_t*)(lds + 52224);
    bf16_t* att = (bf16_t*)lds;
    bf16_t* kT = (bf16_t*)(lds + 9216);
    bf16_t* vT = (bf16_t*)(lds + 27648);
    float* T0 = (float*)(lds + 69632); float* T1 = T0 + 128; float* ssq = T0 + 256;
    const int tid = tidx(), lane = tid & 63, w = tid >> 6, fr = lane & 15, fq = lane >> 4;
    const int k = tid & 127, half = tid >> 7;
    const bf16_t* proj = (const bf16_t*)(p.ws + WS_PROJ); bf16_t* yhg = (bf16_t*)(p.ws + WS_YHG);
    float lb = 0.f;
    if (l == 1) { float a0 = p.in[I_LBL][h * 128 + k], a1 = p.in[I_LBL][1024 + h * 128 + k]; lb = 1.f / (1.f + __expf(a0 - a1)); }
    const float* nw = p.in[I_HGNW] + l * 128;
    const float* st_in; float* st_out;
    if (sq.samp) { st_in = p.in[I_HG] + ((size_t)(l * 16 + sq.b) * 8 + h) * 16384; st_out = p.out + O_HG_S + ((size_t)(l * 16 + sq.b) * 8 + h) * 16384; }
    else { st_out = p.out + O_HG_P + ((size_t)(l * 16 + sq.b) * 8 + h) * 16384; st_in = sq.seg ? st_out : nullptr; }
    f32x4 hacc[2][8];
#pragma unroll
    for (int mf = 0; mf < 2; ++mf)
#pragma unroll
        for (int nf = 0; nf < 8; ++nf)
#pragma unroll
            for (int r = 0; r < 4; ++r) hacc[mf][nf][r] = st_in ? st_in[(32 * w + 16 * mf + 4 * fq + r) * 128 + 16 * nf + fr] : 0.f;
    for (int c = 0; c < sq.nchunk; ++c) {
        const int rowc = sq.row0 + c * 64;
        {
            const bf16_t* pr = proj + (size_t)(rowc + 32 * half) * NPROJ + h * 128 + k;
            float run = 0.f;
#pragma unroll 8
            for (int jj = 0; jj < 32; ++jj) { bool valid = (32 * half + jj) < sq.Q; float f = valid ? bf2f(pr[(size_t)jj * NPROJ + PC_HF]) : 0.f;
                float lg = valid ? __logf(lb + (1.f - lb) * sigm(f)) : 0.f; run += lg; }
            const float T = run;
            if (half == 0) T0[k] = T; else T1[k] = T;
            if (tid < 64) ssq[tid] = 0.f;
            run = 0.f;
#pragma unroll 8
            for (int jj = 0; jj < 32; ++jj) { bool valid = (32 * half + jj) < sq.Q; int j = 32 * half + jj;
                float f = valid ? bf2f(pr[(size_t)jj * NPROJ + PC_HF]) : 0.f; float q = valid ? bf2f(pr[(size_t)jj * NPROJ + PC_HQ]) : 0.f;
                float sg = sigm(f); float lg = valid ? __logf(lb + (1.f - lb) * sg) : 0.f; run += lg;
                float kk = valid ? (1.f - lb) * (1.f - sg) : 0.f;
                float eq = half == 0 ? cexp(run - T) : cexp(run); float ek = half == 0 ? cexp(T - run) : cexp(-run);
                qt[j * 136 + k] = f2bf(q * eq); kt[j * 136 + k] = f2bf(kk * ek); }
        }
        __syncthreads();
#pragma unroll
        for (int mf = 0; mf < 2; ++mf) { int k0 = 32 * w + 16 * mf + 4 * fq; float e0 = __expf(T0[k0]), e1 = __expf(T0[k0 + 1]), e2 = __expf(T0[k0 + 2]), e3 = __expf(T0[k0 + 3]);
#pragma unroll
            for (int nf = 0; nf < 8; ++nf) { hacc[mf][nf][0] *= e0; hacc[mf][nf][1] *= e1; hacc[mf][nf][2] *= e2; hacc[mf][nf][3] *= e3;
                us4 o; o[0] = f2bf(hacc[mf][nf][0]); o[1] = f2bf(hacc[mf][nf][1]); o[2] = f2bf(hacc[mf][nf][2]); o[3] = f2bf(hacc[mf][nf][3]);
                *(us4*)(sb + (16 * nf + fr) * 136 + k0) = o; } }
        f32x4 at[4];
#pragma unroll
        for (int nf = 0; nf < 4; ++nf) at[nf] = (f32x4){0.f, 0.f, 0.f, 0.f};
        lds_mma<4, 4>(at, kt, 136, 16 * w, qt, 136, 0);
        __syncthreads();
        f32x4 oacc[2][4];
#pragma unroll
        for (int mf = 0; mf < 2; ++mf) {
#pragma unroll
            for (int nf = 0; nf < 4; ++nf) oacc[mf][nf] = (f32x4){0.f, 0.f, 0.f, 0.f};
            lds_mma<4, 4>(oacc[mf], sb, 136, 32 * w + 16 * mf, qt, 136, 0); }
        __syncthreads();
#pragma unroll
        for (int nf = 0; nf < 4; ++nf) { int i = 16 * nf + fr; us4 o;
#pragma unroll
            for (int r = 0; r < 4; ++r) { int j = 16 * w + 4 * fq + r; o[r] = f2bf(j <= i ? at[nf][r] : 0.f); }
            *(us4*)(att + i * 72 + 16 * w + 4 * fq) = o; }
        {   const bf16_t* pv = proj + (size_t)(rowc + 32 * half) * NPROJ + PC_HI + h * 128 + k;
#pragma unroll 1
            for (int q4 = 0; q4 < 4; ++q4) { us8 kv, vv;
#pragma unroll
                for (int e = 0; e < 8; ++e) { int jj = q4 * 8 + e; bool valid = (32 * half + jj) < sq.Q; kv[e] = kt[(32 * half + jj) * 136 + k]; vv[e] = valid ? pv[(size_t)jj * NPROJ] : (bf16_t)0; }
                *(us8*)(kT + k * 72 + 32 * half + q4 * 8) = kv; *(us8*)(vT + k * 72 + 32 * half + q4 * 8) = vv; } }
        __syncthreads();
#pragma unroll
        for (int mf = 0; mf < 2; ++mf) {
            lds_mma<4, 2>(oacc[mf], vT, 72, 32 * w + 16 * mf, att, 72, 0);
            lds_mma<8, 2>(hacc[mf], kT, 72, 32 * w + 16 * mf, vT, 72, 0);
            int k0 = 32 * w + 16 * mf + 4 * fq; float e0 = __expf(T1[k0]), e1 = __expf(T1[k0 + 1]), e2 = __expf(T1[k0 + 2]), e3 = __expf(T1[k0 + 3]);
#pragma unroll
            for (int nf = 0; nf < 8; ++nf) { hacc[mf][nf][0] *= e0; hacc[mf][nf][1] *= e1; hacc[mf][nf][2] *= e2; hacc[mf][nf][3] *= e3; } }
#pragma unroll
        for (int nf = 0; nf < 4; ++nf) { float s = 0.f;
#pragma unroll
            for (int mf = 0; mf < 2; ++mf)
#pragma unroll
                for (int r = 0; r < 4; ++r) s += oacc[mf][nf][r] * oacc[mf][nf][r];
            s += __shfl_xor(s, 16); s += __shfl_xor(s, 32);
            if (fq == 0) atomicAdd(&ssq[16 * nf + fr], s); }
        __syncthreads();
#pragma unroll
        for (int nf = 0; nf < 4; ++nf) { int i = 16 * nf + fr;
            if (i < sq.Q) { float rs = rsqrtf(ssq[i] * (1.f / 128.f) + 1e-6f);
#pragma unroll
                for (int mf = 0; mf < 2; ++mf) { int v0 = 32 * w + 16 * mf + 4 * fq; us4 gt = *(const us4*)(proj + (size_t)(rowc + i) * NPROJ + PC_HGATE + h * 128 + v0); f32x4 wv = *(const f32x4*)(nw + v0); us4 o;
#pragma unroll
                    for (int r = 0; r < 4; ++r) o[r] = f2bf(oacc[mf][nf][r] * rs * wv[r] * bf2f(gt[r]));
                    *(us4*)(yhg + (size_t)(rowc + i) * 1024 + h * 128 + v0) = o; } } }
        __syncthreads();
    }
#pragma unroll
    for (int mf = 0; mf < 2; ++mf)
#pragma unroll
        for (int nf = 0; nf < 8; ++nf)
#pragma unroll
            for (int r = 0; r < 4; ++r) st_out[(32 * w + 16 * mf + 4 * fq + r) * 128 + 16 * nf + fr] = hacc[mf][nf][r];
}

DEVI void rg_unit(const Params& p, int l, Seq sq, int blk, char* lds) {
    bf16_t* waT = (bf16_t*)lds; bf16_t* wiT = (bf16_t*)(lds + 9216); bf16_t* xr = (bf16_t*)(lds + 18432);
    float* av = (float*)(lds + 27648); float* uv = (float*)(lds + 44288); float* Pq = (float*)(lds + 60928); float* Hq = Pq + 256; float* carry = Hq + 256;
    const int tid = tidx(), lane = tid & 63, w = tid >> 6, fr = lane & 15, fq = lane >> 4;
    const bf16_t* proj = (const bf16_t*)(p.ws + WS_PROJ); bf16_t* yrg = (bf16_t*)(p.ws + WS_YRG);
    const int cb0 = blk * 64;
    const float* cw = p.in[I_RCW] + (size_t)l * 4 * 1024; const float* cbias = p.in[I_RCB] + l * 1024;
    const float* st_in; float* st_out; const float* hist; float* hist_out;
    if (sq.samp) { st_in = p.in[I_RG] + (size_t)(l * 16 + sq.b) * 1024; st_out = p.out + O_RG_S + (size_t)(l * 16 + sq.b) * 1024;
        hist = p.in[I_RCV] + (size_t)(l * 16 + sq.b) * 3 * 1024; hist_out = p.out + O_RCV_S + (size_t)(l * 16 + sq.b) * 3 * 1024; }
    else { st_out = p.out + O_RG_P + (size_t)(l * 16 + sq.b) * 1024; st_in = sq.seg ? st_out : nullptr;
        hist_out = p.out + O_RCV_P + (size_t)(l * 16 + sq.b) * 3 * 1024; hist = sq.seg ? hist_out : nullptr; }
    {   const float* wa = p.in[I_RWA] + ((size_t)l * 16 + blk) * 4096; const float* wi = p.in[I_RWI] + ((size_t)l * 16 + blk) * 4096;
        for (int e = tid; e < 4096; e += 256) { int i = e >> 6, j = e & 63; waT[j * 72 + i] = f2bf(wa[e]); wiT[j * 72 + i] = f2bf(wi[e]); }
        if (tid < 64) carry[tid] = st_in ? st_in[cb0 + tid] : 0.f; }
    const int j = tid & 63, q = tid >> 6;
    for (int c = 0; c < sq.nchunk; ++c) {
        const int rowc = sq.row0 + c * 64; const bool lastc = (c == sq.nchunk - 1);
#pragma unroll 1
        for (int i = 0; i < 2; ++i) { int it = tid + 256 * i, t = it >> 3, c8 = (it & 7) * 8; float o[8], raw[8]; int ch = cb0 + c8;
            if (t < sq.Q) { conv8(proj, sq.row0, c * 64 + t, PC_RX + ch, hist, 1024, ch, cw, cbias, 1024, ch, o, raw);
                if (lastc && t >= sq.Q - 3) {
#pragma unroll
                    for (int e = 0; e < 8; ++e) hist_out[(t - (sq.Q - 3)) * 1024 + ch + e] = raw[e]; } }
            else {
#pragma unroll
                for (int e = 0; e < 8; ++e) o[e] = 0.f; }
            us8 ov;
#pragma unroll
            for (int e = 0; e < 8; ++e) { ov[e] = f2bf(o[e]); uv[t * 65 + c8 + e] = o[e]; }
            *(us8*)(xr + t * 72 + c8) = ov; }
        __syncthreads();
        f32x4 ra[4], ri[4];
#pragma unroll
        for (int nf = 0; nf < 4; ++nf) { ra[nf] = (f32x4){0.f, 0.f, 0.f, 0.f}; ri[nf] = (f32x4){0.f, 0.f, 0.f, 0.f}; }
        lds_mma<4, 2>(ra, xr, 72, 16 * w, waT, 72, 0);
        lds_mma<4, 2>(ri, xr, 72, 16 * w, wiT, 72, 0);
#pragma unroll
        for (int nf = 0; nf < 4; ++nf) { int jj = 16 * nf + fr, cc = cb0 + jj; float ba = p.in[I_RBA][l * 1024 + cc], bi = p.in[I_RBI][l * 1024 + cc], sp = softplus(-p.in[I_RLAM][l * 1024 + cc]);
#pragma unroll
            for (int r = 0; r < 4; ++r) { int t = 16 * w + 4 * fq + r; float rr = sigm(ra[nf][r] + ba), ii = sigm(ri[nf][r] + bi); float la = -8.f * sp * rr; float aa = __expf(la);
                float u = sqrtf(-expm1f(2.f * la)) * ii * uv[t * 65 + jj];
                if (t >= sq.Q) { aa = 1.f; u = 0.f; }
                av[t * 65 + jj] = aa; uv[t * 65 + jj] = u; } }
        __syncthreads();
        { float P = 1.f, H = 0.f;
#pragma unroll
          for (int tt = 0; tt < 16; ++tt) { int t = 16 * q + tt; float aa = av[t * 65 + j], u = uv[t * 65 + j]; H = aa * H + u; P *= aa; }
          Pq[q * 64 + j] = P; Hq[q * 64 + j] = H; }
        __syncthreads();
        float hcur = carry[j];
        for (int qq = 0; qq < q; ++qq) hcur = Pq[qq * 64 + j] * hcur + Hq[qq * 64 + j];
#pragma unroll
        for (int tt = 0; tt < 16; ++tt) { int t = 16 * q + tt; float aa = av[t * 65 + j], u = uv[t * 65 + j]; hcur = aa * hcur + u;
            if (t < sq.Q) { float gt = bf2f(proj[(size_t)(rowc + t) * NPROJ + PC_RGATE + cb0 + j]); yrg[(size_t)(rowc + t) * 1024 + cb0 + j] = f2bf(gt * hcur); } }
        __syncthreads();
        if (q == 3) carry[j] = hcur;
        __syncthreads();
    }
    if (tid < 64) st_out[cb0 + tid] = carry[tid];
    __syncthreads();
}

DEVI void phase_mix(const Params& p, int l, int seg, char* lds) {
    const int ngrp = seg == 0 ? 2 : 1; const int NU = ngrp * 640;
    for (int u = blockIdx.x; u < NU; u += gridDim.x) {
        int grp = u / 640, v = u % 640;
        if (v < 128) hgrn_unit(p, l, make_seq(seg, grp * 16 + (v >> 3)), v & 7, lds);
        else if (v < 384) { v -= 128; ssd_unit(p, l, make_seq(seg, grp * 16 + (v >> 4)), v & 15, lds); }
        else { v -= 384; rg_unit(p, l, make_seq(seg, grp * 16 + (v >> 4)), v & 15, lds); }
        __syncthreads();
    }
}

__global__ void __launch_bounds__(256) fwd_mega(Params p) {
    extern __shared__ __attribute__((aligned(16))) char lds[];
    cg::grid_group grid = cg::this_grid();
    phase_prep(p, lds);
    grid.sync();
#pragma unroll 1
    for (int seg = 0; seg < NSEG; ++seg) {
        const int nrows = seg == 0 ? ROWS : ROWS_P, MT = nrows / 128;
#pragma unroll 1
        for (int l = 0; l < 2; ++l) {
            const bf16_t* wl = (const bf16_t*)p.ws + (size_t)l * E_LAYER;
            phase_norm(p, seg, nrows, p.in[I_NMIX] + l * 1024, l == 0);
            grid.sync();
            phase_proj(p, l, MT, lds);
            grid.sync();
            phase_mix(p, l, seg, lds);
            grid.sync();
            phase_mbnorm(p, l, nrows);
            grid.sync();
            phase_merge(p, l, MT, lds);
            grid.sync();
            phase_resid(p, seg, MT, (const bf16_t*)(p.ws + WS_MRG), 1024, wl + E_WIN + E_WBR, l == 0, lds);
            grid.sync();
            phase_norm(p, seg, nrows, p.in[I_NFFN] + l * 1024, false);
            grid.sync();
            phase_ffn_in(p, l, MT, lds);
            grid.sync();
            phase_resid(p, seg, MT, (const bf16_t*)(p.ws + WS_PROJ), FFH, wl + E_WIN + E_WBR + E_WOUT + E_WFI, false, lds);
            grid.sync();
        }
        phase_final_norm(p, seg, nrows);
    }
}

extern "C" void kernel_launch(void* const* d_in, const int* in_sizes, int n_in, void* d_out, int out_size, void* d_ws, size_t ws_size, hipStream_t stream) {
    static int grid_blocks = 0;
    if (!grid_blocks) {
        int dev = 0, cus = 0, per_cu = 0;
        hipGetDevice(&dev);
        hipDeviceGetAttribute(&cus, hipDeviceAttributeMultiprocessorCount, dev);
        hipFuncSetAttribute((const void*)fwd_mega, hipFuncAttributeMaxDynamicSharedMemorySize, LDS_BYTES);
        hipOccupancyMaxActiveBlocksPerMultiprocessor(&per_cu, (const void*)fwd_mega, 256, LDS_BYTES);
        if (per_cu < 1) per_cu = 1;
        if (per_cu > 2) per_cu = 2;
        grid_blocks = cus * per_cu;
        if (ws_size < WS_END) fprintf(stderr, "workspace too small: %zu < %zu\n", ws_size, (size_t)WS_END);
    }
    Params p{};
    for (int i = 0; i < 30; ++i) p.in[i] = (const float*)d_in[i];
    p.out = (float*)d_out; p.ws = (unsigned char*)d_ws;
    void* args[] = {&p};
    hipError_t e = hipLaunchCooperativeKernel((const void*)fwd_mega, dim3(grid_blocks), dim3(256), args, LDS_BYTES, stream);
    if (e != hipSuccess) fprintf(stderr, "cooperative launch failed: %s (grid %d)\n", hipGetErrorString(e), grid_blocks);
}
```

```cpp
#include <hip/hip_runtime.h>
#include <hip/hip_cooperative_groups.h>
#include <cstdio>
namespace cg = cooperative_groups;

typedef unsigned short bf16_t;
typedef short bf16x8 __attribute__((ext_vector_type(8)));
typedef float f32x4 __attribute__((ext_vector_type(4)));
typedef unsigned short us4 __attribute__((ext_vector_type(4)));
typedef unsigned short us8 __attribute__((ext_vector_type(8)));
#define DEVI __device__ __forceinline__

constexpr int D = 1024, NPROJ = 12416, SEGT = 512, NSEG = 4, ROWS_P = 8192, ROWS = 8704, FFH = 2816;
constexpr int PC_Z = 0, PC_XBC = 1024, PC_HQ = 3072, PC_HF = 4096, PC_HI = 5120, PC_HGATE = 6144, PC_RGATE = 7168, PC_RX = 8192, PC_MG = 9216, PC_DT = 12288;
constexpr size_t E_WIN = (size_t)NPROJ * 1024, E_WBR = 3u * 1024 * 1024, E_WOUT = 1024u * 1024, E_WFI = 5632u * 1024, E_WFO = 1024u * 2816;
constexpr size_t E_LAYER = E_WIN + E_WBR + E_WOUT + E_WFI + E_WFO;
constexpr size_t WS_PROJ = 2 * E_LAYER * 2;
constexpr size_t WS_DT = WS_PROJ + (size_t)ROWS * NPROJ * 2;
constexpr size_t WS_XB = WS_DT + (size_t)ROWS * 16 * 4;
constexpr size_t WS_YMB = WS_XB + (size_t)ROWS * 1024 * 2;
constexpr size_t WS_YHG = WS_YMB + (size_t)ROWS * 1024 * 2;
constexpr size_t WS_YRG = WS_YHG + (size_t)ROWS * 1024 * 2;
constexpr size_t WS_MRG = WS_YRG + (size_t)ROWS * 1024 * 2;
constexpr size_t WS_END = WS_MRG + (size_t)ROWS * 1024 * 2;
constexpr size_t O_YP = 0, O_YS = 33554432, O_SSM_P = 34078720, O_SCV_P = 38273024, O_HG_P = 38469632, O_RG_P = 42663936, O_RCV_P = 42696704,
                 O_SSM_S = 42795008, O_SCV_S = 46989312, O_HG_S = 47185920, O_RG_S = 51380224, O_RCV_S = 51412992;
constexpr int LDS_BYTES = 3 * 49152;

enum { I_XP = 0, I_XS, I_SSM, I_SCV, I_HG, I_RG, I_RCV, I_NMIX, I_WIN, I_MCW, I_MCB, I_DTB, I_ALOG, I_MBD, I_MBNW, I_LBL, I_HGNW, I_RCW, I_RCB, I_RWA, I_RBA, I_RWI, I_RBI, I_RLAM, I_WBR, I_WOUT, I_NFFN, I_WFI, I_WFO, I_NFIN };

struct Params { const float* in[30]; float* out; unsigned char* ws; };

DEVI int tidx() { int t = __builtin_amdgcn_workitem_id_x(); asm volatile("" : "+v"(t)); return t; }
DEVI bf16_t f2bf(float f) { unsigned u = __float_as_uint(f); u += 0x7fffu + ((u >> 16) & 1u); return (bf16_t)(u >> 16); }
DEVI float bf2f(bf16_t h) { return __uint_as_float(((unsigned)h) << 16); }
DEVI float sigm(float x) { return 1.f / (1.f + __expf(-x)); }
DEVI float silu(float x) { return x / (1.f + __expf(-x)); }
DEVI float softplus(float x) { return x > 20.f ? x : log1pf(__expf(x)); }
DEVI float gelu_t(float x) { float u = 0.7978845608f * (x + 0.044715f * x * x * x); return x * sigm(2.f * u); }
DEVI float cexp(float x) { return __expf(fminf(x, 80.f)); }

DEVI const float* xrow_in(const Params& p, int seg, int r) {
    if (r < ROWS_P) { int b = r >> 9, tt = r & 511; return p.in[I_XP] + ((size_t)(b * 2048 + seg * SEGT + tt)) * D; }
    return p.in[I_XS] + (size_t)(r - ROWS_P) * D;
}
DEVI float* xrow_out(const Params& p, int seg, int r) {
    if (r < ROWS_P) { int b = r >> 9, tt = r & 511; return p.out + O_YP + ((size_t)(b * 2048 + seg * SEGT + tt)) * D; }
    return p.out + O_YS + (size_t)(r - ROWS_P) * D;
}

DEVI int map_win(int n) { return n < 3072 ? n : (n < 12288 ? n + 16 : (n < 12304 ? 3072 + (n - 12288) : -1)); }
DEVI int map_wfi(int n) { int T = n >> 7, q = (n >> 5) & 3, s = (n >> 4) & 1, i = n & 15; return s * FFH + 64 * T + 16 * q + i; }

DEVI void transpose_tile(const float* src, int ldsrc, bf16_t* dst, int K, int k0, int n0, int mode, float* tile  ) {
    const int tid = tidx(), c = tid & 63, rq = tid >> 6;
    int n = n0 + c, sn = mode == 1 ? map_win(n) : (mode == 2 ? map_wfi(n) : n);
#pragma unroll 4
    for (int rr = 0; rr < 16; ++rr) { int kl = rr * 4 + rq; tile[kl * 65 + c] = sn >= 0 ? src[(size_t)(k0 + kl) * ldsrc + sn] : 0.f; }
    __syncthreads();
#pragma unroll 4
    for (int rr = 0; rr < 16; ++rr) { int nl = rr * 4 + rq; dst[(size_t)(n0 + nl) * K + k0 + c] = f2bf(tile[c * 65 + nl]); }
    __syncthreads();
}

DEVI void phase_prep(const Params& p, char* lds) {
    float* tile = (float*)lds;
    bf16_t* wsb = (bf16_t*)p.ws;
    constexpr int T_WIN = 16 * 194, T_WBR = 3 * 256, T_WOUT = 256, T_WFI = 16 * 88, T_WFO = 44 * 16, T_L = T_WIN + T_WBR + T_WOUT + T_WFI + T_WFO;
    for (int t = blockIdx.x; t < 2 * T_L; t += gridDim.x) {
        int l = t / T_L, j = t % T_L;
        bf16_t* wl = wsb + (size_t)l * E_LAYER;
        if (j < T_WIN) { int kt = j & 15, nt = j >> 4; transpose_tile(p.in[I_WIN] + (size_t)l * 1024 * 12304, 12304, wl, 1024, kt * 64, nt * 64, 1, tile); continue; }
        j -= T_WIN;
        if (j < T_WBR) { int k = j >> 8, jj = j & 255, kt = jj & 15, nt = jj >> 4;
            transpose_tile(p.in[I_WBR] + ((size_t)l * 3 + k) * 1024 * 1024, 1024, wl + E_WIN + (size_t)k * 1024 * 1024, 1024, kt * 64, nt * 64, 0, tile); continue; }
        j -= T_WBR;
        if (j < T_WOUT) { int kt = j & 15, nt = j >> 4; transpose_tile(p.in[I_WOUT] + (size_t)l * 1024 * 1024, 1024, wl + E_WIN + E_WBR, 1024, kt * 64, nt * 64, 0, tile); continue; }
        j -= T_WOUT;
        if (j < T_WFI) { int kt = j & 15, nt = j >> 4; transpose_tile(p.in[I_WFI] + (size_t)l * 1024 * 5632, 5632, wl + E_WIN + E_WBR + E_WOUT, 1024, kt * 64, nt * 64, 2, tile); continue; }
        j -= T_WFI;
        { int kt = j % 44, nt = j / 44; transpose_tile(p.in[I_WFO] + (size_t)l * 2816 * 1024, 1024, wl + E_WIN + E_WBR + E_WOUT + E_WFI, 2816, kt * 64, nt * 64, 0, tile); }
    }
}

DEVI void phase_norm(const Params& p, int seg, int nrows, const float* w, bool from_input) {
    bf16_t* xb = (bf16_t*)(p.ws + WS_XB);
    const int lane = tidx() & 63, wv = tidx() >> 6;
    for (int r = blockIdx.x * 4 + wv; r < nrows; r += gridDim.x * 4) {
        const float* x = from_input ? xrow_in(p, seg, r) : xrow_out(p, seg, r);
        f32x4 v[4]; float ss = 0.f;
#pragma unroll
        for (int i = 0; i < 4; ++i) { v[i] = *(const f32x4*)(x + i * 256 + lane * 4); ss += v[i][0] * v[i][0] + v[i][1] * v[i][1] + v[i][2] * v[i][2] + v[i][3] * v[i][3]; }
#pragma unroll
        for (int o = 32; o >= 1; o >>= 1) ss += __shfl_xor(ss, o);
        float rs = rsqrtf(ss * (1.f / 1024.f) + 1e-6f);
#pragma unroll
        for (int i = 0; i < 4; ++i) { f32x4 wv4 = *(const f32x4*)(w + i * 256 + lane * 4); us4 o;
            o[0] = f2bf(v[i][0] * rs * wv4[0]); o[1] = f2bf(v[i][1] * rs * wv4[1]); o[2] = f2bf(v[i][2] * rs * wv4[2]); o[3] = f2bf(v[i][3] * rs * wv4[3]);
            *(us4*)(xb + (size_t)r * 1024 + i * 256 + lane * 4) = o; }
    }
}
DEVI void phase_final_norm(const Params& p, int seg, int nrows) {
    const float* w = p.in[I_NFIN];
    const int lane = tidx() & 63, wv = tidx() >> 6;
    for (int r = blockIdx.x * 4 + wv; r < nrows; r += gridDim.x * 4) {
        float* x = xrow_out(p, seg, r);
        f32x4 v[4]; float ss = 0.f;
#pragma unroll
        for (int i = 0; i < 4; ++i) { v[i] = *(const f32x4*)(x + i * 256 + lane * 4); ss += v[i][0] * v[i][0] + v[i][1] * v[i][1] + v[i][2] * v[i][2] + v[i][3] * v[i][3]; }
#pragma unroll
        for (int o = 32; o >= 1; o >>= 1) ss += __shfl_xor(ss, o);
        float rs = rsqrtf(ss * (1.f / 1024.f) + 1e-6f);
#pragma unroll
        for (int i = 0; i < 4; ++i) { f32x4 wv4 = *(const f32x4*)(w + i * 256 + lane * 4); f32x4 o;
            o[0] = v[i][0] * rs * wv4[0]; o[1] = v[i][1] * rs * wv4[1]; o[2] = v[i][2] * rs * wv4[2]; o[3] = v[i][3] * rs * wv4[3];
            *(f32x4*)(x + i * 256 + lane * 4) = o; }
    }
}
DEVI void phase_mbnorm(const Params& p, int l, int nrows) {
    bf16_t* y = (bf16_t*)(p.ws + WS_YMB); const float* w = p.in[I_MBNW] + l * 1024;
    const int lane = tidx() & 63, wv = tidx() >> 6;
    for (int it = blockIdx.x * 4 + wv; it < nrows * 4; it += gridDim.x * 4) {
        int r = it >> 2, g = it & 3; bf16_t* yp = y + (size_t)r * 1024 + g * 256 + lane * 4;
        us4 v = *(const us4*)yp; float f0 = bf2f(v[0]), f1 = bf2f(v[1]), f2 = bf2f(v[2]), f3 = bf2f(v[3]);
        float ss = f0 * f0 + f1 * f1 + f2 * f2 + f3 * f3;
#pragma unroll
        for (int o = 32; o >= 1; o >>= 1) ss += __shfl_xor(ss, o);
        float rs = rsqrtf(ss * (1.f / 256.f) + 1e-6f); f32x4 wv4 = *(const f32x4*)(w + g * 256 + lane * 4);
        us4 o; o[0] = f2bf(f0 * rs * wv4[0]); o[1] = f2bf(f1 * rs * wv4[1]); o[2] = f2bf(f2 * rs * wv4[2]); o[3] = f2bf(f3 * rs * wv4[3]);
        *(us4*)yp = o;
    }
}

constexpr int G_STAGE = 49152;
DEVI void stage_rc(int b, int& R, int& C) { int st = b >> 10, sb = b & 1023, swz = sb ^ (((sb >> 9) & 1) << 5); R = (st >> 1) * 16 + (swz >> 6); C = (st & 1) * 32 + ((swz & 63) >> 1); }
#define WAIT_V(n) asm volatile("s_waitcnt vmcnt(" #n ")" ::: "memory")
#define RAW_BAR() do { asm volatile("" ::: "memory"); __builtin_amdgcn_s_barrier(); asm volatile("" ::: "memory"); } while (0)
DEVI void stage_tile(const bf16_t* A, const bf16_t* Bt, int K, int t, char* st, int tid) {
#pragma unroll
    for (int i = 0; i < 4; ++i) { int b = tid * 16 + i * 4096, R, C; stage_rc(b, R, C); size_t o = (size_t)R * K + t * 64 + C;
        __builtin_amdgcn_global_load_lds((const unsigned*)(A + o), (unsigned*)(st + b), 16, 0, 0);
        __builtin_amdgcn_global_load_lds((const unsigned*)(A + (size_t)128 * K + o), (unsigned*)(st + 16384 + b), 16, 0, 0);
        __builtin_amdgcn_global_load_lds((const unsigned*)(Bt + o), (unsigned*)(st + 32768 + b), 16, 0, 0); }
}
template <int UNR>
DEVI void gemm_kloop(f32x4 (&acc)[8][4], const bf16_t* A, const bf16_t* Bt, int K, char* lds) {
    const int tid = tidx(), lane = tid & 63, wid = tid >> 6, wr = wid >> 1, wc = wid & 1, fr = lane & 15, fq = lane >> 4;
    const int fo = (fr * 64 + fq * 16) ^ ((fr >> 3) << 5);
    const int aoff = wr * 16384 + fo, boff = 32768 + wc * 4 * 2048 + fo;
    const int nt = K >> 6;
    WAIT_V(0); RAW_BAR();
    stage_tile(A, Bt, K, 0, lds, tid);
    stage_tile(A, Bt, K, 1, lds + G_STAGE, tid);
    int s = 0;
    for (int t = 0; t < nt; ++t) {
        if (t + 1 < nt) WAIT_V(12); else WAIT_V(0);
        RAW_BAR();
        if (t + 2 < nt) { int s2 = s + 2; if (s2 >= 3) s2 -= 3; stage_tile(A, Bt, K, t + 2, lds + s2 * G_STAGE, tid); }
        const char* st = lds + s * G_STAGE;
        if (UNR == 2) {
            bf16x8 af[2][8], bfr[2][4];
#define RDF(i) do { if ((i) < 4) bfr[0][(i) & 3] = *(const bf16x8*)(st + boff + (((i) & 3) * 2) * 1024); \
                    else if ((i) < 12) af[0][((i) - 4) & 7] = *(const bf16x8*)(st + aoff + ((((i) - 4) & 7) * 2) * 1024); \
                    else if ((i) < 16) bfr[1][(i) & 3] = *(const bf16x8*)(st + boff + (((i) & 3) * 2 + 1) * 1024); \
                    else af[1][(i) & 7] = *(const bf16x8*)(st + aoff + (((i) & 7) * 2 + 1) * 1024); } while (0)
#pragma unroll
            for (int i = 0; i < 6; ++i) RDF(i);
#pragma unroll
            for (int g = 0; g < 16; ++g) {
                __builtin_amdgcn_sched_barrier(0);
                if (g < 4) { RDF(6 + 2 * g); RDF(7 + 2 * g); } else if (g < 14) { RDF(10 + g); }
#pragma unroll
                for (int n = 0; n < 4; ++n) acc[g & 7][n] = __builtin_amdgcn_mfma_f32_16x16x32_bf16(bfr[g >> 3][n], af[g >> 3][g & 7], acc[g & 7][n], 0, 0, 0);
            }
            __builtin_amdgcn_sched_barrier(0);
#undef RDF
        } else {
#pragma unroll 1
            for (int ks = 0; ks < 2; ++ks) {
                bf16x8 af[8], bfr[4];
#define RDF(i) do { if ((i) < 4) bfr[(i) & 3] = *(const bf16x8*)(st + boff + (((i) & 3) * 2 + ks) * 1024); \
                    else af[((i) - 4) & 7] = *(const bf16x8*)(st + aoff + ((((i) - 4) & 7) * 2 + ks) * 1024); } while (0)
#pragma unroll
                for (int i = 0; i < 6; ++i) RDF(i);
#pragma unroll
                for (int g = 0; g < 8; ++g) {
                    __builtin_amdgcn_sched_barrier(0);
                    if (g < 6) RDF(6 + g);
#pragma unroll
                    for (int n = 0; n < 4; ++n) acc[g][n] = __builtin_amdgcn_mfma_f32_16x16x32_bf16(bfr[n], af[g], acc[g][n], 0, 0, 0);
                }
                __builtin_amdgcn_sched_barrier(0);
#undef RDF
            }
        }
        s = s + 1 == 3 ? 0 : s + 1;
    }
}
DEVI bool next_tile(int it, int MT, int NT, int& mt, int& nt) {
    int x = blockIdx.x & 7, bl = blockIdx.x >> 3, G8 = gridDim.x >> 3;
    int nI = (MT - x + 7) >> 3; long j = (long)it * G8 + bl;
    if (j >= (long)nI * NT) return false;
    int i = (int)(j % nI); nt = (int)(j / nI); mt = x + 8 * i; return true;
}
#define ZERO_ACC(a) _Pragma("unroll") for (int m_ = 0; m_ < 8; ++m_) _Pragma("unroll") for (int n_ = 0; n_ < 4; ++n_) a[m_][n_] = (f32x4){0.f, 0.f, 0.f, 0.f}
#define EPI_IDS const int lane = tidx() & 63, wid = tidx() >> 6, wr = wid >> 1, wc = wid & 1, fr = lane & 15, fq = lane >> 4

DEVI void phase_proj(const Params& p, int l, int MT, char* lds) {
    const bf16_t* xb = (const bf16_t*)(p.ws + WS_XB); const bf16_t* wt = (const bf16_t*)p.ws + (size_t)l * E_LAYER;
    bf16_t* proj = (bf16_t*)(p.ws + WS_PROJ); float* dtb = (float*)(p.ws + WS_DT);
    int mt, nt;
    for (int it = 0; next_tile(it, MT, 97, mt, nt); ++it) {
        f32x4 acc[8][4]; ZERO_ACC(acc);
        gemm_kloop<2>(acc, xb + (size_t)mt * 256 * 1024, wt + (size_t)nt * 128 * 1024, 1024, lds);
        EPI_IDS;
        int ty = nt < 8 ? 1 : nt < 24 ? 0 : nt < 32 ? 1 : nt < 48 ? 0 : nt < 56 ? 1 : nt < 64 ? 2 : nt < 72 ? 0 : nt < 96 ? 3 : 4;
        if (ty == 4) {
            if (wc == 0) {
                f32x4 b = *(const f32x4*)(p.in[I_DTB] + l * 16 + fq * 4);
#pragma unroll
                for (int m = 0; m < 8; ++m) { int row = mt * 256 + wr * 128 + m * 16 + fr; f32x4 v = acc[m][0];
                    f32x4 o; o[0] = softplus(v[0] + b[0]); o[1] = softplus(v[1] + b[1]); o[2] = softplus(v[2] + b[2]); o[3] = softplus(v[3] + b[3]);
                    *(f32x4*)(dtb + (size_t)row * 16 + fq * 4) = o; }
            }
        } else {
#pragma unroll
            for (int m = 0; m < 8; ++m) { int row = mt * 256 + wr * 128 + m * 16 + fr;
#pragma unroll
                for (int n = 0; n < 4; ++n) { int col = nt * 128 + wc * 64 + n * 16 + fq * 4; f32x4 v = acc[m][n]; us4 o;
#pragma unroll
                    for (int j = 0; j < 4; ++j) { float x = v[j]; x = ty == 1 ? silu(x) : ty == 2 ? gelu_t(x) : ty == 3 ? sigm(x) : x; o[j] = f2bf(x); }
                    *(us4*)(proj + (size_t)row * NPROJ + col) = o; } }
        }
    }
}
DEVI void phase_merge(const Params& p, int l, int MT, char* lds) {
    const bf16_t* wt = (const bf16_t*)p.ws + (size_t)l * E_LAYER + E_WIN; const bf16_t* proj = (const bf16_t*)(p.ws + WS_PROJ);
    bf16_t* mrg = (bf16_t*)(p.ws + WS_MRG);
    int mt, nt;
    for (int it = 0; next_tile(it, MT, 8, mt, nt); ++it) {
        f32x4 tot[8][4]; ZERO_ACC(tot);
#pragma unroll 1
        for (int k = 0; k < 3; ++k) {
            const bf16_t* y = (const bf16_t*)(p.ws + WS_YMB + (size_t)k * ROWS * 1024 * 2);
            f32x4 acc[8][4]; ZERO_ACC(acc);
            gemm_kloop<1>(acc, y + (size_t)mt * 256 * 1024, wt + (size_t)k * 1024 * 1024 + (size_t)nt * 128 * 1024, 1024, lds);
            EPI_IDS;
#pragma unroll
            for (int m = 0; m < 8; ++m) { int row = mt * 256 + wr * 128 + m * 16 + fr; asm volatile("" ::: "memory");
#pragma unroll
                for (int n = 0; n < 4; ++n) { int col = nt * 128 + wc * 64 + n * 16 + fq * 4; us4 g = *(const us4*)(proj + (size_t)row * NPROJ + PC_MG + k * 1024 + col);
#pragma unroll
                    for (int j = 0; j < 4; ++j) tot[m][n][j] += acc[m][n][j] * bf2f(g[j]); } }
        }
        EPI_IDS;
#pragma unroll
        for (int m = 0; m < 8; ++m) { int row = mt * 256 + wr * 128 + m * 16 + fr;
#pragma unroll
            for (int n = 0; n < 4; ++n) { int col = nt * 128 + wc * 64 + n * 16 + fq * 4; us4 o;
#pragma unroll
                for (int j = 0; j < 4; ++j) o[j] = f2bf(tot[m][n][j]);
                *(us4*)(mrg + (size_t)row * 1024 + col) = o; } }
    }
}
DEVI void phase_resid(const Params& p, int seg, int MT, const bf16_t* A, int K, const bf16_t* Bt, bool from_input, char* lds) {
    int mt, nt;
    for (int it = 0; next_tile(it, MT, 8, mt, nt); ++it) {
        f32x4 acc[8][4]; ZERO_ACC(acc);
        gemm_kloop<2>(acc, A + (size_t)mt * 256 * K, Bt + (size_t)nt * 128 * K, K, lds);
        EPI_IDS;
#pragma unroll
        for (int m = 0; m < 8; ++m) { int row = mt * 256 + wr * 128 + m * 16 + fr;
            const float* xi = from_input ? xrow_in(p, seg, row) : xrow_out(p, seg, row); float* xo = xrow_out(p, seg, row);
#pragma unroll
            for (int n = 0; n < 4; ++n) { int col = nt * 128 + wc * 64 + n * 16 + fq * 4; f32x4 v = *(const f32x4*)(xi + col); *(f32x4*)(xo + col) = v + acc[m][n]; } }
    }
}
DEVI void phase_ffn_in(const Params& p, int l, int MT, char* lds) {
    const bf16_t* xb = (const bf16_t*)(p.ws + WS_XB); const bf16_t* wt = (const bf16_t*)p.ws + (size_t)l * E_LAYER + E_WIN + E_WBR + E_WOUT;
    bf16_t* act = (bf16_t*)(p.ws + WS_PROJ);
    int mt, nt;
    for (int it = 0; next_tile(it, MT, 44, mt, nt); ++it) {
        f32x4 acc[8][4]; ZERO_ACC(acc);
        gemm_kloop<2>(acc, xb + (size_t)mt * 256 * 1024, wt + (size_t)nt * 128 * 1024, 1024, lds);
        EPI_IDS;
#pragma unroll
        for (int m = 0; m < 8; ++m) { int row = mt * 256 + wr * 128 + m * 16 + fr;
#pragma unroll
            for (int q = 0; q < 2; ++q) { int col = nt * 64 + 16 * (2 * wc + q) + fq * 4; us4 o;
#pragma unroll
                for (int j = 0; j < 4; ++j) o[j] = f2bf(silu(acc[m][2 * q][j]) * acc[m][2 * q + 1][j]);
                *(us4*)(act + (size_t)row * FFH + col) = o; } }
    }
}

struct Seq { int row0, nchunk, Q, b, samp, seg; };
DEVI Seq make_seq(int seg, int sq) { Seq s; s.seg = seg; if (sq < 16) { s.row0 = sq * SEGT; s.nchunk = 8; s.Q = 64; s.b = sq; s.samp = 0; } else { s.b = sq - 16; s.row0 = ROWS_P + s.b * 32; s.nchunk = 1; s.Q = 32; s.samp = 1; } return s; }

template <int NF, int KS>
DEVI void lds_mma(f32x4* acc, const bf16_t* X, int ldx, int m0, const bf16_t* Y, int ldy, int n0) {
    const int lane = tidx() & 63, fr = lane & 15, fq = lane >> 4;
#pragma unroll
    for (int ks = 0; ks < KS; ++ks) {
        bf16x8 a = *(const bf16x8*)(X + (m0 + fr) * ldx + ks * 32 + fq * 8);
#pragma unroll
        for (int nf = 0; nf < NF; ++nf) { bf16x8 b = *(const bf16x8*)(Y + (n0 + nf * 16 + fr) * ldy + ks * 32 + fq * 8); acc[nf] = __builtin_amdgcn_mfma_f32_16x16x32_bf16(a, b, acc[nf], 0, 0, 0); }
    }
}

DEVI void conv8(const bf16_t* proj, int row0, int tq, int pcol, const float* hist, int histC, int hch, const float* cw, const float* cb, int C, int ch, float (&out)[8], float (&raw)[8]) {
    f32x4 b0 = *(const f32x4*)(cb + ch), b1 = *(const f32x4*)(cb + ch + 4);
    out[0] = b0[0]; out[1] = b0[1]; out[2] = b0[2]; out[3] = b0[3]; out[4] = b1[0]; out[5] = b1[1]; out[6] = b1[2]; out[7] = b1[3];
#pragma unroll
    for (int k = 0; k < 4; ++k) {
        int ts = tq - 3 + k; float v[8];
        if (ts >= 0) { us8 u = *(const us8*)(proj + (size_t)(row0 + ts) * NPROJ + pcol);
#pragma unroll
            for (int e = 0; e < 8; ++e) v[e] = bf2f(u[e]); }
        else if (hist) { f32x4 h0 = *(const f32x4*)(hist + (3 + ts) * histC + hch), h1 = *(const f32x4*)(hist + (3 + ts) * histC + hch + 4);
            v[0] = h0[0]; v[1] = h0[1]; v[2] = h0[2]; v[3] = h0[3]; v[4] = h1[0]; v[5] = h1[1]; v[6] = h1[2]; v[7] = h1[3]; }
        else {
#pragma unroll
            for (int e = 0; e < 8; ++e) v[e] = 0.f; }
        f32x4 w0 = *(const f32x4*)(cw + k * C + ch), w1 = *(const f32x4*)(cw + k * C + ch + 4);
        out[0] += v[0] * w0[0]; out[1] += v[1] * w0[1]; out[2] += v[2] * w0[2]; out[3] += v[3] * w0[3];
        out[4] += v[4] * w1[0]; out[5] += v[5] * w1[1]; out[6] += v[6] * w1[2]; out[7] += v[7] * w1[3];
        if (k == 3) {
#pragma unroll
            for (int e = 0; e < 8; ++e) raw[e] = v[e]; }
    }
}

DEVI void ssd_unit(const Params& p, int l, Seq sq, int hd, char* lds) {
    bf16_t* Bm = (bf16_t*)lds;
    bf16_t* R2 = (bf16_t*)(lds + 17408);
    bf16_t* xT = (bf16_t*)(lds + 35840);
    bf16_t* hb = (bf16_t*)(lds + 45056);
    float* fl = (float*)(lds + 62464);
    const int tid = tidx(), lane = tid & 63, w = tid >> 6, fr = lane & 15, fq = lane >> 4;
    const bf16_t* proj = (const bf16_t*)(p.ws + WS_PROJ); const float* dtb = (const float*)(p.ws + WS_DT); bf16_t* ymb = (bf16_t*)(p.ws + WS_YMB);
    const int g = hd >> 2;
    const float a = -__expf(p.in[I_ALOG][l * 16 + hd]), Dv = p.in[I_MBD][l * 16 + hd];
    const float* cw = p.in[I_MCW] + (size_t)l * 4 * 2048; const float* cbias = p.in[I_MCB] + l * 2048;
    const float* st_in; float* st_out; const float* hist; float* hist_out;
    if (sq.samp) { st_in = p.in[I_SSM] + ((size_t)(l * 16 + sq.b) * 16 + hd) * 8192; st_out = p.out + O_SSM_S + ((size_t)(l * 16 + sq.b) * 16 + hd) * 8192;
        hist = p.in[I_SCV] + (size_t)(l * 16 + sq.b) * 3 * 2048; hist_out = p.out + O_SCV_S + (size_t)(l * 16 + sq.b) * 3 * 2048; }
    else { st_out = p.out + O_SSM_P + ((size_t)(l * 16 + sq.b) * 16 + hd) * 8192; st_in = sq.seg ? st_out : nullptr;
        hist_out = p.out + O_SCV_P + (size_t)(l * 16 + sq.b) * 3 * 2048; hist = sq.seg ? hist_out : nullptr; }
    f32x4 hacc[8];
#pragma unroll
    for (int nf = 0; nf < 8; ++nf)
#pragma unroll
        for (int r = 0; r < 4; ++r) { int pp = 16 * w + 4 * fq + r, n = 16 * nf + fr; float v = st_in ? st_in[pp * 128 + n] : 0.f; hacc[nf][r] = v; hb[pp * 136 + n] = f2bf(v); }
    for (int c = 0; c < sq.nchunk; ++c) {
        const int rowc = sq.row0 + c * 64; const bool lastc = (c == sq.nchunk - 1);
        if (w == 0) {
            float dt = lane < sq.Q ? dtb[(size_t)(rowc + lane) * 16 + hd] : 0.f; float v = dt * a;
#pragma unroll
            for (int o = 1; o < 64; o <<= 1) { float t = __shfl_up(v, o); if (lane >= o) v += t; }
            float last = __shfl(v, 63);
            fl[lane] = v; fl[64 + lane] = dt; fl[128 + lane] = __expf(last - v) * dt; fl[192 + lane] = __expf(v);
        }
        __syncthreads();
        const float elast = __expf(fl[63]);
#pragma unroll 1
        for (int i = 0; i < 2; ++i) { int it = tid + 256 * i, t = it >> 3, c8 = (it & 7) * 8; float o[8], raw[8];
            int ch = hd * 64 + c8;
            if (t < sq.Q) { conv8(proj, sq.row0, c * 64 + t, PC_XBC + ch, hist, 2048, ch, cw, cbias, 2048, ch, o, raw);
#pragma unroll
                for (int e = 0; e < 8; ++e) o[e] = silu(o[e]);
                if (lastc && t >= sq.Q - 3) {
#pragma unroll
                    for (int e = 0; e < 8; ++e) hist_out[(t - (sq.Q - 3)) * 2048 + ch + e] = raw[e]; } }
            else {
#pragma unroll
                for (int e = 0; e < 8; ++e) o[e] = 0.f; }
#pragma unroll
            for (int e = 0; e < 8; ++e) xT[(c8 + e) * 72 + t] = f2bf(o[e]); }
#pragma unroll 1
        for (int i = 0; i < 4; ++i) { int it = tid + 256 * i, t = it >> 4, c8 = (it & 15) * 8; float o[8], raw[8];
            int ch = 1024 + g * 128 + c8;
            if (t < sq.Q) { conv8(proj, sq.row0, c * 64 + t, PC_XBC + ch, hist, 2048, ch, cw, cbias, 2048, ch, o, raw);
#pragma unroll
                for (int e = 0; e < 8; ++e) o[e] = silu(o[e]);
                if (lastc && (hd & 3) == 0 && t >= sq.Q - 3) {
#pragma unroll
                    for (int e = 0; e < 8; ++e) hist_out[(t - (sq.Q - 3)) * 2048 + ch + e] = raw[e]; } }
            else {
#pragma unroll
                for (int e = 0; e < 8; ++e) o[e] = 0.f; }
            us8 ov; float we = fl[128 + t];
#pragma unroll
            for (int e = 0; e < 8; ++e) { ov[e] = f2bf(o[e]); R2[(c8 + e) * 72 + t] = f2bf(o[e] * we); }
            *(us8*)(Bm + t * 136 + c8) = ov; }
        __syncthreads();
#pragma unroll
        for (int nf = 0; nf < 8; ++nf) hacc[nf] *= elast;
        lds_mma<8, 2>(hacc, xT, 72, 16 * w, R2, 72, 0);
        __syncthreads();
#pragma unroll 1
        for (int i = 0; i < 4; ++i) { int it = tid + 256 * i, t = it >> 4, c8 = (it & 15) * 8; float o[8], raw[8];
            int ch = 1536 + g * 128 + c8;
            if (t < sq.Q) { conv8(proj, sq.row0, c * 64 + t, PC_XBC + ch, hist, 2048, ch, cw, cbias, 2048, ch, o, raw);
#pragma unroll
                for (int e = 0; e < 8; ++e) o[e] = silu(o[e]);
                if (lastc && (hd & 3) == 0 && t >= sq.Q - 3) {
#pragma unroll
                    for (int e = 0; e < 8; ++e) hist_out[(t - (sq.Q - 3)) * 2048 + ch + e] = raw[e]; } }
            else {
#pragma unroll
                for (int e = 0; e < 8; ++e) o[e] = 0.f; }
            us8 ov;
#pragma unroll
            for (int e = 0; e < 8; ++e) ov[e] = f2bf(o[e]);
            *(us8*)(R2 + t * 136 + c8) = ov; }
        __syncthreads();
        f32x4 cbv[4];
#pragma unroll
        for (int nf = 0; nf < 4; ++nf) cbv[nf] = (f32x4){0.f, 0.f, 0.f, 0.f};
        lds_mma<4, 4>(cbv, Bm, 136, 16 * w, R2, 136, 0);
        __syncthreads();
#pragma unroll
        for (int nf = 0; nf < 4; ++nf) { int i = 16 * nf + fr; float ai = fl[i]; us4 o;
#pragma unroll
            for (int r = 0; r < 4; ++r) { int j = 16 * w + 4 * fq + r; float v = (j <= i) ? cbv[nf][r] * __expf(ai - fl[j]) * fl[64 + j] : 0.f; o[r] = f2bf(v); }
            *(us4*)(Bm + i * 72 + 16 * w + 4 * fq) = o; }
        __syncthreads();
        f32x4 ya[4];
#pragma unroll
        for (int nf = 0; nf < 4; ++nf) ya[nf] = (f32x4){0.f, 0.f, 0.f, 0.f};
        lds_mma<4, 4>(ya, hb, 136, 16 * w, R2, 136, 0);
#pragma unroll
        for (int nf = 0; nf < 4; ++nf) ya[nf] *= fl[192 + 16 * nf + fr];
        lds_mma<4, 2>(ya, xT, 72, 16 * w, Bm, 72, 0);
#pragma unroll
        for (int nf = 0; nf < 4; ++nf) { int i = 16 * nf + fr, p0 = 16 * w + 4 * fq;
            if (i < sq.Q) { us4 z = *(const us4*)(proj + (size_t)(rowc + i) * NPROJ + PC_Z + hd * 64 + p0); us4 o;
#pragma unroll
                for (int r = 0; r < 4; ++r) o[r] = f2bf((ya[nf][r] + Dv * bf2f(xT[(p0 + r) * 72 + i])) * bf2f(z[r]));
                *(us4*)(ymb + (size_t)(rowc + i) * 1024 + hd * 64 + p0) = o; } }
        __syncthreads();
#pragma unroll
        for (int nf = 0; nf < 8; ++nf)
#pragma unroll
            for (int r = 0; r < 4; ++r) hb[(16 * w + 4 * fq + r) * 136 + 16 * nf + fr] = f2bf(hacc[nf][r]);
    }
#pragma unroll
    for (int nf = 0; nf < 8; ++nf)
#pragma unroll
        for (int r = 0; r < 4; ++r) st_out[(16 * w + 4 * fq + r) * 128 + 16 * nf + fr] = hacc[nf][r];
    __syncthreads();
}

DEVI void hgrn_unit(const Params& p, int l, Seq sq, int h, char* lds) {
    bf16_t* sb = (bf16_t*)lds;
    bf16_t* qt = (bf16_t*)(lds + 34816);
    bf16_t* kt = (bf16_t*)(lds + 52224);
    bf16_t* att = (bf16_t*)lds;
    bf16_t* kT = (bf16_t*)(lds + 9216);
    bf16_t* vT = (bf16_t*)(lds + 27648);
    float* T0 = (float*)(lds + 69632); float* T1 = T0 + 128; float* ssq = T0 + 256;
    const int tid = tidx(), lane = tid & 63, w = tid >> 6, fr = lane & 15, fq = lane >> 4;
    const int k = tid & 127, half = tid >> 7;
    const bf16_t* proj = (const bf16_t*)(p.ws + WS_PROJ); bf16_t* yhg = (bf16_t*)(p.ws + WS_YHG);
    float lb = 0.f;
    if (l == 1) { float a0 = p.in[I_LBL][h * 128 + k], a1 = p.in[I_LBL][1024 + h * 128 + k]; lb = 1.f / (1.f + __expf(a0 - a1)); }
    const float* nw = p.in[I_HGNW] + l * 128;
    const float* st_in; float* st_out;
    if (sq.samp) { st_in = p.in[I_HG] + ((size_t)(l * 16 + sq.b) * 8 + h) * 16384; st_out = p.out + O_HG_S + ((size_t)(l * 16 + sq.b) * 8 + h) * 16384; }
    else { st_out = p.out + O_HG_P + ((size_t)(l * 16 + sq.b) * 8 + h) * 16384; st_in = sq.seg ? st_out : nullptr; }
    f32x4 hacc[2][8];
#pragma unroll
    for (int mf = 0; mf < 2; ++mf)
#pragma unroll
        for (int nf = 0; nf < 8; ++nf)
#pragma unroll
            for (int r = 0; r < 4; ++r) hacc[mf][nf][r] = st_in ? st_in[(32 * w + 16 * mf + 4 * fq + r) * 128 + 16 * nf + fr] : 0.f;
    for (int c = 0; c < sq.nchunk; ++c) {
        const int rowc = sq.row0 + c * 64;
        {
            const bf16_t* pr = proj + (size_t)(rowc + 32 * half) * NPROJ + h * 128 + k;
            float run = 0.f;
#pragma unroll 8
            for (int jj = 0; jj < 32; ++jj) { bool valid = (32 * half + jj) < sq.Q; float f = valid ? bf2f(pr[(size_t)jj * NPROJ + PC_HF]) : 0.f;
                float lg = valid ? __logf(lb + (1.f - lb) * sigm(f)) : 0.f; run += lg; }
            const float T = run;
            if (half == 0) T0[k] = T; else T1[k] = T;
            if (tid < 64) ssq[tid] = 0.f;
            run = 0.f;
#pragma unroll 8
            for (int jj = 0; jj < 32; ++jj) { bool valid = (32 * half + jj) < sq.Q; int j = 32 * half + jj;
                float f = valid ? bf2f(pr[(size_t)jj * NPROJ + PC_HF]) : 0.f; float q = valid ? bf2f(pr[(size_t)jj * NPROJ + PC_HQ]) : 0.f;
                float sg = sigm(f); float lg = valid ? __logf(lb + (1.f - lb) * sg) : 0.f; run += lg;
                float kk = valid ? (1.f - lb) * (1.f - sg) : 0.f;
                float eq = half == 0 ? cexp(run - T) : cexp(run); float ek = half == 0 ? cexp(T - run) : cexp(-run);
                qt[j * 136 + k] = f2bf(q * eq); kt[j * 136 + k] = f2bf(kk * ek); }
        }
        __syncthreads();
#pragma unroll
        for (int mf = 0; mf < 2; ++mf) { int k0 = 32 * w + 16 * mf + 4 * fq; float e0 = __expf(T0[k0]), e1 = __expf(T0[k0 + 1]), e2 = __expf(T0[k0 + 2]), e3 = __expf(T0[k0 + 3]);
#pragma unroll
            for (int nf = 0; nf < 8; ++nf) { hacc[mf][nf][0] *= e0; hacc[mf][nf][1] *= e1; hacc[mf][nf][2] *= e2; hacc[mf][nf][3] *= e3;
                us4 o; o[0] = f2bf(hacc[mf][nf][0]); o[1] = f2bf(hacc[mf][nf][1]); o[2] = f2bf(hacc[mf][nf][2]); o[3] = f2bf(hacc[mf][nf][3]);
                *(us4*)(sb + (16 * nf + fr) * 136 + k0) = o; } }
        f32x4 at[4];
#pragma unroll
        for (int nf = 0; nf < 4; ++nf) at[nf] = (f32x4){0.f, 0.f, 0.f, 0.f};
        lds_mma<4, 4>(at, kt, 136, 16 * w, qt, 136, 0);
        __syncthreads();
        f32x4 oacc[2][4];
#pragma unroll
        for (int mf = 0; mf < 2; ++mf) {
#pragma unroll
            for (int nf = 0; nf < 4; ++nf) oacc[mf][nf] = (f32x4){0.f, 0.f, 0.f, 0.f};
            lds_mma<4, 4>(oacc[mf], sb, 136, 32 * w + 16 * mf, qt, 136, 0); }
        __syncthreads();
#pragma unroll
        for (int nf = 0; nf < 4; ++nf) { int i = 16 * nf + fr; us4 o;
#pragma unroll
            for (int r = 0; r < 4; ++r) { int j = 16 * w + 4 * fq + r; o[r] = f2bf(j <= i ? at[nf][r] : 0.f); }
            *(us4*)(att + i * 72 + 16 * w + 4 * fq) = o; }
        {   const bf16_t* pv = proj + (size_t)(rowc + 32 * half) * NPROJ + PC_HI + h * 128 + k;
#pragma unroll 1
            for (int q4 = 0; q4 < 4; ++q4) { us8 kv, vv;
#pragma unroll
                for (int e = 0; e < 8; ++e) { int jj = q4 * 8 + e; bool valid = (32 * half + jj) < sq.Q; kv[e] = kt[(32 * half + jj) * 136 + k]; vv[e] = valid ? pv[(size_t)jj * NPROJ] : (bf16_t)0; }
                *(us8*)(kT + k * 72 + 32 * half + q4 * 8) = kv; *(us8*)(vT + k * 72 + 32 * half + q4 * 8) = vv; } }
        __syncthreads();
#pragma unroll
        for (int mf = 0; mf < 2; ++mf) {
            lds_mma<4, 2>(oacc[mf], vT, 72, 32 * w + 16 * mf, att, 72, 0);
            lds_mma<8, 2>(hacc[mf], kT, 72, 32 * w + 16 * mf, vT, 72, 0);
            int k0 = 32 * w + 16 * mf + 4 * fq; float e0 = __expf(T1[k0]), e1 = __expf(T1[k0 + 1]), e2 = __expf(T1[k0 + 2]), e3 = __expf(T1[k0 + 3]);
#pragma unroll
            for (int nf = 0; nf < 8; ++nf) { hacc[mf][nf][0] *= e0; hacc[mf][nf][1] *= e1; hacc[mf][nf][2] *= e2; hacc[mf][nf][3] *= e3; } }
#pragma unroll
        for (int nf = 0; nf < 4; ++nf) { float s = 0.f;
#pragma unroll
            for (int mf = 0; mf < 2; ++mf)
#pragma unroll
                for (int r = 0; r < 4; ++r) s += oacc[mf][nf][r] * oacc[mf][nf][r];
            s += __shfl_xor(s, 16); s += __shfl_xor(s, 32);
            if (fq == 0) atomicAdd(&ssq[16 * nf + fr], s); }
        __syncthreads();
#pragma unroll
        for (int nf = 0; nf < 4; ++nf) { int i = 16 * nf + fr;
            if (i < sq.Q) { float rs = rsqrtf(ssq[i] * (1.f / 128.f) + 1e-6f);
#pragma unroll
                for (int mf = 0; mf < 2; ++mf) { int v0 = 32 * w + 16 * mf + 4 * fq; us4 gt = *(const us4*)(proj + (size_t)(rowc + i) * NPROJ + PC_HGATE + h * 128 + v0); f32x4 wv = *(const f32x4*)(nw + v0); us4 o;
#pragma unroll
                    for (int r = 0; r < 4; ++r) o[r] = f2bf(oacc[mf][nf][r] * rs * wv[r] * bf2f(gt[r]));
                    *(us4*)(yhg + (size_t)(rowc + i) * 1024 + h * 128 + v0) = o; } } }
        __syncthreads();
    }
#pragma unroll
    for (int mf = 0; mf < 2; ++mf)
#pragma unroll
        for (int nf = 0; nf < 8; ++nf)
#pragma unroll
            for (int r = 0; r < 4; ++r) st_out[(32 * w + 16 * mf + 4 * fq + r) * 128 + 16 * nf + fr] = hacc[mf][nf][r];
}

DEVI void rg_unit(const Params& p, int l, Seq sq, int blk, char* lds) {
    bf16_t* waT = (bf16_t*)lds; bf16_t* wiT = (bf16_t*)(lds + 9216); bf16_t* xr = (bf16_t*)(lds + 18432);
    float* av = (float*)(lds + 27648); float* uv = (float*)(lds + 44288); float* Pq = (float*)(lds + 60928); float* Hq = Pq + 256; float* carry = Hq + 256;
    const int tid = tidx(), lane = tid & 63, w = tid >> 6, fr = lane & 15, fq = lane >> 4;
    const bf16_t* proj = (const bf16_t*)(p.ws + WS_PROJ); bf16_t* yrg = (bf16_t*)(p.ws + WS_YRG);
    const int cb0 = blk * 64;
    const float* cw = p.in[I_RCW] + (size_t)l * 4 * 1024; const float* cbias = p.in[I_RCB] + l * 1024;
    const float* st_in; float* st_out; const float* hist; float* hist_out;
    if (sq.samp) { st_in = p.in[I_RG] + (size_t)(l * 16 + sq.b) * 1024; st_out = p.out + O_RG_S + (size_t)(l * 16 + sq.b) * 1024;
        hist = p.in[I_RCV] + (size_t)(l * 16 + sq.b) * 3 * 1024; hist_out = p.out + O_RCV_S + (size_t)(l * 16 + sq.b) * 3 * 1024; }
    else { st_out = p.out + O_RG_P + (size_t)(l * 16 + sq.b) * 1024; st_in = sq.seg ? st_out : nullptr;
        hist_out = p.out + O_RCV_P + (size_t)(l * 16 + sq.b) * 3 * 1024; hist = sq.seg ? hist_out : nullptr; }
    {   const float* wa = p.in[I_RWA] + ((size_t)l * 16 + blk) * 4096; const float* wi = p.in[I_RWI] + ((size_t)l * 16 + blk) * 4096;
        for (int e = tid; e < 4096; e += 256) { int i = e >> 6, j = e & 63; waT[j * 72 + i] = f2bf(wa[e]); wiT[j * 72 + i] = f2bf(wi[e]); }
        if (tid < 64) carry[tid] = st_in ? st_in[cb0 + tid] : 0.f; }
    const int j = tid & 63, q = tid >> 6;
    for (int c = 0; c < sq.nchunk; ++c) {
        const int rowc = sq.row0 + c * 64; const bool lastc = (c == sq.nchunk - 1);
#pragma unroll 1
        for (int i = 0; i < 2; ++i) { int it = tid + 256 * i, t = it >> 3, c8 = (it & 7) * 8; float o[8], raw[8]; int ch = cb0 + c8;
            if (t < sq.Q) { conv8(proj, sq.row0, c * 64 + t, PC_RX + ch, hist, 1024, ch, cw, cbias, 1024, ch, o, raw);
                if (lastc && t >= sq.Q - 3) {
#pragma unroll
                    for (int e = 0; e < 8; ++e) hist_out[(t - (sq.Q - 3)) * 1024 + ch + e] = raw[e]; } }
            else {
#pragma unroll
                for (int e = 0; e < 8; ++e) o[e] = 0.f; }
            us8 ov;
#pragma unroll
            for (int e = 0; e < 8; ++e) { ov[e] = f2bf(o[e]); uv[t * 65 + c8 + e] = o[e]; }
            *(us8*)(xr + t * 72 + c8) = ov; }
        __syncthreads();
        f32x4 ra[4], ri[4];
#pragma unroll
        for (int nf = 0; nf < 4; ++nf) { ra[nf] = (f32x4){0.f, 0.f, 0.f, 0.f}; ri[nf] = (f32x4){0.f, 0.f, 0.f, 0.f}; }
        lds_mma<4, 2>(ra, xr, 72, 16 * w, waT, 72, 0);
        lds_mma<4, 2>(ri, xr, 72, 16 * w, wiT, 72, 0);
#pragma unroll
        for (int nf = 0; nf < 4; ++nf) { int jj = 16 * nf + fr, cc = cb0 + jj; float ba = p.in[I_RBA][l * 1024 + cc], bi = p.in[I_RBI][l * 1024 + cc], sp = softplus(-p.in[I_RLAM][l * 1024 + cc]);
#pragma unroll
            for (int r = 0; r < 4; ++r) { int t = 16 * w + 4 * fq + r; float rr = sigm(ra[nf][r] + ba), ii = sigm(ri[nf][r] + bi); float la = -8.f * sp * rr; float aa = __expf(la);
                float u = sqrtf(-expm1f(2.f * la)) * ii * uv[t * 65 + jj];
                if (t >= sq.Q) { aa = 1.f; u = 0.f; }
                av[t * 65 + jj] = aa; uv[t * 65 + jj] = u; } }
        __syncthreads();
        { float P = 1.f, H = 0.f;
#pragma unroll
          for (int tt = 0; tt < 16; ++tt) { int t = 16 * q + tt; float aa = av[t * 65 + j], u = uv[t * 65 + j]; H = aa * H + u; P *= aa; }
          Pq[q * 64 + j] = P; Hq[q * 64 + j] = H; }
        __syncthreads();
        float hcur = carry[j];
        for (int qq = 0; qq < q; ++qq) hcur = Pq[qq * 64 + j] * hcur + Hq[qq * 64 + j];
#pragma unroll
        for (int tt = 0; tt < 16; ++tt) { int t = 16 * q + tt; float aa = av[t * 65 + j], u = uv[t * 65 + j]; hcur = aa * hcur + u;
            if (t < sq.Q) { float gt = bf2f(proj[(size_t)(rowc + t) * NPROJ + PC_RGATE + cb0 + j]); yrg[(size_t)(rowc + t) * 1024 + cb0 + j] = f2bf(gt * hcur); } }
        __syncthreads();
        if (q == 3) carry[j] = hcur;
        __syncthreads();
    }
    if (tid < 64) st_out[cb0 + tid] = carry[tid];
    __syncthreads();
}

DEVI void phase_mix(const Params& p, int l, int seg, char* lds) {
    const int ngrp = seg == 0 ? 2 : 1; const int NU = ngrp * 640;
    for (int u = blockIdx.x; u < NU; u += gridDim.x) {
        int grp = u / 640, v = u % 640;
        if (v < 128) hgrn_unit(p, l, make_seq(seg, grp * 16 + (v >> 3)), v & 7, lds);
        else if (v < 384) { v -= 128; ssd_unit(p, l, make_seq(seg, grp * 16 + (v >> 4)), v & 15, lds); }
        else { v -= 384; rg_unit(p, l, make_seq(seg, grp * 16 + (v >> 4)), v & 15, lds); }
        __syncthreads();
    }
}

DEVI void gbar(unsigned* ctr, unsigned& epoch) {
    asm volatile("s_waitcnt vmcnt(0)" ::: "memory");
    __syncthreads();
    if (tidx() == 0) {
        __builtin_amdgcn_fence(__ATOMIC_RELEASE, "agent");
        asm volatile("s_waitcnt vmcnt(0)" ::: "memory");
        __hip_atomic_fetch_add(ctr, 1u, __ATOMIC_RELAXED, __HIP_MEMORY_SCOPE_AGENT);
        const unsigned target = (epoch + 1u) * gridDim.x;
        while (__hip_atomic_load(ctr, __ATOMIC_RELAXED, __HIP_MEMORY_SCOPE_AGENT) < target) __builtin_amdgcn_s_sleep(1);
        __builtin_amdgcn_fence(__ATOMIC_ACQUIRE, "agent");
        asm volatile("s_waitcnt vmcnt(0)" ::: "memory");
    }
    ++epoch;
    __syncthreads();
}

__global__ void __launch_bounds__(256) fwd_mega(Params p) {
    extern __shared__ __attribute__((aligned(16))) char lds[];
    cg::grid_group grid = cg::this_grid();
    unsigned* ctr = (unsigned*)(p.ws + WS_END); unsigned epoch = 0;
    phase_prep(p, lds);
    grid.sync();
#pragma unroll 1
    for (int seg = 0; seg < NSEG; ++seg) {
        const int nrows = seg == 0 ? ROWS : ROWS_P, MT = nrows / 256;
#pragma unroll 1
        for (int l = 0; l < 2; ++l) {
            const bf16_t* wl = (const bf16_t*)p.ws + (size_t)l * E_LAYER;
            phase_norm(p, seg, nrows, p.in[I_NMIX] + l * 1024, l == 0);
            gbar(ctr, epoch);
            phase_proj(p, l, MT, lds);
            gbar(ctr, epoch);
            phase_mix(p, l, seg, lds);
            gbar(ctr, epoch);
            phase_mbnorm(p, l, nrows);
            gbar(ctr, epoch);
            phase_merge(p, l, MT, lds);
            gbar(ctr, epoch);
            phase_resid(p, seg, MT, (const bf16_t*)(p.ws + WS_MRG), 1024, wl + E_WIN + E_WBR, l == 0, lds);
            gbar(ctr, epoch);
            phase_norm(p, seg, nrows, p.in[I_NFFN] + l * 1024, false);
            gbar(ctr, epoch);
            phase_ffn_in(p, l, MT, lds);
            gbar(ctr, epoch);
            phase_resid(p, seg, MT, (const bf16_t*)(p.ws + WS_PROJ), FFH, wl + E_WIN + E_WBR + E_WOUT + E_WFI, false, lds);
            gbar(ctr, epoch);
        }
        phase_final_norm(p, seg, nrows);
    }
}

extern "C" void kernel_launch(void* const* d_in, const int* in_sizes, int n_in, void* d_out, int out_size, void* d_ws, size_t ws_size, hipStream_t stream) {
    static int grid_blocks = 0;
    if (!grid_blocks) {
        int dev = 0, cus = 0, per_cu = 0;
        (void)hipGetDevice(&dev);
        (void)hipDeviceGetAttribute(&cus, hipDeviceAttributeMultiprocessorCount, dev);
        (void)hipFuncSetAttribute((const void*)fwd_mega, hipFuncAttributeMaxDynamicSharedMemorySize, LDS_BYTES);
        (void)hipOccupancyMaxActiveBlocksPerMultiprocessor(&per_cu, (const void*)fwd_mega, 256, LDS_BYTES);
        if (per_cu < 1) fprintf(stderr, "occupancy query says %d blocks per CU\n", per_cu);
        grid_blocks = cus;
        if (ws_size < WS_END + 256) fprintf(stderr, "workspace too small: %zu < %zu\n", ws_size, (size_t)WS_END + 256);
    }
    (void)hipMemsetAsync((char*)d_ws + WS_END, 0, 256, stream);
    Params p{};
    for (int i = 0; i < 30; ++i) p.in[i] = (const float*)d_in[i];
    p.out = (float*)d_out; p.ws = (unsigned char*)d_ws;
    void* args[] = {&p};
    hipError_t e = hipLaunchCooperativeKernel((const void*)fwd_mega, dim3(grid_blocks), dim3(256), args, LDS_BYTES, stream);
    if (e != hipSuccess) fprintf(stderr, "cooperative launch failed: %s (grid %d)\n", hipGetErrorString(e), grid_blocks);
}
```

```cpp
#include <hip/hip_runtime.h>
#include <hip/hip_cooperative_groups.h>
#include <cstdio>
namespace cg = cooperative_groups;

typedef unsigned short bf16_t;
typedef short bf16x8 __attribute__((ext_vector_type(8)));
typedef float f32x4 __attribute__((ext_vector_type(4)));
typedef unsigned short us4 __attribute__((ext_vector_type(4)));
typedef unsigned short us8 __attribute__((ext_vector_type(8)));
#define DEVI __device__ __forceinline__

constexpr int D = 1024, NPROJ = 12416, SEGT = 512, NSEG = 4, ROWS_P = 8192, ROWS = 8704, FFH = 2816;
constexpr int PC_Z = 0, PC_XBC = 1024, PC_HQ = 3072, PC_HF = 4096, PC_HI = 5120, PC_HGATE = 6144, PC_RGATE = 7168, PC_RX = 8192, PC_MG = 9216, PC_DT = 12288;
constexpr size_t E_WIN = (size_t)NPROJ * 1024, E_WBR = 3u * 1024 * 1024, E_WOUT = 1024u * 1024, E_WFI = 5632u * 1024, E_WFO = 1024u * 2816;
constexpr size_t E_LAYER = E_WIN + E_WBR + E_WOUT + E_WFI + E_WFO;
constexpr size_t WS_PROJ = 2 * E_LAYER * 2;
constexpr size_t WS_DT = WS_PROJ + (size_t)ROWS * NPROJ * 2;
constexpr size_t WS_XB = WS_DT + (size_t)ROWS * 16 * 4;
constexpr size_t WS_YMB = WS_XB + (size_t)ROWS * 1024 * 2;
constexpr size_t WS_YHG = WS_YMB + (size_t)ROWS * 1024 * 2;
constexpr size_t WS_YRG = WS_YHG + (size_t)ROWS * 1024 * 2;
constexpr size_t WS_MRG = WS_YRG + (size_t)ROWS * 1024 * 2;
constexpr size_t WS_END = WS_MRG + (size_t)ROWS * 1024 * 2;
constexpr size_t WS_HB = WS_END + 256;
constexpr size_t WS_TOTAL = WS_HB + 2u * 2 * 16 * 3 * 2048 * 4;
constexpr size_t O_YP = 0, O_YS = 33554432, O_SSM_P = 34078720, O_SCV_P = 38273024, O_HG_P = 38469632, O_RG_P = 42663936, O_RCV_P = 42696704,
                 O_SSM_S = 42795008, O_SCV_S = 46989312, O_HG_S = 47185920, O_RG_S = 51380224, O_RCV_S = 51412992;
constexpr int LDS_BYTES = 3 * 49152;

enum { I_XP = 0, I_XS, I_SSM, I_SCV, I_HG, I_RG, I_RCV, I_NMIX, I_WIN, I_MCW, I_MCB, I_DTB, I_ALOG, I_MBD, I_MBNW, I_LBL, I_HGNW, I_RCW, I_RCB, I_RWA, I_RBA, I_RWI, I_RBI, I_RLAM, I_WBR, I_WOUT, I_NFFN, I_WFI, I_WFO, I_NFIN };

struct Params { const float* in[30]; float* out; unsigned char* ws; };

DEVI int tidx() { int t = __builtin_amdgcn_workitem_id_x(); asm volatile("" : "+v"(t)); return t; }
DEVI bf16_t f2bf(float f) { unsigned u = __float_as_uint(f); u += 0x7fffu + ((u >> 16) & 1u); return (bf16_t)(u >> 16); }
DEVI float bf2f(bf16_t h) { return __uint_as_float(((unsigned)h) << 16); }
DEVI float sigm(float x) { return 1.f / (1.f + __expf(-x)); }
DEVI float silu(float x) { return x / (1.f + __expf(-x)); }
DEVI float softplus(float x) { return x > 20.f ? x : log1pf(__expf(x)); }
DEVI float gelu_t(float x) { float u = 0.7978845608f * (x + 0.044715f * x * x * x); return x * sigm(2.f * u); }
DEVI float cexp(float x) { return __expf(fminf(x, 80.f)); }

DEVI const float* xrow_in(const Params& p, int seg, int r) {
    if (r < ROWS_P) { int b = r >> 9, tt = r & 511; return p.in[I_XP] + ((size_t)(b * 2048 + seg * SEGT + tt)) * D; }
    return p.in[I_XS] + (size_t)(r - ROWS_P) * D;
}
DEVI float* xrow_out(const Params& p, int seg, int r) {
    if (r < ROWS_P) { int b = r >> 9, tt = r & 511; return p.out + O_YP + ((size_t)(b * 2048 + seg * SEGT + tt)) * D; }
    return p.out + O_YS + (size_t)(r - ROWS_P) * D;
}

DEVI int map_win(int n) { return n < 3072 ? n : (n < 12288 ? n + 16 : (n < 12304 ? 3072 + (n - 12288) : -1)); }
DEVI int map_wfi(int n) { int T = n >> 7, q = (n >> 5) & 3, s = (n >> 4) & 1, i = n & 15; return s * FFH + 64 * T + 16 * q + i; }

DEVI void transpose_tile(const float* src, int ldsrc, bf16_t* dst, int K, int k0, int n0, int mode, float* tile  ) {
    const int tid = tidx(), c = tid & 63, rq = tid >> 6;
    int n = n0 + c, sn = mode == 1 ? map_win(n) : (mode == 2 ? map_wfi(n) : n);
#pragma unroll 4
    for (int rr = 0; rr < 16; ++rr) { int kl = rr * 4 + rq; tile[kl * 65 + c] = sn >= 0 ? src[(size_t)(k0 + kl) * ldsrc + sn] : 0.f; }
    __syncthreads();
#pragma unroll 4
    for (int rr = 0; rr < 16; ++rr) { int nl = rr * 4 + rq; dst[(size_t)(n0 + nl) * K + k0 + c] = f2bf(tile[c * 65 + nl]); }
    __syncthreads();
}

DEVI void phase_prep(const Params& p, char* lds) {
    float* tile = (float*)lds;
    bf16_t* wsb = (bf16_t*)p.ws;
    constexpr int T_WIN = 16 * 194, T_WBR = 3 * 256, T_WOUT = 256, T_WFI = 16 * 88, T_WFO = 44 * 16, T_L = T_WIN + T_WBR + T_WOUT + T_WFI + T_WFO;
    for (int t = blockIdx.x; t < 2 * T_L; t += gridDim.x) {
        int l = t / T_L, j = t % T_L;
        bf16_t* wl = wsb + (size_t)l * E_LAYER;
        if (j < T_WIN) { int kt = j & 15, nt = j >> 4; transpose_tile(p.in[I_WIN] + (size_t)l * 1024 * 12304, 12304, wl, 1024, kt * 64, nt * 64, 1, tile); continue; }
        j -= T_WIN;
        if (j < T_WBR) { int k = j >> 8, jj = j & 255, kt = jj & 15, nt = jj >> 4;
            transpose_tile(p.in[I_WBR] + ((size_t)l * 3 + k) * 1024 * 1024, 1024, wl + E_WIN + (size_t)k * 1024 * 1024, 1024, kt * 64, nt * 64, 0, tile); continue; }
        j -= T_WBR;
        if (j < T_WOUT) { int kt = j & 15, nt = j >> 4; transpose_tile(p.in[I_WOUT] + (size_t)l * 1024 * 1024, 1024, wl + E_WIN + E_WBR, 1024, kt * 64, nt * 64, 0, tile); continue; }
        j -= T_WOUT;
        if (j < T_WFI) { int kt = j & 15, nt = j >> 4; transpose_tile(p.in[I_WFI] + (size_t)l * 1024 * 5632, 5632, wl + E_WIN + E_WBR + E_WOUT, 1024, kt * 64, nt * 64, 2, tile); continue; }
        j -= T_WFI;
        { int kt = j % 44, nt = j / 44; transpose_tile(p.in[I_WFO] + (size_t)l * 2816 * 1024, 1024, wl + E_WIN + E_WBR + E_WOUT + E_WFI, 2816, kt * 64, nt * 64, 0, tile); }
    }
}

DEVI void phase_norm(const Params& p, int seg, int nrows, const float* w, bool from_input) {
    bf16_t* xb = (bf16_t*)(p.ws + WS_XB);
    const int lane = tidx() & 63, wv = tidx() >> 6;
    for (int r = blockIdx.x * 4 + wv; r < nrows; r += gridDim.x * 4) {
        const float* x = from_input ? xrow_in(p, seg, r) : xrow_out(p, seg, r);
        f32x4 v[4]; float ss = 0.f;
#pragma unroll
        for (int i = 0; i < 4; ++i) { v[i] = *(const f32x4*)(x + i * 256 + lane * 4); ss += v[i][0] * v[i][0] + v[i][1] * v[i][1] + v[i][2] * v[i][2] + v[i][3] * v[i][3]; }
#pragma unroll
        for (int o = 32; o >= 1; o >>= 1) ss += __shfl_xor(ss, o);
        float rs = rsqrtf(ss * (1.f / 1024.f) + 1e-6f);
#pragma unroll
        for (int i = 0; i < 4; ++i) { f32x4 wv4 = *(const f32x4*)(w + i * 256 + lane * 4); us4 o;
            o[0] = f2bf(v[i][0] * rs * wv4[0]); o[1] = f2bf(v[i][1] * rs * wv4[1]); o[2] = f2bf(v[i][2] * rs * wv4[2]); o[3] = f2bf(v[i][3] * rs * wv4[3]);
            *(us4*)(xb + (size_t)r * 1024 + i * 256 + lane * 4) = o; }
    }
}
DEVI void phase_final_norm(const Params& p, int seg, int nrows) {
    const float* w = p.in[I_NFIN];
    const int lane = tidx() & 63, wv = tidx() >> 6;
    for (int r = blockIdx.x * 4 + wv; r < nrows; r += gridDim.x * 4) {
        float* x = xrow_out(p, seg, r);
        f32x4 v[4]; float ss = 0.f;
#pragma unroll
        for (int i = 0; i < 4; ++i) { v[i] = *(const f32x4*)(x + i * 256 + lane * 4); ss += v[i][0] * v[i][0] + v[i][1] * v[i][1] + v[i][2] * v[i][2] + v[i][3] * v[i][3]; }
#pragma unroll
        for (int o = 32; o >= 1; o >>= 1) ss += __shfl_xor(ss, o);
        float rs = rsqrtf(ss * (1.f / 1024.f) + 1e-6f);
#pragma unroll
        for (int i = 0; i < 4; ++i) { f32x4 wv4 = *(const f32x4*)(w + i * 256 + lane * 4); f32x4 o;
            o[0] = v[i][0] * rs * wv4[0]; o[1] = v[i][1] * rs * wv4[1]; o[2] = v[i][2] * rs * wv4[2]; o[3] = v[i][3] * rs * wv4[3];
            *(f32x4*)(x + i * 256 + lane * 4) = o; }
    }
}
DEVI void phase_mbnorm(const Params& p, int l, int nrows) {
    bf16_t* y = (bf16_t*)(p.ws + WS_YMB); const float* w = p.in[I_MBNW] + l * 1024;
    const int lane = tidx() & 63, wv = tidx() >> 6;
    for (int it = blockIdx.x * 4 + wv; it < nrows * 4; it += gridDim.x * 4) {
        int r = it >> 2, g = it & 3; bf16_t* yp = y + (size_t)r * 1024 + g * 256 + lane * 4;
        us4 v = *(const us4*)yp; float f0 = bf2f(v[0]), f1 = bf2f(v[1]), f2 = bf2f(v[2]), f3 = bf2f(v[3]);
        float ss = f0 * f0 + f1 * f1 + f2 * f2 + f3 * f3;
#pragma unroll
        for (int o = 32; o >= 1; o >>= 1) ss += __shfl_xor(ss, o);
        float rs = rsqrtf(ss * (1.f / 256.f) + 1e-6f); f32x4 wv4 = *(const f32x4*)(w + g * 256 + lane * 4);
        us4 o; o[0] = f2bf(f0 * rs * wv4[0]); o[1] = f2bf(f1 * rs * wv4[1]); o[2] = f2bf(f2 * rs * wv4[2]); o[3] = f2bf(f3 * rs * wv4[3]);
        *(us4*)yp = o;
    }
}

constexpr int G_STAGE = 49152;
DEVI void stage_rc(int b, int& R, int& C) { int st = b >> 10, sb = b & 1023, swz = sb ^ (((sb >> 9) & 1) << 5); R = (st >> 1) * 16 + (swz >> 6); C = (st & 1) * 32 + ((swz & 63) >> 1); }
#define WAIT_V(n) asm volatile("s_waitcnt vmcnt(" #n ")" ::: "memory")
#define RAW_BAR() do { asm volatile("" ::: "memory"); __builtin_amdgcn_s_barrier(); asm volatile("" ::: "memory"); } while (0)
DEVI void stage_tile(const bf16_t* A, const bf16_t* Bt, int K, int t, char* st, int tid) {
#pragma unroll
    for (int i = 0; i < 4; ++i) { int b = tid * 16 + i * 4096, R, C; stage_rc(b, R, C); size_t o = (size_t)R * K + t * 64 + C;
        __builtin_amdgcn_global_load_lds((const unsigned*)(A + o), (unsigned*)(st + b), 16, 0, 0);
        __builtin_amdgcn_global_load_lds((const unsigned*)(A + (size_t)128 * K + o), (unsigned*)(st + 16384 + b), 16, 0, 0);
        __builtin_amdgcn_global_load_lds((const unsigned*)(Bt + o), (unsigned*)(st + 32768 + b), 16, 0, 0); }
}
template <int UNR>
DEVI void gemm_kloop(f32x4 (&acc)[8][4], const bf16_t* A, const bf16_t* Bt, int K, char* lds) {
    const int tid = tidx(), lane = tid & 63, wid = tid >> 6, wr = wid >> 1, wc = wid & 1, fr = lane & 15, fq = lane >> 4;
    const int fo = (fr * 64 + fq * 16) ^ ((fr >> 3) << 5);
    const int aoff = wr * 16384 + fo, boff = 32768 + wc * 4 * 2048 + fo;
    const int nt = K >> 6;
    WAIT_V(0); RAW_BAR();
    stage_tile(A, Bt, K, 0, lds, tid);
    stage_tile(A, Bt, K, 1, lds + G_STAGE, tid);
    int s = 0;
    for (int t = 0; t < nt; ++t) {
        if (t + 1 < nt) WAIT_V(12); else WAIT_V(0);
        RAW_BAR();
        if (t + 2 < nt) { int s2 = s + 2; if (s2 >= 3) s2 -= 3; stage_tile(A, Bt, K, t + 2, lds + s2 * G_STAGE, tid); }
        const char* st = lds + s * G_STAGE;
        if (UNR == 2) {
            bf16x8 af[2][8], bfr[2][4];
#define RDF(i) do { if ((i) < 4) bfr[0][(i) & 3] = *(const bf16x8*)(st + boff + (((i) & 3) * 2) * 1024); \
                    else if ((i) < 12) af[0][((i) - 4) & 7] = *(const bf16x8*)(st + aoff + ((((i) - 4) & 7) * 2) * 1024); \
                    else if ((i) < 16) bfr[1][(i) & 3] = *(const bf16x8*)(st + boff + (((i) & 3) * 2 + 1) * 1024); \
                    else af[1][(i) & 7] = *(const bf16x8*)(st + aoff + (((i) & 7) * 2 + 1) * 1024); } while (0)
#pragma unroll
            for (int i = 0; i < 6; ++i) RDF(i);
#pragma unroll
            for (int g = 0; g < 16; ++g) {
                __builtin_amdgcn_sched_barrier(0);
                if (g < 4) { RDF(6 + 2 * g); RDF(7 + 2 * g); } else if (g < 14) { RDF(10 + g); }
#pragma unroll
                for (int n = 0; n < 4; ++n) acc[g & 7][n] = __builtin_amdgcn_mfma_f32_16x16x32_bf16(bfr[g >> 3][n], af[g >> 3][g & 7], acc[g & 7][n], 0, 0, 0);
            }
            __builtin_amdgcn_sched_barrier(0);
#undef RDF
        } else {
#pragma unroll 1
            for (int ks = 0; ks < 2; ++ks) {
                bf16x8 af[8], bfr[4];
#define RDF(i) do { if ((i) < 4) bfr[(i) & 3] = *(const bf16x8*)(st + boff + (((i) & 3) * 2 + ks) * 1024); \
                    else af[((i) - 4) & 7] = *(const bf16x8*)(st + aoff + ((((i) - 4) & 7) * 2 + ks) * 1024); } while (0)
#pragma unroll
                for (int i = 0; i < 6; ++i) RDF(i);
#pragma unroll
                for (int g = 0; g < 8; ++g) {
                    __builtin_amdgcn_sched_barrier(0);
                    if (g < 6) RDF(6 + g);
#pragma unroll
                    for (int n = 0; n < 4; ++n) acc[g][n] = __builtin_amdgcn_mfma_f32_16x16x32_bf16(bfr[n], af[g], acc[g][n], 0, 0, 0);
                }
                __builtin_amdgcn_sched_barrier(0);
#undef RDF
            }
        }
        s = s + 1 == 3 ? 0 : s + 1;
    }
}
DEVI bool next_tile(int it, int MT, int NT, int& mt, int& nt) {
    int x = blockIdx.x & 7, bl = blockIdx.x >> 3, G8 = gridDim.x >> 3;
    int nI = (MT - x + 7) >> 3; long j = (long)it * G8 + bl;
    if (j >= (long)nI * NT) return false;
    int i = (int)(j % nI); nt = (int)(j / nI); mt = x + 8 * i; return true;
}
#define ZERO_ACC(a) _Pragma("unroll") for (int m_ = 0; m_ < 8; ++m_) _Pragma("unroll") for (int n_ = 0; n_ < 4; ++n_) a[m_][n_] = (f32x4){0.f, 0.f, 0.f, 0.f}
#define EPI_IDS const int lane = tidx() & 63, wid = tidx() >> 6, wr = wid >> 1, wc = wid & 1, fr = lane & 15, fq = lane >> 4

DEVI void phase_proj(const Params& p, int l, int MT, char* lds) {
    const bf16_t* xb = (const bf16_t*)(p.ws + WS_XB); const bf16_t* wt = (const bf16_t*)p.ws + (size_t)l * E_LAYER;
    bf16_t* proj = (bf16_t*)(p.ws + WS_PROJ); float* dtb = (float*)(p.ws + WS_DT);
    int mt, nt;
    for (int it = 0; next_tile(it, MT, 97, mt, nt); ++it) {
        f32x4 acc[8][4]; ZERO_ACC(acc);
        gemm_kloop<2>(acc, xb + (size_t)mt * 256 * 1024, wt + (size_t)nt * 128 * 1024, 1024, lds);
        EPI_IDS;
        int ty = nt < 8 ? 1 : nt < 24 ? 0 : nt < 32 ? 1 : nt < 48 ? 0 : nt < 56 ? 1 : nt < 64 ? 2 : nt < 72 ? 0 : nt < 96 ? 3 : 4;
        if (ty == 4) {
            if (wc == 0) {
                f32x4 b = *(const f32x4*)(p.in[I_DTB] + l * 16 + fq * 4);
#pragma unroll
                for (int m = 0; m < 8; ++m) { int row = mt * 256 + wr * 128 + m * 16 + fr; f32x4 v = acc[m][0];
                    f32x4 o; o[0] = softplus(v[0] + b[0]); o[1] = softplus(v[1] + b[1]); o[2] = softplus(v[2] + b[2]); o[3] = softplus(v[3] + b[3]);
                    *(f32x4*)(dtb + (size_t)row * 16 + fq * 4) = o; }
            }
        } else {
#pragma unroll
            for (int m = 0; m < 8; ++m) { int row = mt * 256 + wr * 128 + m * 16 + fr;
#pragma unroll
                for (int n = 0; n < 4; ++n) { int col = nt * 128 + wc * 64 + n * 16 + fq * 4; f32x4 v = acc[m][n]; us4 o;
#pragma unroll
                    for (int j = 0; j < 4; ++j) { float x = v[j]; x = ty == 1 ? silu(x) : ty == 2 ? gelu_t(x) : ty == 3 ? sigm(x) : x; o[j] = f2bf(x); }
                    *(us4*)(proj + (size_t)row * NPROJ + col) = o; } }
        }
    }
}
DEVI void phase_merge(const Params& p, int l, int MT, char* lds) {
    const bf16_t* wt = (const bf16_t*)p.ws + (size_t)l * E_LAYER + E_WIN; const bf16_t* proj = (const bf16_t*)(p.ws + WS_PROJ);
    bf16_t* mrg = (bf16_t*)(p.ws + WS_MRG);
    int mt, nt;
    for (int it = 0; next_tile(it, MT, 8, mt, nt); ++it) {
        f32x4 tot[8][4]; ZERO_ACC(tot);
#pragma unroll 1
        for (int k = 0; k < 3; ++k) {
            const bf16_t* y = (const bf16_t*)(p.ws + WS_YMB + (size_t)k * ROWS * 1024 * 2);
            f32x4 acc[8][4]; ZERO_ACC(acc);
            gemm_kloop<1>(acc, y + (size_t)mt * 256 * 1024, wt + (size_t)k * 1024 * 1024 + (size_t)nt * 128 * 1024, 1024, lds);
            EPI_IDS;
#pragma unroll
            for (int m = 0; m < 8; ++m) { int row = mt * 256 + wr * 128 + m * 16 + fr; asm volatile("" ::: "memory");
#pragma unroll
                for (int n = 0; n < 4; ++n) { int col = nt * 128 + wc * 64 + n * 16 + fq * 4; us4 g = *(const us4*)(proj + (size_t)row * NPROJ + PC_MG + k * 1024 + col);
#pragma unroll
                    for (int j = 0; j < 4; ++j) tot[m][n][j] += acc[m][n][j] * bf2f(g[j]); } }
        }
        EPI_IDS;
#pragma unroll
        for (int m = 0; m < 8; ++m) { int row = mt * 256 + wr * 128 + m * 16 + fr;
#pragma unroll
            for (int n = 0; n < 4; ++n) { int col = nt * 128 + wc * 64 + n * 16 + fq * 4; us4 o;
#pragma unroll
                for (int j = 0; j < 4; ++j) o[j] = f2bf(tot[m][n][j]);
                *(us4*)(mrg + (size_t)row * 1024 + col) = o; } }
    }
}
DEVI void phase_resid(const Params& p, int seg, int MT, const bf16_t* A, int K, const bf16_t* Bt, bool from_input, char* lds) {
    int mt, nt;
    for (int it = 0; next_tile(it, MT, 8, mt, nt); ++it) {
        f32x4 acc[8][4]; ZERO_ACC(acc);
        gemm_kloop<2>(acc, A + (size_t)mt * 256 * K, Bt + (size_t)nt * 128 * K, K, lds);
        EPI_IDS;
#pragma unroll
        for (int m = 0; m < 8; ++m) { int row = mt * 256 + wr * 128 + m * 16 + fr;
            const float* xi = from_input ? xrow_in(p, seg, row) : xrow_out(p, seg, row); float* xo = xrow_out(p, seg, row);
#pragma unroll
            for (int n = 0; n < 4; ++n) { int col = nt * 128 + wc * 64 + n * 16 + fq * 4; f32x4 v = *(const f32x4*)(xi + col); *(f32x4*)(xo + col) = v + acc[m][n]; } }
    }
}
DEVI void phase_ffn_in(const Params& p, int l, int MT, char* lds) {
    const bf16_t* xb = (const bf16_t*)(p.ws + WS_XB); const bf16_t* wt = (const bf16_t*)p.ws + (size_t)l * E_LAYER + E_WIN + E_WBR + E_WOUT;
    bf16_t* act = (bf16_t*)(p.ws + WS_PROJ);
    int mt, nt;
    for (int it = 0; next_tile(it, MT, 44, mt, nt); ++it) {
        f32x4 acc[8][4]; ZERO_ACC(acc);
        gemm_kloop<2>(acc, xb + (size_t)mt * 256 * 1024, wt + (size_t)nt * 128 * 1024, 1024, lds);
        EPI_IDS;
#pragma unroll
        for (int m = 0; m < 8; ++m) { int row = mt * 256 + wr * 128 + m * 16 + fr;
#pragma unroll
            for (int q = 0; q < 2; ++q) { int col = nt * 64 + 16 * (2 * wc + q) + fq * 4; us4 o;
#pragma unroll
                for (int j = 0; j < 4; ++j) o[j] = f2bf(silu(acc[m][2 * q][j]) * acc[m][2 * q + 1][j]);
                *(us4*)(act + (size_t)row * FFH + col) = o; } }
    }
}

struct Seq { int row0, nchunk, Q, b, samp, seg; };
DEVI Seq make_seq(int seg, int sq) { Seq s; s.seg = seg; if (sq < 16) { s.row0 = sq * SEGT; s.nchunk = 8; s.Q = 64; s.b = sq; s.samp = 0; } else { s.b = sq - 16; s.row0 = ROWS_P + s.b * 32; s.nchunk = 1; s.Q = 32; s.samp = 1; } return s; }

template <int NF, int KS>
DEVI void lds_mma(f32x4* acc, const bf16_t* X, int ldx, int m0, const bf16_t* Y, int ldy, int n0) {
    const int lane = tidx() & 63, fr = lane & 15, fq = lane >> 4;
#pragma unroll
    for (int ks = 0; ks < KS; ++ks) {
        bf16x8 a = *(const bf16x8*)(X + (m0 + fr) * ldx + ks * 32 + fq * 8);
#pragma unroll
        for (int nf = 0; nf < NF; ++nf) { bf16x8 b = *(const bf16x8*)(Y + (n0 + nf * 16 + fr) * ldy + ks * 32 + fq * 8); acc[nf] = __builtin_amdgcn_mfma_f32_16x16x32_bf16(a, b, acc[nf], 0, 0, 0); }
    }
}

DEVI void conv_load(uint4 (&r)[4], const bf16_t* proj, int row0, int tq, int pcol) {
#pragma unroll
    for (int k = 0; k < 4; ++k) { int ts = tq - 3 + k; ts = ts < 0 ? 0 : ts; r[k] = *(const uint4*)(proj + (size_t)(row0 + ts) * NPROJ + pcol); }
}
DEVI void touch4(uint4& v) { asm volatile("" : "+v"(v.x), "+v"(v.y), "+v"(v.z), "+v"(v.w)); }
DEVI void conv_compute(const uint4 (&r)[4], int tq, const float* hl, const float* cwl, int HC, int cl, float (&out)[8], float (&raw)[8]) {
    { f32x4 b0 = *(const f32x4*)(cwl + 4 * HC + cl), b1 = *(const f32x4*)(cwl + 4 * HC + cl + 4);
      out[0] = b0[0]; out[1] = b0[1]; out[2] = b0[2]; out[3] = b0[3]; out[4] = b1[0]; out[5] = b1[1]; out[6] = b1[2]; out[7] = b1[3]; }
#pragma unroll
    for (int k = 0; k < 4; ++k) {
        const int ts = tq - 3 + k; float v[8];
        v[0] = __uint_as_float(r[k].x << 16); v[1] = __uint_as_float(r[k].x & 0xffff0000u); v[2] = __uint_as_float(r[k].y << 16); v[3] = __uint_as_float(r[k].y & 0xffff0000u);
        v[4] = __uint_as_float(r[k].z << 16); v[5] = __uint_as_float(r[k].z & 0xffff0000u); v[6] = __uint_as_float(r[k].w << 16); v[7] = __uint_as_float(r[k].w & 0xffff0000u);
        if (k < 3) { int hi = 3 + ts; hi = hi < 0 ? 0 : (hi > 2 ? 2 : hi); const bool uh = ts < 0;
            f32x4 h0 = *(const f32x4*)(hl + hi * HC + cl), h1 = *(const f32x4*)(hl + hi * HC + cl + 4);
            v[0] = uh ? h0[0] : v[0]; v[1] = uh ? h0[1] : v[1]; v[2] = uh ? h0[2] : v[2]; v[3] = uh ? h0[3] : v[3];
            v[4] = uh ? h1[0] : v[4]; v[5] = uh ? h1[1] : v[5]; v[6] = uh ? h1[2] : v[6]; v[7] = uh ? h1[3] : v[7]; }
        f32x4 w0 = *(const f32x4*)(cwl + k * HC + cl), w1 = *(const f32x4*)(cwl + k * HC + cl + 4);
        out[0] += v[0] * w0[0]; out[1] += v[1] * w0[1]; out[2] += v[2] * w0[2]; out[3] += v[3] * w0[3];
        out[4] += v[4] * w1[0]; out[5] += v[5] * w1[1]; out[6] += v[6] * w1[2]; out[7] += v[7] * w1[3];
        if (k == 3) {
#pragma unroll
            for (int e = 0; e < 8; ++e) raw[e] = v[e]; }
    }
}

DEVI void ssd_unit(const Params& p, int l, Seq sq, int hd, char* lds) {
    bf16_t* Bm = (bf16_t*)lds;
    bf16_t* R2 = (bf16_t*)(lds + 17408);
    bf16_t* xT = (bf16_t*)(lds + 35840);
    bf16_t* hb = (bf16_t*)(lds + 45056);
    float* fl = (float*)(lds + 62464);
    const int tid = tidx(), lane = tid & 63, w = tid >> 6, fr = lane & 15, fq = lane >> 4;
    const bf16_t* proj = (const bf16_t*)(p.ws + WS_PROJ); const float* dtb = (const float*)(p.ws + WS_DT); bf16_t* ymb = (bf16_t*)(p.ws + WS_YMB);
    const int g = hd >> 2;
    const float a = -__expf(p.in[I_ALOG][l * 16 + hd]), Dv = p.in[I_MBD][l * 16 + hd];
    const float* cw = p.in[I_MCW] + (size_t)l * 4 * 2048; const float* cbias = p.in[I_MCB] + l * 2048;
    float* cwl = (float*)(lds + 63488);
    float* hl = (float*)(lds + 69888);
    const float* st_in; float* st_out; const float* hist; float* hist_out; float* hist_out2 = nullptr;
    float* hbuf = (float*)(p.ws + WS_HB);
    if (sq.samp) { st_in = p.in[I_SSM] + ((size_t)(l * 16 + sq.b) * 16 + hd) * 8192; st_out = p.out + O_SSM_S + ((size_t)(l * 16 + sq.b) * 16 + hd) * 8192;
        hist = p.in[I_SCV] + (size_t)(l * 16 + sq.b) * 3 * 2048; hist_out = p.out + O_SCV_S + (size_t)(l * 16 + sq.b) * 3 * 2048; }
    else { st_out = p.out + O_SSM_P + ((size_t)(l * 16 + sq.b) * 16 + hd) * 8192; st_in = sq.seg ? st_out : nullptr;
        hist_out = hbuf + ((size_t)((sq.seg & 1) * 2 + l) * 16 + sq.b) * 3 * 2048; hist = sq.seg ? hbuf + ((size_t)(((sq.seg + 1) & 1) * 2 + l) * 16 + sq.b) * 3 * 2048 : nullptr;
        if (sq.seg == NSEG - 1) hist_out2 = p.out + O_SCV_P + (size_t)(l * 16 + sq.b) * 3 * 2048; }
    for (int idx = tid; idx < 1600; idx += 256) { int k = idx / 320, cc = idx - k * 320; int ch = cc < 64 ? hd * 64 + cc : (cc < 192 ? 1024 + g * 128 + (cc - 64) : 1536 + g * 128 + (cc - 192));
        cwl[idx] = k < 4 ? cw[k * 2048 + ch] : cbias[ch];
        if (idx < 960) hl[idx] = hist ? hist[k * 2048 + ch] : 0.f; }
    f32x4 hacc[8];
#pragma unroll
    for (int nf = 0; nf < 8; ++nf)
#pragma unroll
        for (int r = 0; r < 4; ++r) { int pp = 16 * w + 4 * fq + r, n = 16 * nf + fr; float v = st_in ? st_in[pp * 128 + n] : 0.f; hacc[nf][r] = v; hb[pp * 136 + n] = f2bf(v); }
    for (int c = 0; c < sq.nchunk; ++c) {
        const int tid = tidx(), lane = tid & 63, w = tid >> 6, fr = lane & 15, fq = lane >> 4;
        const int rowc = sq.row0 + c * 64; const bool lastc = (c == sq.nchunk - 1);
        if (w == 0) {
            float dt = lane < sq.Q ? dtb[(size_t)(rowc + lane) * 16 + hd] : 0.f; float v = dt * a;
#pragma unroll
            for (int o = 1; o < 64; o <<= 1) { float t = __shfl_up(v, o); if (lane >= o) v += t; }
            float last = __shfl(v, 63);
            fl[lane] = v; fl[64 + lane] = dt; fl[128 + lane] = __expf(last - v) * dt; fl[192 + lane] = __expf(v);
        }
        __syncthreads();
        const float elast = __expf(fl[63]);
        {   uint4 rx_[2][4];
#pragma unroll
            for (int i = 0; i < 2; ++i) { int it = tid + 256 * i, t = it >> 3, c8 = (it & 7) * 8; conv_load(rx_[i], proj, sq.row0, c * 64 + t, PC_XBC + hd * 64 + c8); }
#pragma unroll
            for (int i = 0; i < 2; ++i)
#pragma unroll
                for (int k = 0; k < 4; ++k) touch4(rx_[i][k]);
#pragma unroll
            for (int i = 0; i < 2; ++i) { int it = tid + 256 * i, t = it >> 3, c8 = (it & 7) * 8; float o[8], raw[8]; int ch = hd * 64 + c8; const bool tv = t < sq.Q;
                conv_compute(rx_[i], c * 64 + t, hl, cwl, 320, c8, o, raw);
#pragma unroll
                for (int e = 0; e < 8; ++e) { float s_ = silu(o[e]); o[e] = tv ? s_ : 0.f; }
                if (lastc && tv && t >= sq.Q - 3) {
#pragma unroll
                    for (int e = 0; e < 8; ++e) { hist_out[(t - (sq.Q - 3)) * 2048 + ch + e] = raw[e]; if (hist_out2) hist_out2[(t - (sq.Q - 3)) * 2048 + ch + e] = raw[e]; } }
#pragma unroll
                for (int e = 0; e < 8; ++e) xT[(c8 + e) * 72 + t] = f2bf(o[e]); }
        }
        {   uint4 rb_[4][4];
#pragma unroll
            for (int i = 0; i < 4; ++i) { int it = tid + 256 * i, t = it >> 4, c8 = (it & 15) * 8; conv_load(rb_[i], proj, sq.row0, c * 64 + t, PC_XBC + 1024 + g * 128 + c8); }
#pragma unroll
            for (int i = 0; i < 4; ++i)
#pragma unroll
                for (int k = 0; k < 4; ++k) touch4(rb_[i][k]);
#pragma unroll
            for (int i = 0; i < 4; ++i) { int it = tid + 256 * i, t = it >> 4, c8 = (it & 15) * 8; float o[8], raw[8]; int ch = 1024 + g * 128 + c8; const bool tv = t < sq.Q;
                conv_compute(rb_[i], c * 64 + t, hl, cwl, 320, 64 + c8, o, raw);
#pragma unroll
                for (int e = 0; e < 8; ++e) { float s_ = silu(o[e]); o[e] = tv ? s_ : 0.f; }
                if (lastc && tv && (hd & 3) == 0 && t >= sq.Q - 3) {
#pragma unroll
                    for (int e = 0; e < 8; ++e) { hist_out[(t - (sq.Q - 3)) * 2048 + ch + e] = raw[e]; if (hist_out2) hist_out2[(t - (sq.Q - 3)) * 2048 + ch + e] = raw[e]; } }
                us8 ov; float we = fl[128 + t];
#pragma unroll
                for (int e = 0; e < 8; ++e) { ov[e] = f2bf(o[e]); R2[(c8 + e) * 72 + t] = f2bf(o[e] * we); }
                *(us8*)(Bm + t * 136 + c8) = ov; }
        }
        __syncthreads();
#pragma unroll
        for (int nf = 0; nf < 8; ++nf) hacc[nf] *= elast;
        lds_mma<8, 2>(hacc, xT, 72, 16 * w, R2, 72, 0);
        __syncthreads();
        {   uint4 rc_[4][4];
#pragma unroll
            for (int i = 0; i < 4; ++i) { int it = tid + 256 * i, t = it >> 4, c8 = (it & 15) * 8; conv_load(rc_[i], proj, sq.row0, c * 64 + t, PC_XBC + 1536 + g * 128 + c8); }
#pragma unroll
            for (int i = 0; i < 4; ++i)
#pragma unroll
                for (int k = 0; k < 4; ++k) touch4(rc_[i][k]);
#pragma unroll
            for (int i = 0; i < 4; ++i) { int it = tid + 256 * i, t = it >> 4, c8 = (it & 15) * 8; float o[8], raw[8]; int ch = 1536 + g * 128 + c8; const bool tv = t < sq.Q;
                conv_compute(rc_[i], c * 64 + t, hl, cwl, 320, 192 + c8, o, raw);
#pragma unroll
                for (int e = 0; e < 8; ++e) { float s_ = silu(o[e]); o[e] = tv ? s_ : 0.f; }
                if (lastc && tv && (hd & 3) == 0 && t >= sq.Q - 3) {
#pragma unroll
                    for (int e = 0; e < 8; ++e) { hist_out[(t - (sq.Q - 3)) * 2048 + ch + e] = raw[e]; if (hist_out2) hist_out2[(t - (sq.Q - 3)) * 2048 + ch + e] = raw[e]; } }
                us8 ov;
#pragma unroll
                for (int e = 0; e < 8; ++e) ov[e] = f2bf(o[e]);
                *(us8*)(R2 + t * 136 + c8) = ov; }
        }
        __syncthreads();
        f32x4 cbv[4];
#pragma unroll
        for (int nf = 0; nf < 4; ++nf) cbv[nf] = (f32x4){0.f, 0.f, 0.f, 0.f};
        lds_mma<4, 4>(cbv, Bm, 136, 16 * w, R2, 136, 0);
        __syncthreads();
#pragma unroll
        for (int nf = 0; nf < 4; ++nf) { int i = 16 * nf + fr; float ai = fl[i]; us4 o;
#pragma unroll
            for (int r = 0; r < 4; ++r) { int j = 16 * w + 4 * fq + r; float v = (j <= i) ? cbv[nf][r] * __expf(ai - fl[j]) * fl[64 + j] : 0.f; o[r] = f2bf(v); }
            *(us4*)(Bm + i * 72 + 16 * w + 4 * fq) = o; }
        __syncthreads();
        f32x4 ya[4];
#pragma unroll
        for (int nf = 0; nf < 4; ++nf) ya[nf] = (f32x4){0.f, 0.f, 0.f, 0.f};
        lds_mma<4, 4>(ya, hb, 136, 16 * w, R2, 136, 0);
#pragma unroll
        for (int nf = 0; nf < 4; ++nf) ya[nf] *= fl[192 + 16 * nf + fr];
        lds_mma<4, 2>(ya, xT, 72, 16 * w, Bm, 72, 0);
#pragma unroll
        for (int nf = 0; nf < 4; ++nf) { int i = 16 * nf + fr, p0 = 16 * w + 4 * fq;
            us4 z = *(const us4*)(proj + (size_t)(rowc + i) * NPROJ + PC_Z + hd * 64 + p0);
            if (i < sq.Q) { us4 o;
#pragma unroll
                for (int r = 0; r < 4; ++r) o[r] = f2bf((ya[nf][r] + Dv * bf2f(xT[(p0 + r) * 72 + i])) * bf2f(z[r]));
                *(us4*)(ymb + (size_t)(rowc + i) * 1024 + hd * 64 + p0) = o; } }
        __syncthreads();
#pragma unroll
        for (int nf = 0; nf < 8; ++nf)
#pragma unroll
            for (int r = 0; r < 4; ++r) hb[(16 * w + 4 * fq + r) * 136 + 16 * nf + fr] = f2bf(hacc[nf][r]);
    }
#pragma unroll
    for (int nf = 0; nf < 8; ++nf)
#pragma unroll
        for (int r = 0; r < 4; ++r) st_out[(16 * w + 4 * fq + r) * 128 + 16 * nf + fr] = hacc[nf][r];
    __syncthreads();
}

DEVI void hgrn_unit(const Params& p, int l, Seq sq, int h, char* lds) {
    bf16_t* sb = (bf16_t*)lds;
    bf16_t* qt = (bf16_t*)(lds + 34816);
    bf16_t* kt = (bf16_t*)(lds + 52224);
    bf16_t* att = (bf16_t*)lds;
    bf16_t* kT = (bf16_t*)(lds + 9216);
    bf16_t* vT = (bf16_t*)(lds + 27648);
    float* T0 = (float*)(lds + 69632); float* T1 = T0 + 128; float* ssq = T0 + 256;
    const int tid = tidx(), lane = tid & 63, w = tid >> 6, fr = lane & 15, fq = lane >> 4;
    const int k = tid & 127, half = tid >> 7;
    const bf16_t* proj = (const bf16_t*)(p.ws + WS_PROJ); bf16_t* yhg = (bf16_t*)(p.ws + WS_YHG);
    float lb = 0.f;
    if (l == 1) { float a0 = p.in[I_LBL][h * 128 + k], a1 = p.in[I_LBL][1024 + h * 128 + k]; lb = 1.f / (1.f + __expf(a0 - a1)); }
    const float* nw = p.in[I_HGNW] + l * 128;
    const float* st_in; float* st_out;
    if (sq.samp) { st_in = p.in[I_HG] + ((size_t)(l * 16 + sq.b) * 8 + h) * 16384; st_out = p.out + O_HG_S + ((size_t)(l * 16 + sq.b) * 8 + h) * 16384; }
    else { st_out = p.out + O_HG_P + ((size_t)(l * 16 + sq.b) * 8 + h) * 16384; st_in = sq.seg ? st_out : nullptr; }
    f32x4 hacc[2][8];
#pragma unroll
    for (int mf = 0; mf < 2; ++mf)
#pragma unroll
        for (int nf = 0; nf < 8; ++nf)
#pragma unroll
            for (int r = 0; r < 4; ++r) hacc[mf][nf][r] = st_in ? st_in[(32 * w + 16 * mf + 4 * fq + r) * 128 + 16 * nf + fr] : 0.f;
    for (int c = 0; c < sq.nchunk; ++c) {
        const int tid = tidx(), lane = tid & 63, w = tid >> 6, fr = lane & 15, fq = lane >> 4, k = tid & 127, half = tid >> 7;
        const int rowc = sq.row0 + c * 64;
        {
            const bf16_t* pr = proj + (size_t)(rowc + 32 * half) * NPROJ + h * 128 + k;
            unsigned fu[32], qu[32];
#pragma unroll
            for (int jj = 0; jj < 32; ++jj) { fu[jj] = pr[(size_t)jj * NPROJ + PC_HF]; qu[jj] = pr[(size_t)jj * NPROJ + PC_HQ]; }
#pragma unroll
            for (int jj = 0; jj < 32; ++jj) asm volatile("" : "+v"(fu[jj]), "+v"(qu[jj]));
            if (tid < 64) ssq[tid] = 0.f;
            float run = 0.f;
            if (half == 0) {
#pragma unroll
                for (int jj = 31; jj >= 0; --jj) { bool valid = jj < sq.Q; float f = __uint_as_float(fu[jj] << 16);
                    float sg = __builtin_amdgcn_rcpf(1.f + __expf(-f)); float lg0 = __logf(lb + (1.f - lb) * sg); float lg = valid ? lg0 : 0.f;
                    float kk0 = (1.f - lb) * (1.f - sg); float kk = valid ? kk0 : 0.f; float q0 = __uint_as_float(qu[jj] << 16); float q = valid ? q0 : 0.f;
                    qt[jj * 136 + k] = f2bf(q * cexp(-run)); kt[jj * 136 + k] = f2bf(kk * cexp(run)); run += lg; }
                T0[k] = run;
            } else {
#pragma unroll
                for (int jj = 0; jj < 32; ++jj) { bool valid = (32 + jj) < sq.Q; float f = __uint_as_float(fu[jj] << 16);
                    float sg = __builtin_amdgcn_rcpf(1.f + __expf(-f)); float lg0 = __logf(lb + (1.f - lb) * sg); float lg = valid ? lg0 : 0.f;
                    float kk0 = (1.f - lb) * (1.f - sg); float kk = valid ? kk0 : 0.f; float q0 = __uint_as_float(qu[jj] << 16); float q = valid ? q0 : 0.f;
                    run += lg; qt[(32 + jj) * 136 + k] = f2bf(q * cexp(run)); kt[(32 + jj) * 136 + k] = f2bf(kk * cexp(-run)); }
                T1[k] = run;
            }
        }
        __syncthreads();
#pragma unroll
        for (int mf = 0; mf < 2; ++mf) { int k0 = 32 * w + 16 * mf + 4 * fq; float e0 = __expf(T0[k0]), e1 = __expf(T0[k0 + 1]), e2 = __expf(T0[k0 + 2]), e3 = __expf(T0[k0 + 3]);
#pragma unroll
            for (int nf = 0; nf < 8; ++nf) { hacc[mf][nf][0] *= e0; hacc[mf][nf][1] *= e1; hacc[mf][nf][2] *= e2; hacc[mf][nf][3] *= e3;
                us4 o; o[0] = f2bf(hacc[mf][nf][0]); o[1] = f2bf(hacc[mf][nf][1]); o[2] = f2bf(hacc[mf][nf][2]); o[3] = f2bf(hacc[mf][nf][3]);
                *(us4*)(sb + (16 * nf + fr) * 136 + k0) = o; } }
        f32x4 at[4];
#pragma unroll
        for (int nf = 0; nf < 4; ++nf) at[nf] = (f32x4){0.f, 0.f, 0.f, 0.f};
        lds_mma<4, 4>(at, kt, 136, 16 * w, qt, 136, 0);
        __syncthreads();
        f32x4 oacc[2][4];
#pragma unroll
        for (int mf = 0; mf < 2; ++mf) {
#pragma unroll
            for (int nf = 0; nf < 4; ++nf) oacc[mf][nf] = (f32x4){0.f, 0.f, 0.f, 0.f};
            lds_mma<4, 4>(oacc[mf], sb, 136, 32 * w + 16 * mf, qt, 136, 0); }
        __syncthreads();
#pragma unroll
        for (int nf = 0; nf < 4; ++nf) { int i = 16 * nf + fr; us4 o;
#pragma unroll
            for (int r = 0; r < 4; ++r) { int j = 16 * w + 4 * fq + r; o[r] = f2bf(j <= i ? at[nf][r] : 0.f); }
            *(us4*)(att + i * 72 + 16 * w + 4 * fq) = o; }
        {   const bf16_t* pv = proj + (size_t)(rowc + 32 * half) * NPROJ + PC_HI + h * 128 + k;
            unsigned vu[32];
#pragma unroll
            for (int jj = 0; jj < 32; ++jj) vu[jj] = pv[(size_t)jj * NPROJ];
#pragma unroll
            for (int jj = 0; jj < 32; ++jj) asm volatile("" : "+v"(vu[jj]));
#pragma unroll
            for (int q4 = 0; q4 < 4; ++q4) { us8 kv, vv;
#pragma unroll
                for (int e = 0; e < 8; ++e) { int jj = q4 * 8 + e; bool valid = (32 * half + jj) < sq.Q; kv[e] = kt[(32 * half + jj) * 136 + k]; vv[e] = valid ? (bf16_t)vu[jj] : (bf16_t)0; }
                *(us8*)(kT + k * 72 + 32 * half + q4 * 8) = kv; *(us8*)(vT + k * 72 + 32 * half + q4 * 8) = vv; } }
        __syncthreads();
#pragma unroll
        for (int mf = 0; mf < 2; ++mf) {
            lds_mma<4, 2>(oacc[mf], vT, 72, 32 * w + 16 * mf, att, 72, 0);
            lds_mma<8, 2>(hacc[mf], kT, 72, 32 * w + 16 * mf, vT, 72, 0);
            int k0 = 32 * w + 16 * mf + 4 * fq; float e0 = __expf(T1[k0]), e1 = __expf(T1[k0 + 1]), e2 = __expf(T1[k0 + 2]), e3 = __expf(T1[k0 + 3]);
#pragma unroll
            for (int nf = 0; nf < 8; ++nf) { hacc[mf][nf][0] *= e0; hacc[mf][nf][1] *= e1; hacc[mf][nf][2] *= e2; hacc[mf][nf][3] *= e3; } }
#pragma unroll
        for (int nf = 0; nf < 4; ++nf) { float s = 0.f;
#pragma unroll
            for (int mf = 0; mf < 2; ++mf)
#pragma unroll
                for (int r = 0; r < 4; ++r) s += oacc[mf][nf][r] * oacc[mf][nf][r];
            s += __shfl_xor(s, 16); s += __shfl_xor(s, 32);
            if (fq == 0) atomicAdd(&ssq[16 * nf + fr], s); }
        __syncthreads();
#pragma unroll
        for (int nf = 0; nf < 4; ++nf) { int i = 16 * nf + fr; float rs = rsqrtf(ssq[i] * (1.f / 128.f) + 1e-6f);
#pragma unroll
            for (int mf = 0; mf < 2; ++mf) { int v0 = 32 * w + 16 * mf + 4 * fq; us4 gt = *(const us4*)(proj + (size_t)(rowc + i) * NPROJ + PC_HGATE + h * 128 + v0); f32x4 wv = *(const f32x4*)(nw + v0); us4 o;
#pragma unroll
                for (int r = 0; r < 4; ++r) o[r] = f2bf(oacc[mf][nf][r] * rs * wv[r] * bf2f(gt[r]));
                if (i < sq.Q) *(us4*)(yhg + (size_t)(rowc + i) * 1024 + h * 128 + v0) = o; } }
        __syncthreads();
    }
#pragma unroll
    for (int mf = 0; mf < 2; ++mf)
#pragma unroll
        for (int nf = 0; nf < 8; ++nf)
#pragma unroll
            for (int r = 0; r < 4; ++r) st_out[(32 * w + 16 * mf + 4 * fq + r) * 128 + 16 * nf + fr] = hacc[mf][nf][r];
}

DEVI void rg_unit(const Params& p, int l, Seq sq, int blk, char* lds) {
    bf16_t* waT = (bf16_t*)lds; bf16_t* wiT = (bf16_t*)(lds + 9216); bf16_t* xr = (bf16_t*)(lds + 18432);
    float* av = (float*)(lds + 27648); float* uv = (float*)(lds + 44288); float* Pq = (float*)(lds + 60928); float* Hq = Pq + 256; float* carry = Hq + 256;
    const int tid = tidx(), lane = tid & 63, w = tid >> 6, fr = lane & 15, fq = lane >> 4;
    const bf16_t* proj = (const bf16_t*)(p.ws + WS_PROJ); bf16_t* yrg = (bf16_t*)(p.ws + WS_YRG);
    const int cb0 = blk * 64;
    const float* cw = p.in[I_RCW] + (size_t)l * 4 * 1024; const float* cbias = p.in[I_RCB] + l * 1024;
    const float* st_in; float* st_out; const float* hist; float* hist_out;
    if (sq.samp) { st_in = p.in[I_RG] + (size_t)(l * 16 + sq.b) * 1024; st_out = p.out + O_RG_S + (size_t)(l * 16 + sq.b) * 1024;
        hist = p.in[I_RCV] + (size_t)(l * 16 + sq.b) * 3 * 1024; hist_out = p.out + O_RCV_S + (size_t)(l * 16 + sq.b) * 3 * 1024; }
    else { st_out = p.out + O_RG_P + (size_t)(l * 16 + sq.b) * 1024; st_in = sq.seg ? st_out : nullptr;
        hist_out = p.out + O_RCV_P + (size_t)(l * 16 + sq.b) * 3 * 1024; hist = sq.seg ? hist_out : nullptr; }
    float* cwl = (float*)(lds + 63232);
    float* hl = (float*)(lds + 64512);
    for (int idx = tid; idx < 320; idx += 256) { int k = idx >> 6, cc = idx & 63; cwl[idx] = k < 4 ? cw[k * 1024 + cb0 + cc] : cbias[cb0 + cc]; if (idx < 192) hl[idx] = hist ? hist[k * 1024 + cb0 + cc] : 0.f; }
    {   const float* wa = p.in[I_RWA] + ((size_t)l * 16 + blk) * 4096; const float* wi = p.in[I_RWI] + ((size_t)l * 16 + blk) * 4096;
        for (int e = tid; e < 4096; e += 256) { int i = e >> 6, j = e & 63; waT[j * 72 + i] = f2bf(wa[e]); wiT[j * 72 + i] = f2bf(wi[e]); }
        if (tid < 64) carry[tid] = st_in ? st_in[cb0 + tid] : 0.f; }
    __syncthreads();
    for (int c = 0; c < sq.nchunk; ++c) {
        const int tid = tidx(), lane = tid & 63, w = tid >> 6, fr = lane & 15, fq = lane >> 4, j = tid & 63, q = tid >> 6;
        const int rowc = sq.row0 + c * 64; const bool lastc = (c == sq.nchunk - 1);
        {   uint4 rr_[2][4];
#pragma unroll
            for (int i = 0; i < 2; ++i) { int it = tid + 256 * i, t = it >> 3, c8 = (it & 7) * 8; conv_load(rr_[i], proj, sq.row0, c * 64 + t, PC_RX + cb0 + c8); }
#pragma unroll
            for (int i = 0; i < 2; ++i)
#pragma unroll
                for (int k = 0; k < 4; ++k) touch4(rr_[i][k]);
#pragma unroll
            for (int i = 0; i < 2; ++i) { int it = tid + 256 * i, t = it >> 3, c8 = (it & 7) * 8; float o[8], raw[8]; int ch = cb0 + c8; const bool tv = t < sq.Q;
                conv_compute(rr_[i], c * 64 + t, hl, cwl, 64, c8, o, raw);
                if (lastc && tv && t >= sq.Q - 3) {
#pragma unroll
                    for (int e = 0; e < 8; ++e) hist_out[(t - (sq.Q - 3)) * 1024 + ch + e] = raw[e]; }
                us8 ov;
#pragma unroll
                for (int e = 0; e < 8; ++e) { float ox = tv ? o[e] : 0.f; ov[e] = f2bf(ox); uv[t * 65 + c8 + e] = ox; }
                *(us8*)(xr + t * 72 + c8) = ov; }
        }
        __syncthreads();
        f32x4 ra[4], ri[4];
#pragma unroll
        for (int nf = 0; nf < 4; ++nf) { ra[nf] = (f32x4){0.f, 0.f, 0.f, 0.f}; ri[nf] = (f32x4){0.f, 0.f, 0.f, 0.f}; }
        lds_mma<4, 2>(ra, xr, 72, 16 * w, waT, 72, 0);
        lds_mma<4, 2>(ri, xr, 72, 16 * w, wiT, 72, 0);
#pragma unroll
        for (int nf = 0; nf < 4; ++nf) { int jj = 16 * nf + fr, cc = cb0 + jj; float ba = p.in[I_RBA][l * 1024 + cc], bi = p.in[I_RBI][l * 1024 + cc], sp = softplus(-p.in[I_RLAM][l * 1024 + cc]);
#pragma unroll
            for (int r = 0; r < 4; ++r) { int t = 16 * w + 4 * fq + r; float rr = sigm(ra[nf][r] + ba), ii = sigm(ri[nf][r] + bi); float la = -8.f * sp * rr; float aa = __expf(la);
                float u = sqrtf(-expm1f(2.f * la)) * ii * uv[t * 65 + jj];
                if (t >= sq.Q) { aa = 1.f; u = 0.f; }
                av[t * 65 + jj] = aa; uv[t * 65 + jj] = u; } }
        __syncthreads();
        { float P = 1.f, H = 0.f;
#pragma unroll
          for (int tt = 0; tt < 16; ++tt) { int t = 16 * q + tt; float aa = av[t * 65 + j], u = uv[t * 65 + j]; H = aa * H + u; P *= aa; }
          Pq[q * 64 + j] = P; Hq[q * 64 + j] = H; }
        __syncthreads();
        float hcur = carry[j];
        for (int qq = 0; qq < q; ++qq) hcur = Pq[qq * 64 + j] * hcur + Hq[qq * 64 + j];
        bf16_t gts[16];
#pragma unroll
        for (int tt = 0; tt < 16; ++tt) gts[tt] = proj[(size_t)(rowc + 16 * q + tt) * NPROJ + PC_RGATE + cb0 + j];
#pragma unroll
        for (int tt = 0; tt < 16; ++tt) { int t = 16 * q + tt; float aa = av[t * 65 + j], u = uv[t * 65 + j]; hcur = aa * hcur + u;
            if (t < sq.Q) yrg[(size_t)(rowc + t) * 1024 + cb0 + j] = f2bf(bf2f(gts[tt]) * hcur); }
        __syncthreads();
        if (q == 3) carry[j] = hcur;
        __syncthreads();
    }
    if (tid < 64) st_out[cb0 + tid] = carry[tid];
    __syncthreads();
}

DEVI void phase_mix(const Params& p, int l, int seg, char* lds) {
    const int ngrp = seg == 0 ? 2 : 1; const int NU = ngrp * 640;
    for (int u = blockIdx.x; u < NU; u += gridDim.x) {
        int grp = u / 640, v = u % 640;
        if (v < 128) hgrn_unit(p, l, make_seq(seg, grp * 16 + (v >> 3)), v & 7, lds);
        else if (v < 384) { v -= 128; ssd_unit(p, l, make_seq(seg, grp * 16 + (v >> 4)), v & 15, lds); }
        else { v -= 384; rg_unit(p, l, make_seq(seg, grp * 16 + (v >> 4)), v & 15, lds); }
        __syncthreads();
    }
}

DEVI void gbar(unsigned* ctr, unsigned& epoch) {
    asm volatile("s_waitcnt vmcnt(0)" ::: "memory");
    __syncthreads();
    if (tidx() == 0) {
        __builtin_amdgcn_fence(__ATOMIC_RELEASE, "agent");
        asm volatile("s_waitcnt vmcnt(0)" ::: "memory");
        __hip_atomic_fetch_add(ctr, 1u, __ATOMIC_RELAXED, __HIP_MEMORY_SCOPE_AGENT);
        const unsigned target = (epoch + 1u) * gridDim.x;
        while (__hip_atomic_load(ctr, __ATOMIC_RELAXED, __HIP_MEMORY_SCOPE_AGENT) < target) __builtin_amdgcn_s_sleep(1);
        __builtin_amdgcn_fence(__ATOMIC_ACQUIRE, "agent");
        asm volatile("s_waitcnt vmcnt(0)" ::: "memory");
    }
    ++epoch;
    __syncthreads();
}

__global__ void __launch_bounds__(256) fwd_mega(Params p) {
    extern __shared__ __attribute__((aligned(16))) char lds[];
    cg::grid_group grid = cg::this_grid();
    unsigned* ctr = (unsigned*)(p.ws + WS_END); unsigned epoch = 0;
    phase_prep(p, lds);
    grid.sync();
#pragma unroll 1
    for (int seg = 0; seg < NSEG; ++seg) {
        const int nrows = seg == 0 ? ROWS : ROWS_P, MT = nrows / 256;
#pragma unroll 1
        for (int l = 0; l < 2; ++l) {
            const bf16_t* wl = (const bf16_t*)p.ws + (size_t)l * E_LAYER;
            phase_norm(p, seg, nrows, p.in[I_NMIX] + l * 1024, l == 0);
            gbar(ctr, epoch);
            phase_proj(p, l, MT, lds);
            gbar(ctr, epoch);
            phase_mix(p, l, seg, lds);
            gbar(ctr, epoch);
            phase_mbnorm(p, l, nrows);
            gbar(ctr, epoch);
            phase_merge(p, l, MT, lds);
            gbar(ctr, epoch);
            phase_resid(p, seg, MT, (const bf16_t*)(p.ws + WS_MRG), 1024, wl + E_WIN + E_WBR, l == 0, lds);
            gbar(ctr, epoch);
            phase_norm(p, seg, nrows, p.in[I_NFFN] + l * 1024, false);
            gbar(ctr, epoch);
            phase_ffn_in(p, l, MT, lds);
            gbar(ctr, epoch);
            phase_resid(p, seg, MT, (const bf16_t*)(p.ws + WS_PROJ), FFH, wl + E_WIN + E_WBR + E_WOUT + E_WFI, false, lds);
            gbar(ctr, epoch);
        }
        phase_final_norm(p, seg, nrows);
    }
}

extern "C" void kernel_launch(void* const* d_in, const int* in_sizes, int n_in, void* d_out, int out_size, void* d_ws, size_t ws_size, hipStream_t stream) {
    static int grid_blocks = 0;
    if (!grid_blocks) {
        int dev = 0, cus = 0, per_cu = 0;
        (void)hipGetDevice(&dev);
        (void)hipDeviceGetAttribute(&cus, hipDeviceAttributeMultiprocessorCount, dev);
        (void)hipFuncSetAttribute((const void*)fwd_mega, hipFuncAttributeMaxDynamicSharedMemorySize, LDS_BYTES);
        (void)hipOccupancyMaxActiveBlocksPerMultiprocessor(&per_cu, (const void*)fwd_mega, 256, LDS_BYTES);
        if (per_cu < 1) fprintf(stderr, "occupancy query says %d blocks per CU\n", per_cu);
        grid_blocks = cus;
        if (ws_size < WS_TOTAL) fprintf(stderr, "workspace too small: %zu < %zu\n", ws_size, (size_t)WS_END + 256);
    }
    (void)hipMemsetAsync((char*)d_ws + WS_END, 0, 256, stream);
    Params p{};
    for (int i = 0; i < 30; ++i) p.in[i] = (const float*)d_in[i];
    p.out = (float*)d_out; p.ws = (unsigned char*)d_ws;
    void* args[] = {&p};
    hipError_t e = hipLaunchCooperativeKernel((const void*)fwd_mega, dim3(grid_blocks), dim3(256), args, LDS_BYTES, stream);
    if (e != hipSuccess) fprintf(stderr, "cooperative launch failed: %s (grid %d)\n", hipGetErrorString(e), grid_blocks);
}
```

```cpp
#include <hip/hip_runtime.h>
#include <hip/hip_cooperative_groups.h>
#include <cstdio>
namespace cg = cooperative_groups;

typedef unsigned short bf16_t;
typedef short bf16x8 __attribute__((ext_vector_type(8)));
typedef float f32x4 __attribute__((ext_vector_type(4)));
typedef unsigned short us4 __attribute__((ext_vector_type(4)));
typedef unsigned short us8 __attribute__((ext_vector_type(8)));
#define DEVI __device__ __forceinline__

constexpr int D = 1024, NPROJ = 12288, SEGT = 512, NSEG = 4, ROWS_P = 8192, ROWS = 8704, FFH = 2816;
constexpr int PC_Z = 0, PC_XBC = 1024, PC_HQ = 3072, PC_HF = 4096, PC_HI = 5120, PC_HGATE = 6144, PC_RGATE = 7168, PC_RX = 8192, PC_MG = 9216, PC_DT = 12288;
constexpr size_t E_WIN = (size_t)NPROJ * 1024, E_WBR = 3u * 1024 * 1024, E_WOUT = 1024u * 1024, E_WFI = 5632u * 1024, E_WFO = 1024u * 2816;
constexpr size_t E_LAYER = E_WIN + E_WBR + E_WOUT + E_WFI + E_WFO;
constexpr size_t WS_PROJ = 2 * E_LAYER * 2;
constexpr size_t WS_DT = WS_PROJ + (size_t)ROWS * NPROJ * 2;
constexpr size_t WS_XB = WS_DT + (size_t)ROWS * 16 * 4;
constexpr size_t WS_YMB = WS_XB + (size_t)ROWS * 1024 * 2;
constexpr size_t WS_YHG = WS_YMB + (size_t)ROWS * 1024 * 2;
constexpr size_t WS_YRG = WS_YHG + (size_t)ROWS * 1024 * 2;
constexpr size_t WS_MRG = WS_YRG + (size_t)ROWS * 1024 * 2;
constexpr size_t WS_END = WS_MRG + (size_t)ROWS * 1024 * 2;
constexpr size_t WS_HB = WS_END + 256;
constexpr size_t WS_DTW = WS_HB + 2u * 2 * 16 * 3 * 2048 * 4;
constexpr size_t WS_TOTAL = WS_DTW + 2u * 16 * 1024 * 4;
constexpr size_t O_YP = 0, O_YS = 33554432, O_SSM_P = 34078720, O_SCV_P = 38273024, O_HG_P = 38469632, O_RG_P = 42663936, O_RCV_P = 42696704,
                 O_SSM_S = 42795008, O_SCV_S = 46989312, O_HG_S = 47185920, O_RG_S = 51380224, O_RCV_S = 51412992;
constexpr int REP0 = 1, REP1 = 1, REP2 = 1, REP3 = 1;
constexpr int LDS_BYTES = 144 * 1024;

enum { I_XP = 0, I_XS, I_SSM, I_SCV, I_HG, I_RG, I_RCV, I_NMIX, I_WIN, I_MCW, I_MCB, I_DTB, I_ALOG, I_MBD, I_MBNW, I_LBL, I_HGNW, I_RCW, I_RCB, I_RWA, I_RBA, I_RWI, I_RBI, I_RLAM, I_WBR, I_WOUT, I_NFFN, I_WFI, I_WFO, I_NFIN };

struct Params { const float* in[30]; float* out; unsigned char* ws; int rep[4]; };

DEVI int tidx(int wv_) { int t = (wv_ << 6) | (int)__builtin_amdgcn_mbcnt_hi(~0u, __builtin_amdgcn_mbcnt_lo(~0u, 0u)); asm volatile("" : "+v"(t)); return t; }
DEVI float shfli(float v, int srcl) { return __int_as_float(__builtin_amdgcn_ds_bpermute(srcl << 2, __float_as_int(v))); }
DEVI float shflx(float v, int m, int lane) { return shfli(v, lane ^ m); }
DEVI bf16_t f2bf(float f) { unsigned u = __float_as_uint(f); u += 0x7fffu + ((u >> 16) & 1u); return (bf16_t)(u >> 16); }
DEVI float bf2f(bf16_t h) { return __uint_as_float(((unsigned)h) << 16); }
DEVI float sigm(float x) { return 1.f / (1.f + __expf(-x)); }
DEVI float silu(float x) { return x / (1.f + __expf(-x)); }
DEVI float softplus(float x) { return x > 20.f ? x : __logf(1.f + __expf(x)); }
DEVI float gelu_t(float x) { float u = 0.7978845608f * (x + 0.044715f * x * x * x); return x * sigm(2.f * u); }
DEVI float cexp(float x) { return __expf(fminf(x, 80.f)); }

DEVI const float* xrow_in(const Params& p, int seg, int r) {
    if (r < ROWS_P) { int b = r >> 9, tt = r & 511; return p.in[I_XP] + ((size_t)(b * 2048 + seg * SEGT + tt)) * D; }
    return p.in[I_XS] + (size_t)(r - ROWS_P) * D;
}
DEVI float* xrow_out(const Params& p, int seg, int r) {
    if (r < ROWS_P) { int b = r >> 9, tt = r & 511; return p.out + O_YP + ((size_t)(b * 2048 + seg * SEGT + tt)) * D; }
    return p.out + O_YS + (size_t)(r - ROWS_P) * D;
}

DEVI int map_win(int n) { return n < 3072 ? n : n + 16; }
DEVI int map_wfi(int n) { int T = n >> 7, q = (n >> 5) & 3, s = (n >> 4) & 1, i = n & 15; return s * FFH + 64 * T + 16 * q + i; }

DEVI void transpose_tile(const float* src, int ldsrc, bf16_t* dst, int K, int k0, int n0, int mode, float* tile  , int wv_) {
    const int tid = tidx(wv_), c = tid & 63, rq = tid >> 6;
    int n = n0 + c, sn = mode == 1 ? map_win(n) : (mode == 2 ? map_wfi(n) : n);
#pragma unroll
    for (int rr = 0; rr < 16; ++rr) { int kl = rr * 4 + rq; tile[kl * 65 + c] = sn >= 0 ? src[(size_t)(k0 + kl) * ldsrc + sn] : 0.f; }
    __syncthreads();
#pragma unroll
    for (int rr = 0; rr < 16; ++rr) { int nl = rr * 4 + rq; dst[(size_t)(n0 + nl) * K + k0 + c] = f2bf(tile[c * 65 + nl]); }
    __syncthreads();
}

DEVI void phase_prep(const Params& p, char* lds, int wv_) {
    float* tile = (float*)lds;
    bf16_t* wsb = (bf16_t*)p.ws;
    constexpr int T_WIN = 16 * 192, T_WBR = 3 * 256, T_WOUT = 256, T_WFI = 16 * 88, T_WFO = 44 * 16, T_L = T_WIN + T_WBR + T_WOUT + T_WFI + T_WFO;
    {   float* dtw = (float*)(p.ws + WS_DTW);
        for (int e = blockIdx.x * 256 + tidx(wv_); e < 32768; e += gridDim.x * 256) { int l = e >> 14, j = (e >> 10) & 15, k = e & 1023; dtw[e] = p.in[I_WIN][(size_t)l * 1024 * 12304 + (size_t)k * 12304 + 3072 + j]; } }
    for (int t = blockIdx.x; t < 2 * T_L; t += gridDim.x) {
        int l = t / T_L, j = t % T_L;
        bf16_t* wl = wsb + (size_t)l * E_LAYER;
        if (j < T_WIN) { int kt = j & 15, nt = j >> 4; transpose_tile(p.in[I_WIN] + (size_t)l * 1024 * 12304, 12304, wl, 1024, kt * 64, nt * 64, 1, tile, wv_); continue; }
        j -= T_WIN;
        if (j < T_WBR) { int k = j >> 8, jj = j & 255, kt = jj & 15, nt = jj >> 4;
            transpose_tile(p.in[I_WBR] + ((size_t)l * 3 + k) * 1024 * 1024, 1024, wl + E_WIN + (size_t)k * 1024 * 1024, 1024, kt * 64, nt * 64, 0, tile, wv_); continue; }
        j -= T_WBR;
        if (j < T_WOUT) { int kt = j & 15, nt = j >> 4; transpose_tile(p.in[I_WOUT] + (size_t)l * 1024 * 1024, 1024, wl + E_WIN + E_WBR, 1024, kt * 64, nt * 64, 0, tile, wv_); continue; }
        j -= T_WOUT;
        if (j < T_WFI) { int kt = j & 15, nt = j >> 4; transpose_tile(p.in[I_WFI] + (size_t)l * 1024 * 5632, 5632, wl + E_WIN + E_WBR + E_WOUT, 1024, kt * 64, nt * 64, 2, tile, wv_); continue; }
        j -= T_WFI;
        { int kt = j % 44, nt = j / 44; transpose_tile(p.in[I_WFO] + (size_t)l * 2816 * 1024, 1024, wl + E_WIN + E_WBR + E_WOUT + E_WFI, 2816, kt * 64, nt * 64, 0, tile, wv_); }
    }
}

DEVI void phase_norm(const Params& p, int seg, int nrows, const float* w, bool from_input, int ldt  , char* lds, int wv_) {
    bf16_t* xb = (bf16_t*)(p.ws + WS_XB); float* dtb = (float*)(p.ws + WS_DT);
    const int lane = tidx(wv_) & 63, wv = tidx(wv_) >> 6;
    float* dw = (float*)lds;
    if (ldt >= 0) { const float* dtw = (const float*)(p.ws + WS_DTW) + ldt * 16384; f32x4 t_[16];
#pragma unroll
        for (int u = 0; u < 16; ++u) t_[u] = *(const f32x4*)(dtw + (tidx(wv_) + 256 * u) * 4);
#pragma unroll
        for (int u = 0; u < 16; ++u) *(f32x4*)(dw + (tidx(wv_) + 256 * u) * 4) = t_[u];
        __syncthreads(); }
    for (int r = blockIdx.x * 4 + wv; r < nrows; r += gridDim.x * 4) {
        const float* x = from_input ? xrow_in(p, seg, r) : xrow_out(p, seg, r);
        f32x4 v[4]; float ss = 0.f;
#pragma unroll
        for (int i = 0; i < 4; ++i) { v[i] = *(const f32x4*)(x + i * 256 + lane * 4); ss += v[i][0] * v[i][0] + v[i][1] * v[i][1] + v[i][2] * v[i][2] + v[i][3] * v[i][3]; }
#pragma unroll
        for (int o = 32; o >= 1; o >>= 1) ss += shflx(ss, o, lane);
        float rs = rsqrtf(ss * (1.f / 1024.f) + 1e-6f);
#pragma unroll
        for (int i = 0; i < 4; ++i) { f32x4 wv4 = *(const f32x4*)(w + i * 256 + lane * 4); us4 o;
            v[i][0] *= rs * wv4[0]; v[i][1] *= rs * wv4[1]; v[i][2] *= rs * wv4[2]; v[i][3] *= rs * wv4[3];
            o[0] = f2bf(v[i][0]); o[1] = f2bf(v[i][1]); o[2] = f2bf(v[i][2]); o[3] = f2bf(v[i][3]);
            *(us4*)(xb + (size_t)r * 1024 + i * 256 + lane * 4) = o; }
        if (ldt >= 0) {
            float d[16];
#pragma unroll
            for (int j = 0; j < 16; ++j) { float s = 0.f;
#pragma unroll
                for (int i = 0; i < 4; ++i) { f32x4 ww = *(const f32x4*)(dw + j * 1024 + i * 256 + lane * 4); s += v[i][0] * ww[0] + v[i][1] * ww[1] + v[i][2] * ww[2] + v[i][3] * ww[3]; }
                d[j] = s; }
            { const bool hi = lane & 32;
#pragma unroll
              for (int i = 0; i < 8; ++i) { float send = hi ? d[i] : d[i + 8], keep = hi ? d[i + 8] : d[i]; d[i] = keep + shfli(send, lane ^ 32); } }
            { const bool hi = lane & 16;
#pragma unroll
              for (int i = 0; i < 4; ++i) { float send = hi ? d[i] : d[i + 4], keep = hi ? d[i + 4] : d[i]; d[i] = keep + shfli(send, lane ^ 16); } }
            { const bool hi = lane & 8;
#pragma unroll
              for (int i = 0; i < 2; ++i) { float send = hi ? d[i] : d[i + 2], keep = hi ? d[i + 2] : d[i]; d[i] = keep + shfli(send, lane ^ 8); } }
            { const bool hi = lane & 4; float send = hi ? d[0] : d[1], keep = hi ? d[1] : d[0]; d[0] = keep + shfli(send, lane ^ 4); }
            d[0] += shfli(d[0], lane ^ 2); d[0] += shfli(d[0], lane ^ 1);
            if ((lane & 3) == 0) { int j = lane >> 2; dtb[(size_t)r * 16 + j] = softplus(d[0] + p.in[I_DTB][ldt * 16 + j]); }
        }
    }
    if (ldt >= 0) __syncthreads();
}
DEVI void phase_final_norm(const Params& p, int seg, int nrows, int wv_) {
    const float* w = p.in[I_NFIN];
    const int lane = tidx(wv_) & 63, wv = tidx(wv_) >> 6;
    for (int r = blockIdx.x * 4 + wv; r < nrows; r += gridDim.x * 4) {
        float* x = xrow_out(p, seg, r);
        f32x4 v[4]; float ss = 0.f;
#pragma unroll
        for (int i = 0; i < 4; ++i) { v[i] = *(const f32x4*)(x + i * 256 + lane * 4); ss += v[i][0] * v[i][0] + v[i][1] * v[i][1] + v[i][2] * v[i][2] + v[i][3] * v[i][3]; }
#pragma unroll
        for (int o = 32; o >= 1; o >>= 1) ss += shflx(ss, o, lane);
        float rs = rsqrtf(ss * (1.f / 1024.f) + 1e-6f);
#pragma unroll
        for (int i = 0; i < 4; ++i) { f32x4 wv4 = *(const f32x4*)(w + i * 256 + lane * 4); f32x4 o;
            o[0] = v[i][0] * rs * wv4[0]; o[1] = v[i][1] * rs * wv4[1]; o[2] = v[i][2] * rs * wv4[2]; o[3] = v[i][3] * rs * wv4[3];
            *(f32x4*)(x + i * 256 + lane * 4) = o; }
    }
}
DEVI void phase_mbnorm(const Params& p, int l, int nrows, int wv_) {
    bf16_t* y = (bf16_t*)(p.ws + WS_YMB); const float* w = p.in[I_MBNW] + l * 1024;
    const int lane = tidx(wv_) & 63, wv = tidx(wv_) >> 6;
    for (int it = blockIdx.x * 4 + wv; it < nrows * 4; it += gridDim.x * 4) {
        int r = it >> 2, g = it & 3; bf16_t* yp = y + (size_t)r * 1024 + g * 256 + lane * 4;
        us4 v = *(const us4*)yp; float f0 = bf2f(v[0]), f1 = bf2f(v[1]), f2 = bf2f(v[2]), f3 = bf2f(v[3]);
        float ss = f0 * f0 + f1 * f1 + f2 * f2 + f3 * f3;
#pragma unroll
        for (int o = 32; o >= 1; o >>= 1) ss += shflx(ss, o, lane);
        float rs = rsqrtf(ss * (1.f / 256.f) + 1e-6f); f32x4 wv4 = *(const f32x4*)(w + g * 256 + lane * 4);
        us4 o; o[0] = f2bf(f0 * rs * wv4[0]); o[1] = f2bf(f1 * rs * wv4[1]); o[2] = f2bf(f2 * rs * wv4[2]); o[3] = f2bf(f3 * rs * wv4[3]);
        *(us4*)yp = o;
    }
}

#define WAIT_V(n) asm volatile("s_waitcnt vmcnt(" #n ")" ::: "memory")
#define RAW_BAR() do { asm volatile("" ::: "memory"); __builtin_amdgcn_s_barrier(); asm volatile("" ::: "memory"); } while (0)
template <int NF>
DEVI void stage_tile(const bf16_t* A, const bf16_t* Bt, int K, int t, char* st, int tid, size_t soff) {
    const size_t o = soff + (size_t)t * 32;
#pragma unroll
    for (int i = 0; i < 4; ++i) __builtin_amdgcn_global_load_lds((const unsigned*)(A + o + (size_t)i * 64 * K), (unsigned*)(st + tid * 16 + i * 4096), 16, 0, 0);
#pragma unroll
    for (int i = 0; i < NF / 2; ++i) __builtin_amdgcn_global_load_lds((const unsigned*)(Bt + o + (size_t)i * 64 * K), (unsigned*)(st + 16384 + tid * 16 + i * 4096), 16, 0, 0);
}
template <int NF>
DEVI void gemm_kloop(f32x4 (&acc)[8][NF], const bf16_t* A, const bf16_t* Bt, int K, char* lds, int wv_) {
    constexpr int STAGE = 16384 + NF * 2048;
    const int tid = tidx(wv_), lane = tid & 63, wid = tid >> 6, wr = wid >> 1, wc = wid & 1, fr = lane & 15, fq = lane >> 4;
    const int fo = fr * 64 + ((fq ^ (fr >> 2)) & 3) * 16;
    const int aoff = wr * 8192 + fo, boff = 16384 + wc * NF * 1024 + fo;
    const size_t soff = (size_t)(tid >> 2) * K + (((tid & 3) ^ ((tid >> 4) & 3)) * 8);
    const int nt = K >> 5;
    WAIT_V(0); RAW_BAR();
    stage_tile<NF>(A, Bt, K, 0, lds, tid, soff);
    stage_tile<NF>(A, Bt, K, 1, lds + STAGE, tid, soff);
    stage_tile<NF>(A, Bt, K, 2, lds + 2 * STAGE, tid, soff);
    for (int t = 0; t < nt; ++t) {
        if (t + 2 < nt) { if (NF == 8) WAIT_V(16); else WAIT_V(12); }
        else if (t + 1 < nt) { if (NF == 8) WAIT_V(8); else WAIT_V(6); }
        else WAIT_V(0);
        RAW_BAR();
        if (t + 3 < nt) stage_tile<NF>(A, Bt, K, t + 3, lds + ((t + 3) & 3) * STAGE, tid, soff);
        const char* st = lds + (t & 3) * STAGE;
        bf16x8 af[8], bfr[NF];
        af[0] = *(const bf16x8*)(st + aoff);
#pragma unroll
        for (int n = 0; n < NF; ++n) bfr[n] = *(const bf16x8*)(st + boff + n * 1024);
        af[1] = *(const bf16x8*)(st + aoff + 1024);
#pragma unroll
        for (int g = 0; g < 8; ++g) {
            __builtin_amdgcn_sched_barrier(0);
            if (g < 6) af[g + 2] = *(const bf16x8*)(st + aoff + (g + 2) * 1024);
#pragma unroll
            for (int n = 0; n < NF; ++n) acc[g][n] = __builtin_amdgcn_mfma_f32_16x16x32_bf16(bfr[n], af[g], acc[g][n], 0, 0, 0);
        }
        __builtin_amdgcn_sched_barrier(0);
    }
}
DEVI bool next_tile(int it, int MT, int NT, int& mt, int& nt) {
    int x = blockIdx.x & 7, bl = blockIdx.x >> 3, G8 = gridDim.x >> 3;
    int nI = (MT - x + 7) >> 3; long j = (long)it * G8 + bl;
    if (j >= (long)nI * NT) return false;
    int i = (int)(j % nI); nt = (int)(j / nI); mt = x + 8 * i; return true;
}
#define ZERO_ACC(a, NF_) _Pragma("unroll") for (int m_ = 0; m_ < 8; ++m_) _Pragma("unroll") for (int n_ = 0; n_ < NF_; ++n_) a[m_][n_] = (f32x4){0.f, 0.f, 0.f, 0.f}
#define EPI_IDS const int lane = tidx(wv_) & 63, wid = tidx(wv_) >> 6, wr = wid >> 1, wc = wid & 1, fr = lane & 15, fq = lane >> 4

template <int ACT>
DEVI void proj_store(const f32x4 (&acc)[8][8], bf16_t* pbase, float c1, float c3, bool issig) {
#pragma unroll
    for (int m = 0; m < 8; ++m)
#pragma unroll
        for (int n = 0; n < 8; ++n) { f32x4 v = acc[m][n]; us4 o;
#pragma unroll
            for (int j = 0; j < 4; ++j) { float x = v[j];
                if (ACT) { float u = x * (c1 + c3 * x * x); float s = __builtin_amdgcn_rcpf(1.f + __expf(-u)); x = s * (issig ? 1.f : x); }
                o[j] = f2bf(x); }
            *(us4*)(pbase + (size_t)m * 16 * NPROJ + n * 16) = o; }
}
DEVI void phase_proj(const Params& p, int l, int MT, char* lds, int wv_) {
    const bf16_t* xb = (const bf16_t*)(p.ws + WS_XB); const bf16_t* wt = (const bf16_t*)p.ws + (size_t)l * E_LAYER;
    bf16_t* proj = (bf16_t*)(p.ws + WS_PROJ);
    int mt, nt;
    for (int it = 0; next_tile(it, MT, 48, mt, nt); ++it) {
        f32x4 acc[8][8]; ZERO_ACC(acc, 8);
        gemm_kloop<8>(acc, xb + (size_t)mt * 256 * 1024, wt + (size_t)nt * 256 * 1024, 1024, lds, wv_);
        EPI_IDS;
        const int sg = nt >> 2;
        const int ty = (sg == 0 || sg == 3 || sg == 6) ? 1 : (sg == 7 ? 2 : (sg >= 9 ? 3 : 0));
        bf16_t* pbase = proj + (size_t)(mt * 256 + wr * 128 + fr) * NPROJ + nt * 256 + wc * 128 + fq * 4;
        if (ty == 0) proj_store<0>(acc, pbase, 0.f, 0.f, false); else proj_store<1>(acc, pbase, ty == 2 ? 1.5957691216f : 1.f, ty == 2 ? 0.0713548163f : 0.f, ty == 3);
    }
}
DEVI void phase_merge(const Params& p, int l, int MT, char* lds, int wv_) {
    const bf16_t* wt = (const bf16_t*)p.ws + (size_t)l * E_LAYER + E_WIN; const bf16_t* proj = (const bf16_t*)(p.ws + WS_PROJ);
    bf16_t* mrg = (bf16_t*)(p.ws + WS_MRG);
    int mt, nt;
    for (int it = 0; next_tile(it, MT, 8, mt, nt); ++it) {
        f32x4 tot[8][4]; ZERO_ACC(tot, 4);
#pragma unroll 1
        for (int k = 0; k < 3; ++k) {
            const bf16_t* y = (const bf16_t*)(p.ws + WS_YMB + (size_t)k * ROWS * 1024 * 2);
            f32x4 acc[8][4]; ZERO_ACC(acc, 4);
            gemm_kloop<4>(acc, y + (size_t)mt * 256 * 1024, wt + (size_t)k * 1024 * 1024 + (size_t)nt * 128 * 1024, 1024, lds, wv_);
            EPI_IDS;
#pragma unroll
            for (int m = 0; m < 8; ++m) { int row = mt * 256 + wr * 128 + m * 16 + fr; asm volatile("" ::: "memory");
#pragma unroll
                for (int n = 0; n < 4; ++n) { int col = nt * 128 + wc * 64 + n * 16 + fq * 4; us4 g = *(const us4*)(proj + (size_t)row * NPROJ + PC_MG + k * 1024 + col);
#pragma unroll
                    for (int j = 0; j < 4; ++j) tot[m][n][j] += acc[m][n][j] * bf2f(g[j]); } }
        }
        EPI_IDS;
#pragma unroll
        for (int m = 0; m < 8; ++m) { int row = mt * 256 + wr * 128 + m * 16 + fr;
#pragma unroll
            for (int n = 0; n < 4; ++n) { int col = nt * 128 + wc * 64 + n * 16 + fq * 4; us4 o;
#pragma unroll
                for (int j = 0; j < 4; ++j) o[j] = f2bf(tot[m][n][j]);
                *(us4*)(mrg + (size_t)row * 1024 + col) = o; } }
    }
}
DEVI void phase_resid(const Params& p, int seg, int MT, const bf16_t* A, int K, const bf16_t* Bt, bool from_input, char* lds, int wv_) {
    int mt, nt;
    for (int it = 0; next_tile(it, MT, 8, mt, nt); ++it) {
        f32x4 acc[8][4]; ZERO_ACC(acc, 4);
        gemm_kloop<4>(acc, A + (size_t)mt * 256 * K, Bt + (size_t)nt * 128 * K, K, lds, wv_);
        EPI_IDS;
#pragma unroll
        for (int m = 0; m < 8; ++m) { int row = mt * 256 + wr * 128 + m * 16 + fr;
            const float* xi = from_input ? xrow_in(p, seg, row) : xrow_out(p, seg, row); float* xo = xrow_out(p, seg, row);
#pragma unroll
            for (int n = 0; n < 4; ++n) { int col = nt * 128 + wc * 64 + n * 16 + fq * 4; f32x4 v = *(const f32x4*)(xi + col); *(f32x4*)(xo + col) = v + acc[m][n]; } }
    }
}
DEVI void phase_ffn_in(const Params& p, int l, int MT, char* lds, int wv_) {
    const bf16_t* xb = (const bf16_t*)(p.ws + WS_XB); const bf16_t* wt = (const bf16_t*)p.ws + (size_t)l * E_LAYER + E_WIN + E_WBR + E_WOUT;
    bf16_t* act = (bf16_t*)(p.ws + WS_PROJ);
    int mt, nt;
    for (int it = 0; next_tile(it, MT, 22, mt, nt); ++it) {
        f32x4 acc[8][8]; ZERO_ACC(acc, 8);
        gemm_kloop<8>(acc, xb + (size_t)mt * 256 * 1024, wt + (size_t)nt * 256 * 1024, 1024, lds, wv_);
        EPI_IDS;
#pragma unroll
        for (int m = 0; m < 8; ++m) { int row = mt * 256 + wr * 128 + m * 16 + fr;
#pragma unroll
            for (int q = 0; q < 4; ++q) { int col = (nt * 2 + wc) * 64 + 16 * q + fq * 4; us4 o;
#pragma unroll
                for (int j = 0; j < 4; ++j) o[j] = f2bf(silu(acc[m][2 * q][j]) * acc[m][2 * q + 1][j]);
                *(us4*)(act + (size_t)row * FFH + col) = o; } }
    }
}

struct Seq { int row0, nchunk, Q, b, samp, seg; };
DEVI Seq make_seq(int seg, int sq) { Seq s; s.seg = seg; if (sq < 16) { s.row0 = sq * SEGT; s.nchunk = 8; s.Q = 64; s.b = sq; s.samp = 0; } else { s.b = sq - 16; s.row0 = ROWS_P + s.b * 32; s.nchunk = 1; s.Q = 32; s.samp = 1; } return s; }

template <int NF, int KS>
DEVI void lds_mma(f32x4* acc, const bf16_t* X, int ldx, int m0, const bf16_t* Y, int ldy, int n0, int wv_) {
    const int lane = tidx(wv_) & 63, fr = lane & 15, fq = lane >> 4;
#pragma unroll
    for (int ks = 0; ks < KS; ++ks) {
        bf16x8 a = *(const bf16x8*)(X + (m0 + fr) * ldx + ks * 32 + fq * 8);
#pragma unroll
        for (int nf = 0; nf < NF; ++nf) { bf16x8 b = *(const bf16x8*)(Y + (n0 + nf * 16 + fr) * ldy + ks * 32 + fq * 8); acc[nf] = __builtin_amdgcn_mfma_f32_16x16x32_bf16(a, b, acc[nf], 0, 0, 0); }
    }
}

DEVI void conv_load(uint4 (&r)[4], const bf16_t* proj, int row0, int tq, int pcol) {
#pragma unroll
    for (int k = 0; k < 4; ++k) { int ts = tq - 3 + k; ts = ts < 0 ? 0 : ts; r[k] = *(const uint4*)(proj + (size_t)(row0 + ts) * NPROJ + pcol); }
}
DEVI void touch4(uint4& v) { asm volatile("" : "+v"(v.x), "+v"(v.y), "+v"(v.z), "+v"(v.w)); }
DEVI void conv_compute(const uint4 (&r)[4], int tq, const float* hl, const float* cwl, int HC, int cl, float (&out)[8], float (&raw)[8]) {
    { f32x4 b0 = *(const f32x4*)(cwl + 4 * HC + cl), b1 = *(const f32x4*)(cwl + 4 * HC + cl + 4);
      out[0] = b0[0]; out[1] = b0[1]; out[2] = b0[2]; out[3] = b0[3]; out[4] = b1[0]; out[5] = b1[1]; out[6] = b1[2]; out[7] = b1[3]; }
#pragma unroll
    for (int k = 0; k < 4; ++k) {
        const int ts = tq - 3 + k; float v[8];
        v[0] = __uint_as_float(r[k].x << 16); v[1] = __uint_as_float(r[k].x & 0xffff0000u); v[2] = __uint_as_float(r[k].y << 16); v[3] = __uint_as_float(r[k].y & 0xffff0000u);
        v[4] = __uint_as_float(r[k].z << 16); v[5] = __uint_as_float(r[k].z & 0xffff0000u); v[6] = __uint_as_float(r[k].w << 16); v[7] = __uint_as_float(r[k].w & 0xffff0000u);
        if (k < 3) { int hi = 3 + ts; hi = hi < 0 ? 0 : (hi > 2 ? 2 : hi); const bool uh = ts < 0;
            f32x4 h0 = *(const f32x4*)(hl + hi * HC + cl), h1 = *(const f32x4*)(hl + hi * HC + cl + 4);
            v[0] = uh ? h0[0] : v[0]; v[1] = uh ? h0[1] : v[1]; v[2] = uh ? h0[2] : v[2]; v[3] = uh ? h0[3] : v[3];
            v[4] = uh ? h1[0] : v[4]; v[5] = uh ? h1[1] : v[5]; v[6] = uh ? h1[2] : v[6]; v[7] = uh ? h1[3] : v[7]; }
        f32x4 w0 = *(const f32x4*)(cwl + k * HC + cl), w1 = *(const f32x4*)(cwl + k * HC + cl + 4);
        out[0] += v[0] * w0[0]; out[1] += v[1] * w0[1]; out[2] += v[2] * w0[2]; out[3] += v[3] * w0[3];
        out[4] += v[4] * w1[0]; out[5] += v[5] * w1[1]; out[6] += v[6] * w1[2]; out[7] += v[7] * w1[3];
        if (k == 3) {
#pragma unroll
            for (int e = 0; e < 8; ++e) raw[e] = v[e]; }
    }
}

template <int ROWB>
DEVI void stage_raw(const char* g0, size_t ldgB, char* dst, int tid) {
#pragma unroll
    for (int i = 0; i < ROWB / 64; ++i) { int b = tid * 16 + i * 4096, row = b / ROWB, cb = b % ROWB;
        __builtin_amdgcn_global_load_lds((const unsigned*)(g0 + (size_t)row * ldgB + cb), (unsigned*)(dst + b), 16, 0, 0); }
}
DEVI void conv_lds(const bf16_t* rawt, int RS, int t, int cloc, const float* hl, const float* cwl, int HC, int cl, float (&out)[8], float (&raw)[8]) {
    { f32x4 b0 = *(const f32x4*)(cwl + 4 * HC + cl), b1 = *(const f32x4*)(cwl + 4 * HC + cl + 4);
      out[0] = b0[0]; out[1] = b0[1]; out[2] = b0[2]; out[3] = b0[3]; out[4] = b1[0]; out[5] = b1[1]; out[6] = b1[2]; out[7] = b1[3]; }
#pragma unroll
    for (int k = 0; k < 4; ++k) {
        const int tt = t - 3 + k; const int tc = tt < 0 ? 0 : tt; float v[8];
        const uint4 r = *(const uint4*)(rawt + tc * RS + cloc);
        v[0] = __uint_as_float(r.x << 16); v[1] = __uint_as_float(r.x & 0xffff0000u); v[2] = __uint_as_float(r.y << 16); v[3] = __uint_as_float(r.y & 0xffff0000u);
        v[4] = __uint_as_float(r.z << 16); v[5] = __uint_as_float(r.z & 0xffff0000u); v[6] = __uint_as_float(r.w << 16); v[7] = __uint_as_float(r.w & 0xffff0000u);
        if (k < 3) { int hi = 3 + tt; hi = hi < 0 ? 0 : (hi > 2 ? 2 : hi); const bool uh = tt < 0;
            f32x4 h0 = *(const f32x4*)(hl + hi * HC + cl), h1 = *(const f32x4*)(hl + hi * HC + cl + 4);
            v[0] = uh ? h0[0] : v[0]; v[1] = uh ? h0[1] : v[1]; v[2] = uh ? h0[2] : v[2]; v[3] = uh ? h0[3] : v[3];
            v[4] = uh ? h1[0] : v[4]; v[5] = uh ? h1[1] : v[5]; v[6] = uh ? h1[2] : v[6]; v[7] = uh ? h1[3] : v[7]; }
        f32x4 w0 = *(const f32x4*)(cwl + k * HC + cl), w1 = *(const f32x4*)(cwl + k * HC + cl + 4);
        out[0] += v[0] * w0[0]; out[1] += v[1] * w0[1]; out[2] += v[2] * w0[2]; out[3] += v[3] * w0[3];
        out[4] += v[4] * w1[0]; out[5] += v[5] * w1[1]; out[6] += v[6] * w1[2]; out[7] += v[7] * w1[3];
        if (k == 3) {
#pragma unroll
            for (int e = 0; e < 8; ++e) raw[e] = v[e]; }
    }
}

DEVI void ssd_unit(const Params& p, int l, Seq sq, int hd, char* lds, int wv_) {
    bf16_t* Bm = (bf16_t*)lds;
    bf16_t* R2 = (bf16_t*)(lds + 17408);
    bf16_t* xT = (bf16_t*)(lds + 35840);
    bf16_t* hb = (bf16_t*)(lds + 45056);
    float* fl = (float*)(lds + 62464);
    const int tid = tidx(wv_), lane = tid & 63, w = tid >> 6, fr = lane & 15, fq = lane >> 4;
    const bf16_t* proj = (const bf16_t*)(p.ws + WS_PROJ); const float* dtb = (const float*)(p.ws + WS_DT); bf16_t* ymb = (bf16_t*)(p.ws + WS_YMB);
    const int g = hd >> 2;
    const float a = -__expf(p.in[I_ALOG][l * 16 + hd]), Dv = p.in[I_MBD][l * 16 + hd];
    const float* cw = p.in[I_MCW] + (size_t)l * 4 * 2048; const float* cbias = p.in[I_MCB] + l * 2048;
    float* cwl = (float*)(lds + 63488);
    float* hl = (float*)(lds + 69888);
    const float* st_in; float* st_out; const float* hist; float* hist_out; float* hist_out2 = nullptr;
    float* hbuf = (float*)(p.ws + WS_HB);
    if (sq.samp) { st_in = p.in[I_SSM] + ((size_t)(l * 16 + sq.b) * 16 + hd) * 8192; st_out = p.out + O_SSM_S + ((size_t)(l * 16 + sq.b) * 16 + hd) * 8192;
        hist = p.in[I_SCV] + (size_t)(l * 16 + sq.b) * 3 * 2048; hist_out = p.out + O_SCV_S + (size_t)(l * 16 + sq.b) * 3 * 2048; }
    else { st_out = p.out + O_SSM_P + ((size_t)(l * 16 + sq.b) * 16 + hd) * 8192; st_in = sq.seg ? st_out : nullptr;
        hist_out = hbuf + ((size_t)((sq.seg & 1) * 2 + l) * 16 + sq.b) * 3 * 2048; hist = sq.seg ? hbuf + ((size_t)(((sq.seg + 1) & 1) * 2 + l) * 16 + sq.b) * 3 * 2048 : nullptr;
        if (sq.seg == NSEG - 1) hist_out2 = p.out + O_SCV_P + (size_t)(l * 16 + sq.b) * 3 * 2048; }
    for (int idx = tid; idx < 1600; idx += 256) { int k = idx / 320, cc = idx - k * 320; int ch = cc < 64 ? hd * 64 + cc : (cc < 192 ? 1024 + g * 128 + (cc - 64) : 1536 + g * 128 + (cc - 192));
        cwl[idx] = k < 4 ? cw[k * 2048 + ch] : cbias[ch];
        if (idx < 960) hl[idx] = hist ? hist[k * 2048 + ch] : 0.f; }
    f32x4 hacc[8];
#pragma unroll
    for (int nf = 0; nf < 8; ++nf)
#pragma unroll
        for (int r = 0; r < 4; ++r) { int pp = 16 * w + 4 * fq + r, n = 16 * nf + fr; float v = st_in ? st_in[pp * 128 + n] : 0.f; hacc[nf][r] = v; hb[pp * 136 + n] = f2bf(v); }
    bf16_t* rawX = (bf16_t*)(lds + 77568); bf16_t* rawB = (bf16_t*)(lds + 85760); bf16_t* rawC = (bf16_t*)(lds + 102144); bf16_t* rawZ = (bf16_t*)(lds + 118528); float* rawDt = (float*)(lds + 126720);
    const char* gx = (const char*)(proj + PC_XBC + hd * 64); const char* gb = (const char*)(proj + PC_XBC + 1024 + g * 128); const char* gc = (const char*)(proj + PC_XBC + 1536 + g * 128); const char* gz = (const char*)(proj + PC_Z + hd * 64);
    asm volatile("s_waitcnt vmcnt(0)" ::: "memory");
    {   const size_t ro = (size_t)sq.row0 * NPROJ * 2;
        stage_raw<128>(gx + ro, (size_t)NPROJ * 2, (char*)rawX, tid); stage_raw<256>(gb + ro, (size_t)NPROJ * 2, (char*)rawB, tid); stage_raw<256>(gc + ro, (size_t)NPROJ * 2, (char*)rawC, tid);
        stage_raw<128>(gz + ro, (size_t)NPROJ * 2, (char*)rawZ, tid); stage_raw<64>((const char*)(dtb + (size_t)sq.row0 * 16), 64, (char*)rawDt, tid); }
    for (int c = 0; c < sq.nchunk; ++c) {
        const int tid = tidx(wv_), lane = tid & 63, w = tid >> 6, fr = lane & 15, fq = lane >> 4;
        const int rowc = sq.row0 + c * 64; const bool lastc = (c == sq.nchunk - 1);
        const float* hlr = hl + (c & 1) * 960; float* hlw = hl + ((c + 1) & 1) * 960;
        asm volatile("s_waitcnt vmcnt(0)" ::: "memory");
        __syncthreads();
        if (w == 0) {
            float dt = lane < sq.Q ? rawDt[lane * 16 + hd] : 0.f; float v = dt * a;
#pragma unroll
            for (int o = 1; o < 64; o <<= 1) { float t = shfli(v, lane - o); if (lane >= o) v += t; }
            float last = shfli(v, 63);
            fl[lane] = v; fl[64 + lane] = dt; fl[128 + lane] = __expf(last - v) * dt; fl[192 + lane] = __expf(v);
        }
        __syncthreads();
        const float elast = __expf(fl[63]);
#pragma unroll
        for (int i = 0; i < 2; ++i) { int it = tid + 256 * i, t = it >> 3, c8 = (it & 7) * 8; float o[8], raw[8]; int ch = hd * 64 + c8; const bool tv = t < sq.Q;
            conv_lds(rawX, 64, t, c8, hlr, cwl, 320, c8, o, raw);
#pragma unroll
            for (int e = 0; e < 8; ++e) { float s_ = silu(o[e]); o[e] = tv ? s_ : 0.f; }
            if (t >= 61) {
#pragma unroll
                for (int e = 0; e < 8; ++e) hlw[(t - 61) * 320 + c8 + e] = raw[e]; }
            if (lastc && tv && t >= sq.Q - 3) {
#pragma unroll
                for (int e = 0; e < 8; ++e) { hist_out[(t - (sq.Q - 3)) * 2048 + ch + e] = raw[e]; if (hist_out2) hist_out2[(t - (sq.Q - 3)) * 2048 + ch + e] = raw[e]; } }
#pragma unroll
            for (int e = 0; e < 8; ++e) xT[(c8 + e) * 72 + t] = f2bf(o[e]); }
#pragma unroll
        for (int i = 0; i < 4; ++i) { int it = tid + 256 * i, t = it >> 4, c8 = (it & 15) * 8; float o[8], raw[8]; int ch = 1024 + g * 128 + c8; const bool tv = t < sq.Q;
            conv_lds(rawB, 128, t, c8, hlr, cwl, 320, 64 + c8, o, raw);
#pragma unroll
            for (int e = 0; e < 8; ++e) { float s_ = silu(o[e]); o[e] = tv ? s_ : 0.f; }
            if (t >= 61) {
#pragma unroll
                for (int e = 0; e < 8; ++e) hlw[(t - 61) * 320 + 64 + c8 + e] = raw[e]; }
            if (lastc && tv && (hd & 3) == 0 && t >= sq.Q - 3) {
#pragma unroll
                for (int e = 0; e < 8; ++e) { hist_out[(t - (sq.Q - 3)) * 2048 + ch + e] = raw[e]; if (hist_out2) hist_out2[(t - (sq.Q - 3)) * 2048 + ch + e] = raw[e]; } }
            us8 ov; float we = fl[128 + t];
#pragma unroll
            for (int e = 0; e < 8; ++e) { ov[e] = f2bf(o[e]); R2[(c8 + e) * 72 + t] = f2bf(o[e] * we); }
            *(us8*)(Bm + t * 136 + c8) = ov; }
        __syncthreads();
#pragma unroll
        for (int nf = 0; nf < 8; ++nf) hacc[nf] *= elast;
        lds_mma<8, 2>(hacc, xT, 72, 16 * w, R2, 72, 0, wv_);
        __syncthreads();
#pragma unroll
        for (int i = 0; i < 4; ++i) { int it = tid + 256 * i, t = it >> 4, c8 = (it & 15) * 8; float o[8], raw[8]; int ch = 1536 + g * 128 + c8; const bool tv = t < sq.Q;
            conv_lds(rawC, 128, t, c8, hlr, cwl, 320, 192 + c8, o, raw);
#pragma unroll
            for (int e = 0; e < 8; ++e) { float s_ = silu(o[e]); o[e] = tv ? s_ : 0.f; }
            if (t >= 61) {
#pragma unroll
                for (int e = 0; e < 8; ++e) hlw[(t - 61) * 320 + 192 + c8 + e] = raw[e]; }
            if (lastc && tv && (hd & 3) == 0 && t >= sq.Q - 3) {
#pragma unroll
                for (int e = 0; e < 8; ++e) { hist_out[(t - (sq.Q - 3)) * 2048 + ch + e] = raw[e]; if (hist_out2) hist_out2[(t - (sq.Q - 3)) * 2048 + ch + e] = raw[e]; } }
            us8 ov;
#pragma unroll
            for (int e = 0; e < 8; ++e) ov[e] = f2bf(o[e]);
            *(us8*)(R2 + t * 136 + c8) = ov; }
        us4 zr[4];
#pragma unroll
        for (int nf = 0; nf < 4; ++nf) zr[nf] = *(const us4*)(rawZ + (16 * nf + fr) * 64 + 16 * w + 4 * fq);
        __syncthreads();
        if (!lastc) { const size_t ro = (size_t)(rowc + 64) * NPROJ * 2;
            stage_raw<128>(gx + ro, (size_t)NPROJ * 2, (char*)rawX, tid); stage_raw<256>(gb + ro, (size_t)NPROJ * 2, (char*)rawB, tid); stage_raw<256>(gc + ro, (size_t)NPROJ * 2, (char*)rawC, tid);
            stage_raw<128>(gz + ro, (size_t)NPROJ * 2, (char*)rawZ, tid); stage_raw<64>((const char*)(dtb + (size_t)(rowc + 64) * 16), 64, (char*)rawDt, tid); }
        f32x4 cbv[4];
#pragma unroll
        for (int nf = 0; nf < 4; ++nf) cbv[nf] = (f32x4){0.f, 0.f, 0.f, 0.f};
        lds_mma<4, 4>(cbv, Bm, 136, 16 * w, R2, 136, 0, wv_);
        __syncthreads();
#pragma unroll
        for (int nf = 0; nf < 4; ++nf) { int i = 16 * nf + fr; float ai = fl[i]; us4 o;
#pragma unroll
            for (int r = 0; r < 4; ++r) { int j = 16 * w + 4 * fq + r; float v = (j <= i) ? cbv[nf][r] * __expf(ai - fl[j]) * fl[64 + j] : 0.f; o[r] = f2bf(v); }
            *(us4*)(Bm + i * 72 + 16 * w + 4 * fq) = o; }
        __syncthreads();
        f32x4 ya[4];
#pragma unroll
        for (int nf = 0; nf < 4; ++nf) ya[nf] = (f32x4){0.f, 0.f, 0.f, 0.f};
        lds_mma<4, 4>(ya, hb, 136, 16 * w, R2, 136, 0, wv_);
#pragma unroll
        for (int nf = 0; nf < 4; ++nf) ya[nf] *= fl[192 + 16 * nf + fr];
        lds_mma<4, 2>(ya, xT, 72, 16 * w, Bm, 72, 0, wv_);
#pragma unroll
        for (int nf = 0; nf < 4; ++nf) { int i = 16 * nf + fr, p0 = 16 * w + 4 * fq;
            us4 z = zr[nf];
            if (i < sq.Q) { us4 o;
#pragma unroll
                for (int r = 0; r < 4; ++r) o[r] = f2bf((ya[nf][r] + Dv * bf2f(xT[(p0 + r) * 72 + i])) * bf2f(z[r]));
                *(us4*)(ymb + (size_t)(rowc + i) * 1024 + hd * 64 + p0) = o; } }
        __syncthreads();
#pragma unroll
        for (int nf = 0; nf < 8; ++nf)
#pragma unroll
            for (int r = 0; r < 4; ++r) hb[(16 * w + 4 * fq + r) * 136 + 16 * nf + fr] = f2bf(hacc[nf][r]);
    }
#pragma unroll
    for (int nf = 0; nf < 8; ++nf)
#pragma unroll
        for (int r = 0; r < 4; ++r) st_out[(16 * w + 4 * fq + r) * 128 + 16 * nf + fr] = hacc[nf][r];
    __syncthreads();
}

DEVI void hgrn_unit(const Params& p, int l, Seq sq, int h, char* lds, int wv_) {
    bf16_t* sb = (bf16_t*)lds;
    bf16_t* qt = (bf16_t*)(lds + 34816);
    bf16_t* kt = (bf16_t*)(lds + 52224);
    bf16_t* att = (bf16_t*)lds;
    bf16_t* kT = (bf16_t*)(lds + 9216);
    bf16_t* vT = (bf16_t*)(lds + 27648);
    float* T0 = (float*)(lds + 69632); float* T1 = T0 + 128; float* ssq = T0 + 256;
    const int tid = tidx(wv_), lane = tid & 63, w = tid >> 6, fr = lane & 15, fq = lane >> 4;
    const int k = tid & 127, half = tid >> 7;
    const bf16_t* proj = (const bf16_t*)(p.ws + WS_PROJ); bf16_t* yhg = (bf16_t*)(p.ws + WS_YHG);
    float lb = 0.f;
    if (l == 1) { float a0 = p.in[I_LBL][h * 128 + k], a1 = p.in[I_LBL][1024 + h * 128 + k]; lb = 1.f / (1.f + __expf(a0 - a1)); }
    const float* nw = p.in[I_HGNW] + l * 128;
    const float* st_in; float* st_out;
    if (sq.samp) { st_in = p.in[I_HG] + ((size_t)(l * 16 + sq.b) * 8 + h) * 16384; st_out = p.out + O_HG_S + ((size_t)(l * 16 + sq.b) * 8 + h) * 16384; }
    else { st_out = p.out + O_HG_P + ((size_t)(l * 16 + sq.b) * 8 + h) * 16384; st_in = sq.seg ? st_out : nullptr; }
    f32x4 hacc[2][8];
#pragma unroll
    for (int mf = 0; mf < 2; ++mf)
#pragma unroll
        for (int nf = 0; nf < 8; ++nf)
#pragma unroll
            for (int r = 0; r < 4; ++r) hacc[mf][nf][r] = st_in ? st_in[(32 * w + 16 * mf + 4 * fq + r) * 128 + 16 * nf + fr] : 0.f;
    f32x4 nwr[2];
#pragma unroll
    for (int mf = 0; mf < 2; ++mf) nwr[mf] = *(const f32x4*)(nw + 32 * w + 16 * mf + 4 * fq);
    bf16_t* rawF = (bf16_t*)(lds + 71680); bf16_t* rawQ = (bf16_t*)(lds + 88064); bf16_t* rawV = (bf16_t*)(lds + 104448); bf16_t* rawH = (bf16_t*)(lds + 120832);
    const char* gf = (const char*)(proj + PC_HF + h * 128); const char* gq = (const char*)(proj + PC_HQ + h * 128); const char* gv = (const char*)(proj + PC_HI + h * 128); const char* gh = (const char*)(proj + PC_HGATE + h * 128);
    asm volatile("s_waitcnt vmcnt(0)" ::: "memory");
    {   const size_t ro = (size_t)sq.row0 * NPROJ * 2;
        stage_raw<256>(gf + ro, (size_t)NPROJ * 2, (char*)rawF, tid); stage_raw<256>(gq + ro, (size_t)NPROJ * 2, (char*)rawQ, tid); stage_raw<256>(gv + ro, (size_t)NPROJ * 2, (char*)rawV, tid); }
    for (int c = 0; c < sq.nchunk; ++c) {
        const int tid = tidx(wv_), lane = tid & 63, w = tid >> 6, fr = lane & 15, fq = lane >> 4, k = tid & 127, half = tid >> 7;
        const int rowc = sq.row0 + c * 64; const bool lastc = (c == sq.nchunk - 1);
        asm volatile("s_waitcnt vmcnt(0)" ::: "memory");
        __syncthreads();
        stage_raw<256>(gh + (size_t)rowc * NPROJ * 2, (size_t)NPROJ * 2, (char*)rawH, tid);
        {
            unsigned fu[32], qu[32];
#pragma unroll
            for (int jj = 0; jj < 32; ++jj) { fu[jj] = rawF[(32 * half + jj) * 128 + k]; qu[jj] = rawQ[(32 * half + jj) * 128 + k]; }
            if (tid < 64) ssq[tid] = 0.f;
            float run = 0.f;
            if (half == 0) {
#pragma unroll
                for (int jj = 31; jj >= 0; --jj) { bool valid = jj < sq.Q; float f = __uint_as_float(fu[jj] << 16);
                    float sg = __builtin_amdgcn_rcpf(1.f + __expf(-f)); float lg0 = __logf(lb + (1.f - lb) * sg); float lg = valid ? lg0 : 0.f;
                    float kk0 = (1.f - lb) * (1.f - sg); float kk = valid ? kk0 : 0.f; float q0 = __uint_as_float(qu[jj] << 16); float q = valid ? q0 : 0.f;
                    qt[jj * 136 + k] = f2bf(q * cexp(-run)); kt[jj * 136 + k] = f2bf(kk * cexp(run)); run += lg; }
                T0[k] = run;
            } else {
#pragma unroll
                for (int jj = 0; jj < 32; ++jj) { bool valid = (32 + jj) < sq.Q; float f = __uint_as_float(fu[jj] << 16);
                    float sg = __builtin_amdgcn_rcpf(1.f + __expf(-f)); float lg0 = __logf(lb + (1.f - lb) * sg); float lg = valid ? lg0 : 0.f;
                    float kk0 = (1.f - lb) * (1.f - sg); float kk = valid ? kk0 : 0.f; float q0 = __uint_as_float(qu[jj] << 16); float q = valid ? q0 : 0.f;
                    run += lg; qt[(32 + jj) * 136 + k] = f2bf(q * cexp(run)); kt[(32 + jj) * 136 + k] = f2bf(kk * cexp(-run)); }
                T1[k] = run;
            }
        }
        __syncthreads();
#pragma unroll
        for (int mf = 0; mf < 2; ++mf) { int k0 = 32 * w + 16 * mf + 4 * fq; float e0 = __expf(T0[k0]), e1 = __expf(T0[k0 + 1]), e2 = __expf(T0[k0 + 2]), e3 = __expf(T0[k0 + 3]);
#pragma unroll
            for (int nf = 0; nf < 8; ++nf) { hacc[mf][nf][0] *= e0; hacc[mf][nf][1] *= e1; hacc[mf][nf][2] *= e2; hacc[mf][nf][3] *= e3;
                us4 o; o[0] = f2bf(hacc[mf][nf][0]); o[1] = f2bf(hacc[mf][nf][1]); o[2] = f2bf(hacc[mf][nf][2]); o[3] = f2bf(hacc[mf][nf][3]);
                *(us4*)(sb + (16 * nf + fr) * 136 + k0) = o; } }
        f32x4 at[4];
#pragma unroll
        for (int nf = 0; nf < 4; ++nf) at[nf] = (f32x4){0.f, 0.f, 0.f, 0.f};
        lds_mma<4, 4>(at, kt, 136, 16 * w, qt, 136, 0, wv_);
        __syncthreads();
        f32x4 oacc[2][4];
#pragma unroll
        for (int mf = 0; mf < 2; ++mf) {
#pragma unroll
            for (int nf = 0; nf < 4; ++nf) oacc[mf][nf] = (f32x4){0.f, 0.f, 0.f, 0.f};
            lds_mma<4, 4>(oacc[mf], sb, 136, 32 * w + 16 * mf, qt, 136, 0, wv_); }
        __syncthreads();
#pragma unroll
        for (int nf = 0; nf < 4; ++nf) { int i = 16 * nf + fr; us4 o;
#pragma unroll
            for (int r = 0; r < 4; ++r) { int j = 16 * w + 4 * fq + r; o[r] = f2bf(j <= i ? at[nf][r] : 0.f); }
            *(us4*)(att + i * 72 + 16 * w + 4 * fq) = o; }
        {   unsigned vu[32];
#pragma unroll
            for (int jj = 0; jj < 32; ++jj) vu[jj] = rawV[(32 * half + jj) * 128 + k];
#pragma unroll
            for (int q4 = 0; q4 < 4; ++q4) { us8 kv, vv;
#pragma unroll
                for (int e = 0; e < 8; ++e) { int jj = q4 * 8 + e; bool valid = (32 * half + jj) < sq.Q; kv[e] = kt[(32 * half + jj) * 136 + k]; vv[e] = valid ? (bf16_t)vu[jj] : (bf16_t)0; }
                *(us8*)(kT + k * 72 + 32 * half + q4 * 8) = kv; *(us8*)(vT + k * 72 + 32 * half + q4 * 8) = vv; } }
        __syncthreads();
        if (!lastc) { const size_t ro = (size_t)(rowc + 64) * NPROJ * 2;
            stage_raw<256>(gf + ro, (size_t)NPROJ * 2, (char*)rawF, tid); stage_raw<256>(gq + ro, (size_t)NPROJ * 2, (char*)rawQ, tid); stage_raw<256>(gv + ro, (size_t)NPROJ * 2, (char*)rawV, tid); }
#pragma unroll
        for (int mf = 0; mf < 2; ++mf) {
            lds_mma<4, 2>(oacc[mf], vT, 72, 32 * w + 16 * mf, att, 72, 0, wv_);
            lds_mma<8, 2>(hacc[mf], kT, 72, 32 * w + 16 * mf, vT, 72, 0, wv_);
            int k0 = 32 * w + 16 * mf + 4 * fq; float e0 = __expf(T1[k0]), e1 = __expf(T1[k0 + 1]), e2 = __expf(T1[k0 + 2]), e3 = __expf(T1[k0 + 3]);
#pragma unroll
            for (int nf = 0; nf < 8; ++nf) { hacc[mf][nf][0] *= e0; hacc[mf][nf][1] *= e1; hacc[mf][nf][2] *= e2; hacc[mf][nf][3] *= e3; } }
#pragma unroll
        for (int nf = 0; nf < 4; ++nf) { float s = 0.f;
#pragma unroll
            for (int mf = 0; mf < 2; ++mf)
#pragma unroll
                for (int r = 0; r < 4; ++r) s += oacc[mf][nf][r] * oacc[mf][nf][r];
            s += shflx(s, 16, lane); s += shflx(s, 32, lane);
            if (fq == 0) atomicAdd(&ssq[16 * nf + fr], s); }
        if (lastc) asm volatile("s_waitcnt vmcnt(0)" ::: "memory"); else asm volatile("s_waitcnt vmcnt(12)" ::: "memory");
        __syncthreads();
#pragma unroll
        for (int nf = 0; nf < 4; ++nf) { int i = 16 * nf + fr; float rs = rsqrtf(ssq[i] * (1.f / 128.f) + 1e-6f);
#pragma unroll
            for (int mf = 0; mf < 2; ++mf) { int v0 = 32 * w + 16 * mf + 4 * fq; us4 gt = *(const us4*)(rawH + i * 128 + v0); f32x4 wv = nwr[mf]; us4 o;
#pragma unroll
                for (int r = 0; r < 4; ++r) o[r] = f2bf(oacc[mf][nf][r] * rs * wv[r] * bf2f(gt[r]));
                if (i < sq.Q) *(us4*)(yhg + (size_t)(rowc + i) * 1024 + h * 128 + v0) = o; } }
        __syncthreads();
    }
#pragma unroll
    for (int mf = 0; mf < 2; ++mf)
#pragma unroll
        for (int nf = 0; nf < 8; ++nf)
#pragma unroll
            for (int r = 0; r < 4; ++r) st_out[(32 * w + 16 * mf + 4 * fq + r) * 128 + 16 * nf + fr] = hacc[mf][nf][r];
}

DEVI void rg_unit(const Params& p, int l, Seq sq, int blk, char* lds, int wv_) {
    bf16_t* waT = (bf16_t*)lds; bf16_t* wiT = (bf16_t*)(lds + 9216); bf16_t* xr = (bf16_t*)(lds + 18432);
    float* av = (float*)(lds + 27648); float* uv = (float*)(lds + 44288); float* Pq = (float*)(lds + 60928); float* Hq = Pq + 256; float* carry = Hq + 256;
    const int tid = tidx(wv_), lane = tid & 63, w = tid >> 6, fr = lane & 15, fq = lane >> 4;
    const bf16_t* proj = (const bf16_t*)(p.ws + WS_PROJ); bf16_t* yrg = (bf16_t*)(p.ws + WS_YRG);
    const int cb0 = blk * 64;
    const float* cw = p.in[I_RCW] + (size_t)l * 4 * 1024; const float* cbias = p.in[I_RCB] + l * 1024;
    const float* st_in; float* st_out; const float* hist; float* hist_out;
    if (sq.samp) { st_in = p.in[I_RG] + (size_t)(l * 16 + sq.b) * 1024; st_out = p.out + O_RG_S + (size_t)(l * 16 + sq.b) * 1024;
        hist = p.in[I_RCV] + (size_t)(l * 16 + sq.b) * 3 * 1024; hist_out = p.out + O_RCV_S + (size_t)(l * 16 + sq.b) * 3 * 1024; }
    else { st_out = p.out + O_RG_P + (size_t)(l * 16 + sq.b) * 1024; st_in = sq.seg ? st_out : nullptr;
        hist_out = p.out + O_RCV_P + (size_t)(l * 16 + sq.b) * 3 * 1024; hist = sq.seg ? hist_out : nullptr; }
    float* cwl = (float*)(lds + 63232);
    float* hl = (float*)(lds + 64512);
    float* hl2 = (float*)(lds + 90112);
    for (int idx = tid; idx < 320; idx += 256) { int k = idx >> 6, cc = idx & 63; cwl[idx] = k < 4 ? cw[k * 1024 + cb0 + cc] : cbias[cb0 + cc]; if (idx < 192) hl[idx] = hist ? hist[k * 1024 + cb0 + cc] : 0.f; }
    {   const float* wa = p.in[I_RWA] + ((size_t)l * 16 + blk) * 4096; const float* wi = p.in[I_RWI] + ((size_t)l * 16 + blk) * 4096;
        float wa_[16], wi_[16];
#pragma unroll
        for (int u = 0; u < 16; ++u) { wa_[u] = wa[tid + 256 * u]; wi_[u] = wi[tid + 256 * u]; }
#pragma unroll
        for (int u = 0; u < 16; ++u) { int e = tid + 256 * u, i = e >> 6, j = e & 63; waT[j * 72 + i] = f2bf(wa_[u]); wiT[j * 72 + i] = f2bf(wi_[u]); }
        if (tid < 64) carry[tid] = st_in ? st_in[cb0 + tid] : 0.f; }
    float cba[4], cbi[4], csp[4];
#pragma unroll
    for (int nf = 0; nf < 4; ++nf) { int cc = cb0 + 16 * nf + fr; cba[nf] = p.in[I_RBA][l * 1024 + cc]; cbi[nf] = p.in[I_RBI][l * 1024 + cc]; csp[nf] = softplus(-p.in[I_RLAM][l * 1024 + cc]); }
    bf16_t* rawR = (bf16_t*)(lds + 65536); bf16_t* rawG = (bf16_t*)(lds + 73728);
    const char* gr = (const char*)(proj + PC_RX + cb0); const char* gg = (const char*)(proj + PC_RGATE + cb0);
    asm volatile("s_waitcnt vmcnt(0)" ::: "memory");
    stage_raw<128>(gr + (size_t)sq.row0 * NPROJ * 2, (size_t)NPROJ * 2, (char*)rawR, tid); stage_raw<128>(gg + (size_t)sq.row0 * NPROJ * 2, (size_t)NPROJ * 2, (char*)rawG, tid);
    for (int c = 0; c < sq.nchunk; ++c) {
        const int tid = tidx(wv_), lane = tid & 63, w = tid >> 6, fr = lane & 15, fq = lane >> 4, j = tid & 63, q = tid >> 6;
        const int rowc = sq.row0 + c * 64; const bool lastc = (c == sq.nchunk - 1);
        const float* hlr = (c & 1) ? hl2 : hl; float* hlw = (c & 1) ? hl : hl2;
        asm volatile("s_waitcnt vmcnt(0)" ::: "memory");
        __syncthreads();
#pragma unroll
        for (int i = 0; i < 2; ++i) { int it = tid + 256 * i, t = it >> 3, c8 = (it & 7) * 8; float o[8], raw[8]; int ch = cb0 + c8; const bool tv = t < sq.Q;
            conv_lds(rawR, 64, t, c8, hlr, cwl, 64, c8, o, raw);
            if (t >= 61) {
#pragma unroll
                for (int e = 0; e < 8; ++e) hlw[(t - 61) * 64 + c8 + e] = raw[e]; }
            if (lastc && tv && t >= sq.Q - 3) {
#pragma unroll
                for (int e = 0; e < 8; ++e) hist_out[(t - (sq.Q - 3)) * 1024 + ch + e] = raw[e]; }
            us8 ov;
#pragma unroll
            for (int e = 0; e < 8; ++e) { float ox = tv ? o[e] : 0.f; ov[e] = f2bf(ox); uv[t * 65 + c8 + e] = ox; }
            *(us8*)(xr + t * 72 + c8) = ov; }
        __syncthreads();
        if (!lastc) { const size_t ro = (size_t)(rowc + 64) * NPROJ * 2; stage_raw<128>(gr + ro, (size_t)NPROJ * 2, (char*)rawR, tid); stage_raw<128>(gg + ro, (size_t)NPROJ * 2, (char*)(rawG + ((c + 1) & 1) * 4096), tid); }
        f32x4 ra[4], ri[4];
#pragma unroll
        for (int nf = 0; nf < 4; ++nf) { ra[nf] = (f32x4){0.f, 0.f, 0.f, 0.f}; ri[nf] = (f32x4){0.f, 0.f, 0.f, 0.f}; }
        lds_mma<4, 2>(ra, xr, 72, 16 * w, waT, 72, 0, wv_);
        lds_mma<4, 2>(ri, xr, 72, 16 * w, wiT, 72, 0, wv_);
#pragma unroll
        for (int nf = 0; nf < 4; ++nf) { int jj = 16 * nf + fr; float ba = cba[nf], bi = cbi[nf], sp = csp[nf];
#pragma unroll
            for (int r = 0; r < 4; ++r) { int t = 16 * w + 4 * fq + r; float rr = sigm(ra[nf][r] + ba), ii = sigm(ri[nf][r] + bi); float la = -8.f * sp * rr; float aa = __expf(la);
                float u = __builtin_sqrtf(fmaxf(1.f - aa * aa, 0.f)) * ii * uv[t * 65 + jj];
                if (t >= sq.Q) { aa = 1.f; u = 0.f; }
                av[t * 65 + jj] = aa; uv[t * 65 + jj] = u; } }
        __syncthreads();
        { float P = 1.f, H = 0.f;
#pragma unroll
          for (int tt = 0; tt < 16; ++tt) { int t = 16 * q + tt; float aa = av[t * 65 + j], u = uv[t * 65 + j]; H = aa * H + u; P *= aa; }
          Pq[q * 64 + j] = P; Hq[q * 64 + j] = H; }
        __syncthreads();
        float hcur = carry[j];
        for (int qq = 0; qq < q; ++qq) hcur = Pq[qq * 64 + j] * hcur + Hq[qq * 64 + j];
        const bf16_t* rg_ = rawG + (c & 1) * 4096;
        bf16_t gts[16];
#pragma unroll
        for (int tt = 0; tt < 16; ++tt) gts[tt] = rg_[(16 * q + tt) * 64 + j];
#pragma unroll
        for (int tt = 0; tt < 16; ++tt) { int t = 16 * q + tt; float aa = av[t * 65 + j], u = uv[t * 65 + j]; hcur = aa * hcur + u;
            if (t < sq.Q) yrg[(size_t)(rowc + t) * 1024 + cb0 + j] = f2bf(bf2f(gts[tt]) * hcur); }
        __syncthreads();
        if (q == 3) carry[j] = hcur;
        __syncthreads();
    }
    if (tid < 64) st_out[cb0 + tid] = carry[tid];
    __syncthreads();
}

DEVI void phase_mix(const Params& p, int l, int seg, char* lds, int wv_) {
    const int ngrp = seg == 0 ? 2 : 1; const int NU = ngrp * 640;
    for (int u = blockIdx.x; u < NU; u += gridDim.x) {
        int grp = u / 640, v = u % 640;
        if (v < 128) hgrn_unit(p, l, make_seq(seg, grp * 16 + (v >> 3)), v & 7, lds, wv_);
        else if (v < 384) { v -= 128; ssd_unit(p, l, make_seq(seg, grp * 16 + (v >> 4)), v & 15, lds, wv_); }
        else { v -= 384; rg_unit(p, l, make_seq(seg, grp * 16 + (v >> 4)), v & 15, lds, wv_); }
        __syncthreads();
    }
}

DEVI void gbar(const Params& p, unsigned& epoch_, int wv_) {
    const unsigned epoch = __builtin_amdgcn_readfirstlane(epoch_); epoch_ = epoch + 1u;
    unsigned* ctr = (unsigned*)(p.ws + WS_END); asm volatile("" : "+s"(ctr));
    asm volatile("s_waitcnt vmcnt(0)" ::: "memory");
    __syncthreads();
    if (tidx(wv_) == 0) {
        __builtin_amdgcn_fence(__ATOMIC_RELEASE, "agent");
        asm volatile("s_waitcnt vmcnt(0)" ::: "memory");
        __hip_atomic_fetch_add(ctr, 1u, __ATOMIC_RELAXED, __HIP_MEMORY_SCOPE_AGENT);
        const unsigned target = (epoch + 1u) * gridDim.x;
        while (__hip_atomic_load(ctr, __ATOMIC_RELAXED, __HIP_MEMORY_SCOPE_AGENT) < target) __builtin_amdgcn_s_sleep(1);
        __builtin_amdgcn_fence(__ATOMIC_ACQUIRE, "agent");
        asm volatile("s_waitcnt vmcnt(0)" ::: "memory");
    }
    __syncthreads();
}

__global__ void __launch_bounds__(256) fwd_mega(Params p) {
    extern __shared__ __attribute__((aligned(16))) char lds[];
    const int wv_ = __builtin_amdgcn_readfirstlane((int)(__builtin_amdgcn_workitem_id_x() >> 6));
    cg::grid_group grid = cg::this_grid();
    unsigned epoch = 0;
    phase_prep(p, lds, wv_);
    grid.sync();
#pragma unroll 1
    for (int seg = 0; seg < NSEG; ++seg) {
        const int nrows = seg == 0 ? ROWS : ROWS_P, MT = nrows / 256;
#pragma unroll 1
        for (int l = 0; l < 2; ++l) {
            const bf16_t* wl = (const bf16_t*)p.ws + (size_t)l * E_LAYER;
            phase_norm(p, seg, nrows, p.in[I_NMIX] + l * 1024, l == 0, l, lds, wv_);
            gbar(p, epoch, wv_);
            for (int r = 0; r < p.rep[0]; ++r) { phase_proj(p, l, MT, lds, wv_); gbar(p, epoch, wv_); }
            for (int r = 0; r < (seg == 0 ? p.rep[3] : 1); ++r) { phase_mix(p, l, seg, lds, wv_); gbar(p, epoch, wv_); }
            phase_mbnorm(p, l, nrows, wv_);
            gbar(p, epoch, wv_);
            for (int r = 0; r < p.rep[1]; ++r) { phase_merge(p, l, MT, lds, wv_); gbar(p, epoch, wv_); }
            phase_resid(p, seg, MT, (const bf16_t*)(p.ws + WS_MRG), 1024, wl + E_WIN + E_WBR, l == 0, lds, wv_);
            gbar(p, epoch, wv_);
            phase_norm(p, seg, nrows, p.in[I_NFFN] + l * 1024, false, -1, lds, wv_);
            gbar(p, epoch, wv_);
            for (int r = 0; r < p.rep[2]; ++r) { phase_ffn_in(p, l, MT, lds, wv_); gbar(p, epoch, wv_); }
            phase_resid(p, seg, MT, (const bf16_t*)(p.ws + WS_PROJ), FFH, wl + E_WIN + E_WBR + E_WOUT + E_WFI, false, lds, wv_);
            gbar(p, epoch, wv_);
        }
        phase_final_norm(p, seg, nrows, wv_);
    }
}

extern "C" void kernel_launch(void* const* d_in, const int* in_sizes, int n_in, void* d_out, int out_size, void* d_ws, size_t ws_size, hipStream_t stream) {
    static int grid_blocks = 0;
    if (!grid_blocks) {
        int dev = 0, cus = 0, per_cu = 0;
        (void)hipGetDevice(&dev);
        (void)hipDeviceGetAttribute(&cus, hipDeviceAttributeMultiprocessorCount, dev);
        (void)hipFuncSetAttribute((const void*)fwd_mega, hipFuncAttributeMaxDynamicSharedMemorySize, LDS_BYTES);
        (void)hipOccupancyMaxActiveBlocksPerMultiprocessor(&per_cu, (const void*)fwd_mega, 256, LDS_BYTES);
        if (per_cu < 1) fprintf(stderr, "occupancy query says %d blocks per CU\n", per_cu);
        grid_blocks = cus;
        if (ws_size < WS_TOTAL) fprintf(stderr, "workspace too small: %zu < %zu\n", ws_size, (size_t)WS_END + 256);
    }
    (void)hipMemsetAsync((char*)d_ws + WS_END, 0, 256, stream);
    Params p{};
    for (int i = 0; i < 30; ++i) p.in[i] = (const float*)d_in[i];
    p.out = (float*)d_out; p.ws = (unsigned char*)d_ws; p.rep[0] = REP0; p.rep[1] = REP1; p.rep[2] = REP2; p.rep[3] = REP3;
    void* args[] = {&p};
    hipError_t e = hipLaunchCooperativeKernel((const void*)fwd_mega, dim3(grid_blocks), dim3(256), args, LDS_BYTES, stream);
    if (e != hipSuccess) fprintf(stderr, "cooperative launch failed: %s (grid %d)\n", hipGetErrorString(e), grid_blocks);
}
```

```cpp
#include <hip/hip_runtime.h>
#include <hip/hip_cooperative_groups.h>
#include <cstdio>
namespace cg = cooperative_groups;

typedef unsigned short bf16_t;
typedef short bf16x8 __attribute__((ext_vector_type(8)));
typedef float f32x4 __attribute__((ext_vector_type(4)));
typedef unsigned short us4 __attribute__((ext_vector_type(4)));
typedef unsigned short us8 __attribute__((ext_vector_type(8)));
#define DEVI __device__ __forceinline__

constexpr int LDK = 1088, LDF = 2880;
constexpr int D = 1024, NPROJ = 12288, SEGT = 512, NSEG = 4, ROWS_P = 8192, ROWS = 8704, FFH = 2816;
constexpr int PC_Z = 0, PC_XBC = 1024, PC_HQ = 3072, PC_HF = 4096, PC_HI = 5120, PC_HGATE = 6144, PC_RGATE = 7168, PC_RX = 8192, PC_MG = 9216, PC_DT = 12288;
constexpr size_t E_WIN = (size_t)NPROJ * LDK, E_WBR = 3u * 1024 * LDK, E_WOUT = 1024u * LDK, E_WFI = 5632u * LDK, E_WFO = 1024u * LDF;
constexpr size_t E_LAYER = E_WIN + E_WBR + E_WOUT + E_WFI + E_WFO;
constexpr size_t WS_PROJ = 2 * E_LAYER * 2;
constexpr size_t WS_DT = WS_PROJ + (size_t)ROWS * NPROJ * 2;
constexpr size_t WS_XB = WS_DT + (size_t)ROWS * 16 * 4;
constexpr size_t WS_YMB = WS_XB + (size_t)ROWS * LDK * 2;
constexpr size_t WS_YHG = WS_YMB + (size_t)ROWS * LDK * 2;
constexpr size_t WS_YRG = WS_YHG + (size_t)ROWS * LDK * 2;
constexpr size_t WS_MRG = WS_YRG + (size_t)ROWS * LDK * 2;
constexpr size_t WS_END = WS_MRG + (size_t)ROWS * LDK * 2;
constexpr size_t WS_HB = WS_END + 256;
constexpr size_t WS_DTW = WS_HB + 2u * 2 * 16 * 3 * 2048 * 4;
constexpr size_t WS_TOTAL = WS_DTW + 2u * 16 * 1024 * 4;
constexpr size_t O_YP = 0, O_YS = 33554432, O_SSM_P = 34078720, O_SCV_P = 38273024, O_HG_P = 38469632, O_RG_P = 42663936, O_RCV_P = 42696704,
                 O_SSM_S = 42795008, O_SCV_S = 46989312, O_HG_S = 47185920, O_RG_S = 51380224, O_RCV_S = 51412992;
constexpr int REP0 = 1, REP1 = 1, REP2 = 1, REP3 = 1;
constexpr int LDS_BYTES = 144 * 1024;

enum { I_XP = 0, I_XS, I_SSM, I_SCV, I_HG, I_RG, I_RCV, I_NMIX, I_WIN, I_MCW, I_MCB, I_DTB, I_ALOG, I_MBD, I_MBNW, I_LBL, I_HGNW, I_RCW, I_RCB, I_RWA, I_RBA, I_RWI, I_RBI, I_RLAM, I_WBR, I_WOUT, I_NFFN, I_WFI, I_WFO, I_NFIN };

struct Params { const float* in[30]; float* out; unsigned char* ws; int rep[4]; };

DEVI int tidx(int wv_) { int t = ((wv_ & 3) << 6) | (int)__builtin_amdgcn_mbcnt_hi(~0u, __builtin_amdgcn_mbcnt_lo(~0u, 0u)); asm volatile("" : "+v"(t)); return t; }
DEVI float shfli(float v, int srcl) { return __int_as_float(__builtin_amdgcn_ds_bpermute(srcl << 2, __float_as_int(v))); }
DEVI float shflx(float v, int m, int lane) { return shfli(v, lane ^ m); }
DEVI bf16_t f2bf(float f) { unsigned u = __float_as_uint(f); u += 0x7fffu + ((u >> 16) & 1u); return (bf16_t)(u >> 16); }
DEVI float bf2f(bf16_t h) { return __uint_as_float(((unsigned)h) << 16); }
DEVI float sigm(float x) { return 1.f / (1.f + __expf(-x)); }
DEVI float silu(float x) { return x / (1.f + __expf(-x)); }
DEVI float softplus(float x) { return x > 20.f ? x : __logf(1.f + __expf(x)); }
DEVI float gelu_t(float x) { float u = 0.7978845608f * (x + 0.044715f * x * x * x); return x * sigm(2.f * u); }
DEVI float cexp(float x) { return __expf(fminf(x, 80.f)); }

DEVI const float* xrow_in(const Params& p, int seg, int r) {
    if (r < ROWS_P) { int b = r >> 9, tt = r & 511; return p.in[I_XP] + ((size_t)(b * 2048 + seg * SEGT + tt)) * D; }
    return p.in[I_XS] + (size_t)(r - ROWS_P) * D;
}
DEVI float* xrow_out(const Params& p, int seg, int r) {
    if (r < ROWS_P) { int b = r >> 9, tt = r & 511; return p.out + O_YP + ((size_t)(b * 2048 + seg * SEGT + tt)) * D; }
    return p.out + O_YS + (size_t)(r - ROWS_P) * D;
}

DEVI int map_win(int n) { return n < 3072 ? n : n + 16; }
DEVI int map_wfi(int n) { int T = n >> 7, q = (n >> 5) & 3, s = (n >> 4) & 1, i = n & 15; return s * FFH + 64 * T + 16 * q + i; }

DEVI void transpose_tile(const float* src, int ldsrc, bf16_t* dst, int K, int k0, int n0, int mode, float* tile  , int wv_) {
    const int tid = tidx(wv_), c = tid & 63, rq = tid >> 6;
    int n = n0 + c, sn = mode == 1 ? map_win(n) : (mode == 2 ? map_wfi(n) : n);
#pragma unroll
    for (int rr = 0; rr < 16; ++rr) { int kl = rr * 4 + rq; tile[kl * 65 + c] = sn >= 0 ? src[(size_t)(k0 + kl) * ldsrc + sn] : 0.f; }
    __syncthreads();
#pragma unroll
    for (int rr = 0; rr < 16; ++rr) { int nl = rr * 4 + rq; dst[(size_t)(n0 + nl) * K + k0 + c] = f2bf(tile[c * 65 + nl]); }
    __syncthreads();
}

DEVI void phase_prep(const Params& p, char* lds, int wv_) {
    float* tile = (float*)lds;
    bf16_t* wsb = (bf16_t*)p.ws;
    constexpr int T_WIN = 16 * 192, T_WBR = 3 * 256, T_WOUT = 256, T_WFI = 16 * 88, T_WFO = 44 * 16, T_L = T_WIN + T_WBR + T_WOUT + T_WFI + T_WFO;
    {   float* dtw = (float*)(p.ws + WS_DTW);
        for (int e = blockIdx.x * 256 + tidx(wv_); e < 32768; e += gridDim.x * 256) { int l = e >> 14, j = (e >> 10) & 15, k = e & 1023; dtw[e] = p.in[I_WIN][(size_t)l * 1024 * 12304 + (size_t)k * 12304 + 3072 + j]; } }
    for (int t = blockIdx.x; t < 2 * T_L; t += gridDim.x) {
        int l = t / T_L, j = t % T_L;
        bf16_t* wl = wsb + (size_t)l * E_LAYER;
        if (j < T_WIN) { int kt = j & 15, nt = j >> 4; transpose_tile(p.in[I_WIN] + (size_t)l * 1024 * 12304, 12304, wl, LDK, kt * 64, nt * 64, 1, tile, wv_); continue; }
        j -= T_WIN;
        if (j < T_WBR) { int k = j >> 8, jj = j & 255, kt = jj & 15, nt = jj >> 4;
            transpose_tile(p.in[I_WBR] + ((size_t)l * 3 + k) * 1024 * 1024, 1024, wl + E_WIN + (size_t)k * 1024 * LDK, LDK, kt * 64, nt * 64, 0, tile, wv_); continue; }
        j -= T_WBR;
        if (j < T_WOUT) { int kt = j & 15, nt = j >> 4; transpose_tile(p.in[I_WOUT] + (size_t)l * 1024 * 1024, 1024, wl + E_WIN + E_WBR, LDK, kt * 64, nt * 64, 0, tile, wv_); continue; }
        j -= T_WOUT;
        if (j < T_WFI) { int kt = j & 15, nt = j >> 4; transpose_tile(p.in[I_WFI] + (size_t)l * 1024 * 5632, 5632, wl + E_WIN + E_WBR + E_WOUT, LDK, kt * 64, nt * 64, 2, tile, wv_); continue; }
        j -= T_WFI;
        { int kt = j % 44, nt = j / 44; transpose_tile(p.in[I_WFO] + (size_t)l * 2816 * 1024, 1024, wl + E_WIN + E_WBR + E_WOUT + E_WFI, LDF, kt * 64, nt * 64, 0, tile, wv_); }
    }
}

DEVI void phase_norm(const Params& p, int seg, int nrows, const float* w, bool from_input, int ldt  , char* lds, int wv_) {
    bf16_t* xb = (bf16_t*)(p.ws + WS_XB); float* dtb = (float*)(p.ws + WS_DT);
    const int lane = tidx(wv_) & 63, wv = tidx(wv_) >> 6;
    float* dw = (float*)lds;
    if (ldt >= 0) { const float* dtw = (const float*)(p.ws + WS_DTW) + ldt * 16384; f32x4 t_[16];
#pragma unroll
        for (int u = 0; u < 16; ++u) t_[u] = *(const f32x4*)(dtw + (tidx(wv_) + 256 * u) * 4);
#pragma unroll
        for (int u = 0; u < 16; ++u) *(f32x4*)(dw + (tidx(wv_) + 256 * u) * 4) = t_[u];
        __syncthreads(); }
    for (int r = blockIdx.x * 4 + wv; r < nrows; r += gridDim.x * 4) {
        const float* x = from_input ? xrow_in(p, seg, r) : xrow_out(p, seg, r);
        f32x4 v[4]; float ss = 0.f;
#pragma unroll
        for (int i = 0; i < 4; ++i) { v[i] = *(const f32x4*)(x + i * 256 + lane * 4); ss += v[i][0] * v[i][0] + v[i][1] * v[i][1] + v[i][2] * v[i][2] + v[i][3] * v[i][3]; }
#pragma unroll
        for (int o = 32; o >= 1; o >>= 1) ss += shflx(ss, o, lane);
        float rs = rsqrtf(ss * (1.f / 1024.f) + 1e-6f);
#pragma unroll
        for (int i = 0; i < 4; ++i) { f32x4 wv4 = *(const f32x4*)(w + i * 256 + lane * 4); us4 o;
            v[i][0] *= rs * wv4[0]; v[i][1] *= rs * wv4[1]; v[i][2] *= rs * wv4[2]; v[i][3] *= rs * wv4[3];
            o[0] = f2bf(v[i][0]); o[1] = f2bf(v[i][1]); o[2] = f2bf(v[i][2]); o[3] = f2bf(v[i][3]);
            *(us4*)(xb + (size_t)r * LDK + i * 256 + lane * 4) = o; }
        if (ldt >= 0) {
            float d[16];
#pragma unroll
            for (int j = 0; j < 16; ++j) { float s = 0.f;
#pragma unroll
                for (int i = 0; i < 4; ++i) { f32x4 ww = *(const f32x4*)(dw + j * 1024 + i * 256 + lane * 4); s += v[i][0] * ww[0] + v[i][1] * ww[1] + v[i][2] * ww[2] + v[i][3] * ww[3]; }
                d[j] = s; }
            { const bool hi = lane & 32;
#pragma unroll
              for (int i = 0; i < 8; ++i) { float send = hi ? d[i] : d[i + 8], keep = hi ? d[i + 8] : d[i]; d[i] = keep + shfli(send, lane ^ 32); } }
            { const bool hi = lane & 16;
#pragma unroll
              for (int i = 0; i < 4; ++i) { float send = hi ? d[i] : d[i + 4], keep = hi ? d[i + 4] : d[i]; d[i] = keep + shfli(send, lane ^ 16); } }
            { const bool hi = lane & 8;
#pragma unroll
              for (int i = 0; i < 2; ++i) { float send = hi ? d[i] : d[i + 2], keep = hi ? d[i + 2] : d[i]; d[i] = keep + shfli(send, lane ^ 8); } }
            { const bool hi = lane & 4; float send = hi ? d[0] : d[1], keep = hi ? d[1] : d[0]; d[0] = keep + shfli(send, lane ^ 4); }
            d[0] += shfli(d[0], lane ^ 2); d[0] += shfli(d[0], lane ^ 1);
            if ((lane & 3) == 0) { int j = lane >> 2; dtb[(size_t)r * 16 + j] = softplus(d[0] + p.in[I_DTB][ldt * 16 + j]); }
        }
    }
    if (ldt >= 0) __syncthreads();
}
DEVI void phase_final_norm(const Params& p, int seg, int nrows, int wv_) {
    const float* w = p.in[I_NFIN];
    const int lane = tidx(wv_) & 63, wv = tidx(wv_) >> 6;
    for (int r = blockIdx.x * 4 + wv; r < nrows; r += gridDim.x * 4) {
        float* x = xrow_out(p, seg, r);
        f32x4 v[4]; float ss = 0.f;
#pragma unroll
        for (int i = 0; i < 4; ++i) { v[i] = *(const f32x4*)(x + i * 256 + lane * 4); ss += v[i][0] * v[i][0] + v[i][1] * v[i][1] + v[i][2] * v[i][2] + v[i][3] * v[i][3]; }
#pragma unroll
        for (int o = 32; o >= 1; o >>= 1) ss += shflx(ss, o, lane);
        float rs = rsqrtf(ss * (1.f / 1024.f) + 1e-6f);
#pragma unroll
        for (int i = 0; i < 4; ++i) { f32x4 wv4 = *(const f32x4*)(w + i * 256 + lane * 4); f32x4 o;
            o[0] = v[i][0] * rs * wv4[0]; o[1] = v[i][1] * rs * wv4[1]; o[2] = v[i][2] * rs * wv4[2]; o[3] = v[i][3] * rs * wv4[3];
            *(f32x4*)(x + i * 256 + lane * 4) = o; }
    }
}
DEVI void phase_mbnorm(const Params& p, int l, int nrows, int wv_) {
    bf16_t* y = (bf16_t*)(p.ws + WS_YMB); const float* w = p.in[I_MBNW] + l * 1024;
    const int lane = tidx(wv_) & 63, wv = tidx(wv_) >> 6;
    for (int it = blockIdx.x * 4 + wv; it < nrows * 4; it += gridDim.x * 4) {
        int r = it >> 2, g = it & 3; bf16_t* yp = y + (size_t)r * LDK + g * 256 + lane * 4;
        us4 v = *(const us4*)yp; float f0 = bf2f(v[0]), f1 = bf2f(v[1]), f2 = bf2f(v[2]), f3 = bf2f(v[3]);
        float ss = f0 * f0 + f1 * f1 + f2 * f2 + f3 * f3;
#pragma unroll
        for (int o = 32; o >= 1; o >>= 1) ss += shflx(ss, o, lane);
        float rs = rsqrtf(ss * (1.f / 256.f) + 1e-6f); f32x4 wv4 = *(const f32x4*)(w + g * 256 + lane * 4);
        us4 o; o[0] = f2bf(f0 * rs * wv4[0]); o[1] = f2bf(f1 * rs * wv4[1]); o[2] = f2bf(f2 * rs * wv4[2]); o[3] = f2bf(f3 * rs * wv4[3]);
        *(us4*)yp = o;
    }
}

#define WAIT_V(n) asm volatile("s_waitcnt vmcnt(" #n ")" ::: "memory")
#define RAW_BAR() do { asm volatile("" ::: "memory"); __builtin_amdgcn_s_barrier(); asm volatile("" ::: "memory"); } while (0)
template <int NF>
DEVI void stage_tile(const bf16_t* A, const bf16_t* Bt, int K, int t, char* st, int tid, size_t soff) {
    const size_t o = soff + (size_t)t * 32;
#pragma unroll
    for (int i = 0; i < 4; ++i) __builtin_amdgcn_global_load_lds((const unsigned*)(A + o + (size_t)i * 64 * K), (unsigned*)(st + tid * 16 + i * 4096), 16, 0, 0);
#pragma unroll
    for (int i = 0; i < NF / 2; ++i) __builtin_amdgcn_global_load_lds((const unsigned*)(Bt + o + (size_t)i * 64 * K), (unsigned*)(st + 16384 + tid * 16 + i * 4096), 16, 0, 0);
}
template <int NF>
DEVI void gemm_kloop(f32x4 (&acc)[8][NF], const bf16_t* A, const bf16_t* Bt, int K, int ld, char* lds, int wv_) {
    constexpr int STAGE = 16384 + NF * 2048;
    const int tid = tidx(wv_), lane = tid & 63, wid = tid >> 6, wr = wid >> 1, wc = wid & 1, fr = lane & 15, fq = lane >> 4;
    const int fo = fr * 64 + ((fq ^ (fr >> 2)) & 3) * 16;
    const int aoff = wr * 8192 + fo, boff = 16384 + wc * NF * 1024 + fo;
    const size_t soff = (size_t)(tid >> 2) * ld + (((tid & 3) ^ ((tid >> 4) & 3)) * 8);
    const int nt = K >> 5;
    WAIT_V(0); RAW_BAR();
    stage_tile<NF>(A, Bt, ld, 0, lds, tid, soff);
    stage_tile<NF>(A, Bt, ld, 1, lds + STAGE, tid, soff);
    stage_tile<NF>(A, Bt, ld, 2, lds + 2 * STAGE, tid, soff);
    for (int t = 0; t < nt; ++t) {
        if (t + 2 < nt) { if (NF == 8) WAIT_V(16); else WAIT_V(12); }
        else if (t + 1 < nt) { if (NF == 8) WAIT_V(8); else WAIT_V(6); }
        else WAIT_V(0);
        RAW_BAR();
        if (t + 3 < nt) stage_tile<NF>(A, Bt, ld, t + 3, lds + ((t + 3) & 3) * STAGE, tid, soff);
        const char* st = lds + (t & 3) * STAGE;
        bf16x8 af[8], bfr[NF];
        af[0] = *(const bf16x8*)(st + aoff);
#pragma unroll
        for (int n = 0; n < NF; ++n) bfr[n] = *(const bf16x8*)(st + boff + n * 1024);
        af[1] = *(const bf16x8*)(st + aoff + 1024);
#pragma unroll
        for (int g = 0; g < 8; ++g) {
            __builtin_amdgcn_sched_barrier(0);
            if (g < 6) af[g + 2] = *(const bf16x8*)(st + aoff + (g + 2) * 1024);
#pragma unroll
            for (int n = 0; n < NF; ++n) acc[g][n] = __builtin_amdgcn_mfma_f32_16x16x32_bf16(bfr[n], af[g], acc[g][n], 0, 0, 0);
        }
        __builtin_amdgcn_sched_barrier(0);
    }
}
DEVI bool next_tile(int it, int MT, int NT, int& mt, int& nt, int wv_) {
    const int x = (wv_ >> 2) & 7, bl = (wv_ >> 5) & 511, G8 = (wv_ >> 14) & 511;
    int nI = (MT - x + 7) >> 3; long j = (long)it * G8 + bl;
    if (j >= (long)nI * NT) return false;
    int i = (int)(j % nI); nt = (int)(j / nI); mt = x + 8 * i; return true;
}
#define ZERO_ACC(a, NF_) _Pragma("unroll") for (int m_ = 0; m_ < 8; ++m_) _Pragma("unroll") for (int n_ = 0; n_ < NF_; ++n_) a[m_][n_] = (f32x4){0.f, 0.f, 0.f, 0.f}
#define EPI_IDS const int lane = tidx(wv_) & 63, wid = tidx(wv_) >> 6, wr = wid >> 1, wc = wid & 1, fr = lane & 15, fq = lane >> 4

template <int ACT>
DEVI void proj_store(const f32x4 (&acc)[8][8], bf16_t* pbase, float c1, float c3, bool issig) {
#pragma unroll
    for (int m = 0; m < 8; ++m)
#pragma unroll
        for (int n = 0; n < 8; ++n) { f32x4 v = acc[m][n]; us4 o;
#pragma unroll
            for (int j = 0; j < 4; ++j) { float x = v[j];
                if (ACT) { float u = x * (c1 + c3 * x * x); float s = __builtin_amdgcn_rcpf(1.f + __expf(-u)); x = s * (issig ? 1.f : x); }
                o[j] = f2bf(x); }
            *(us4*)(pbase + (size_t)m * 16 * NPROJ + n * 16) = o; }
}
DEVI void phase_proj(const Params& p, int l, int MT, char* lds, int wv_) {
    const bf16_t* xb = (const bf16_t*)(p.ws + WS_XB); const bf16_t* wt = (const bf16_t*)p.ws + (size_t)l * E_LAYER;
    bf16_t* proj = (bf16_t*)(p.ws + WS_PROJ);
    int mt, nt;
    for (int it = 0; next_tile(it, MT, 48, mt, nt, wv_); ++it) {
        f32x4 acc[8][8]; ZERO_ACC(acc, 8);
        gemm_kloop<8>(acc, xb + (size_t)mt * 256 * LDK, wt + (size_t)nt * 256 * LDK, 1024, LDK, lds, wv_);
        EPI_IDS;
        const int sg = nt >> 2;
        const int ty = (sg == 0 || sg == 3 || sg == 6) ? 1 : (sg == 7 ? 2 : (sg >= 9 ? 3 : 0));
        bf16_t* pbase = proj + (size_t)(mt * 256 + wr * 128 + fr) * NPROJ + nt * 256 + wc * 128 + fq * 4;
        if (ty == 0) proj_store<0>(acc, pbase, 0.f, 0.f, false); else proj_store<1>(acc, pbase, ty == 2 ? 1.5957691216f : 1.f, ty == 2 ? 0.0713548163f : 0.f, ty == 3);
    }
}
DEVI void phase_merge(const Params& p, int l, int MT, char* lds, int wv_) {
    const bf16_t* wt = (const bf16_t*)p.ws + (size_t)l * E_LAYER + E_WIN; const bf16_t* proj = (const bf16_t*)(p.ws + WS_PROJ);
    bf16_t* mrg = (bf16_t*)(p.ws + WS_MRG);
    int mt, nt;
    for (int it = 0; next_tile(it, MT, 8, mt, nt, wv_); ++it) {
        f32x4 tot[8][4]; ZERO_ACC(tot, 4);
#pragma unroll 1
        for (int k = 0; k < 3; ++k) {
            const bf16_t* y = (const bf16_t*)(p.ws + WS_YMB + (size_t)k * ROWS * LDK * 2);
            f32x4 acc[8][4]; ZERO_ACC(acc, 4);
            gemm_kloop<4>(acc, y + (size_t)mt * 256 * LDK, wt + (size_t)k * 1024 * LDK + (size_t)nt * 128 * LDK, 1024, LDK, lds, wv_);
            EPI_IDS;
#pragma unroll
            for (int m = 0; m < 8; ++m) { int row = mt * 256 + wr * 128 + m * 16 + fr; asm volatile("" ::: "memory");
#pragma unroll
                for (int n = 0; n < 4; ++n) { int col = nt * 128 + wc * 64 + n * 16 + fq * 4; us4 g = *(const us4*)(proj + (size_t)row * NPROJ + PC_MG + k * 1024 + col);
#pragma unroll
                    for (int j = 0; j < 4; ++j) tot[m][n][j] += acc[m][n][j] * bf2f(g[j]); } }
        }
        EPI_IDS;
#pragma unroll
        for (int m = 0; m < 8; ++m) { int row = mt * 256 + wr * 128 + m * 16 + fr;
#pragma unroll
            for (int n = 0; n < 4; ++n) { int col = nt * 128 + wc * 64 + n * 16 + fq * 4; us4 o;
#pragma unroll
                for (int j = 0; j < 4; ++j) o[j] = f2bf(tot[m][n][j]);
                *(us4*)(mrg + (size_t)row * LDK + col) = o; } }
    }
}
DEVI void phase_resid(const Params& p, int seg, int MT, const bf16_t* A, int K, int ld, const bf16_t* Bt, bool from_input, char* lds, int wv_) {
    int mt, nt;
    for (int it = 0; next_tile(it, MT, 8, mt, nt, wv_); ++it) {
        f32x4 acc[8][4]; ZERO_ACC(acc, 4);
        gemm_kloop<4>(acc, A + (size_t)mt * 256 * ld, Bt + (size_t)nt * 128 * ld, K, ld, lds, wv_);
        EPI_IDS;
#pragma unroll
        for (int m = 0; m < 8; ++m) { int row = mt * 256 + wr * 128 + m * 16 + fr;
            const float* xi = from_input ? xrow_in(p, seg, row) : xrow_out(p, seg, row); float* xo = xrow_out(p, seg, row);
#pragma unroll
            for (int n = 0; n < 4; ++n) { int col = nt * 128 + wc * 64 + n * 16 + fq * 4; f32x4 v = *(const f32x4*)(xi + col); *(f32x4*)(xo + col) = v + acc[m][n]; } }
    }
}
DEVI void phase_ffn_in(const Params& p, int l, int MT, char* lds, int wv_) {
    const bf16_t* xb = (const bf16_t*)(p.ws + WS_XB); const bf16_t* wt = (const bf16_t*)p.ws + (size_t)l * E_LAYER + E_WIN + E_WBR + E_WOUT;
    bf16_t* act = (bf16_t*)(p.ws + WS_PROJ);
    int mt, nt;
    for (int it = 0; next_tile(it, MT, 22, mt, nt, wv_); ++it) {
        f32x4 acc[8][8]; ZERO_ACC(acc, 8);
        gemm_kloop<8>(acc, xb + (size_t)mt * 256 * LDK, wt + (size_t)nt * 256 * LDK, 1024, LDK, lds, wv_);
        EPI_IDS;
#pragma unroll
        for (int m = 0; m < 8; ++m) { int row = mt * 256 + wr * 128 + m * 16 + fr;
#pragma unroll
            for (int q = 0; q < 4; ++q) { int col = (nt * 2 + wc) * 64 + 16 * q + fq * 4; us4 o;
#pragma unroll
                for (int j = 0; j < 4; ++j) o[j] = f2bf(silu(acc[m][2 * q][j]) * acc[m][2 * q + 1][j]);
                *(us4*)(act + (size_t)row * LDF + col) = o; } }
    }
}

struct Seq { int row0, nchunk, Q, b, samp, seg; };
DEVI Seq make_seq(int seg, int sq) { Seq s; s.seg = seg; if (sq < 16) { s.row0 = sq * SEGT; s.nchunk = 8; s.Q = 64; s.b = sq; s.samp = 0; } else { s.b = sq - 16; s.row0 = ROWS_P + s.b * 32; s.nchunk = 1; s.Q = 32; s.samp = 1; } return s; }

template <int NF, int KS>
DEVI void lds_mma(f32x4* acc, const bf16_t* X, int ldx, int m0, const bf16_t* Y, int ldy, int n0, int wv_) {
    const int lane = tidx(wv_) & 63, fr = lane & 15, fq = lane >> 4;
#pragma unroll
    for (int ks = 0; ks < KS; ++ks) {
        bf16x8 a = *(const bf16x8*)(X + (m0 + fr) * ldx + ks * 32 + fq * 8);
#pragma unroll
        for (int nf = 0; nf < NF; ++nf) { bf16x8 b = *(const bf16x8*)(Y + (n0 + nf * 16 + fr) * ldy + ks * 32 + fq * 8); acc[nf] = __builtin_amdgcn_mfma_f32_16x16x32_bf16(a, b, acc[nf], 0, 0, 0); }
    }
}

DEVI void conv_load(uint4 (&r)[4], const bf16_t* proj, int row0, int tq, int pcol) {
#pragma unroll
    for (int k = 0; k < 4; ++k) { int ts = tq - 3 + k; ts = ts < 0 ? 0 : ts; r[k] = *(const uint4*)(proj + (size_t)(row0 + ts) * NPROJ + pcol); }
}
DEVI void touch4(uint4& v) { asm volatile("" : "+v"(v.x), "+v"(v.y), "+v"(v.z), "+v"(v.w)); }
DEVI void conv_compute(const uint4 (&r)[4], int tq, const float* hl, const float* cwl, int HC, int cl, float (&out)[8], float (&raw)[8]) {
    { f32x4 b0 = *(const f32x4*)(cwl + 4 * HC + cl), b1 = *(const f32x4*)(cwl + 4 * HC + cl + 4);
      out[0] = b0[0]; out[1] = b0[1]; out[2] = b0[2]; out[3] = b0[3]; out[4] = b1[0]; out[5] = b1[1]; out[6] = b1[2]; out[7] = b1[3]; }
#pragma unroll
    for (int k = 0; k < 4; ++k) {
        const int ts = tq - 3 + k; float v[8];
        v[0] = __uint_as_float(r[k].x << 16); v[1] = __uint_as_float(r[k].x & 0xffff0000u); v[2] = __uint_as_float(r[k].y << 16); v[3] = __uint_as_float(r[k].y & 0xffff0000u);
        v[4] = __uint_as_float(r[k].z << 16); v[5] = __uint_as_float(r[k].z & 0xffff0000u); v[6] = __uint_as_float(r[k].w << 16); v[7] = __uint_as_float(r[k].w & 0xffff0000u);
        if (k < 3) { int hi = 3 + ts; hi = hi < 0 ? 0 : (hi > 2 ? 2 : hi); const bool uh = ts < 0;
            f32x4 h0 = *(const f32x4*)(hl + hi * HC + cl), h1 = *(const f32x4*)(hl + hi * HC + cl + 4);
            v[0] = uh ? h0[0] : v[0]; v[1] = uh ? h0[1] : v[1]; v[2] = uh ? h0[2] : v[2]; v[3] = uh ? h0[3] : v[3];
            v[4] = uh ? h1[0] : v[4]; v[5] = uh ? h1[1] : v[5]; v[6] = uh ? h1[2] : v[6]; v[7] = uh ? h1[3] : v[7]; }
        f32x4 w0 = *(const f32x4*)(cwl + k * HC + cl), w1 = *(const f32x4*)(cwl + k * HC + cl + 4);
        out[0] += v[0] * w0[0]; out[1] += v[1] * w0[1]; out[2] += v[2] * w0[2]; out[3] += v[3] * w0[3];
        out[4] += v[4] * w1[0]; out[5] += v[5] * w1[1]; out[6] += v[6] * w1[2]; out[7] += v[7] * w1[3];
        if (k == 3) {
#pragma unroll
            for (int e = 0; e < 8; ++e) raw[e] = v[e]; }
    }
}

template <int ROWB>
DEVI void stage_raw(const char* g0, size_t ldgB, char* dst, int tid) {
#pragma unroll
    for (int i = 0; i < ROWB / 64; ++i) { int b = tid * 16 + i * 4096, row = b / ROWB, cb = b % ROWB;
        __builtin_amdgcn_global_load_lds((const unsigned*)(g0 + (size_t)row * ldgB + cb), (unsigned*)(dst + b), 16, 0, 0); }
}
DEVI void conv_lds(const bf16_t* rawt, int RS, int t, int cloc, const float* hl, const float* cwl, int HC, int cl, float (&out)[8], float (&raw)[8]) {
    { f32x4 b0 = *(const f32x4*)(cwl + 4 * HC + cl), b1 = *(const f32x4*)(cwl + 4 * HC + cl + 4);
      out[0] = b0[0]; out[1] = b0[1]; out[2] = b0[2]; out[3] = b0[3]; out[4] = b1[0]; out[5] = b1[1]; out[6] = b1[2]; out[7] = b1[3]; }
#pragma unroll
    for (int k = 0; k < 4; ++k) {
        const int tt = t - 3 + k; const int tc = tt < 0 ? 0 : tt; float v[8];
        const uint4 r = *(const uint4*)(rawt + tc * RS + cloc);
        v[0] = __uint_as_float(r.x << 16); v[1] = __uint_as_float(r.x & 0xffff0000u); v[2] = __uint_as_float(r.y << 16); v[3] = __uint_as_float(r.y & 0xffff0000u);
        v[4] = __uint_as_float(r.z << 16); v[5] = __uint_as_float(r.z & 0xffff0000u); v[6] = __uint_as_float(r.w << 16); v[7] = __uint_as_float(r.w & 0xffff0000u);
        if (k < 3) { int hi = 3 + tt; hi = hi < 0 ? 0 : (hi > 2 ? 2 : hi); const bool uh = tt < 0;
            f32x4 h0 = *(const f32x4*)(hl + hi * HC + cl), h1 = *(const f32x4*)(hl + hi * HC + cl + 4);
            v[0] = uh ? h0[0] : v[0]; v[1] = uh ? h0[1] : v[1]; v[2] = uh ? h0[2] : v[2]; v[3] = uh ? h0[3] : v[3];
            v[4] = uh ? h1[0] : v[4]; v[5] = uh ? h1[1] : v[5]; v[6] = uh ? h1[2] : v[6]; v[7] = uh ? h1[3] : v[7]; }
        f32x4 w0 = *(const f32x4*)(cwl + k * HC + cl), w1 = *(const f32x4*)(cwl + k * HC + cl + 4);
        out[0] += v[0] * w0[0]; out[1] += v[1] * w0[1]; out[2] += v[2] * w0[2]; out[3] += v[3] * w0[3];
        out[4] += v[4] * w1[0]; out[5] += v[5] * w1[1]; out[6] += v[6] * w1[2]; out[7] += v[7] * w1[3];
        if (k == 3) {
#pragma unroll
            for (int e = 0; e < 8; ++e) raw[e] = v[e]; }
    }
}

DEVI void ssd_unit(const Params& p, int l, Seq sq, int hd, char* lds, int wv_) {
    bf16_t* Bm = (bf16_t*)lds;
    bf16_t* R2 = (bf16_t*)(lds + 17408);
    bf16_t* xT = (bf16_t*)(lds + 35840);
    bf16_t* hb = (bf16_t*)(lds + 45056);
    float* fl = (float*)(lds + 62464);
    const int tid = tidx(wv_), lane = tid & 63, w = tid >> 6, fr = lane & 15, fq = lane >> 4;
    const bf16_t* proj = (const bf16_t*)(p.ws + WS_PROJ); const float* dtb = (const float*)(p.ws + WS_DT); bf16_t* ymb = (bf16_t*)(p.ws + WS_YMB);
    const int g = hd >> 2;
    const float a = -__expf(p.in[I_ALOG][l * 16 + hd]), Dv = p.in[I_MBD][l * 16 + hd];
    const float* cw = p.in[I_MCW] + (size_t)l * 4 * 2048; const float* cbias = p.in[I_MCB] + l * 2048;
    float* cwl = (float*)(lds + 63488);
    float* hl = (float*)(lds + 69888);
    const float* st_in; float* st_out; const float* hist; float* hist_out; float* hist_out2 = nullptr;
    float* hbuf = (float*)(p.ws + WS_HB);
    if (sq.samp) { st_in = p.in[I_SSM] + ((size_t)(l * 16 + sq.b) * 16 + hd) * 8192; st_out = p.out + O_SSM_S + ((size_t)(l * 16 + sq.b) * 16 + hd) * 8192;
        hist = p.in[I_SCV] + (size_t)(l * 16 + sq.b) * 3 * 2048; hist_out = p.out + O_SCV_S + (size_t)(l * 16 + sq.b) * 3 * 2048; }
    else { st_out = p.out + O_SSM_P + ((size_t)(l * 16 + sq.b) * 16 + hd) * 8192; st_in = sq.seg ? st_out : nullptr;
        hist_out = hbuf + ((size_t)((sq.seg & 1) * 2 + l) * 16 + sq.b) * 3 * 2048; hist = sq.seg ? hbuf + ((size_t)(((sq.seg + 1) & 1) * 2 + l) * 16 + sq.b) * 3 * 2048 : nullptr;
        if (sq.seg == NSEG - 1) hist_out2 = p.out + O_SCV_P + (size_t)(l * 16 + sq.b) * 3 * 2048; }
    for (int idx = tid; idx < 1600; idx += 256) { int k = idx / 320, cc = idx - k * 320; int ch = cc < 64 ? hd * 64 + cc : (cc < 192 ? 1024 + g * 128 + (cc - 64) : 1536 + g * 128 + (cc - 192));
        cwl[idx] = k < 4 ? cw[k * 2048 + ch] : cbias[ch];
        if (idx < 960) hl[idx] = hist ? hist[k * 2048 + ch] : 0.f; }
    f32x4 hacc[8];
#pragma unroll
    for (int nf = 0; nf < 8; ++nf)
#pragma unroll
        for (int r = 0; r < 4; ++r) { int pp = 16 * w + 4 * fq + r, n = 16 * nf + fr; float v = st_in ? st_in[pp * 128 + n] : 0.f; hacc[nf][r] = v; hb[pp * 136 + n] = f2bf(v); }
    bf16_t* rawX = (bf16_t*)(lds + 77568); bf16_t* rawB = (bf16_t*)(lds + 85760); bf16_t* rawC = (bf16_t*)(lds + 102144); bf16_t* rawZ = (bf16_t*)(lds + 118528); float* rawDt = (float*)(lds + 126720);
    const char* gx = (const char*)(proj + PC_XBC + hd * 64); const char* gb = (const char*)(proj + PC_XBC + 1024 + g * 128); const char* gc = (const char*)(proj + PC_XBC + 1536 + g * 128); const char* gz = (const char*)(proj + PC_Z + hd * 64);
    asm volatile("s_waitcnt vmcnt(0)" ::: "memory");
    {   const size_t ro = (size_t)sq.row0 * NPROJ * 2;
        stage_raw<128>(gx + ro, (size_t)NPROJ * 2, (char*)rawX, tid); stage_raw<256>(gb + ro, (size_t)NPROJ * 2, (char*)rawB, tid); stage_raw<256>(gc + ro, (size_t)NPROJ * 2, (char*)rawC, tid);
        stage_raw<128>(gz + ro, (size_t)NPROJ * 2, (char*)rawZ, tid); stage_raw<64>((const char*)(dtb + (size_t)sq.row0 * 16), 64, (char*)rawDt, tid); }
    for (int c = 0; c < sq.nchunk; ++c) {
        const int tid = tidx(wv_), lane = tid & 63, w = tid >> 6, fr = lane & 15, fq = lane >> 4;
        const int rowc = sq.row0 + c * 64; const bool lastc = (c == sq.nchunk - 1);
        const float* hlr = hl + (c & 1) * 960; float* hlw = hl + ((c + 1) & 1) * 960;
        asm volatile("s_waitcnt vmcnt(0)" ::: "memory");
        __syncthreads();
        if (w == 0) {
            float dt = lane < sq.Q ? rawDt[lane * 16 + hd] : 0.f; float v = dt * a;
#pragma unroll
            for (int o = 1; o < 64; o <<= 1) { float t = shfli(v, lane - o); if (lane >= o) v += t; }
            float last = shfli(v, 63);
            fl[lane] = v; fl[64 + lane] = dt; fl[128 + lane] = __expf(last - v) * dt; fl[192 + lane] = __expf(v);
        }
        __syncthreads();
        const float elast = __expf(fl[63]);
#pragma unroll
        for (int i = 0; i < 2; ++i) { int it = tid + 256 * i, t = it >> 3, c8 = (it & 7) * 8; float o[8], raw[8]; int ch = hd * 64 + c8; const bool tv = t < sq.Q;
            conv_lds(rawX, 64, t, c8, hlr, cwl, 320, c8, o, raw);
#pragma unroll
            for (int e = 0; e < 8; ++e) { float s_ = silu(o[e]); o[e] = tv ? s_ : 0.f; }
            if (t >= 61) {
#pragma unroll
                for (int e = 0; e < 8; ++e) hlw[(t - 61) * 320 + c8 + e] = raw[e]; }
            if (lastc && tv && t >= sq.Q - 3) {
#pragma unroll
                for (int e = 0; e < 8; ++e) { hist_out[(t - (sq.Q - 3)) * 2048 + ch + e] = raw[e]; if (hist_out2) hist_out2[(t - (sq.Q - 3)) * 2048 + ch + e] = raw[e]; } }
#pragma unroll
            for (int e = 0; e < 8; ++e) xT[(c8 + e) * 72 + t] = f2bf(o[e]); }
#pragma unroll
        for (int i = 0; i < 4; ++i) { int it = tid + 256 * i, t = it >> 4, c8 = (it & 15) * 8; float o[8], raw[8]; int ch = 1024 + g * 128 + c8; const bool tv = t < sq.Q;
            conv_lds(rawB, 128, t, c8, hlr, cwl, 320, 64 + c8, o, raw);
#pragma unroll
            for (int e = 0; e < 8; ++e) { float s_ = silu(o[e]); o[e] = tv ? s_ : 0.f; }
            if (t >= 61) {
#pragma unroll
                for (int e = 0; e < 8; ++e) hlw[(t - 61) * 320 + 64 + c8 + e] = raw[e]; }
            if (lastc && tv && (hd & 3) == 0 && t >= sq.Q - 3) {
#pragma unroll
                for (int e = 0; e < 8; ++e) { hist_out[(t - (sq.Q - 3)) * 2048 + ch + e] = raw[e]; if (hist_out2) hist_out2[(t - (sq.Q - 3)) * 2048 + ch + e] = raw[e]; } }
            us8 ov; float we = fl[128 + t];
#pragma unroll
            for (int e = 0; e < 8; ++e) { ov[e] = f2bf(o[e]); R2[(c8 + e) * 72 + t] = f2bf(o[e] * we); }
            *(us8*)(Bm + t * 136 + c8) = ov; }
        __syncthreads();
#pragma unroll
        for (int nf = 0; nf < 8; ++nf) hacc[nf] *= elast;
        lds_mma<8, 2>(hacc, xT, 72, 16 * w, R2, 72, 0, wv_);
        __syncthreads();
#pragma unroll
        for (int i = 0; i < 4; ++i) { int it = tid + 256 * i, t = it >> 4, c8 = (it & 15) * 8; float o[8], raw[8]; int ch = 1536 + g * 128 + c8; const bool tv = t < sq.Q;
            conv_lds(rawC, 128, t, c8, hlr, cwl, 320, 192 + c8, o, raw);
#pragma unroll
            for (int e = 0; e < 8; ++e) { float s_ = silu(o[e]); o[e] = tv ? s_ : 0.f; }
            if (t >= 61) {
#pragma unroll
                for (int e = 0; e < 8; ++e) hlw[(t - 61) * 320 + 192 + c8 + e] = raw[e]; }
            if (lastc && tv && (hd & 3) == 0 && t >= sq.Q - 3) {
#pragma unroll
                for (int e = 0; e < 8; ++e) { hist_out[(t - (sq.Q - 3)) * 2048 + ch + e] = raw[e]; if (hist_out2) hist_out2[(t - (sq.Q - 3)) * 2048 + ch + e] = raw[e]; } }
            us8 ov;
#pragma unroll
            for (int e = 0; e < 8; ++e) ov[e] = f2bf(o[e]);
            *(us8*)(R2 + t * 136 + c8) = ov; }
        us4 zr[4];
#pragma unroll
        for (int nf = 0; nf < 4; ++nf) zr[nf] = *(const us4*)(rawZ + (16 * nf + fr) * 64 + 16 * w + 4 * fq);
        __syncthreads();
        if (!lastc) { const size_t ro = (size_t)(rowc + 64) * NPROJ * 2;
            stage_raw<128>(gx + ro, (size_t)NPROJ * 2, (char*)rawX, tid); stage_raw<256>(gb + ro, (size_t)NPROJ * 2, (char*)rawB, tid); stage_raw<256>(gc + ro, (size_t)NPROJ * 2, (char*)rawC, tid);
            stage_raw<128>(gz + ro, (size_t)NPROJ * 2, (char*)rawZ, tid); stage_raw<64>((const char*)(dtb + (size_t)(rowc + 64) * 16), 64, (char*)rawDt, tid); }
        f32x4 cbv[4];
#pragma unroll
        for (int nf = 0; nf < 4; ++nf) cbv[nf] = (f32x4){0.f, 0.f, 0.f, 0.f};
        lds_mma<4, 4>(cbv, Bm, 136, 16 * w, R2, 136, 0, wv_);
        __syncthreads();
#pragma unroll
        for (int nf = 0; nf < 4; ++nf) { int i = 16 * nf + fr; float ai = fl[i]; us4 o;
#pragma unroll
            for (int r = 0; r < 4; ++r) { int j = 16 * w + 4 * fq + r; float v = (j <= i) ? cbv[nf][r] * __expf(ai - fl[j]) * fl[64 + j] : 0.f; o[r] = f2bf(v); }
            *(us4*)(Bm + i * 72 + 16 * w + 4 * fq) = o; }
        __syncthreads();
        f32x4 ya[4];
#pragma unroll
        for (int nf = 0; nf < 4; ++nf) ya[nf] = (f32x4){0.f, 0.f, 0.f, 0.f};
        lds_mma<4, 4>(ya, hb, 136, 16 * w, R2, 136, 0, wv_);
#pragma unroll
        for (int nf = 0; nf < 4; ++nf) ya[nf] *= fl[192 + 16 * nf + fr];
        lds_mma<4, 2>(ya, xT, 72, 16 * w, Bm, 72, 0, wv_);
#pragma unroll
        for (int nf = 0; nf < 4; ++nf) { int i = 16 * nf + fr, p0 = 16 * w + 4 * fq;
            us4 z = zr[nf];
            if (i < sq.Q) { us4 o;
#pragma unroll
                for (int r = 0; r < 4; ++r) o[r] = f2bf((ya[nf][r] + Dv * bf2f(xT[(p0 + r) * 72 + i])) * bf2f(z[r]));
                *(us4*)(ymb + (size_t)(rowc + i) * LDK + hd * 64 + p0) = o; } }
        __syncthreads();
#pragma unroll
        for (int nf = 0; nf < 8; ++nf)
#pragma unroll
            for (int r = 0; r < 4; ++r) hb[(16 * w + 4 * fq + r) * 136 + 16 * nf + fr] = f2bf(hacc[nf][r]);
    }
#pragma unroll
    for (int nf = 0; nf < 8; ++nf)
#pragma unroll
        for (int r = 0; r < 4; ++r) st_out[(16 * w + 4 * fq + r) * 128 + 16 * nf + fr] = hacc[nf][r];
    __syncthreads();
}

DEVI void hgrn_unit(const Params& p, int l, Seq sq, int h, char* lds, int wv_) {
    bf16_t* sb = (bf16_t*)lds;
    bf16_t* qt = (bf16_t*)(lds + 34816);
    bf16_t* kt = (bf16_t*)(lds + 52224);
    bf16_t* att = (bf16_t*)lds;
    bf16_t* kT = (bf16_t*)(lds + 9216);
    bf16_t* vT = (bf16_t*)(lds + 27648);
    float* T0 = (float*)(lds + 69632); float* T1 = T0 + 128; float* ssq = T0 + 256;
    const int tid = tidx(wv_), lane = tid & 63, w = tid >> 6, fr = lane & 15, fq = lane >> 4;
    const int k = tid & 127, half = tid >> 7;
    const bf16_t* proj = (const bf16_t*)(p.ws + WS_PROJ); bf16_t* yhg = (bf16_t*)(p.ws + WS_YHG);
    float lb = 0.f;
    if (l == 1) { float a0 = p.in[I_LBL][h * 128 + k], a1 = p.in[I_LBL][1024 + h * 128 + k]; lb = 1.f / (1.f + __expf(a0 - a1)); }
    const float* nw = p.in[I_HGNW] + l * 128;
    const float* st_in; float* st_out;
    if (sq.samp) { st_in = p.in[I_HG] + ((size_t)(l * 16 + sq.b) * 8 + h) * 16384; st_out = p.out + O_HG_S + ((size_t)(l * 16 + sq.b) * 8 + h) * 16384; }
    else { st_out = p.out + O_HG_P + ((size_t)(l * 16 + sq.b) * 8 + h) * 16384; st_in = sq.seg ? st_out : nullptr; }
    f32x4 hacc[2][8];
#pragma unroll
    for (int mf = 0; mf < 2; ++mf)
#pragma unroll
        for (int nf = 0; nf < 8; ++nf)
#pragma unroll
            for (int r = 0; r < 4; ++r) hacc[mf][nf][r] = st_in ? st_in[(32 * w + 16 * mf + 4 * fq + r) * 128 + 16 * nf + fr] : 0.f;
    f32x4 nwr[2];
#pragma unroll
    for (int mf = 0; mf < 2; ++mf) nwr[mf] = *(const f32x4*)(nw + 32 * w + 16 * mf + 4 * fq);
    bf16_t* rawF = (bf16_t*)(lds + 71680); bf16_t* rawQ = (bf16_t*)(lds + 88064); bf16_t* rawV = (bf16_t*)(lds + 104448); bf16_t* rawH = (bf16_t*)(lds + 120832);
    const char* gf = (const char*)(proj + PC_HF + h * 128); const char* gq = (const char*)(proj + PC_HQ + h * 128); const char* gv = (const char*)(proj + PC_HI + h * 128); const char* gh = (const char*)(proj + PC_HGATE + h * 128);
    asm volatile("s_waitcnt vmcnt(0)" ::: "memory");
    {   const size_t ro = (size_t)sq.row0 * NPROJ * 2;
        stage_raw<256>(gf + ro, (size_t)NPROJ * 2, (char*)rawF, tid); stage_raw<256>(gq + ro, (size_t)NPROJ * 2, (char*)rawQ, tid); stage_raw<256>(gv + ro, (size_t)NPROJ * 2, (char*)rawV, tid); }
    for (int c = 0; c < sq.nchunk; ++c) {
        const int tid = tidx(wv_), lane = tid & 63, w = tid >> 6, fr = lane & 15, fq = lane >> 4, k = tid & 127, half = tid >> 7;
        const int rowc = sq.row0 + c * 64; const bool lastc = (c == sq.nchunk - 1);
        asm volatile("s_waitcnt vmcnt(0)" ::: "memory");
        __syncthreads();
        stage_raw<256>(gh + (size_t)rowc * NPROJ * 2, (size_t)NPROJ * 2, (char*)rawH, tid);
        {
            unsigned fu[32], qu[32];
#pragma unroll
            for (int jj = 0; jj < 32; ++jj) { fu[jj] = rawF[(32 * half + jj) * 128 + k]; qu[jj] = rawQ[(32 * half + jj) * 128 + k]; }
            if (tid < 64) ssq[tid] = 0.f;
            float run = 0.f;
            if (half == 0) {
#pragma unroll
                for (int jj = 31; jj >= 0; --jj) { bool valid = jj < sq.Q; float f = __uint_as_float(fu[jj] << 16);
                    float sg = __builtin_amdgcn_rcpf(1.f + __expf(-f)); float lg0 = __logf(lb + (1.f - lb) * sg); float lg = valid ? lg0 : 0.f;
                    float kk0 = (1.f - lb) * (1.f - sg); float kk = valid ? kk0 : 0.f; float q0 = __uint_as_float(qu[jj] << 16); float q = valid ? q0 : 0.f;
                    qt[jj * 136 + k] = f2bf(q * cexp(-run)); kt[jj * 136 + k] = f2bf(kk * cexp(run)); run += lg; }
                T0[k] = run;
            } else {
#pragma unroll
                for (int jj = 0; jj < 32; ++jj) { bool valid = (32 + jj) < sq.Q; float f = __uint_as_float(fu[jj] << 16);
                    float sg = __builtin_amdgcn_rcpf(1.f + __expf(-f)); float lg0 = __logf(lb + (1.f - lb) * sg); float lg = valid ? lg0 : 0.f;
                    float kk0 = (1.f - lb) * (1.f - sg); float kk = valid ? kk0 : 0.f; float q0 = __uint_as_float(qu[jj] << 16); float q = valid ? q0 : 0.f;
                    run += lg; qt[(32 + jj) * 136 + k] = f2bf(q * cexp(run)); kt[(32 + jj) * 136 + k] = f2bf(kk * cexp(-run)); }
                T1[k] = run;
            }
        }
        __syncthreads();
#pragma unroll
        for (int mf = 0; mf < 2; ++mf) { int k0 = 32 * w + 16 * mf + 4 * fq; float e0 = __expf(T0[k0]), e1 = __expf(T0[k0 + 1]), e2 = __expf(T0[k0 + 2]), e3 = __expf(T0[k0 + 3]);
#pragma unroll
            for (int nf = 0; nf < 8; ++nf) { hacc[mf][nf][0] *= e0; hacc[mf][nf][1] *= e1; hacc[mf][nf][2] *= e2; hacc[mf][nf][3] *= e3;
                us4 o; o[0] = f2bf(hacc[mf][nf][0]); o[1] = f2bf(hacc[mf][nf][1]); o[2] = f2bf(hacc[mf][nf][2]); o[3] = f2bf(hacc[mf][nf][3]);
                *(us4*)(sb + (16 * nf + fr) * 136 + k0) = o; } }
        f32x4 at[4];
#pragma unroll
        for (int nf = 0; nf < 4; ++nf) at[nf] = (f32x4){0.f, 0.f, 0.f, 0.f};
        lds_mma<4, 4>(at, kt, 136, 16 * w, qt, 136, 0, wv_);
        __syncthreads();
        f32x4 oacc[2][4];
#pragma unroll
        for (int mf = 0; mf < 2; ++mf) {
#pragma unroll
            for (int nf = 0; nf < 4; ++nf) oacc[mf][nf] = (f32x4){0.f, 0.f, 0.f, 0.f};
            lds_mma<4, 4>(oacc[mf], sb, 136, 32 * w + 16 * mf, qt, 136, 0, wv_); }
        __syncthreads();
#pragma unroll
        for (int nf = 0; nf < 4; ++nf) { int i = 16 * nf + fr; us4 o;
#pragma unroll
            for (int r = 0; r < 4; ++r) { int j = 16 * w + 4 * fq + r; o[r] = f2bf(j <= i ? at[nf][r] : 0.f); }
            *(us4*)(att + i * 72 + 16 * w + 4 * fq) = o; }
        {   unsigned vu[32];
#pragma unroll
            for (int jj = 0; jj < 32; ++jj) vu[jj] = rawV[(32 * half + jj) * 128 + k];
#pragma unroll
            for (int q4 = 0; q4 < 4; ++q4) { us8 kv, vv;
#pragma unroll
                for (int e = 0; e < 8; ++e) { int jj = q4 * 8 + e; bool valid = (32 * half + jj) < sq.Q; kv[e] = kt[(32 * half + jj) * 136 + k]; vv[e] = valid ? (bf16_t)vu[jj] : (bf16_t)0; }
                *(us8*)(kT + k * 72 + 32 * half + q4 * 8) = kv; *(us8*)(vT + k * 72 + 32 * half + q4 * 8) = vv; } }
        __syncthreads();
        if (!lastc) { const size_t ro = (size_t)(rowc + 64) * NPROJ * 2;
            stage_raw<256>(gf + ro, (size_t)NPROJ * 2, (char*)rawF, tid); stage_raw<256>(gq + ro, (size_t)NPROJ * 2, (char*)rawQ, tid); stage_raw<256>(gv + ro, (size_t)NPROJ * 2, (char*)rawV, tid); }
#pragma unroll
        for (int mf = 0; mf < 2; ++mf) {
            lds_mma<4, 2>(oacc[mf], vT, 72, 32 * w + 16 * mf, att, 72, 0, wv_);
            lds_mma<8, 2>(hacc[mf], kT, 72, 32 * w + 16 * mf, vT, 72, 0, wv_);
            int k0 = 32 * w + 16 * mf + 4 * fq; float e0 = __expf(T1[k0]), e1 = __expf(T1[k0 + 1]), e2 = __expf(T1[k0 + 2]), e3 = __expf(T1[k0 + 3]);
#pragma unroll
            for (int nf = 0; nf < 8; ++nf) { hacc[mf][nf][0] *= e0; hacc[mf][nf][1] *= e1; hacc[mf][nf][2] *= e2; hacc[mf][nf][3] *= e3; } }
#pragma unroll
        for (int nf = 0; nf < 4; ++nf) { float s = 0.f;
#pragma unroll
            for (int mf = 0; mf < 2; ++mf)
#pragma unroll
                for (int r = 0; r < 4; ++r) s += oacc[mf][nf][r] * oacc[mf][nf][r];
            s += shflx(s, 16, lane); s += shflx(s, 32, lane);
            if (fq == 0) atomicAdd(&ssq[16 * nf + fr], s); }
        if (lastc) asm volatile("s_waitcnt vmcnt(0)" ::: "memory"); else asm volatile("s_waitcnt vmcnt(12)" ::: "memory");
        __syncthreads();
#pragma unroll
        for (int nf = 0; nf < 4; ++nf) { int i = 16 * nf + fr; float rs = rsqrtf(ssq[i] * (1.f / 128.f) + 1e-6f);
#pragma unroll
            for (int mf = 0; mf < 2; ++mf) { int v0 = 32 * w + 16 * mf + 4 * fq; us4 gt = *(const us4*)(rawH + i * 128 + v0); f32x4 wv = nwr[mf]; us4 o;
#pragma unroll
                for (int r = 0; r < 4; ++r) o[r] = f2bf(oacc[mf][nf][r] * rs * wv[r] * bf2f(gt[r]));
                if (i < sq.Q) *(us4*)(yhg + (size_t)(rowc + i) * LDK + h * 128 + v0) = o; } }
        __syncthreads();
    }
#pragma unroll
    for (int mf = 0; mf < 2; ++mf)
#pragma unroll
        for (int nf = 0; nf < 8; ++nf)
#pragma unroll
            for (int r = 0; r < 4; ++r) st_out[(32 * w + 16 * mf + 4 * fq + r) * 128 + 16 * nf + fr] = hacc[mf][nf][r];
}

DEVI void rg_unit(const Params& p, int l, Seq sq, int blk, char* lds, int wv_) {
    bf16_t* waT = (bf16_t*)lds; bf16_t* wiT = (bf16_t*)(lds + 9216); bf16_t* xr = (bf16_t*)(lds + 18432);
    float* av = (float*)(lds + 27648); float* uv = (float*)(lds + 44288); float* Pq = (float*)(lds + 60928); float* Hq = Pq + 256; float* carry = Hq + 256;
    const int tid = tidx(wv_), lane = tid & 63, w = tid >> 6, fr = lane & 15, fq = lane >> 4;
    const bf16_t* proj = (const bf16_t*)(p.ws + WS_PROJ); bf16_t* yrg = (bf16_t*)(p.ws + WS_YRG);
    const int cb0 = blk * 64;
    const float* cw = p.in[I_RCW] + (size_t)l * 4 * 1024; const float* cbias = p.in[I_RCB] + l * 1024;
    const float* st_in; float* st_out; const float* hist; float* hist_out;
    if (sq.samp) { st_in = p.in[I_RG] + (size_t)(l * 16 + sq.b) * 1024; st_out = p.out + O_RG_S + (size_t)(l * 16 + sq.b) * 1024;
        hist = p.in[I_RCV] + (size_t)(l * 16 + sq.b) * 3 * 1024; hist_out = p.out + O_RCV_S + (size_t)(l * 16 + sq.b) * 3 * 1024; }
    else { st_out = p.out + O_RG_P + (size_t)(l * 16 + sq.b) * 1024; st_in = sq.seg ? st_out : nullptr;
        hist_out = p.out + O_RCV_P + (size_t)(l * 16 + sq.b) * 3 * 1024; hist = sq.seg ? hist_out : nullptr; }
    float* cwl = (float*)(lds + 63232);
    float* hl = (float*)(lds + 64512);
    float* hl2 = (float*)(lds + 90112);
    for (int idx = tid; idx < 320; idx += 256) { int k = idx >> 6, cc = idx & 63; cwl[idx] = k < 4 ? cw[k * 1024 + cb0 + cc] : cbias[cb0 + cc]; if (idx < 192) hl[idx] = hist ? hist[k * 1024 + cb0 + cc] : 0.f; }
    {   const float* wa = p.in[I_RWA] + ((size_t)l * 16 + blk) * 4096; const float* wi = p.in[I_RWI] + ((size_t)l * 16 + blk) * 4096;
        float wa_[16], wi_[16];
#pragma unroll
        for (int u = 0; u < 16; ++u) { wa_[u] = wa[tid + 256 * u]; wi_[u] = wi[tid + 256 * u]; }
#pragma unroll
        for (int u = 0; u < 16; ++u) { int e = tid + 256 * u, i = e >> 6, j = e & 63; waT[j * 72 + i] = f2bf(wa_[u]); wiT[j * 72 + i] = f2bf(wi_[u]); }
        if (tid < 64) carry[tid] = st_in ? st_in[cb0 + tid] : 0.f; }
    float cba[4], cbi[4], csp[4];
#pragma unroll
    for (int nf = 0; nf < 4; ++nf) { int cc = cb0 + 16 * nf + fr; cba[nf] = p.in[I_RBA][l * 1024 + cc]; cbi[nf] = p.in[I_RBI][l * 1024 + cc]; csp[nf] = softplus(-p.in[I_RLAM][l * 1024 + cc]); }
    bf16_t* rawR = (bf16_t*)(lds + 65536); bf16_t* rawG = (bf16_t*)(lds + 73728);
    const char* gr = (const char*)(proj + PC_RX + cb0); const char* gg = (const char*)(proj + PC_RGATE + cb0);
    asm volatile("s_waitcnt vmcnt(0)" ::: "memory");
    stage_raw<128>(gr + (size_t)sq.row0 * NPROJ * 2, (size_t)NPROJ * 2, (char*)rawR, tid); stage_raw<128>(gg + (size_t)sq.row0 * NPROJ * 2, (size_t)NPROJ * 2, (char*)rawG, tid);
    for (int c = 0; c < sq.nchunk; ++c) {
        const int tid = tidx(wv_), lane = tid & 63, w = tid >> 6, fr = lane & 15, fq = lane >> 4, j = tid & 63, q = tid >> 6;
        const int rowc = sq.row0 + c * 64; const bool lastc = (c == sq.nchunk - 1);
        const float* hlr = (c & 1) ? hl2 : hl; float* hlw = (c & 1) ? hl : hl2;
        asm volatile("s_waitcnt vmcnt(0)" ::: "memory");
        __syncthreads();
#pragma unroll
        for (int i = 0; i < 2; ++i) { int it = tid + 256 * i, t = it >> 3, c8 = (it & 7) * 8; float o[8], raw[8]; int ch = cb0 + c8; const bool tv = t < sq.Q;
            conv_lds(rawR, 64, t, c8, hlr, cwl, 64, c8, o, raw);
            if (t >= 61) {
#pragma unroll
                for (int e = 0; e < 8; ++e) hlw[(t - 61) * 64 + c8 + e] = raw[e]; }
            if (lastc && tv && t >= sq.Q - 3) {
#pragma unroll
                for (int e = 0; e < 8; ++e) hist_out[(t - (sq.Q - 3)) * 1024 + ch + e] = raw[e]; }
            us8 ov;
#pragma unroll
            for (int e = 0; e < 8; ++e) { float ox = tv ? o[e] : 0.f; ov[e] = f2bf(ox); uv[t * 65 + c8 + e] = ox; }
            *(us8*)(xr + t * 72 + c8) = ov; }
        __syncthreads();
        if (!lastc) { const size_t ro = (size_t)(rowc + 64) * NPROJ * 2; stage_raw<128>(gr + ro, (size_t)NPROJ * 2, (char*)rawR, tid); stage_raw<128>(gg + ro, (size_t)NPROJ * 2, (char*)(rawG + ((c + 1) & 1) * 4096), tid); }
        f32x4 ra[4], ri[4];
#pragma unroll
        for (int nf = 0; nf < 4; ++nf) { ra[nf] = (f32x4){0.f, 0.f, 0.f, 0.f}; ri[nf] = (f32x4){0.f, 0.f, 0.f, 0.f}; }
        lds_mma<4, 2>(ra, xr, 72, 16 * w, waT, 72, 0, wv_);
        lds_mma<4, 2>(ri, xr, 72, 16 * w, wiT, 72, 0, wv_);
#pragma unroll
        for (int nf = 0; nf < 4; ++nf) { int jj = 16 * nf + fr; float ba = cba[nf], bi = cbi[nf], sp = csp[nf];
#pragma unroll
            for (int r = 0; r < 4; ++r) { int t = 16 * w + 4 * fq + r; float rr = sigm(ra[nf][r] + ba), ii = sigm(ri[nf][r] + bi); float la = -8.f * sp * rr; float aa = __expf(la);
                float u = __builtin_sqrtf(fmaxf(1.f - aa * aa, 0.f)) * ii * uv[t * 65 + jj];
                if (t >= sq.Q) { aa = 1.f; u = 0.f; }
                av[t * 65 + jj] = aa; uv[t * 65 + jj] = u; } }
        __syncthreads();
        { float P = 1.f, H = 0.f;
#pragma unroll
          for (int tt = 0; tt < 16; ++tt) { int t = 16 * q + tt; float aa = av[t * 65 + j], u = uv[t * 65 + j]; H = aa * H + u; P *= aa; }
          Pq[q * 64 + j] = P; Hq[q * 64 + j] = H; }
        __syncthreads();
        float hcur = carry[j];
        for (int qq = 0; qq < q; ++qq) hcur = Pq[qq * 64 + j] * hcur + Hq[qq * 64 + j];
        const bf16_t* rg_ = rawG + (c & 1) * 4096;
        bf16_t gts[16];
#pragma unroll
        for (int tt = 0; tt < 16; ++tt) gts[tt] = rg_[(16 * q + tt) * 64 + j];
#pragma unroll
        for (int tt = 0; tt < 16; ++tt) { int t = 16 * q + tt; float aa = av[t * 65 + j], u = uv[t * 65 + j]; hcur = aa * hcur + u;
            if (t < sq.Q) yrg[(size_t)(rowc + t) * LDK + cb0 + j] = f2bf(bf2f(gts[tt]) * hcur); }
        __syncthreads();
        if (q == 3) carry[j] = hcur;
        __syncthreads();
    }
    if (tid < 64) st_out[cb0 + tid] = carry[tid];
    __syncthreads();
}

DEVI void phase_mix(const Params& p, int l, int seg, char* lds, int wv_) {
    const int ngrp = seg == 0 ? 2 : 1; const int NU = ngrp * 640;
    for (int u = blockIdx.x; u < NU; u += gridDim.x) {
        int grp = u / 640, v = u % 640;
        if (v < 128) hgrn_unit(p, l, make_seq(seg, grp * 16 + (v >> 3)), v & 7, lds, wv_);
        else if (v < 384) { v -= 128; ssd_unit(p, l, make_seq(seg, grp * 16 + (v >> 4)), v & 15, lds, wv_); }
        else { v -= 384; rg_unit(p, l, make_seq(seg, grp * 16 + (v >> 4)), v & 15, lds, wv_); }
        __syncthreads();
    }
}

DEVI void gbar(const Params& p, unsigned& epoch_, int wv_) {
    const unsigned epoch = __builtin_amdgcn_readfirstlane(epoch_); epoch_ = epoch + 1u;
    unsigned* bw = (unsigned*)(p.ws + WS_END); asm volatile("" : "+s"(bw));
    asm volatile("s_waitcnt vmcnt(0)" ::: "memory");
    __syncthreads();
    if (tidx(wv_) == 0) {
        if ((wv_ >> 23) & 1) {
            const unsigned x = (wv_ >> 2) & 7, NB = (wv_ >> 14) & 511;
            const unsigned old = __hip_atomic_fetch_add(bw + 32 + x, 1u, __ATOMIC_RELAXED, __HIP_MEMORY_SCOPE_AGENT);
            if (old + 1u == (epoch + 1u) * NB) {
                __builtin_amdgcn_fence(__ATOMIC_RELEASE, "agent");
                asm volatile("s_waitcnt vmcnt(0)" ::: "memory");
                const unsigned og = __hip_atomic_fetch_add(bw + 56, 1u, __ATOMIC_RELAXED, __HIP_MEMORY_SCOPE_AGENT);
                if (og + 1u == (epoch + 1u) * 8u) __hip_atomic_fetch_add(bw + 57, 1u, __ATOMIC_RELAXED, __HIP_MEMORY_SCOPE_AGENT);
                else while (__hip_atomic_load(bw + 57, __ATOMIC_RELAXED, __HIP_MEMORY_SCOPE_AGENT) < epoch + 1u) __builtin_amdgcn_s_sleep(1);
                __builtin_amdgcn_fence(__ATOMIC_ACQUIRE, "agent");
                __hip_atomic_fetch_add(bw + 48 + x, 1u, __ATOMIC_RELAXED, __HIP_MEMORY_SCOPE_AGENT);
                asm volatile("s_waitcnt vmcnt(0)" ::: "memory");
            } else {
                while (__hip_atomic_load(bw + 48 + x, __ATOMIC_RELAXED, __HIP_MEMORY_SCOPE_AGENT) < epoch + 1u) __builtin_amdgcn_s_sleep(1);
                __builtin_amdgcn_fence(__ATOMIC_ACQUIRE, "agent");
                asm volatile("s_waitcnt vmcnt(0)" ::: "memory");
            }
        } else {
            __builtin_amdgcn_fence(__ATOMIC_RELEASE, "agent");
            asm volatile("s_waitcnt vmcnt(0)" ::: "memory");
            __hip_atomic_fetch_add(bw, 1u, __ATOMIC_RELAXED, __HIP_MEMORY_SCOPE_AGENT);
            const unsigned target = (epoch + 1u) * gridDim.x;
            while (__hip_atomic_load(bw, __ATOMIC_RELAXED, __HIP_MEMORY_SCOPE_AGENT) < target) __builtin_amdgcn_s_sleep(1);
            __builtin_amdgcn_fence(__ATOMIC_ACQUIRE, "agent");
            asm volatile("s_waitcnt vmcnt(0)" ::: "memory");
        }
    }
    __syncthreads();
}

__global__ void __launch_bounds__(256) fwd_mega(Params p) {
    extern __shared__ __attribute__((aligned(16))) char lds[];
    int wv_ = __builtin_amdgcn_readfirstlane((int)(__builtin_amdgcn_workitem_id_x() >> 6));
    cg::grid_group grid = cg::this_grid();
    unsigned* xcnt = (unsigned*)(p.ws + WS_END) + 16;
    const int xcc = (int)(__builtin_amdgcn_s_getreg((3 << 11) | 20) & 7u);
    int xrank;
    { int* sh = (int*)lds; if (__builtin_amdgcn_workitem_id_x() == 0) sh[0] = (int)__hip_atomic_fetch_add(xcnt + xcc, 1u, __ATOMIC_RELAXED, __HIP_MEMORY_SCOPE_AGENT); __syncthreads(); xrank = __builtin_amdgcn_readfirstlane(sh[0]); __syncthreads(); }
    unsigned epoch = 0;
    phase_prep(p, lds, wv_);
    grid.sync();
    {   unsigned c[8]; bool ok = true;
#pragma unroll
        for (int i = 0; i < 8; ++i) { c[i] = __hip_atomic_load(xcnt + i, __ATOMIC_RELAXED, __HIP_MEMORY_SCOPE_AGENT); ok = ok && c[i] > 0u && c[i] < 512u; }
        unsigned mine = 0, tot_ = 0;
#pragma unroll
        for (int i = 0; i < 8; ++i) { mine = (i == xcc) ? c[i] : mine; tot_ += c[i]; }
        ok = ok && tot_ == gridDim.x;
        int X = xcc, R = xrank, NB = (int)mine;
        if (!ok) { X = blockIdx.x & 7; R = blockIdx.x >> 3; NB = gridDim.x >> 3; }
        wv_ = __builtin_amdgcn_readfirstlane((wv_ & 3) | (X << 2) | (R << 5) | (NB << 14) | (ok ? (1 << 23) : 0)); }
#pragma unroll 1
    for (int seg = 0; seg < NSEG; ++seg) {
        const int nrows = seg == 0 ? ROWS : ROWS_P, MT = nrows / 256;
#pragma unroll 1
        for (int l = 0; l < 2; ++l) {
            const bf16_t* wl = (const bf16_t*)p.ws + (size_t)l * E_LAYER;
            phase_norm(p, seg, nrows, p.in[I_NMIX] + l * 1024, l == 0, l, lds, wv_);
            gbar(p, epoch, wv_);
            for (int r = 0; r < p.rep[0]; ++r) { phase_proj(p, l, MT, lds, wv_); gbar(p, epoch, wv_); }
            for (int r = 0; r < (seg == 0 ? p.rep[3] : 1); ++r) { phase_mix(p, l, seg, lds, wv_); gbar(p, epoch, wv_); }
            phase_mbnorm(p, l, nrows, wv_);
            gbar(p, epoch, wv_);
            for (int r = 0; r < p.rep[1]; ++r) { phase_merge(p, l, MT, lds, wv_); gbar(p, epoch, wv_); }
            phase_resid(p, seg, MT, (const bf16_t*)(p.ws + WS_MRG), 1024, LDK, wl + E_WIN + E_WBR, l == 0, lds, wv_);
            gbar(p, epoch, wv_);
            phase_norm(p, seg, nrows, p.in[I_NFFN] + l * 1024, false, -1, lds, wv_);
            gbar(p, epoch, wv_);
            for (int r = 0; r < p.rep[2]; ++r) { phase_ffn_in(p, l, MT, lds, wv_); gbar(p, epoch, wv_); }
            phase_resid(p, seg, MT, (const bf16_t*)(p.ws + WS_PROJ), FFH, LDF, wl + E_WIN + E_WBR + E_WOUT + E_WFI, false, lds, wv_);
            gbar(p, epoch, wv_);
        }
        phase_final_norm(p, seg, nrows, wv_);
    }
}

extern "C" void kernel_launch(void* const* d_in, const int* in_sizes, int n_in, void* d_out, int out_size, void* d_ws, size_t ws_size, hipStream_t stream) {
    static int grid_blocks = 0;
    if (!grid_blocks) {
        int dev = 0, cus = 0, per_cu = 0;
        (void)hipGetDevice(&dev);
        (void)hipDeviceGetAttribute(&cus, hipDeviceAttributeMultiprocessorCount, dev);
        (void)hipFuncSetAttribute((const void*)fwd_mega, hipFuncAttributeMaxDynamicSharedMemorySize, LDS_BYTES);
        (void)hipOccupancyMaxActiveBlocksPerMultiprocessor(&per_cu, (const void*)fwd_mega, 256, LDS_BYTES);
        if (per_cu < 1) fprintf(stderr, "occupancy query says %d blocks per CU\n", per_cu);
        grid_blocks = cus;
        if (ws_size < WS_TOTAL) fprintf(stderr, "workspace too small: %zu < %zu\n", ws_size, (size_t)WS_END + 256);
    }
    (void)hipMemsetAsync((char*)d_ws + WS_END, 0, 256, stream);
    Params p{};
    for (int i = 0; i < 30; ++i) p.in[i] = (const float*)d_in[i];
    p.out = (float*)d_out; p.ws = (unsigned char*)d_ws; p.rep[0] = REP0; p.rep[1] = REP1; p.rep[2] = REP2; p.rep[3] = REP3;
    void* args[] = {&p};
    hipError_t e = hipLaunchCooperativeKernel((const void*)fwd_mega, dim3(grid_blocks), dim3(256), args, LDS_BYTES, stream);
    if (e != hipSuccess) fprintf(stderr, "cooperative launch failed: %s (grid %d)\n", hipGetErrorString(e), grid_blocks);
}
```

```cpp
#include <hip/hip_runtime.h>
#include <hip/hip_cooperative_groups.h>
#include <cstdio>
namespace cg = cooperative_groups;

typedef unsigned short bf16_t;
typedef short bf16x8 __attribute__((ext_vector_type(8)));
typedef float f32x4 __attribute__((ext_vector_type(4)));
typedef unsigned short us4 __attribute__((ext_vector_type(4)));
typedef unsigned short us8 __attribute__((ext_vector_type(8)));
#define DEVI __device__ __forceinline__

constexpr int LDK = 1088, LDF = 2880;
constexpr int D = 1024, NPROJ = 12288, SEGT = 512, NSEG = 4, ROWS_P = 8192, ROWS = 8704, FFH = 2816;
constexpr int PC_Z = 0, PC_XBC = 1024, PC_HQ = 3072, PC_HF = 4096, PC_HI = 5120, PC_HGATE = 6144, PC_RGATE = 7168, PC_RX = 8192, PC_MG = 9216, PC_DT = 12288;
constexpr size_t E_WIN = (size_t)NPROJ * LDK, E_WBR = 3u * 1024 * LDK, E_WOUT = 1024u * LDK, E_WFI = 5632u * LDK, E_WFO = 1024u * LDF;
constexpr size_t E_LAYER = E_WIN + E_WBR + E_WOUT + E_WFI + E_WFO;
constexpr size_t WS_PROJ = 2 * E_LAYER * 2;
constexpr size_t WS_DT = WS_PROJ + (size_t)ROWS * NPROJ * 2;
constexpr size_t WS_XB = WS_DT + (size_t)ROWS * 16 * 4;
constexpr size_t WS_YMB = WS_XB + (size_t)ROWS * LDK * 2;
constexpr size_t WS_YHG = WS_YMB + (size_t)ROWS * LDK * 2;
constexpr size_t WS_YRG = WS_YHG + (size_t)ROWS * LDK * 2;
constexpr size_t WS_MRG = WS_YRG + (size_t)ROWS * LDK * 2;
constexpr size_t WS_END = WS_MRG + (size_t)ROWS * LDK * 2;
constexpr size_t WS_HB = WS_END + 256;
constexpr size_t WS_DTW = WS_HB + 2u * 2 * 16 * 3 * 2048 * 4;
constexpr size_t WS_TOTAL = WS_DTW + 2u * 16 * 1024 * 4;
constexpr size_t O_YP = 0, O_YS = 33554432, O_SSM_P = 34078720, O_SCV_P = 38273024, O_HG_P = 38469632, O_RG_P = 42663936, O_RCV_P = 42696704,
                 O_SSM_S = 42795008, O_SCV_S = 46989312, O_HG_S = 47185920, O_RG_S = 51380224, O_RCV_S = 51412992;
constexpr int REP0 = 1, REP1 = 1, REP2 = 1, REP3 = 1;
constexpr int LDS_BYTES = 144 * 1024;

enum { I_XP = 0, I_XS, I_SSM, I_SCV, I_HG, I_RG, I_RCV, I_NMIX, I_WIN, I_MCW, I_MCB, I_DTB, I_ALOG, I_MBD, I_MBNW, I_LBL, I_HGNW, I_RCW, I_RCB, I_RWA, I_RBA, I_RWI, I_RBI, I_RLAM, I_WBR, I_WOUT, I_NFFN, I_WFI, I_WFO, I_NFIN };

struct Params { const float* in[30]; float* out; unsigned char* ws; int rep[4]; };

DEVI int tidx(int wv_) { int t = ((wv_ & 3) << 6) | (int)__builtin_amdgcn_mbcnt_hi(~0u, __builtin_amdgcn_mbcnt_lo(~0u, 0u)); asm volatile("" : "+v"(t)); return t; }
DEVI float shfli(float v, int srcl) { return __int_as_float(__builtin_amdgcn_ds_bpermute(srcl << 2, __float_as_int(v))); }
DEVI float shflx(float v, int m, int lane) { return shfli(v, lane ^ m); }
DEVI bf16_t f2bf(float f) { unsigned u = __float_as_uint(f); u += 0x7fffu + ((u >> 16) & 1u); return (bf16_t)(u >> 16); }
DEVI float bf2f(bf16_t h) { return __uint_as_float(((unsigned)h) << 16); }
DEVI float sigm(float x) { return 1.f / (1.f + __expf(-x)); }
DEVI float silu(float x) { return x / (1.f + __expf(-x)); }
DEVI float softplus(float x) { return x > 20.f ? x : __logf(1.f + __expf(x)); }
DEVI float gelu_t(float x) { float u = 0.7978845608f * (x + 0.044715f * x * x * x); return x * sigm(2.f * u); }
DEVI float cexp(float x) { return __expf(fminf(x, 80.f)); }

DEVI const float* xrow_in(const Params& p, int seg, int r) {
    if (r < ROWS_P) { int b = r >> 9, tt = r & 511; return p.in[I_XP] + ((size_t)(b * 2048 + seg * SEGT + tt)) * D; }
    return p.in[I_XS] + (size_t)(r - ROWS_P) * D;
}
DEVI float* xrow_out(const Params& p, int seg, int r) {
    if (r < ROWS_P) { int b = r >> 9, tt = r & 511; return p.out + O_YP + ((size_t)(b * 2048 + seg * SEGT + tt)) * D; }
    return p.out + O_YS + (size_t)(r - ROWS_P) * D;
}

DEVI int perm32(int rho) { int n = rho >> 4, i = rho & 15; return 8 * (i >> 2) + 4 * n + (i & 3); }
DEVI int map_win(int n) { n = (n & ~31) + perm32(n & 31); return n < 3072 ? n : n + 16; }
DEVI int map_wfi(int n) { int T = n >> 7, nf = (n >> 4) & 7, i = n & 15, G = nf >> 2, h = (nf >> 1) & 1, s = nf & 1; return s * FFH + 64 * T + 32 * G + 8 * (i >> 2) + 4 * h + (i & 3); }

DEVI void transpose_tile(const float* src, int ldsrc, bf16_t* dst, int K, int k0, int n0, int mode, float* tile  , int wv_) {
    const int tid = tidx(wv_), c = tid & 63, rq = tid >> 6;
    int n = n0 + c, sn = mode == 1 ? map_win(n) : (mode == 2 ? map_wfi(n) : n);
#pragma unroll
    for (int rr = 0; rr < 16; ++rr) { int kl = rr * 4 + rq; tile[kl * 65 + c] = sn >= 0 ? src[(size_t)(k0 + kl) * ldsrc + sn] : 0.f; }
    __syncthreads();
#pragma unroll
    for (int rr = 0; rr < 16; ++rr) { int nl = rr * 4 + rq; dst[(size_t)(n0 + nl) * K + k0 + c] = f2bf(tile[c * 65 + nl]); }
    __syncthreads();
}

DEVI void phase_prep(const Params& p, char* lds, int wv_) {
    float* tile = (float*)lds;
    bf16_t* wsb = (bf16_t*)p.ws;
    constexpr int T_WIN = 16 * 192, T_WBR = 3 * 256, T_WOUT = 256, T_WFI = 16 * 88, T_WFO = 44 * 16, T_L = T_WIN + T_WBR + T_WOUT + T_WFI + T_WFO;
    {   float* dtw = (float*)(p.ws + WS_DTW);
        for (int e = blockIdx.x * 256 + tidx(wv_); e < 32768; e += gridDim.x * 256) { int l = e >> 14, j = (e >> 10) & 15, k = e & 1023; dtw[e] = p.in[I_WIN][(size_t)l * 1024 * 12304 + (size_t)k * 12304 + 3072 + j]; } }
    for (int t = blockIdx.x; t < 2 * T_L; t += gridDim.x) {
        int l = t / T_L, j = t % T_L;
        bf16_t* wl = wsb + (size_t)l * E_LAYER;
        if (j < T_WIN) { int kt = j & 15, nt = j >> 4; transpose_tile(p.in[I_WIN] + (size_t)l * 1024 * 12304, 12304, wl, LDK, kt * 64, nt * 64, 1, tile, wv_); continue; }
        j -= T_WIN;
        if (j < T_WBR) { int k = j >> 8, jj = j & 255, kt = jj & 15, nt = jj >> 4;
            transpose_tile(p.in[I_WBR] + ((size_t)l * 3 + k) * 1024 * 1024, 1024, wl + E_WIN + (size_t)k * 1024 * LDK, LDK, kt * 64, nt * 64, 0, tile, wv_); continue; }
        j -= T_WBR;
        if (j < T_WOUT) { int kt = j & 15, nt = j >> 4; transpose_tile(p.in[I_WOUT] + (size_t)l * 1024 * 1024, 1024, wl + E_WIN + E_WBR, LDK, kt * 64, nt * 64, 0, tile, wv_); continue; }
        j -= T_WOUT;
        if (j < T_WFI) { int kt = j & 15, nt = j >> 4; transpose_tile(p.in[I_WFI] + (size_t)l * 1024 * 5632, 5632, wl + E_WIN + E_WBR + E_WOUT, LDK, kt * 64, nt * 64, 2, tile, wv_); continue; }
        j -= T_WFI;
        { int kt = j % 44, nt = j / 44; transpose_tile(p.in[I_WFO] + (size_t)l * 2816 * 1024, 1024, wl + E_WIN + E_WBR + E_WOUT + E_WFI, LDF, kt * 64, nt * 64, 0, tile, wv_); }
    }
}

DEVI void phase_norm(const Params& p, int seg, int nrows, const float* w, bool from_input, int ldt  , char* lds, int wv_) {
    bf16_t* xb = (bf16_t*)(p.ws + WS_XB); float* dtb = (float*)(p.ws + WS_DT);
    const int lane = tidx(wv_) & 63, wv = tidx(wv_) >> 6;
    float* dw = (float*)lds;
    if (ldt >= 0) { const float* dtw = (const float*)(p.ws + WS_DTW) + ldt * 16384; f32x4 t_[16];
#pragma unroll
        for (int u = 0; u < 16; ++u) t_[u] = *(const f32x4*)(dtw + (tidx(wv_) + 256 * u) * 4);
#pragma unroll
        for (int u = 0; u < 16; ++u) *(f32x4*)(dw + (tidx(wv_) + 256 * u) * 4) = t_[u];
        __syncthreads(); }
    for (int r = blockIdx.x * 4 + wv; r < nrows; r += gridDim.x * 4) {
        const float* x = from_input ? xrow_in(p, seg, r) : xrow_out(p, seg, r);
        f32x4 v[4]; float ss = 0.f;
#pragma unroll
        for (int i = 0; i < 4; ++i) { v[i] = *(const f32x4*)(x + i * 256 + lane * 4); ss += v[i][0] * v[i][0] + v[i][1] * v[i][1] + v[i][2] * v[i][2] + v[i][3] * v[i][3]; }
#pragma unroll
        for (int o = 32; o >= 1; o >>= 1) ss += shflx(ss, o, lane);
        float rs = rsqrtf(ss * (1.f / 1024.f) + 1e-6f);
#pragma unroll
        for (int i = 0; i < 4; ++i) { f32x4 wv4 = *(const f32x4*)(w + i * 256 + lane * 4); us4 o;
            v[i][0] *= rs * wv4[0]; v[i][1] *= rs * wv4[1]; v[i][2] *= rs * wv4[2]; v[i][3] *= rs * wv4[3];
            o[0] = f2bf(v[i][0]); o[1] = f2bf(v[i][1]); o[2] = f2bf(v[i][2]); o[3] = f2bf(v[i][3]);
            *(us4*)(xb + (size_t)r * LDK + i * 256 + lane * 4) = o; }
        if (ldt >= 0) {
            float d[16];
#pragma unroll
            for (int j = 0; j < 16; ++j) { float s = 0.f;
#pragma unroll
                for (int i = 0; i < 4; ++i) { f32x4 ww = *(const f32x4*)(dw + j * 1024 + i * 256 + lane * 4); s += v[i][0] * ww[0] + v[i][1] * ww[1] + v[i][2] * ww[2] + v[i][3] * ww[3]; }
                d[j] = s; }
            { const bool hi = lane & 32;
#pragma unroll
              for (int i = 0; i < 8; ++i) { float send = hi ? d[i] : d[i + 8], keep = hi ? d[i + 8] : d[i]; d[i] = keep + shfli(send, lane ^ 32); } }
            { const bool hi = lane & 16;
#pragma unroll
              for (int i = 0; i < 4; ++i) { float send = hi ? d[i] : d[i + 4], keep = hi ? d[i + 4] : d[i]; d[i] = keep + shfli(send, lane ^ 16); } }
            { const bool hi = lane & 8;
#pragma unroll
              for (int i = 0; i < 2; ++i) { float send = hi ? d[i] : d[i + 2], keep = hi ? d[i + 2] : d[i]; d[i] = keep + shfli(send, lane ^ 8); } }
            { const bool hi = lane & 4; float send = hi ? d[0] : d[1], keep = hi ? d[1] : d[0]; d[0] = keep + shfli(send, lane ^ 4); }
            d[0] += shfli(d[0], lane ^ 2); d[0] += shfli(d[0], lane ^ 1);
            if ((lane & 3) == 0) { int j = lane >> 2; dtb[(size_t)r * 16 + j] = softplus(d[0] + p.in[I_DTB][ldt * 16 + j]); }
        }
    }
    if (ldt >= 0) __syncthreads();
}
DEVI void phase_final_norm(const Params& p, int seg, int nrows, int wv_) {
    const float* w = p.in[I_NFIN];
    const int lane = tidx(wv_) & 63, wv = tidx(wv_) >> 6;
    for (int r = blockIdx.x * 4 + wv; r < nrows; r += gridDim.x * 4) {
        float* x = xrow_out(p, seg, r);
        f32x4 v[4]; float ss = 0.f;
#pragma unroll
        for (int i = 0; i < 4; ++i) { v[i] = *(const f32x4*)(x + i * 256 + lane * 4); ss += v[i][0] * v[i][0] + v[i][1] * v[i][1] + v[i][2] * v[i][2] + v[i][3] * v[i][3]; }
#pragma unroll
        for (int o = 32; o >= 1; o >>= 1) ss += shflx(ss, o, lane);
        float rs = rsqrtf(ss * (1.f / 1024.f) + 1e-6f);
#pragma unroll
        for (int i = 0; i < 4; ++i) { f32x4 wv4 = *(const f32x4*)(w + i * 256 + lane * 4); f32x4 o;
            o[0] = v[i][0] * rs * wv4[0]; o[1] = v[i][1] * rs * wv4[1]; o[2] = v[i][2] * rs * wv4[2]; o[3] = v[i][3] * rs * wv4[3];
            *(f32x4*)(x + i * 256 + lane * 4) = o; }
    }
}
DEVI void phase_mbnorm(const Params& p, int l, int nrows, int wv_) {
    bf16_t* y = (bf16_t*)(p.ws + WS_YMB); const float* w = p.in[I_MBNW] + l * 1024;
    const int lane = tidx(wv_) & 63, wv = tidx(wv_) >> 6;
    for (int it = blockIdx.x * 4 + wv; it < nrows * 4; it += gridDim.x * 4) {
        int r = it >> 2, g = it & 3; bf16_t* yp = y + (size_t)r * LDK + g * 256 + lane * 4;
        us4 v = *(const us4*)yp; float f0 = bf2f(v[0]), f1 = bf2f(v[1]), f2 = bf2f(v[2]), f3 = bf2f(v[3]);
        float ss = f0 * f0 + f1 * f1 + f2 * f2 + f3 * f3;
#pragma unroll
        for (int o = 32; o >= 1; o >>= 1) ss += shflx(ss, o, lane);
        float rs = rsqrtf(ss * (1.f / 256.f) + 1e-6f); f32x4 wv4 = *(const f32x4*)(w + g * 256 + lane * 4);
        us4 o; o[0] = f2bf(f0 * rs * wv4[0]); o[1] = f2bf(f1 * rs * wv4[1]); o[2] = f2bf(f2 * rs * wv4[2]); o[3] = f2bf(f3 * rs * wv4[3]);
        *(us4*)yp = o;
    }
}

#define WAIT_V(n) asm volatile("s_waitcnt vmcnt(" #n ")" ::: "memory")
#define RAW_BAR() do { asm volatile("" ::: "memory"); __builtin_amdgcn_s_barrier(); asm volatile("" ::: "memory"); } while (0)
template <int NF>
DEVI void stage_tile(const bf16_t* A, const bf16_t* Bt, int K, int t, char* st, int tid, size_t soff) {
    const size_t o = soff + (size_t)t * 32;
#pragma unroll
    for (int i = 0; i < 4; ++i) __builtin_amdgcn_global_load_lds((const unsigned*)(A + o + (size_t)i * 64 * K), (unsigned*)(st + tid * 16 + i * 4096), 16, 0, 0);
#pragma unroll
    for (int i = 0; i < NF / 2; ++i) __builtin_amdgcn_global_load_lds((const unsigned*)(Bt + o + (size_t)i * 64 * K), (unsigned*)(st + 16384 + tid * 16 + i * 4096), 16, 0, 0);
}
template <int NF>
DEVI void gemm_kloop(f32x4 (&acc)[8][NF], const bf16_t* A, const bf16_t* Bt, int K, int ld, char* lds, int wv_) {
    constexpr int STAGE = 16384 + NF * 2048;
    const int tid = tidx(wv_), lane = tid & 63, wid = tid >> 6, wr = wid >> 1, wc = wid & 1, fr = lane & 15, fq = lane >> 4;
    const int fo = fr * 64 + ((fq ^ (fr >> 2)) & 3) * 16;
    const int aoff = wr * 8192 + fo, boff = 16384 + wc * NF * 1024 + fo;
    const size_t soff = (size_t)(tid >> 2) * ld + (((tid & 3) ^ ((tid >> 4) & 3)) * 8);
    const int nt = K >> 5;
    WAIT_V(0); RAW_BAR();
    stage_tile<NF>(A, Bt, ld, 0, lds, tid, soff);
    stage_tile<NF>(A, Bt, ld, 1, lds + STAGE, tid, soff);
    stage_tile<NF>(A, Bt, ld, 2, lds + 2 * STAGE, tid, soff);
    for (int t = 0; t < nt; ++t) {
        if (t + 2 < nt) { if (NF == 8) WAIT_V(16); else WAIT_V(12); }
        else if (t + 1 < nt) { if (NF == 8) WAIT_V(8); else WAIT_V(6); }
        else WAIT_V(0);
        RAW_BAR();
        if (t + 3 < nt) stage_tile<NF>(A, Bt, ld, t + 3, lds + ((t + 3) & 3) * STAGE, tid, soff);
        const char* st = lds + (t & 3) * STAGE;
        bf16x8 af[8], bfr[NF];
        af[0] = *(const bf16x8*)(st + aoff);
#pragma unroll
        for (int n = 0; n < NF; ++n) bfr[n] = *(const bf16x8*)(st + boff + n * 1024);
        af[1] = *(const bf16x8*)(st + aoff + 1024);
#pragma unroll
        for (int g = 0; g < 8; ++g) {
            __builtin_amdgcn_sched_barrier(0);
            if (g < 6) af[g + 2] = *(const bf16x8*)(st + aoff + (g + 2) * 1024);
#pragma unroll
            for (int n = 0; n < NF; ++n) acc[g][n] = __builtin_amdgcn_mfma_f32_16x16x32_bf16(bfr[n], af[g], acc[g][n], 0, 0, 0);
        }
        __builtin_amdgcn_sched_barrier(0);
    }
}
DEVI bool next_tile(int it, int MT, int NT, int& mt, int& nt, int wv_) {
    const int x = (wv_ >> 2) & 7, bl = (wv_ >> 5) & 511, G8 = (wv_ >> 14) & 511;
    int nI = (MT - x + 7) >> 3; long j = (long)it * G8 + bl;
    if (j >= (long)nI * NT) return false;
    int i = (int)(j % nI); nt = (int)(j / nI); mt = x + 8 * i; return true;
}
#define ZERO_ACC(a, NF_) _Pragma("unroll") for (int m_ = 0; m_ < 8; ++m_) _Pragma("unroll") for (int n_ = 0; n_ < NF_; ++n_) a[m_][n_] = (f32x4){0.f, 0.f, 0.f, 0.f}
#define EPI_IDS const int lane = tidx(wv_) & 63, wid = tidx(wv_) >> 6, wr = wid >> 1, wc = wid & 1, fr = lane & 15, fq = lane >> 4

template <int ACT>
DEVI void proj_store(const f32x4 (&acc)[8][8], bf16_t* pbase, float c1, float c3, bool issig) {
#pragma unroll
    for (int m = 0; m < 8; ++m)
#pragma unroll
        for (int q = 0; q < 4; ++q) { __builtin_amdgcn_sched_barrier(0); us8 o;
#pragma unroll
            for (int s = 0; s < 2; ++s)
#pragma unroll
                for (int j = 0; j < 4; ++j) { float x = acc[m][2 * q + s][j];
                    if (ACT) { float u = x * (c1 + c3 * x * x); float sg = __builtin_amdgcn_rcpf(1.f + __expf(-u)); x = sg * (issig ? 1.f : x); }
                    o[4 * s + j] = f2bf(x); }
            *(us8*)(pbase + (size_t)m * 16 * NPROJ + q * 32) = o; }
}
DEVI void phase_proj(const Params& p, int l, int MT, char* lds, int wv_) {
    const bf16_t* xb = (const bf16_t*)(p.ws + WS_XB); const bf16_t* wt = (const bf16_t*)p.ws + (size_t)l * E_LAYER;
    bf16_t* proj = (bf16_t*)(p.ws + WS_PROJ);
    int mt, nt;
    for (int it = 0; next_tile(it, MT, 48, mt, nt, wv_); ++it) {
        f32x4 acc[8][8]; ZERO_ACC(acc, 8);
        gemm_kloop<8>(acc, xb + (size_t)mt * 256 * LDK, wt + (size_t)nt * 256 * LDK, 1024, LDK, lds, wv_);
        EPI_IDS;
        const int sg = nt >> 2;
        const int ty = (sg == 0 || sg == 3 || sg == 6) ? 1 : (sg == 7 ? 2 : (sg >= 9 ? 3 : 0));
        bf16_t* pbase = proj + (size_t)(mt * 256 + wr * 128 + fr) * NPROJ + nt * 256 + wc * 128 + fq * 8;
        if (ty == 0) proj_store<0>(acc, pbase, 0.f, 0.f, false); else proj_store<1>(acc, pbase, ty == 2 ? 1.5957691216f : 1.f, ty == 2 ? 0.0713548163f : 0.f, ty == 3);
    }
}
DEVI void phase_merge(const Params& p, int l, int MT, char* lds, int wv_) {
    const bf16_t* wt = (const bf16_t*)p.ws + (size_t)l * E_LAYER + E_WIN; const bf16_t* proj = (const bf16_t*)(p.ws + WS_PROJ);
    bf16_t* mrg = (bf16_t*)(p.ws + WS_MRG);
    int mt, nt;
    for (int it = 0; next_tile(it, MT, 8, mt, nt, wv_); ++it) {
        f32x4 tot[8][4]; ZERO_ACC(tot, 4);
#pragma unroll 1
        for (int k = 0; k < 3; ++k) {
            const bf16_t* y = (const bf16_t*)(p.ws + WS_YMB + (size_t)k * ROWS * LDK * 2);
            f32x4 acc[8][4]; ZERO_ACC(acc, 4);
            gemm_kloop<4>(acc, y + (size_t)mt * 256 * LDK, wt + (size_t)k * 1024 * LDK + (size_t)nt * 128 * LDK, 1024, LDK, lds, wv_);
            EPI_IDS;
#pragma unroll
            for (int m = 0; m < 8; ++m) { int row = mt * 256 + wr * 128 + m * 16 + fr; asm volatile("" ::: "memory");
#pragma unroll
                for (int n = 0; n < 4; ++n) { int col = nt * 128 + wc * 64 + n * 16 + fq * 4; us4 g = *(const us4*)(proj + (size_t)row * NPROJ + PC_MG + k * 1024 + col);
#pragma unroll
                    for (int j = 0; j < 4; ++j) tot[m][n][j] += acc[m][n][j] * bf2f(g[j]); } }
        }
        EPI_IDS;
#pragma unroll
        for (int m = 0; m < 8; ++m) { int row = mt * 256 + wr * 128 + m * 16 + fr;
#pragma unroll
            for (int n = 0; n < 4; ++n) { int col = nt * 128 + wc * 64 + n * 16 + fq * 4; us4 o;
#pragma unroll
                for (int j = 0; j < 4; ++j) o[j] = f2bf(tot[m][n][j]);
                *(us4*)(mrg + (size_t)row * LDK + col) = o; } }
    }
}
DEVI void phase_resid(const Params& p, int seg, int MT, const bf16_t* A, int K, int ld, const bf16_t* Bt, bool from_input, char* lds, int wv_) {
    int mt, nt;
    for (int it = 0; next_tile(it, MT, 8, mt, nt, wv_); ++it) {
        f32x4 acc[8][4]; ZERO_ACC(acc, 4);
        gemm_kloop<4>(acc, A + (size_t)mt * 256 * ld, Bt + (size_t)nt * 128 * ld, K, ld, lds, wv_);
        EPI_IDS;
#pragma unroll
        for (int m = 0; m < 8; ++m) { int row = mt * 256 + wr * 128 + m * 16 + fr;
            const float* xi = from_input ? xrow_in(p, seg, row) : xrow_out(p, seg, row); float* xo = xrow_out(p, seg, row);
#pragma unroll
            for (int n = 0; n < 4; ++n) { int col = nt * 128 + wc * 64 + n * 16 + fq * 4; f32x4 v = *(const f32x4*)(xi + col); *(f32x4*)(xo + col) = v + acc[m][n]; } }
    }
}
DEVI void phase_ffn_in(const Params& p, int l, int MT, char* lds, int wv_) {
    const bf16_t* xb = (const bf16_t*)(p.ws + WS_XB); const bf16_t* wt = (const bf16_t*)p.ws + (size_t)l * E_LAYER + E_WIN + E_WBR + E_WOUT;
    bf16_t* act = (bf16_t*)(p.ws + WS_PROJ);
    int mt, nt;
    for (int it = 0; next_tile(it, MT, 22, mt, nt, wv_); ++it) {
        f32x4 acc[8][8]; ZERO_ACC(acc, 8);
        gemm_kloop<8>(acc, xb + (size_t)mt * 256 * LDK, wt + (size_t)nt * 256 * LDK, 1024, LDK, lds, wv_);
        EPI_IDS;
#pragma unroll
        for (int m = 0; m < 8; ++m) { int row = mt * 256 + wr * 128 + m * 16 + fr;
#pragma unroll
            for (int G = 0; G < 2; ++G) { int col = (nt * 2 + wc) * 64 + 32 * G + fq * 8; us8 o;
#pragma unroll
                for (int h = 0; h < 2; ++h)
#pragma unroll
                    for (int j = 0; j < 4; ++j) o[4 * h + j] = f2bf(silu(acc[m][4 * G + 2 * h][j]) * acc[m][4 * G + 2 * h + 1][j]);
                *(us8*)(act + (size_t)row * LDF + col) = o; } }
    }
}

struct Seq { int row0, nchunk, Q, b, samp, seg; };
DEVI Seq make_seq(int seg, int sq) { Seq s; s.seg = seg; if (sq < 16) { s.row0 = sq * SEGT; s.nchunk = 8; s.Q = 64; s.b = sq; s.samp = 0; } else { s.b = sq - 16; s.row0 = ROWS_P + s.b * 32; s.nchunk = 1; s.Q = 32; s.samp = 1; } return s; }

template <int NF, int KS>
DEVI void lds_mma(f32x4* acc, const bf16_t* X, int ldx, int m0, const bf16_t* Y, int ldy, int n0, int wv_) {
    const int lane = tidx(wv_) & 63, fr = lane & 15, fq = lane >> 4;
#pragma unroll
    for (int ks = 0; ks < KS; ++ks) {
        bf16x8 a = *(const bf16x8*)(X + (m0 + fr) * ldx + ks * 32 + fq * 8);
#pragma unroll
        for (int nf = 0; nf < NF; ++nf) { bf16x8 b = *(const bf16x8*)(Y + (n0 + nf * 16 + fr) * ldy + ks * 32 + fq * 8); acc[nf] = __builtin_amdgcn_mfma_f32_16x16x32_bf16(a, b, acc[nf], 0, 0, 0); }
    }
}

DEVI void conv_load(uint4 (&r)[4], const bf16_t* proj, int row0, int tq, int pcol) {
#pragma unroll
    for (int k = 0; k < 4; ++k) { int ts = tq - 3 + k; ts = ts < 0 ? 0 : ts; r[k] = *(const uint4*)(proj + (size_t)(row0 + ts) * NPROJ + pcol); }
}
DEVI void touch4(uint4& v) { asm volatile("" : "+v"(v.x), "+v"(v.y), "+v"(v.z), "+v"(v.w)); }
DEVI void conv_compute(const uint4 (&r)[4], int tq, const float* hl, const float* cwl, int HC, int cl, float (&out)[8], float (&raw)[8]) {
    { f32x4 b0 = *(const f32x4*)(cwl + 4 * HC + cl), b1 = *(const f32x4*)(cwl + 4 * HC + cl + 4);
      out[0] = b0[0]; out[1] = b0[1]; out[2] = b0[2]; out[3] = b0[3]; out[4] = b1[0]; out[5] = b1[1]; out[6] = b1[2]; out[7] = b1[3]; }
#pragma unroll
    for (int k = 0; k < 4; ++k) {
        const int ts = tq - 3 + k; float v[8];
        v[0] = __uint_as_float(r[k].x << 16); v[1] = __uint_as_float(r[k].x & 0xffff0000u); v[2] = __uint_as_float(r[k].y << 16); v[3] = __uint_as_float(r[k].y & 0xffff0000u);
        v[4] = __uint_as_float(r[k].z << 16); v[5] = __uint_as_float(r[k].z & 0xffff0000u); v[6] = __uint_as_float(r[k].w << 16); v[7] = __uint_as_float(r[k].w & 0xffff0000u);
        if (k < 3) { int hi = 3 + ts; hi = hi < 0 ? 0 : (hi > 2 ? 2 : hi); const bool uh = ts < 0;
            f32x4 h0 = *(const f32x4*)(hl + hi * HC + cl), h1 = *(const f32x4*)(hl + hi * HC + cl + 4);
            v[0] = uh ? h0[0] : v[0]; v[1] = uh ? h0[1] : v[1]; v[2] = uh ? h0[2] : v[2]; v[3] = uh ? h0[3] : v[3];
            v[4] = uh ? h1[0] : v[4]; v[5] = uh ? h1[1] : v[5]; v[6] = uh ? h1[2] : v[6]; v[7] = uh ? h1[3] : v[7]; }
        f32x4 w0 = *(const f32x4*)(cwl + k * HC + cl), w1 = *(const f32x4*)(cwl + k * HC + cl + 4);
        out[0] += v[0] * w0[0]; out[1] += v[1] * w0[1]; out[2] += v[2] * w0[2]; out[3] += v[3] * w0[3];
        out[4] += v[4] * w1[0]; out[5] += v[5] * w1[1]; out[6] += v[6] * w1[2]; out[7] += v[7] * w1[3];
        if (k == 3) {
#pragma unroll
            for (int e = 0; e < 8; ++e) raw[e] = v[e]; }
    }
}

template <int ROWB>
DEVI void stage_raw(const char* g0, size_t ldgB, char* dst, int tid) {
#pragma unroll
    for (int i = 0; i < ROWB / 64; ++i) { int b = tid * 16 + i * 4096, row = b / ROWB, cb = b % ROWB;
        __builtin_amdgcn_global_load_lds((const unsigned*)(g0 + (size_t)row * ldgB + cb), (unsigned*)(dst + b), 16, 0, 0); }
}
DEVI void conv_lds(const bf16_t* rawt, int RS, int t, int cloc, const float* hl, const float* cwl, int HC, int cl, float (&out)[8], float (&raw)[8]) {
    { f32x4 b0 = *(const f32x4*)(cwl + 4 * HC + cl), b1 = *(const f32x4*)(cwl + 4 * HC + cl + 4);
      out[0] = b0[0]; out[1] = b0[1]; out[2] = b0[2]; out[3] = b0[3]; out[4] = b1[0]; out[5] = b1[1]; out[6] = b1[2]; out[7] = b1[3]; }
#pragma unroll
    for (int k = 0; k < 4; ++k) {
        const int tt = t - 3 + k; const int tc = tt < 0 ? 0 : tt; float v[8];
        const uint4 r = *(const uint4*)(rawt + tc * RS + cloc);
        v[0] = __uint_as_float(r.x << 16); v[1] = __uint_as_float(r.x & 0xffff0000u); v[2] = __uint_as_float(r.y << 16); v[3] = __uint_as_float(r.y & 0xffff0000u);
        v[4] = __uint_as_float(r.z << 16); v[5] = __uint_as_float(r.z & 0xffff0000u); v[6] = __uint_as_float(r.w << 16); v[7] = __uint_as_float(r.w & 0xffff0000u);
        if (k < 3) { int hi = 3 + tt; hi = hi < 0 ? 0 : (hi > 2 ? 2 : hi); const bool uh = tt < 0;
            f32x4 h0 = *(const f32x4*)(hl + hi * HC + cl), h1 = *(const f32x4*)(hl + hi * HC + cl + 4);
            v[0] = uh ? h0[0] : v[0]; v[1] = uh ? h0[1] : v[1]; v[2] = uh ? h0[2] : v[2]; v[3] = uh ? h0[3] : v[3];
            v[4] = uh ? h1[0] : v[4]; v[5] = uh ? h1[1] : v[5]; v[6] = uh ? h1[2] : v[6]; v[7] = uh ? h1[3] : v[7]; }
        f32x4 w0 = *(const f32x4*)(cwl + k * HC + cl), w1 = *(const f32x4*)(cwl + k * HC + cl + 4);
        out[0] += v[0] * w0[0]; out[1] += v[1] * w0[1]; out[2] += v[2] * w0[2]; out[3] += v[3] * w0[3];
        out[4] += v[4] * w1[0]; out[5] += v[5] * w1[1]; out[6] += v[6] * w1[2]; out[7] += v[7] * w1[3];
        if (k == 3) {
#pragma unroll
            for (int e = 0; e < 8; ++e) raw[e] = v[e]; }
    }
}

DEVI void ssd_unit(const Params& p, int l, Seq sq, int hd, char* lds, int wv_) {
    bf16_t* Bm = (bf16_t*)lds;
    bf16_t* R2 = (bf16_t*)(lds + 17408);
    bf16_t* xT = (bf16_t*)(lds + 35840);
    bf16_t* hb = (bf16_t*)(lds + 45056);
    float* fl = (float*)(lds + 62464);
    const int tid = tidx(wv_), lane = tid & 63, w = tid >> 6, fr = lane & 15, fq = lane >> 4;
    const bf16_t* proj = (const bf16_t*)(p.ws + WS_PROJ); const float* dtb = (const float*)(p.ws + WS_DT); bf16_t* ymb = (bf16_t*)(p.ws + WS_YMB);
    const int g = hd >> 2;
    const float a = -__expf(p.in[I_ALOG][l * 16 + hd]), Dv = p.in[I_MBD][l * 16 + hd];
    const float* cw = p.in[I_MCW] + (size_t)l * 4 * 2048; const float* cbias = p.in[I_MCB] + l * 2048;
    float* cwl = (float*)(lds + 63488);
    float* hl = (float*)(lds + 69888);
    const float* st_in; float* st_out; const float* hist; float* hist_out; float* hist_out2 = nullptr;
    float* hbuf = (float*)(p.ws + WS_HB);
    if (sq.samp) { st_in = p.in[I_SSM] + ((size_t)(l * 16 + sq.b) * 16 + hd) * 8192; st_out = p.out + O_SSM_S + ((size_t)(l * 16 + sq.b) * 16 + hd) * 8192;
        hist = p.in[I_SCV] + (size_t)(l * 16 + sq.b) * 3 * 2048; hist_out = p.out + O_SCV_S + (size_t)(l * 16 + sq.b) * 3 * 2048; }
    else { st_out = p.out + O_SSM_P + ((size_t)(l * 16 + sq.b) * 16 + hd) * 8192; st_in = sq.seg ? st_out : nullptr;
        hist_out = hbuf + ((size_t)((sq.seg & 1) * 2 + l) * 16 + sq.b) * 3 * 2048; hist = sq.seg ? hbuf + ((size_t)(((sq.seg + 1) & 1) * 2 + l) * 16 + sq.b) * 3 * 2048 : nullptr;
        if (sq.seg == NSEG - 1) hist_out2 = p.out + O_SCV_P + (size_t)(l * 16 + sq.b) * 3 * 2048; }
    for (int idx = tid; idx < 1600; idx += 256) { int k = idx / 320, cc = idx - k * 320; int ch = cc < 64 ? hd * 64 + cc : (cc < 192 ? 1024 + g * 128 + (cc - 64) : 1536 + g * 128 + (cc - 192));
        cwl[idx] = k < 4 ? cw[k * 2048 + ch] : cbias[ch];
        if (idx < 960) hl[idx] = hist ? hist[k * 2048 + ch] : 0.f; }
    f32x4 hacc[8];
#pragma unroll
    for (int nf = 0; nf < 8; ++nf)
#pragma unroll
        for (int r = 0; r < 4; ++r) { int pp = 16 * w + 4 * fq + r, n = 16 * nf + fr; float v = st_in ? st_in[pp * 128 + n] : 0.f; hacc[nf][r] = v; hb[pp * 136 + n] = f2bf(v); }
    bf16_t* rawX = (bf16_t*)(lds + 77568); bf16_t* rawB = (bf16_t*)(lds + 85760); bf16_t* rawC = (bf16_t*)(lds + 102144); bf16_t* rawZ = (bf16_t*)(lds + 118528); float* rawDt = (float*)(lds + 126720);
    const char* gx = (const char*)(proj + PC_XBC + hd * 64); const char* gb = (const char*)(proj + PC_XBC + 1024 + g * 128); const char* gc = (const char*)(proj + PC_XBC + 1536 + g * 128); const char* gz = (const char*)(proj + PC_Z + hd * 64);
    asm volatile("s_waitcnt vmcnt(0)" ::: "memory");
    {   const size_t ro = (size_t)sq.row0 * NPROJ * 2;
        stage_raw<128>(gx + ro, (size_t)NPROJ * 2, (char*)rawX, tid); stage_raw<256>(gb + ro, (size_t)NPROJ * 2, (char*)rawB, tid); stage_raw<256>(gc + ro, (size_t)NPROJ * 2, (char*)rawC, tid);
        stage_raw<128>(gz + ro, (size_t)NPROJ * 2, (char*)rawZ, tid); stage_raw<64>((const char*)(dtb + (size_t)sq.row0 * 16), 64, (char*)rawDt, tid); }
    for (int c = 0; c < sq.nchunk; ++c) {
        const int tid = tidx(wv_), lane = tid & 63, w = tid >> 6, fr = lane & 15, fq = lane >> 4;
        const int rowc = sq.row0 + c * 64; const bool lastc = (c == sq.nchunk - 1);
        const float* hlr = hl + (c & 1) * 960; float* hlw = hl + ((c + 1) & 1) * 960;
        asm volatile("s_waitcnt vmcnt(0)" ::: "memory");
        __syncthreads();
        if (w == 0) {
            float dt = lane < sq.Q ? rawDt[lane * 16 + hd] : 0.f; float v = dt * a;
#pragma unroll
            for (int o = 1; o < 64; o <<= 1) { float t = shfli(v, lane - o); if (lane >= o) v += t; }
            float last = shfli(v, 63);
            fl[lane] = v; fl[64 + lane] = dt; fl[128 + lane] = __expf(last - v) * dt; fl[192 + lane] = __expf(v);
        }
        __syncthreads();
        const float elast = __expf(fl[63]);
#pragma unroll
        for (int i = 0; i < 2; ++i) { int it = tid + 256 * i, t = it >> 3, c8 = (it & 7) * 8; float o[8], raw[8]; int ch = hd * 64 + c8; const bool tv = t < sq.Q;
            conv_lds(rawX, 64, t, c8, hlr, cwl, 320, c8, o, raw);
#pragma unroll
            for (int e = 0; e < 8; ++e) { float s_ = silu(o[e]); o[e] = tv ? s_ : 0.f; }
            if (t >= 61) {
#pragma unroll
                for (int e = 0; e < 8; ++e) hlw[(t - 61) * 320 + c8 + e] = raw[e]; }
            if (lastc && tv && t >= sq.Q - 3) {
#pragma unroll
                for (int e = 0; e < 8; ++e) { hist_out[(t - (sq.Q - 3)) * 2048 + ch + e] = raw[e]; if (hist_out2) hist_out2[(t - (sq.Q - 3)) * 2048 + ch + e] = raw[e]; } }
#pragma unroll
            for (int e = 0; e < 8; ++e) xT[(c8 + e) * 72 + t] = f2bf(o[e]); }
#pragma unroll
        for (int i = 0; i < 4; ++i) { int it = tid + 256 * i, t = it >> 4, c8 = (it & 15) * 8; float o[8], raw[8]; int ch = 1024 + g * 128 + c8; const bool tv = t < sq.Q;
            conv_lds(rawB, 128, t, c8, hlr, cwl, 320, 64 + c8, o, raw);
#pragma unroll
            for (int e = 0; e < 8; ++e) { float s_ = silu(o[e]); o[e] = tv ? s_ : 0.f; }
            if (t >= 61) {
#pragma unroll
                for (int e = 0; e < 8; ++e) hlw[(t - 61) * 320 + 64 + c8 + e] = raw[e]; }
            if (lastc && tv && (hd & 3) == 0 && t >= sq.Q - 3) {
#pragma unroll
                for (int e = 0; e < 8; ++e) { hist_out[(t - (sq.Q - 3)) * 2048 + ch + e] = raw[e]; if (hist_out2) hist_out2[(t - (sq.Q - 3)) * 2048 + ch + e] = raw[e]; } }
            us8 ov; float we = fl[128 + t];
#pragma unroll
            for (int e = 0; e < 8; ++e) { ov[e] = f2bf(o[e]); R2[(c8 + e) * 72 + t] = f2bf(o[e] * we); }
            *(us8*)(Bm + t * 136 + c8) = ov; }
        __syncthreads();
#pragma unroll
        for (int nf = 0; nf < 8; ++nf) hacc[nf] *= elast;
        lds_mma<8, 2>(hacc, xT, 72, 16 * w, R2, 72, 0, wv_);
        __syncthreads();
#pragma unroll
        for (int i = 0; i < 4; ++i) { int it = tid + 256 * i, t = it >> 4, c8 = (it & 15) * 8; float o[8], raw[8]; int ch = 1536 + g * 128 + c8; const bool tv = t < sq.Q;
            conv_lds(rawC, 128, t, c8, hlr, cwl, 320, 192 + c8, o, raw);
#pragma unroll
            for (int e = 0; e < 8; ++e) { float s_ = silu(o[e]); o[e] = tv ? s_ : 0.f; }
            if (t >= 61) {
#pragma unroll
                for (int e = 0; e < 8; ++e) hlw[(t - 61) * 320 + 192 + c8 + e] = raw[e]; }
            if (lastc && tv && (hd & 3) == 0 && t >= sq.Q - 3) {
#pragma unroll
                for (int e = 0; e < 8; ++e) { hist_out[(t - (sq.Q - 3)) * 2048 + ch + e] = raw[e]; if (hist_out2) hist_out2[(t - (sq.Q - 3)) * 2048 + ch + e] = raw[e]; } }
            us8 ov;
#pragma unroll
            for (int e = 0; e < 8; ++e) ov[e] = f2bf(o[e]);
            *(us8*)(R2 + t * 136 + c8) = ov; }
        us4 zr[4];
#pragma unroll
        for (int nf = 0; nf < 4; ++nf) zr[nf] = *(const us4*)(rawZ + (16 * nf + fr) * 64 + 16 * w + 4 * fq);
        __syncthreads();
        if (!lastc) { const size_t ro = (size_t)(rowc + 64) * NPROJ * 2;
            stage_raw<128>(gx + ro, (size_t)NPROJ * 2, (char*)rawX, tid); stage_raw<256>(gb + ro, (size_t)NPROJ * 2, (char*)rawB, tid); stage_raw<256>(gc + ro, (size_t)NPROJ * 2, (char*)rawC, tid);
            stage_raw<128>(gz + ro, (size_t)NPROJ * 2, (char*)rawZ, tid); stage_raw<64>((const char*)(dtb + (size_t)(rowc + 64) * 16), 64, (char*)rawDt, tid); }
        f32x4 cbv[4];
#pragma unroll
        for (int nf = 0; nf < 4; ++nf) cbv[nf] = (f32x4){0.f, 0.f, 0.f, 0.f};
        lds_mma<4, 4>(cbv, Bm, 136, 16 * w, R2, 136, 0, wv_);
        __syncthreads();
#pragma unroll
        for (int nf = 0; nf < 4; ++nf) { int i = 16 * nf + fr; float ai = fl[i]; us4 o;
#pragma unroll
            for (int r = 0; r < 4; ++r) { int j = 16 * w + 4 * fq + r; float v = (j <= i) ? cbv[nf][r] * __expf(ai - fl[j]) * fl[64 + j] : 0.f; o[r] = f2bf(v); }
            *(us4*)(Bm + i * 72 + 16 * w + 4 * fq) = o; }
        __syncthreads();
        f32x4 ya[4];
#pragma unroll
        for (int nf = 0; nf < 4; ++nf) ya[nf] = (f32x4){0.f, 0.f, 0.f, 0.f};
        lds_mma<4, 4>(ya, hb, 136, 16 * w, R2, 136, 0, wv_);
#pragma unroll
        for (int nf = 0; nf < 4; ++nf) ya[nf] *= fl[192 + 16 * nf + fr];
        lds_mma<4, 2>(ya, xT, 72, 16 * w, Bm, 72, 0, wv_);
#pragma unroll
        for (int nf = 0; nf < 4; ++nf) { int i = 16 * nf + fr, p0 = 16 * w + 4 * fq;
            us4 z = zr[nf];
            if (i < sq.Q) { us4 o;
#pragma unroll
                for (int r = 0; r < 4; ++r) o[r] = f2bf((ya[nf][r] + Dv * bf2f(xT[(p0 + r) * 72 + i])) * bf2f(z[r]));
                *(us4*)(ymb + (size_t)(rowc + i) * LDK + hd * 64 + p0) = o; } }
        __syncthreads();
#pragma unroll
        for (int nf = 0; nf < 8; ++nf)
#pragma unroll
            for (int r = 0; r < 4; ++r) hb[(16 * w + 4 * fq + r) * 136 + 16 * nf + fr] = f2bf(hacc[nf][r]);
    }
#pragma unroll
    for (int nf = 0; nf < 8; ++nf)
#pragma unroll
        for (int r = 0; r < 4; ++r) st_out[(16 * w + 4 * fq + r) * 128 + 16 * nf + fr] = hacc[nf][r];
    __syncthreads();
}

DEVI void hgrn_unit(const Params& p, int l, Seq sq, int h, char* lds, int wv_) {
    bf16_t* sb = (bf16_t*)lds;
    bf16_t* qt = (bf16_t*)(lds + 34816);
    bf16_t* kt = (bf16_t*)(lds + 52224);
    bf16_t* att = (bf16_t*)lds;
    bf16_t* kT = (bf16_t*)(lds + 9216);
    bf16_t* vT = (bf16_t*)(lds + 27648);
    float* T0 = (float*)(lds + 69632); float* T1 = T0 + 128; float* ssq = T0 + 256;
    const int tid = tidx(wv_), lane = tid & 63, w = tid >> 6, fr = lane & 15, fq = lane >> 4;
    const int k = tid & 127, half = tid >> 7;
    const bf16_t* proj = (const bf16_t*)(p.ws + WS_PROJ); bf16_t* yhg = (bf16_t*)(p.ws + WS_YHG);
    float lb = 0.f;
    if (l == 1) { float a0 = p.in[I_LBL][h * 128 + k], a1 = p.in[I_LBL][1024 + h * 128 + k]; lb = 1.f / (1.f + __expf(a0 - a1)); }
    const float* nw = p.in[I_HGNW] + l * 128;
    const float* st_in; float* st_out;
    if (sq.samp) { st_in = p.in[I_HG] + ((size_t)(l * 16 + sq.b) * 8 + h) * 16384; st_out = p.out + O_HG_S + ((size_t)(l * 16 + sq.b) * 8 + h) * 16384; }
    else { st_out = p.out + O_HG_P + ((size_t)(l * 16 + sq.b) * 8 + h) * 16384; st_in = sq.seg ? st_out : nullptr; }
    f32x4 hacc[2][8];
#pragma unroll
    for (int mf = 0; mf < 2; ++mf)
#pragma unroll
        for (int nf = 0; nf < 8; ++nf)
#pragma unroll
            for (int r = 0; r < 4; ++r) hacc[mf][nf][r] = st_in ? st_in[(32 * w + 16 * mf + 4 * fq + r) * 128 + 16 * nf + fr] : 0.f;
    f32x4 nwr[2];
#pragma unroll
    for (int mf = 0; mf < 2; ++mf) nwr[mf] = *(const f32x4*)(nw + 32 * w + 16 * mf + 4 * fq);
    bf16_t* rawF = (bf16_t*)(lds + 71680); bf16_t* rawQ = (bf16_t*)(lds + 88064); bf16_t* rawV = (bf16_t*)(lds + 104448); bf16_t* rawH = (bf16_t*)(lds + 120832);
    const char* gf = (const char*)(proj + PC_HF + h * 128); const char* gq = (const char*)(proj + PC_HQ + h * 128); const char* gv = (const char*)(proj + PC_HI + h * 128); const char* gh = (const char*)(proj + PC_HGATE + h * 128);
    asm volatile("s_waitcnt vmcnt(0)" ::: "memory");
    {   const size_t ro = (size_t)sq.row0 * NPROJ * 2;
        stage_raw<256>(gf + ro, (size_t)NPROJ * 2, (char*)rawF, tid); stage_raw<256>(gq + ro, (size_t)NPROJ * 2, (char*)rawQ, tid); stage_raw<256>(gv + ro, (size_t)NPROJ * 2, (char*)rawV, tid); }
    for (int c = 0; c < sq.nchunk; ++c) {
        const int tid = tidx(wv_), lane = tid & 63, w = tid >> 6, fr = lane & 15, fq = lane >> 4, k = tid & 127, half = tid >> 7;
        const int rowc = sq.row0 + c * 64; const bool lastc = (c == sq.nchunk - 1);
        asm volatile("s_waitcnt vmcnt(0)" ::: "memory");
        __syncthreads();
        stage_raw<256>(gh + (size_t)rowc * NPROJ * 2, (size_t)NPROJ * 2, (char*)rawH, tid);
        {
            unsigned fu[32], qu[32];
#pragma unroll
            for (int jj = 0; jj < 32; ++jj) { fu[jj] = rawF[(32 * half + jj) * 128 + k]; qu[jj] = rawQ[(32 * half + jj) * 128 + k]; }
            if (tid < 64) ssq[tid] = 0.f;
            float run = 0.f;
            if (half == 0) {
#pragma unroll
                for (int jj = 31; jj >= 0; --jj) { bool valid = jj < sq.Q; float f = __uint_as_float(fu[jj] << 16);
                    float sg = __builtin_amdgcn_rcpf(1.f + __expf(-f)); float lg0 = __logf(lb + (1.f - lb) * sg); float lg = valid ? lg0 : 0.f;
                    float kk0 = (1.f - lb) * (1.f - sg); float kk = valid ? kk0 : 0.f; float q0 = __uint_as_float(qu[jj] << 16); float q = valid ? q0 : 0.f;
                    qt[jj * 136 + k] = f2bf(q * cexp(-run)); kt[jj * 136 + k] = f2bf(kk * cexp(run)); run += lg; }
                T0[k] = run;
            } else {
#pragma unroll
                for (int jj = 0; jj < 32; ++jj) { bool valid = (32 + jj) < sq.Q; float f = __uint_as_float(fu[jj] << 16);
                    float sg = __builtin_amdgcn_rcpf(1.f + __expf(-f)); float lg0 = __logf(lb + (1.f - lb) * sg); float lg = valid ? lg0 : 0.f;
                    float kk0 = (1.f - lb) * (1.f - sg); float kk = valid ? kk0 : 0.f; float q0 = __uint_as_float(qu[jj] << 16); float q = valid ? q0 : 0.f;
                    run += lg; qt[(32 + jj) * 136 + k] = f2bf(q * cexp(run)); kt[(32 + jj) * 136 + k] = f2bf(kk * cexp(-run)); }
                T1[k] = run;
            }
        }
        __syncthreads();
#pragma unroll
        for (int mf = 0; mf < 2; ++mf) { int k0 = 32 * w + 16 * mf + 4 * fq; float e0 = __expf(T0[k0]), e1 = __expf(T0[k0 + 1]), e2 = __expf(T0[k0 + 2]), e3 = __expf(T0[k0 + 3]);
#pragma unroll
            for (int nf = 0; nf < 8; ++nf) { hacc[mf][nf][0] *= e0; hacc[mf][nf][1] *= e1; hacc[mf][nf][2] *= e2; hacc[mf][nf][3] *= e3;
                us4 o; o[0] = f2bf(hacc[mf][nf][0]); o[1] = f2bf(hacc[mf][nf][1]); o[2] = f2bf(hacc[mf][nf][2]); o[3] = f2bf(hacc[mf][nf][3]);
                *(us4*)(sb + (16 * nf + fr) * 136 + k0) = o; } }
        f32x4 at[4];
#pragma unroll
        for (int nf = 0; nf < 4; ++nf) at[nf] = (f32x4){0.f, 0.f, 0.f, 0.f};
        lds_mma<4, 4>(at, kt, 136, 16 * w, qt, 136, 0, wv_);
        __syncthreads();
        f32x4 oacc[2][4];
#pragma unroll
        for (int mf = 0; mf < 2; ++mf) {
#pragma unroll
            for (int nf = 0; nf < 4; ++nf) oacc[mf][nf] = (f32x4){0.f, 0.f, 0.f, 0.f};
            lds_mma<4, 4>(oacc[mf], sb, 136, 32 * w + 16 * mf, qt, 136, 0, wv_); }
        __syncthreads();
#pragma unroll
        for (int nf = 0; nf < 4; ++nf) { int i = 16 * nf + fr; us4 o;
#pragma unroll
            for (int r = 0; r < 4; ++r) { int j = 16 * w + 4 * fq + r; o[r] = f2bf(j <= i ? at[nf][r] : 0.f); }
            *(us4*)(att + i * 72 + 16 * w + 4 * fq) = o; }
        {   unsigned vu[32];
#pragma unroll
            for (int jj = 0; jj < 32; ++jj) vu[jj] = rawV[(32 * half + jj) * 128 + k];
#pragma unroll
            for (int q4 = 0; q4 < 4; ++q4) { us8 kv, vv;
#pragma unroll
                for (int e = 0; e < 8; ++e) { int jj = q4 * 8 + e; bool valid = (32 * half + jj) < sq.Q; kv[e] = kt[(32 * half + jj) * 136 + k]; vv[e] = valid ? (bf16_t)vu[jj] : (bf16_t)0; }
                *(us8*)(kT + k * 72 + 32 * half + q4 * 8) = kv; *(us8*)(vT + k * 72 + 32 * half + q4 * 8) = vv; } }
        __syncthreads();
        if (!lastc) { const size_t ro = (size_t)(rowc + 64) * NPROJ * 2;
            stage_raw<256>(gf + ro, (size_t)NPROJ * 2, (char*)rawF, tid); stage_raw<256>(gq + ro, (size_t)NPROJ * 2, (char*)rawQ, tid); stage_raw<256>(gv + ro, (size_t)NPROJ * 2, (char*)rawV, tid); }
#pragma unroll
        for (int mf = 0; mf < 2; ++mf) {
            lds_mma<4, 2>(oacc[mf], vT, 72, 32 * w + 16 * mf, att, 72, 0, wv_);
            lds_mma<8, 2>(hacc[mf], kT, 72, 32 * w + 16 * mf, vT, 72, 0, wv_);
            int k0 = 32 * w + 16 * mf + 4 * fq; float e0 = __expf(T1[k0]), e1 = __expf(T1[k0 + 1]), e2 = __expf(T1[k0 + 2]), e3 = __expf(T1[k0 + 3]);
#pragma unroll
            for (int nf = 0; nf < 8; ++nf) { hacc[mf][nf][0] *= e0; hacc[mf][nf][1] *= e1; hacc[mf][nf][2] *= e2; hacc[mf][nf][3] *= e3; } }
#pragma unroll
        for (int nf = 0; nf < 4; ++nf) { float s = 0.f;
#pragma unroll
            for (int mf = 0; mf < 2; ++mf)
#pragma unroll
                for (int r = 0; r < 4; ++r) s += oacc[mf][nf][r] * oacc[mf][nf][r];
            s += shflx(s, 16, lane); s += shflx(s, 32, lane);
            if (fq == 0) atomicAdd(&ssq[16 * nf + fr], s); }
        if (lastc) asm volatile("s_waitcnt vmcnt(0)" ::: "memory"); else asm volatile("s_waitcnt vmcnt(12)" ::: "memory");
        __syncthreads();
#pragma unroll
        for (int nf = 0; nf < 4; ++nf) { int i = 16 * nf + fr; float rs = rsqrtf(ssq[i] * (1.f / 128.f) + 1e-6f);
#pragma unroll
            for (int mf = 0; mf < 2; ++mf) { int v0 = 32 * w + 16 * mf + 4 * fq; us4 gt = *(const us4*)(rawH + i * 128 + v0); f32x4 wv = nwr[mf]; us4 o;
#pragma unroll
                for (int r = 0; r < 4; ++r) o[r] = f2bf(oacc[mf][nf][r] * rs * wv[r] * bf2f(gt[r]));
                if (i < sq.Q) *(us4*)(yhg + (size_t)(rowc + i) * LDK + h * 128 + v0) = o; } }
        __syncthreads();
    }
#pragma unroll
    for (int mf = 0; mf < 2; ++mf)
#pragma unroll
        for (int nf = 0; nf < 8; ++nf)
#pragma unroll
            for (int r = 0; r < 4; ++r) st_out[(32 * w + 16 * mf + 4 * fq + r) * 128 + 16 * nf + fr] = hacc[mf][nf][r];
}

DEVI void rg_unit(const Params& p, int l, Seq sq, int blk, char* lds, int wv_) {
    bf16_t* waT = (bf16_t*)lds; bf16_t* wiT = (bf16_t*)(lds + 9216); bf16_t* xr = (bf16_t*)(lds + 18432);
    float* av = (float*)(lds + 27648); float* uv = (float*)(lds + 44288); float* Pq = (float*)(lds + 60928); float* Hq = Pq + 256; float* carry = Hq + 256;
    const int tid = tidx(wv_), lane = tid & 63, w = tid >> 6, fr = lane & 15, fq = lane >> 4;
    const bf16_t* proj = (const bf16_t*)(p.ws + WS_PROJ); bf16_t* yrg = (bf16_t*)(p.ws + WS_YRG);
    const int cb0 = blk * 64;
    const float* cw = p.in[I_RCW] + (size_t)l * 4 * 1024; const float* cbias = p.in[I_RCB] + l * 1024;
    const float* st_in; float* st_out; const float* hist; float* hist_out;
    if (sq.samp) { st_in = p.in[I_RG] + (size_t)(l * 16 + sq.b) * 1024; st_out = p.out + O_RG_S + (size_t)(l * 16 + sq.b) * 1024;
        hist = p.in[I_RCV] + (size_t)(l * 16 + sq.b) * 3 * 1024; hist_out = p.out + O_RCV_S + (size_t)(l * 16 + sq.b) * 3 * 1024; }
    else { st_out = p.out + O_RG_P + (size_t)(l * 16 + sq.b) * 1024; st_in = sq.seg ? st_out : nullptr;
        hist_out = p.out + O_RCV_P + (size_t)(l * 16 + sq.b) * 3 * 1024; hist = sq.seg ? hist_out : nullptr; }
    float* cwl = (float*)(lds + 63232);
    float* hl = (float*)(lds + 64512);
    float* hl2 = (float*)(lds + 90112);
    for (int idx = tid; idx < 320; idx += 256) { int k = idx >> 6, cc = idx & 63; cwl[idx] = k < 4 ? cw[k * 1024 + cb0 + cc] : cbias[cb0 + cc]; if (idx < 192) hl[idx] = hist ? hist[k * 1024 + cb0 + cc] : 0.f; }
    {   const float* wa = p.in[I_RWA] + ((size_t)l * 16 + blk) * 4096; const float* wi = p.in[I_RWI] + ((size_t)l * 16 + blk) * 4096;
        float wa_[16], wi_[16];
#pragma unroll
        for (int u = 0; u < 16; ++u) { wa_[u] = wa[tid + 256 * u]; wi_[u] = wi[tid + 256 * u]; }
#pragma unroll
        for (int u = 0; u < 16; ++u) { int e = tid + 256 * u, i = e >> 6, j = e & 63; waT[j * 72 + i] = f2bf(wa_[u]); wiT[j * 72 + i] = f2bf(wi_[u]); }
        if (tid < 64) carry[tid] = st_in ? st_in[cb0 + tid] : 0.f; }
    float cba[4], cbi[4], csp[4];
#pragma unroll
    for (int nf = 0; nf < 4; ++nf) { int cc = cb0 + 16 * nf + fr; cba[nf] = p.in[I_RBA][l * 1024 + cc]; cbi[nf] = p.in[I_RBI][l * 1024 + cc]; csp[nf] = softplus(-p.in[I_RLAM][l * 1024 + cc]); }
    bf16_t* rawR = (bf16_t*)(lds + 65536); bf16_t* rawG = (bf16_t*)(lds + 73728);
    const char* gr = (const char*)(proj + PC_RX + cb0); const char* gg = (const char*)(proj + PC_RGATE + cb0);
    asm volatile("s_waitcnt vmcnt(0)" ::: "memory");
    stage_raw<128>(gr + (size_t)sq.row0 * NPROJ * 2, (size_t)NPROJ * 2, (char*)rawR, tid); stage_raw<128>(gg + (size_t)sq.row0 * NPROJ * 2, (size_t)NPROJ * 2, (char*)rawG, tid);
    for (int c = 0; c < sq.nchunk; ++c) {
        const int tid = tidx(wv_), lane = tid & 63, w = tid >> 6, fr = lane & 15, fq = lane >> 4, j = tid & 63, q = tid >> 6;
        const int rowc = sq.row0 + c * 64; const bool lastc = (c == sq.nchunk - 1);
        const float* hlr = (c & 1) ? hl2 : hl; float* hlw = (c & 1) ? hl : hl2;
        asm volatile("s_waitcnt vmcnt(0)" ::: "memory");
        __syncthreads();
#pragma unroll
        for (int i = 0; i < 2; ++i) { int it = tid + 256 * i, t = it >> 3, c8 = (it & 7) * 8; float o[8], raw[8]; int ch = cb0 + c8; const bool tv = t < sq.Q;
            conv_lds(rawR, 64, t, c8, hlr, cwl, 64, c8, o, raw);
            if (t >= 61) {
#pragma unroll
                for (int e = 0; e < 8; ++e) hlw[(t - 61) * 64 + c8 + e] = raw[e]; }
            if (lastc && tv && t >= sq.Q - 3) {
#pragma unroll
                for (int e = 0; e < 8; ++e) hist_out[(t - (sq.Q - 3)) * 1024 + ch + e] = raw[e]; }
            us8 ov;
#pragma unroll
            for (int e = 0; e < 8; ++e) { float ox = tv ? o[e] : 0.f; ov[e] = f2bf(ox); uv[t * 65 + c8 + e] = ox; }
            *(us8*)(xr + t * 72 + c8) = ov; }
        __syncthreads();
        if (!lastc) { const size_t ro = (size_t)(rowc + 64) * NPROJ * 2; stage_raw<128>(gr + ro, (size_t)NPROJ * 2, (char*)rawR, tid); stage_raw<128>(gg + ro, (size_t)NPROJ * 2, (char*)(rawG + ((c + 1) & 1) * 4096), tid); }
        f32x4 ra[4], ri[4];
#pragma unroll
        for (int nf = 0; nf < 4; ++nf) { ra[nf] = (f32x4){0.f, 0.f, 0.f, 0.f}; ri[nf] = (f32x4){0.f, 0.f, 0.f, 0.f}; }
        lds_mma<4, 2>(ra, xr, 72, 16 * w, waT, 72, 0, wv_);
        lds_mma<4, 2>(ri, xr, 72, 16 * w, wiT, 72, 0, wv_);
#pragma unroll
        for (int nf = 0; nf < 4; ++nf) { int jj = 16 * nf + fr; float ba = cba[nf], bi = cbi[nf], sp = csp[nf];
#pragma unroll
            for (int r = 0; r < 4; ++r) { int t = 16 * w + 4 * fq + r; float rr = sigm(ra[nf][r] + ba), ii = sigm(ri[nf][r] + bi); float la = -8.f * sp * rr; float aa = __expf(la);
                float u = __builtin_sqrtf(fmaxf(1.f - aa * aa, 0.f)) * ii * uv[t * 65 + jj];
                if (t >= sq.Q) { aa = 1.f; u = 0.f; }
                av[t * 65 + jj] = aa; uv[t * 65 + jj] = u; } }
        __syncthreads();
        { float P = 1.f, H = 0.f;
#pragma unroll
          for (int tt = 0; tt < 16; ++tt) { int t = 16 * q + tt; float aa = av[t * 65 + j], u = uv[t * 65 + j]; H = aa * H + u; P *= aa; }
          Pq[q * 64 + j] = P; Hq[q * 64 + j] = H; }
        __syncthreads();
        float hcur = carry[j];
        for (int qq = 0; qq < q; ++qq) hcur = Pq[qq * 64 + j] * hcur + Hq[qq * 64 + j];
        const bf16_t* rg_ = rawG + (c & 1) * 4096;
        bf16_t gts[16];
#pragma unroll
        for (int tt = 0; tt < 16; ++tt) gts[tt] = rg_[(16 * q + tt) * 64 + j];
#pragma unroll
        for (int tt = 0; tt < 16; ++tt) { int t = 16 * q + tt; float aa = av[t * 65 + j], u = uv[t * 65 + j]; hcur = aa * hcur + u;
            if (t < sq.Q) yrg[(size_t)(rowc + t) * LDK + cb0 + j] = f2bf(bf2f(gts[tt]) * hcur); }
        __syncthreads();
        if (q == 3) carry[j] = hcur;
        __syncthreads();
    }
    if (tid < 64) st_out[cb0 + tid] = carry[tid];
    __syncthreads();
}

DEVI void phase_mix(const Params& p, int l, int seg, char* lds, int wv_) {
    const int ngrp = seg == 0 ? 2 : 1; const int NU = ngrp * 640;
    for (int u = blockIdx.x; u < NU; u += gridDim.x) {
        int grp = u / 640, v = u % 640;
        if (v < 128) hgrn_unit(p, l, make_seq(seg, grp * 16 + (v >> 3)), v & 7, lds, wv_);
        else if (v < 384) { v -= 128; ssd_unit(p, l, make_seq(seg, grp * 16 + (v >> 4)), v & 15, lds, wv_); }
        else { v -= 384; rg_unit(p, l, make_seq(seg, grp * 16 + (v >> 4)), v & 15, lds, wv_); }
        __syncthreads();
    }
}

DEVI void gbar(const Params& p, unsigned& epoch_, int wv_) {
    const unsigned epoch = __builtin_amdgcn_readfirstlane(epoch_); epoch_ = epoch + 1u;
    unsigned* bw = (unsigned*)(p.ws + WS_END); asm volatile("" : "+s"(bw));
    asm volatile("s_waitcnt vmcnt(0)" ::: "memory");
    __syncthreads();
    if (tidx(wv_) == 0) {
        if ((wv_ >> 23) & 1) {
            const unsigned x = (wv_ >> 2) & 7, NB = (wv_ >> 14) & 511;
            const unsigned old = __hip_atomic_fetch_add(bw + 32 + x, 1u, __ATOMIC_RELAXED, __HIP_MEMORY_SCOPE_AGENT);
            if (old + 1u == (epoch + 1u) * NB) {
                __builtin_amdgcn_fence(__ATOMIC_RELEASE, "agent");
                asm volatile("s_waitcnt vmcnt(0)" ::: "memory");
                const unsigned og = __hip_atomic_fetch_add(bw + 56, 1u, __ATOMIC_RELAXED, __HIP_MEMORY_SCOPE_AGENT);
                if (og + 1u == (epoch + 1u) * 8u) __hip_atomic_fetch_add(bw + 57, 1u, __ATOMIC_RELAXED, __HIP_MEMORY_SCOPE_AGENT);
                else while (__hip_atomic_load(bw + 57, __ATOMIC_RELAXED, __HIP_MEMORY_SCOPE_AGENT) < epoch + 1u) __builtin_amdgcn_s_sleep(1);
                __builtin_amdgcn_fence(__ATOMIC_ACQUIRE, "agent");
                __hip_atomic_fetch_add(bw + 48 + x, 1u, __ATOMIC_RELAXED, __HIP_MEMORY_SCOPE_AGENT);
                asm volatile("s_waitcnt vmcnt(0)" ::: "memory");
            } else {
                while (__hip_atomic_load(bw + 48 + x, __ATOMIC_RELAXED, __HIP_MEMORY_SCOPE_AGENT) < epoch + 1u) __builtin_amdgcn_s_sleep(1);
                __builtin_amdgcn_fence(__ATOMIC_ACQUIRE, "agent");
                asm volatile("s_waitcnt vmcnt(0)" ::: "memory");
            }
        } else {
            __builtin_amdgcn_fence(__ATOMIC_RELEASE, "agent");
            asm volatile("s_waitcnt vmcnt(0)" ::: "memory");
            __hip_atomic_fetch_add(bw, 1u, __ATOMIC_RELAXED, __HIP_MEMORY_SCOPE_AGENT);
            const unsigned target = (epoch + 1u) * gridDim.x;
            while (__hip_atomic_load(bw, __ATOMIC_RELAXED, __HIP_MEMORY_SCOPE_AGENT) < target) __builtin_amdgcn_s_sleep(1);
            __builtin_amdgcn_fence(__ATOMIC_ACQUIRE, "agent");
            asm volatile("s_waitcnt vmcnt(0)" ::: "memory");
        }
    }
    __syncthreads();
}

__global__ void __launch_bounds__(256) fwd_mega(Params p) {
    extern __shared__ __attribute__((aligned(16))) char lds[];
    int wv_ = __builtin_amdgcn_readfirstlane((int)(__builtin_amdgcn_workitem_id_x() >> 6));
    cg::grid_group grid = cg::this_grid();
    unsigned* xcnt = (unsigned*)(p.ws + WS_END) + 16;
    const int xcc = (int)(__builtin_amdgcn_s_getreg((3 << 11) | 20) & 7u);
    int xrank;
    { int* sh = (int*)lds; if (__builtin_amdgcn_workitem_id_x() == 0) sh[0] = (int)__hip_atomic_fetch_add(xcnt + xcc, 1u, __ATOMIC_RELAXED, __HIP_MEMORY_SCOPE_AGENT); __syncthreads(); xrank = __builtin_amdgcn_readfirstlane(sh[0]); __syncthreads(); }
    unsigned epoch = 0;
    phase_prep(p, lds, wv_);
    grid.sync();
    {   unsigned c[8]; bool ok = true;
#pragma unroll
        for (int i = 0; i < 8; ++i) { c[i] = __hip_atomic_load(xcnt + i, __ATOMIC_RELAXED, __HIP_MEMORY_SCOPE_AGENT); ok = ok && c[i] > 0u && c[i] < 512u; }
        unsigned mine = 0, tot_ = 0;
#pragma unroll
        for (int i = 0; i < 8; ++i) { mine = (i == xcc) ? c[i] : mine; tot_ += c[i]; }
        ok = ok && tot_ == gridDim.x;
        int X = xcc, R = xrank, NB = (int)mine;
        if (!ok) { X = blockIdx.x & 7; R = blockIdx.x >> 3; NB = gridDim.x >> 3; }
        wv_ = __builtin_amdgcn_readfirstlane((wv_ & 3) | (X << 2) | (R << 5) | (NB << 14) | (ok ? (1 << 23) : 0)); }
#pragma unroll 1
    for (int seg = 0; seg < NSEG; ++seg) {
        const int nrows = seg == 0 ? ROWS : ROWS_P, MT = nrows / 256;
#pragma unroll 1
        for (int l = 0; l < 2; ++l) {
            const bf16_t* wl = (const bf16_t*)p.ws + (size_t)l * E_LAYER;
            phase_norm(p, seg, nrows, p.in[I_NMIX] + l * 1024, l == 0, l, lds, wv_);
            gbar(p, epoch, wv_);
            for (int r = 0; r < p.rep[0]; ++r) { phase_proj(p, l, MT, lds, wv_); gbar(p, epoch, wv_); }
            for (int r = 0; r < (seg == 0 ? p.rep[3] : 1); ++r) { phase_mix(p, l, seg, lds, wv_); gbar(p, epoch, wv_); }
            phase_mbnorm(p, l, nrows, wv_);
            gbar(p, epoch, wv_);
            for (int r = 0; r < p.rep[1]; ++r) { phase_merge(p, l, MT, lds, wv_); gbar(p, epoch, wv_); }
            phase_resid(p, seg, MT, (const bf16_t*)(p.ws + WS_MRG), 1024, LDK, wl + E_WIN + E_WBR, l == 0, lds, wv_);
            gbar(p, epoch, wv_);
            phase_norm(p, seg, nrows, p.in[I_NFFN] + l * 1024, false, -1, lds, wv_);
            gbar(p, epoch, wv_);
            for (int r = 0; r < p.rep[2]; ++r) { phase_ffn_in(p, l, MT, lds, wv_); gbar(p, epoch, wv_); }
            phase_resid(p, seg, MT, (const bf16_t*)(p.ws + WS_PROJ), FFH, LDF, wl + E_WIN + E_WBR + E_WOUT + E_WFI, false, lds, wv_);
            gbar(p, epoch, wv_);
        }
        phase_final_norm(p, seg, nrows, wv_);
    }
}

extern "C" void kernel_launch(void* const* d_in, const int* in_sizes, int n_in, void* d_out, int out_size, void* d_ws, size_t ws_size, hipStream_t stream) {
    static int grid_blocks = 0;
    if (!grid_blocks) {
        int dev = 0, cus = 0, per_cu = 0;
        (void)hipGetDevice(&dev);
        (void)hipDeviceGetAttribute(&cus, hipDeviceAttributeMultiprocessorCount, dev);
        (void)hipFuncSetAttribute((const void*)fwd_mega, hipFuncAttributeMaxDynamicSharedMemorySize, LDS_BYTES);
        (void)hipOccupancyMaxActiveBlocksPerMultiprocessor(&per_cu, (const void*)fwd_mega, 256, LDS_BYTES);
        if (per_cu < 1) fprintf(stderr, "occupancy query says %d blocks per CU\n", per_cu);
        grid_blocks = cus;
        if (ws_size < WS_TOTAL) fprintf(stderr, "workspace too small: %zu < %zu\n", ws_size, (size_t)WS_END + 256);
    }
    (void)hipMemsetAsync((char*)d_ws + WS_END, 0, 256, stream);
    Params p{};
    for (int i = 0; i < 30; ++i) p.in[i] = (const float*)d_in[i];
    p.out = (float*)d_out; p.ws = (unsigned char*)d_ws; p.rep[0] = REP0; p.rep[1] = REP1; p.rep[2] = REP2; p.rep[3] = REP3;
    void* args[] = {&p};
    hipError_t e = hipLaunchCooperativeKernel((const void*)fwd_mega, dim3(grid_blocks), dim3(256), args, LDS_BYTES, stream);
    if (e != hipSuccess) fprintf(stderr, "cooperative launch failed: %s (grid %d)\n", hipGetErrorString(e), grid_blocks);
}
```

```cpp
#include <hip/hip_runtime.h>
#include <hip/hip_cooperative_groups.h>
#include <cstdio>
namespace cg = cooperative_groups;

typedef unsigned short bf16_t;
typedef short bf16x8 __attribute__((ext_vector_type(8)));
typedef float f32x4 __attribute__((ext_vector_type(4)));
typedef unsigned short us4 __attribute__((ext_vector_type(4)));
typedef unsigned short us8 __attribute__((ext_vector_type(8)));
#define DEVI __device__ __forceinline__

constexpr int LDK = 1088, LDF = 2880;
constexpr int D = 1024, NPROJ = 12288, SEGT = 512, NSEG = 4, ROWS_P = 8192, ROWS = 8704, FFH = 2816;
constexpr int PC_Z = 0, PC_XBC = 1024, PC_HQ = 3072, PC_HF = 4096, PC_HI = 5120, PC_HGATE = 6144, PC_RGATE = 7168, PC_RX = 8192, PC_MG = 9216, PC_DT = 12288;
constexpr size_t E_WIN = (size_t)NPROJ * LDK, E_WBR = 3u * 1024 * LDK, E_WOUT = 1024u * LDK, E_WFI = 5632u * LDK, E_WFO = 1024u * LDF;
constexpr size_t E_LAYER = E_WIN + E_WBR + E_WOUT + E_WFI + E_WFO;
constexpr size_t WS_PROJ = 2 * E_LAYER * 2;
constexpr size_t WS_DT = WS_PROJ + (size_t)ROWS * NPROJ * 2;
constexpr size_t WS_XB = WS_DT + (size_t)ROWS * 16 * 4;
constexpr size_t WS_YMB = WS_XB + (size_t)ROWS * LDK * 2;
constexpr size_t WS_YHG = WS_YMB + (size_t)ROWS * LDK * 2;
constexpr size_t WS_YRG = WS_YHG + (size_t)ROWS * LDK * 2;
constexpr size_t WS_MRG = WS_YRG + (size_t)ROWS * LDK * 2;
constexpr size_t WS_END = WS_MRG + (size_t)ROWS * LDK * 2;
constexpr size_t WS_HB = WS_END + 256;
constexpr size_t WS_DTW = WS_HB + 2u * 2 * 16 * 3 * 2048 * 4;
constexpr size_t WS_TOTAL = WS_DTW + 2u * 16 * 1024 * 4;
constexpr size_t O_YP = 0, O_YS = 33554432, O_SSM_P = 34078720, O_SCV_P = 38273024, O_HG_P = 38469632, O_RG_P = 42663936, O_RCV_P = 42696704,
                 O_SSM_S = 42795008, O_SCV_S = 46989312, O_HG_S = 47185920, O_RG_S = 51380224, O_RCV_S = 51412992;
constexpr int REP0 = 1, REP1 = 1, REP2 = 1, REP3 = 1;
constexpr int LDS_BYTES = 144 * 1024;

enum { I_XP = 0, I_XS, I_SSM, I_SCV, I_HG, I_RG, I_RCV, I_NMIX, I_WIN, I_MCW, I_MCB, I_DTB, I_ALOG, I_MBD, I_MBNW, I_LBL, I_HGNW, I_RCW, I_RCB, I_RWA, I_RBA, I_RWI, I_RBI, I_RLAM, I_WBR, I_WOUT, I_NFFN, I_WFI, I_WFO, I_NFIN };

struct Params { const float* in[30]; float* out; unsigned char* ws; int rep[4]; };

DEVI int tidx(int wv_) { int t = ((wv_ & 3) << 6) | (int)__builtin_amdgcn_mbcnt_hi(~0u, __builtin_amdgcn_mbcnt_lo(~0u, 0u)); asm volatile("" : "+v"(t)); return t; }
DEVI float shfli(float v, int srcl) { return __int_as_float(__builtin_amdgcn_ds_bpermute(srcl << 2, __float_as_int(v))); }
DEVI float shflx(float v, int m, int lane) { return shfli(v, lane ^ m); }
DEVI bf16_t f2bf(float f) { unsigned u = __float_as_uint(f); u += 0x7fffu + ((u >> 16) & 1u); return (bf16_t)(u >> 16); }
DEVI float bf2f(bf16_t h) { return __uint_as_float(((unsigned)h) << 16); }
DEVI float sigm(float x) { return 1.f / (1.f + __expf(-x)); }
DEVI float silu(float x) { return x / (1.f + __expf(-x)); }
DEVI float softplus(float x) { return x > 20.f ? x : __logf(1.f + __expf(x)); }
DEVI float gelu_t(float x) { float u = 0.7978845608f * (x + 0.044715f * x * x * x); return x * sigm(2.f * u); }
DEVI float cexp(float x) { return __expf(fminf(x, 80.f)); }

DEVI const float* xrow_in(const Params& p, int seg, int r) {
    if (r < ROWS_P) { int b = r >> 9, tt = r & 511; return p.in[I_XP] + ((size_t)(b * 2048 + seg * SEGT + tt)) * D; }
    return p.in[I_XS] + (size_t)(r - ROWS_P) * D;
}
DEVI float* xrow_out(const Params& p, int seg, int r) {
    if (r < ROWS_P) { int b = r >> 9, tt = r & 511; return p.out + O_YP + ((size_t)(b * 2048 + seg * SEGT + tt)) * D; }
    return p.out + O_YS + (size_t)(r - ROWS_P) * D;
}

DEVI int perm32(int rho) { int n = rho >> 4, i = rho & 15; return 8 * (i >> 2) + 4 * n + (i & 3); }
DEVI int map_win(int n) { n = (n & ~31) + perm32(n & 31); return n < 3072 ? n : n + 16; }
DEVI int map_wfi(int n) { int T = n >> 7, nf = (n >> 4) & 7, i = n & 15, G = nf >> 2, h = (nf >> 1) & 1, s = nf & 1; return s * FFH + 64 * T + 32 * G + 8 * (i >> 2) + 4 * h + (i & 3); }

DEVI void transpose_tile(const float* src, int ldsrc, bf16_t* dst, int K, int k0, int n0, int mode, float* tile  , int wv_) {
    const int tid = tidx(wv_), c = tid & 63, rq = tid >> 6;
    int n = n0 + c, sn = mode == 1 ? map_win(n) : (mode == 2 ? map_wfi(n) : (mode == 3 ? (n & ~31) + perm32(n & 31) : n));
#pragma unroll
    for (int rr = 0; rr < 16; ++rr) { int kl = rr * 4 + rq; tile[kl * 65 + c] = sn >= 0 ? src[(size_t)(k0 + kl) * ldsrc + sn] : 0.f; }
    __syncthreads();
#pragma unroll
    for (int rr = 0; rr < 16; ++rr) { int nl = rr * 4 + rq; dst[(size_t)(n0 + nl) * K + k0 + c] = f2bf(tile[c * 65 + nl]); }
    __syncthreads();
}

DEVI void phase_prep(const Params& p, char* lds, int wv_) {
    float* tile = (float*)lds;
    bf16_t* wsb = (bf16_t*)p.ws;
    constexpr int T_WIN = 16 * 192, T_WBR = 3 * 256, T_WOUT = 256, T_WFI = 16 * 88, T_WFO = 44 * 16, T_L = T_WIN + T_WBR + T_WOUT + T_WFI + T_WFO;
    {   float* dtw = (float*)(p.ws + WS_DTW);
        for (int e = blockIdx.x * 256 + tidx(wv_); e < 32768; e += gridDim.x * 256) { int l = e >> 14, j = (e >> 10) & 15, k = e & 1023; dtw[e] = p.in[I_WIN][(size_t)l * 1024 * 12304 + (size_t)k * 12304 + 3072 + j]; } }
    for (int t = blockIdx.x; t < 2 * T_L; t += gridDim.x) {
        int l = t / T_L, j = t % T_L;
        bf16_t* wl = wsb + (size_t)l * E_LAYER;
        if (j < T_WIN) { int kt = j & 15, nt = j >> 4; transpose_tile(p.in[I_WIN] + (size_t)l * 1024 * 12304, 12304, wl, LDK, kt * 64, nt * 64, 1, tile, wv_); continue; }
        j -= T_WIN;
        if (j < T_WBR) { int k = j >> 8, jj = j & 255, kt = jj & 15, nt = jj >> 4;
            transpose_tile(p.in[I_WBR] + ((size_t)l * 3 + k) * 1024 * 1024, 1024, wl + E_WIN + (size_t)k * 1024 * LDK, LDK, kt * 64, nt * 64, 3, tile, wv_); continue; }
        j -= T_WBR;
        if (j < T_WOUT) { int kt = j & 15, nt = j >> 4; transpose_tile(p.in[I_WOUT] + (size_t)l * 1024 * 1024, 1024, wl + E_WIN + E_WBR, LDK, kt * 64, nt * 64, 0, tile, wv_); continue; }
        j -= T_WOUT;
        if (j < T_WFI) { int kt = j & 15, nt = j >> 4; transpose_tile(p.in[I_WFI] + (size_t)l * 1024 * 5632, 5632, wl + E_WIN + E_WBR + E_WOUT, LDK, kt * 64, nt * 64, 2, tile, wv_); continue; }
        j -= T_WFI;
        { int kt = j % 44, nt = j / 44; transpose_tile(p.in[I_WFO] + (size_t)l * 2816 * 1024, 1024, wl + E_WIN + E_WBR + E_WOUT + E_WFI, LDF, kt * 64, nt * 64, 0, tile, wv_); }
    }
}

DEVI void phase_norm(const Params& p, int seg, int nrows, const float* w, bool from_input, int ldt  , char* lds, int wv_) {
    bf16_t* xb = (bf16_t*)(p.ws + WS_XB); float* dtb = (float*)(p.ws + WS_DT);
    const int lane = tidx(wv_) & 63, wv = tidx(wv_) >> 6;
    float* dw = (float*)lds;
    if (ldt >= 0) { const float* dtw = (const float*)(p.ws + WS_DTW) + ldt * 16384; f32x4 t_[16];
#pragma unroll
        for (int u = 0; u < 16; ++u) t_[u] = *(const f32x4*)(dtw + (tidx(wv_) + 256 * u) * 4);
#pragma unroll
        for (int u = 0; u < 16; ++u) *(f32x4*)(dw + (tidx(wv_) + 256 * u) * 4) = t_[u];
        __syncthreads(); }
    for (int r = blockIdx.x * 4 + wv; r < nrows; r += gridDim.x * 4) {
        const float* x = from_input ? xrow_in(p, seg, r) : xrow_out(p, seg, r);
        f32x4 v[4]; float ss = 0.f;
#pragma unroll
        for (int i = 0; i < 4; ++i) { v[i] = *(const f32x4*)(x + i * 256 + lane * 4); ss += v[i][0] * v[i][0] + v[i][1] * v[i][1] + v[i][2] * v[i][2] + v[i][3] * v[i][3]; }
#pragma unroll
        for (int o = 32; o >= 1; o >>= 1) ss += shflx(ss, o, lane);
        float rs = rsqrtf(ss * (1.f / 1024.f) + 1e-6f);
#pragma unroll
        for (int i = 0; i < 4; ++i) { f32x4 wv4 = *(const f32x4*)(w + i * 256 + lane * 4); us4 o;
            v[i][0] *= rs * wv4[0]; v[i][1] *= rs * wv4[1]; v[i][2] *= rs * wv4[2]; v[i][3] *= rs * wv4[3];
            o[0] = f2bf(v[i][0]); o[1] = f2bf(v[i][1]); o[2] = f2bf(v[i][2]); o[3] = f2bf(v[i][3]);
            *(us4*)(xb + (size_t)r * LDK + i * 256 + lane * 4) = o; }
        if (ldt >= 0) {
            float d[16];
#pragma unroll
            for (int j = 0; j < 16; ++j) { float s = 0.f;
#pragma unroll
                for (int i = 0; i < 4; ++i) { f32x4 ww = *(const f32x4*)(dw + j * 1024 + i * 256 + lane * 4); s += v[i][0] * ww[0] + v[i][1] * ww[1] + v[i][2] * ww[2] + v[i][3] * ww[3]; }
                d[j] = s; }
            { const bool hi = lane & 32;
#pragma unroll
              for (int i = 0; i < 8; ++i) { float send = hi ? d[i] : d[i + 8], keep = hi ? d[i + 8] : d[i]; d[i] = keep + shfli(send, lane ^ 32); } }
            { const bool hi = lane & 16;
#pragma unroll
              for (int i = 0; i < 4; ++i) { float send = hi ? d[i] : d[i + 4], keep = hi ? d[i + 4] : d[i]; d[i] = keep + shfli(send, lane ^ 16); } }
            { const bool hi = lane & 8;
#pragma unroll
              for (int i = 0; i < 2; ++i) { float send = hi ? d[i] : d[i + 2], keep = hi ? d[i + 2] : d[i]; d[i] = keep + shfli(send, lane ^ 8); } }
            { const bool hi = lane & 4; float send = hi ? d[0] : d[1], keep = hi ? d[1] : d[0]; d[0] = keep + shfli(send, lane ^ 4); }
            d[0] += shfli(d[0], lane ^ 2); d[0] += shfli(d[0], lane ^ 1);
            if ((lane & 3) == 0) { int j = lane >> 2; dtb[(size_t)r * 16 + j] = softplus(d[0] + p.in[I_DTB][ldt * 16 + j]); }
        }
    }
    if (ldt >= 0) __syncthreads();
}
DEVI void phase_final_norm(const Params& p, int seg, int nrows, int wv_) {
    const float* w = p.in[I_NFIN];
    const int lane = tidx(wv_) & 63, wv = tidx(wv_) >> 6;
    for (int r = blockIdx.x * 4 + wv; r < nrows; r += gridDim.x * 4) {
        float* x = xrow_out(p, seg, r);
        f32x4 v[4]; float ss = 0.f;
#pragma unroll
        for (int i = 0; i < 4; ++i) { v[i] = *(const f32x4*)(x + i * 256 + lane * 4); ss += v[i][0] * v[i][0] + v[i][1] * v[i][1] + v[i][2] * v[i][2] + v[i][3] * v[i][3]; }
#pragma unroll
        for (int o = 32; o >= 1; o >>= 1) ss += shflx(ss, o, lane);
        float rs = rsqrtf(ss * (1.f / 1024.f) + 1e-6f);
#pragma unroll
        for (int i = 0; i < 4; ++i) { f32x4 wv4 = *(const f32x4*)(w + i * 256 + lane * 4); f32x4 o;
            o[0] = v[i][0] * rs * wv4[0]; o[1] = v[i][1] * rs * wv4[1]; o[2] = v[i][2] * rs * wv4[2]; o[3] = v[i][3] * rs * wv4[3];
            *(f32x4*)(x + i * 256 + lane * 4) = o; }
    }
}
DEVI void phase_mbnorm(const Params& p, int l, int nrows, int wv_) {
    bf16_t* y = (bf16_t*)(p.ws + WS_YMB); const float* w = p.in[I_MBNW] + l * 1024;
    const int lane = tidx(wv_) & 63, wv = tidx(wv_) >> 6;
    for (int it = blockIdx.x * 4 + wv; it < nrows * 4; it += gridDim.x * 4) {
        int r = it >> 2, g = it & 3; bf16_t* yp = y + (size_t)r * LDK + g * 256 + lane * 4;
        us4 v = *(const us4*)yp; float f0 = bf2f(v[0]), f1 = bf2f(v[1]), f2 = bf2f(v[2]), f3 = bf2f(v[3]);
        float ss = f0 * f0 + f1 * f1 + f2 * f2 + f3 * f3;
#pragma unroll
        for (int o = 32; o >= 1; o >>= 1) ss += shflx(ss, o, lane);
        float rs = rsqrtf(ss * (1.f / 256.f) + 1e-6f); f32x4 wv4 = *(const f32x4*)(w + g * 256 + lane * 4);
        us4 o; o[0] = f2bf(f0 * rs * wv4[0]); o[1] = f2bf(f1 * rs * wv4[1]); o[2] = f2bf(f2 * rs * wv4[2]); o[3] = f2bf(f3 * rs * wv4[3]);
        *(us4*)yp = o;
    }
}

#define WAIT_V(n) asm volatile("s_waitcnt vmcnt(" #n ")" ::: "memory")
#define RAW_BAR() do { asm volatile("" ::: "memory"); __builtin_amdgcn_s_barrier(); asm volatile("" ::: "memory"); } while (0)
template <int NF>
DEVI void stage_tile(const bf16_t* A, const bf16_t* Bt, int K, int t, char* st, int tid, size_t soff) {
    const size_t o = soff + (size_t)t * 32;
#pragma unroll
    for (int i = 0; i < 4; ++i) __builtin_amdgcn_global_load_lds((const unsigned*)(A + o + (size_t)i * 64 * K), (unsigned*)(st + tid * 16 + i * 4096), 16, 0, 0);
#pragma unroll
    for (int i = 0; i < NF / 2; ++i) __builtin_amdgcn_global_load_lds((const unsigned*)(Bt + o + (size_t)i * 64 * K), (unsigned*)(st + 16384 + tid * 16 + i * 4096), 16, 0, 0);
}
template <int NF>
DEVI void gemm_kloop(f32x4 (&acc)[8][NF], const bf16_t* A, const bf16_t* Bt, int K, int ld, char* lds, int wv_) {
    constexpr int STAGE = 16384 + NF * 2048;
    const int tid = tidx(wv_), lane = tid & 63, wid = tid >> 6, wr = wid >> 1, wc = wid & 1, fr = lane & 15, fq = lane >> 4;
    const int fo = fr * 64 + ((fq ^ (fr >> 2)) & 3) * 16;
    const int aoff = wr * 8192 + fo, boff = 16384 + wc * NF * 1024 + fo;
    const size_t soff = (size_t)(tid >> 2) * ld + (((tid & 3) ^ ((tid >> 4) & 3)) * 8);
    const int nt = K >> 5;
    WAIT_V(0); RAW_BAR();
    stage_tile<NF>(A, Bt, ld, 0, lds, tid, soff);
    stage_tile<NF>(A, Bt, ld, 1, lds + STAGE, tid, soff);
    stage_tile<NF>(A, Bt, ld, 2, lds + 2 * STAGE, tid, soff);
    for (int t = 0; t < nt; ++t) {
        if (t + 2 < nt) { if (NF == 8) WAIT_V(16); else WAIT_V(12); }
        else if (t + 1 < nt) { if (NF == 8) WAIT_V(8); else WAIT_V(6); }
        else WAIT_V(0);
        RAW_BAR();
        if (t + 3 < nt) stage_tile<NF>(A, Bt, ld, t + 3, lds + ((t + 3) & 3) * STAGE, tid, soff);
        const char* st = lds + (t & 3) * STAGE;
        bf16x8 af[8], bfr[NF];
        af[0] = *(const bf16x8*)(st + aoff);
#pragma unroll
        for (int n = 0; n < NF; ++n) bfr[n] = *(const bf16x8*)(st + boff + n * 1024);
        af[1] = *(const bf16x8*)(st + aoff + 1024);
#pragma unroll
        for (int g = 0; g < 8; ++g) {
            __builtin_amdgcn_sched_barrier(0);
            if (g < 6) af[g + 2] = *(const bf16x8*)(st + aoff + (g + 2) * 1024);
#pragma unroll
            for (int n = 0; n < NF; ++n) acc[g][n] = __builtin_amdgcn_mfma_f32_16x16x32_bf16(bfr[n], af[g], acc[g][n], 0, 0, 0);
        }
        __builtin_amdgcn_sched_barrier(0);
    }
}
DEVI bool next_tile(int it, int MT, int NT, int& mt, int& nt, int wv_) {
    const int x = (wv_ >> 2) & 7, bl = (wv_ >> 5) & 511, G8 = (wv_ >> 14) & 511;
    int nI = (MT - x + 7) >> 3; long j = (long)it * G8 + bl;
    if (j >= (long)nI * NT) return false;
    int i = (int)(j % nI); nt = (int)(j / nI); mt = x + 8 * i; return true;
}
#define ZERO_ACC(a, NF_) _Pragma("unroll") for (int m_ = 0; m_ < 8; ++m_) _Pragma("unroll") for (int n_ = 0; n_ < NF_; ++n_) a[m_][n_] = (f32x4){0.f, 0.f, 0.f, 0.f}
#define EPI_IDS const int lane = tidx(wv_) & 63, wid = tidx(wv_) >> 6, wr = wid >> 1, wc = wid & 1, fr = lane & 15, fq = lane >> 4

template <int ACT>
DEVI void proj_store(const f32x4 (&acc)[8][8], bf16_t* pbase, float c1, float c3, bool issig) {
#pragma unroll
    for (int m = 0; m < 8; ++m)
#pragma unroll
        for (int q = 0; q < 4; ++q) { __builtin_amdgcn_sched_barrier(0); us8 o;
#pragma unroll
            for (int s = 0; s < 2; ++s)
#pragma unroll
                for (int j = 0; j < 4; ++j) { float x = acc[m][2 * q + s][j];
                    if (ACT) { float u = x * (c1 + c3 * x * x); float sg = __builtin_amdgcn_rcpf(1.f + __expf(-u)); x = sg * (issig ? 1.f : x); }
                    o[4 * s + j] = f2bf(x); }
            *(us8*)(pbase + (size_t)m * 16 * NPROJ + q * 32) = o; }
}
DEVI void phase_proj(const Params& p, int l, int MT, char* lds, int wv_) {
    const bf16_t* xb = (const bf16_t*)(p.ws + WS_XB); const bf16_t* wt = (const bf16_t*)p.ws + (size_t)l * E_LAYER;
    bf16_t* proj = (bf16_t*)(p.ws + WS_PROJ);
    int mt, nt;
    for (int it = 0; next_tile(it, MT, 48, mt, nt, wv_); ++it) {
        f32x4 acc[8][8]; ZERO_ACC(acc, 8);
        gemm_kloop<8>(acc, xb + (size_t)mt * 256 * LDK, wt + (size_t)nt * 256 * LDK, 1024, LDK, lds, wv_);
        EPI_IDS;
        const int sg = nt >> 2;
        const int ty = (sg == 0 || sg == 3 || sg == 6) ? 1 : (sg == 7 ? 2 : (sg >= 9 ? 3 : 0));
        bf16_t* pbase = proj + (size_t)(mt * 256 + wr * 128 + fr) * NPROJ + nt * 256 + wc * 128 + fq * 8;
        if (ty == 0) proj_store<0>(acc, pbase, 0.f, 0.f, false); else proj_store<1>(acc, pbase, ty == 2 ? 1.5957691216f : 1.f, ty == 2 ? 0.0713548163f : 0.f, ty == 3);
    }
}
DEVI void phase_merge(const Params& p, int l, int MT, char* lds, int wv_) {
    const bf16_t* wt = (const bf16_t*)p.ws + (size_t)l * E_LAYER + E_WIN; const bf16_t* proj = (const bf16_t*)(p.ws + WS_PROJ);
    bf16_t* mrg = (bf16_t*)(p.ws + WS_MRG);
    int mt, nt;
    for (int it = 0; next_tile(it, MT, 8, mt, nt, wv_); ++it) {
        f32x4 tot[8][4]; ZERO_ACC(tot, 4);
#pragma unroll 1
        for (int k = 0; k < 3; ++k) {
            const bf16_t* y = (const bf16_t*)(p.ws + WS_YMB + (size_t)k * ROWS * LDK * 2);
            f32x4 acc[8][4]; ZERO_ACC(acc, 4);
            gemm_kloop<4>(acc, y + (size_t)mt * 256 * LDK, wt + (size_t)k * 1024 * LDK + (size_t)nt * 128 * LDK, 1024, LDK, lds, wv_);
            EPI_IDS;
#pragma unroll
            for (int m = 0; m < 8; ++m) { int row = mt * 256 + wr * 128 + m * 16 + fr; asm volatile("" ::: "memory");
#pragma unroll
                for (int q = 0; q < 2; ++q) { int col = nt * 128 + wc * 64 + 32 * q + fq * 8; us8 g = *(const us8*)(proj + (size_t)row * NPROJ + PC_MG + k * 1024 + col);
#pragma unroll
                    for (int s = 0; s < 2; ++s)
#pragma unroll
                        for (int j = 0; j < 4; ++j) tot[m][2 * q + s][j] += acc[m][2 * q + s][j] * bf2f(g[4 * s + j]); } }
        }
        EPI_IDS;
#pragma unroll
        for (int m = 0; m < 8; ++m) { int row = mt * 256 + wr * 128 + m * 16 + fr;
#pragma unroll
            for (int q = 0; q < 2; ++q) { int col = nt * 128 + wc * 64 + 32 * q + fq * 8; us8 o;
#pragma unroll
                for (int s = 0; s < 2; ++s)
#pragma unroll
                    for (int j = 0; j < 4; ++j) o[4 * s + j] = f2bf(tot[m][2 * q + s][j]);
                *(us8*)(mrg + (size_t)row * LDK + col) = o; } }
    }
}
DEVI void phase_resid(const Params& p, int seg, int MT, const bf16_t* A, int K, int ld, const bf16_t* Bt, bool from_input, char* lds, int wv_) {
    int mt, nt;
    for (int it = 0; next_tile(it, MT, 8, mt, nt, wv_); ++it) {
        f32x4 acc[8][4]; ZERO_ACC(acc, 4);
        gemm_kloop<4>(acc, A + (size_t)mt * 256 * ld, Bt + (size_t)nt * 128 * ld, K, ld, lds, wv_);
        EPI_IDS;
#pragma unroll
        for (int m = 0; m < 8; ++m) { int row = mt * 256 + wr * 128 + m * 16 + fr;
            const float* xi = from_input ? xrow_in(p, seg, row) : xrow_out(p, seg, row); float* xo = xrow_out(p, seg, row);
#pragma unroll
            for (int n = 0; n < 4; ++n) { int col = nt * 128 + wc * 64 + n * 16 + fq * 4; f32x4 v = *(const f32x4*)(xi + col); *(f32x4*)(xo + col) = v + acc[m][n]; } }
    }
}
DEVI void phase_ffn_in(const Params& p, int l, int MT, char* lds, int wv_) {
    const bf16_t* xb = (const bf16_t*)(p.ws + WS_XB); const bf16_t* wt = (const bf16_t*)p.ws + (size_t)l * E_LAYER + E_WIN + E_WBR + E_WOUT;
    bf16_t* act = (bf16_t*)(p.ws + WS_PROJ);
    int mt, nt;
    for (int it = 0; next_tile(it, MT, 22, mt, nt, wv_); ++it) {
        f32x4 acc[8][8]; ZERO_ACC(acc, 8);
        gemm_kloop<8>(acc, xb + (size_t)mt * 256 * LDK, wt + (size_t)nt * 256 * LDK, 1024, LDK, lds, wv_);
        EPI_IDS;
#pragma unroll
        for (int m = 0; m < 8; ++m) { int row = mt * 256 + wr * 128 + m * 16 + fr;
#pragma unroll
            for (int G = 0; G < 2; ++G) { int col = (nt * 2 + wc) * 64 + 32 * G + fq * 8; us8 o;
#pragma unroll
                for (int h = 0; h < 2; ++h)
#pragma unroll
                    for (int j = 0; j < 4; ++j) o[4 * h + j] = f2bf(silu(acc[m][4 * G + 2 * h][j]) * acc[m][4 * G + 2 * h + 1][j]);
                *(us8*)(act + (size_t)row * LDF + col) = o; } }
    }
}

struct Seq { int row0, nchunk, Q, b, samp, seg; };
DEVI Seq make_seq(int seg, int sq) { Seq s; s.seg = seg; if (sq < 16) { s.row0 = sq * SEGT; s.nchunk = 8; s.Q = 64; s.b = sq; s.samp = 0; } else { s.b = sq - 16; s.row0 = ROWS_P + s.b * 32; s.nchunk = 1; s.Q = 32; s.samp = 1; } return s; }

template <int NF, int KS>
DEVI void lds_mma(f32x4* acc, const bf16_t* X, int ldx, int m0, const bf16_t* Y, int ldy, int n0, int wv_) {
    const int lane = tidx(wv_) & 63, fr = lane & 15, fq = lane >> 4;
#pragma unroll
    for (int ks = 0; ks < KS; ++ks) {
        bf16x8 a = *(const bf16x8*)(X + (m0 + fr) * ldx + ks * 32 + fq * 8);
#pragma unroll
        for (int nf = 0; nf < NF; ++nf) { bf16x8 b = *(const bf16x8*)(Y + (n0 + nf * 16 + fr) * ldy + ks * 32 + fq * 8); acc[nf] = __builtin_amdgcn_mfma_f32_16x16x32_bf16(a, b, acc[nf], 0, 0, 0); }
    }
}

DEVI void conv_load(uint4 (&r)[4], const bf16_t* proj, int row0, int tq, int pcol) {
#pragma unroll
    for (int k = 0; k < 4; ++k) { int ts = tq - 3 + k; ts = ts < 0 ? 0 : ts; r[k] = *(const uint4*)(proj + (size_t)(row0 + ts) * NPROJ + pcol); }
}
DEVI void touch4(uint4& v) { asm volatile("" : "+v"(v.x), "+v"(v.y), "+v"(v.z), "+v"(v.w)); }
DEVI void conv_compute(const uint4 (&r)[4], int tq, const float* hl, const float* cwl, int HC, int cl, float (&out)[8], float (&raw)[8]) {
    { f32x4 b0 = *(const f32x4*)(cwl + 4 * HC + cl), b1 = *(const f32x4*)(cwl + 4 * HC + cl + 4);
      out[0] = b0[0]; out[1] = b0[1]; out[2] = b0[2]; out[3] = b0[3]; out[4] = b1[0]; out[5] = b1[1]; out[6] = b1[2]; out[7] = b1[3]; }
#pragma unroll
    for (int k = 0; k < 4; ++k) {
        const int ts = tq - 3 + k; float v[8];
        v[0] = __uint_as_float(r[k].x << 16); v[1] = __uint_as_float(r[k].x & 0xffff0000u); v[2] = __uint_as_float(r[k].y << 16); v[3] = __uint_as_float(r[k].y & 0xffff0000u);
        v[4] = __uint_as_float(r[k].z << 16); v[5] = __uint_as_float(r[k].z & 0xffff0000u); v[6] = __uint_as_float(r[k].w << 16); v[7] = __uint_as_float(r[k].w & 0xffff0000u);
        if (k < 3) { int hi = 3 + ts; hi = hi < 0 ? 0 : (hi > 2 ? 2 : hi); const bool uh = ts < 0;
            f32x4 h0 = *(const f32x4*)(hl + hi * HC + cl), h1 = *(const f32x4*)(hl + hi * HC + cl + 4);
            v[0] = uh ? h0[0] : v[0]; v[1] = uh ? h0[1] : v[1]; v[2] = uh ? h0[2] : v[2]; v[3] = uh ? h0[3] : v[3];
            v[4] = uh ? h1[0] : v[4]; v[5] = uh ? h1[1] : v[5]; v[6] = uh ? h1[2] : v[6]; v[7] = uh ? h1[3] : v[7]; }
        f32x4 w0 = *(const f32x4*)(cwl + k * HC + cl), w1 = *(const f32x4*)(cwl + k * HC + cl + 4);
        out[0] += v[0] * w0[0]; out[1] += v[1] * w0[1]; out[2] += v[2] * w0[2]; out[3] += v[3] * w0[3];
        out[4] += v[4] * w1[0]; out[5] += v[5] * w1[1]; out[6] += v[6] * w1[2]; out[7] += v[7] * w1[3];
        if (k == 3) {
#pragma unroll
            for (int e = 0; e < 8; ++e) raw[e] = v[e]; }
    }
}

template <int ROWB>
DEVI void stage_raw(const char* g0, size_t ldgB, char* dst, int tid) {
#pragma unroll
    for (int i = 0; i < ROWB / 64; ++i) { int b = tid * 16 + i * 4096, row = b / ROWB, cb = b % ROWB;
        __builtin_amdgcn_global_load_lds((const unsigned*)(g0 + (size_t)row * ldgB + cb), (unsigned*)(dst + b), 16, 0, 0); }
}
DEVI void conv_lds(const bf16_t* rawt, int RS, int t, int cloc, const float* hl, const float* cwl, int HC, int cl, float (&out)[8], float (&raw)[8]) {
    { f32x4 b0 = *(const f32x4*)(cwl + 4 * HC + cl), b1 = *(const f32x4*)(cwl + 4 * HC + cl + 4);
      out[0] = b0[0]; out[1] = b0[1]; out[2] = b0[2]; out[3] = b0[3]; out[4] = b1[0]; out[5] = b1[1]; out[6] = b1[2]; out[7] = b1[3]; }
#pragma unroll
    for (int k = 0; k < 4; ++k) {
        const int tt = t - 3 + k; const int tc = tt < 0 ? 0 : tt; float v[8];
        const uint4 r = *(const uint4*)(rawt + tc * RS + cloc);
        v[0] = __uint_as_float(r.x << 16); v[1] = __uint_as_float(r.x & 0xffff0000u); v[2] = __uint_as_float(r.y << 16); v[3] = __uint_as_float(r.y & 0xffff0000u);
        v[4] = __uint_as_float(r.z << 16); v[5] = __uint_as_float(r.z & 0xffff0000u); v[6] = __uint_as_float(r.w << 16); v[7] = __uint_as_float(r.w & 0xffff0000u);
        if (k < 3) { int hi = 3 + tt; hi = hi < 0 ? 0 : (hi > 2 ? 2 : hi); const bool uh = tt < 0;
            f32x4 h0 = *(const f32x4*)(hl + hi * HC + cl), h1 = *(const f32x4*)(hl + hi * HC + cl + 4);
            v[0] = uh ? h0[0] : v[0]; v[1] = uh ? h0[1] : v[1]; v[2] = uh ? h0[2] : v[2]; v[3] = uh ? h0[3] : v[3];
            v[4] = uh ? h1[0] : v[4]; v[5] = uh ? h1[1] : v[5]; v[6] = uh ? h1[2] : v[6]; v[7] = uh ? h1[3] : v[7]; }
        f32x4 w0 = *(const f32x4*)(cwl + k * HC + cl), w1 = *(const f32x4*)(cwl + k * HC + cl + 4);
        out[0] += v[0] * w0[0]; out[1] += v[1] * w0[1]; out[2] += v[2] * w0[2]; out[3] += v[3] * w0[3];
        out[4] += v[4] * w1[0]; out[5] += v[5] * w1[1]; out[6] += v[6] * w1[2]; out[7] += v[7] * w1[3];
        if (k == 3) {
#pragma unroll
            for (int e = 0; e < 8; ++e) raw[e] = v[e]; }
    }
}

DEVI void ssd_unit(const Params& p, int l, Seq sq, int hd, char* lds, int wv_) {
    bf16_t* Bm = (bf16_t*)lds;
    bf16_t* R2 = (bf16_t*)(lds + 17408);
    bf16_t* xT = (bf16_t*)(lds + 35840);
    bf16_t* hb = (bf16_t*)(lds + 45056);
    float* fl = (float*)(lds + 62464);
    const int tid = tidx(wv_), lane = tid & 63, w = tid >> 6, fr = lane & 15, fq = lane >> 4;
    const bf16_t* proj = (const bf16_t*)(p.ws + WS_PROJ); const float* dtb = (const float*)(p.ws + WS_DT); bf16_t* ymb = (bf16_t*)(p.ws + WS_YMB);
    const int g = hd >> 2;
    const float a = -__expf(p.in[I_ALOG][l * 16 + hd]), Dv = p.in[I_MBD][l * 16 + hd];
    const float* cw = p.in[I_MCW] + (size_t)l * 4 * 2048; const float* cbias = p.in[I_MCB] + l * 2048;
    float* cwl = (float*)(lds + 63488);
    float* hl = (float*)(lds + 69888);
    const float* st_in; float* st_out; const float* hist; float* hist_out; float* hist_out2 = nullptr;
    float* hbuf = (float*)(p.ws + WS_HB);
    if (sq.samp) { st_in = p.in[I_SSM] + ((size_t)(l * 16 + sq.b) * 16 + hd) * 8192; st_out = p.out + O_SSM_S + ((size_t)(l * 16 + sq.b) * 16 + hd) * 8192;
        hist = p.in[I_SCV] + (size_t)(l * 16 + sq.b) * 3 * 2048; hist_out = p.out + O_SCV_S + (size_t)(l * 16 + sq.b) * 3 * 2048; }
    else { st_out = p.out + O_SSM_P + ((size_t)(l * 16 + sq.b) * 16 + hd) * 8192; st_in = sq.seg ? st_out : nullptr;
        hist_out = hbuf + ((size_t)((sq.seg & 1) * 2 + l) * 16 + sq.b) * 3 * 2048; hist = sq.seg ? hbuf + ((size_t)(((sq.seg + 1) & 1) * 2 + l) * 16 + sq.b) * 3 * 2048 : nullptr;
        if (sq.seg == NSEG - 1) hist_out2 = p.out + O_SCV_P + (size_t)(l * 16 + sq.b) * 3 * 2048; }
    for (int idx = tid; idx < 1600; idx += 256) { int k = idx / 320, cc = idx - k * 320; int ch = cc < 64 ? hd * 64 + cc : (cc < 192 ? 1024 + g * 128 + (cc - 64) : 1536 + g * 128 + (cc - 192));
        cwl[idx] = k < 4 ? cw[k * 2048 + ch] : cbias[ch];
        if (idx < 960) hl[idx] = hist ? hist[k * 2048 + ch] : 0.f; }
    f32x4 hacc[8];
#pragma unroll
    for (int nf = 0; nf < 8; ++nf)
#pragma unroll
        for (int r = 0; r < 4; ++r) { int pp = 16 * w + 4 * fq + r, n = 16 * nf + fr; float v = st_in ? st_in[pp * 128 + n] : 0.f; hacc[nf][r] = v; hb[pp * 136 + n] = f2bf(v); }
    bf16_t* rawX = (bf16_t*)(lds + 77568); bf16_t* rawB = (bf16_t*)(lds + 85760); bf16_t* rawC = (bf16_t*)(lds + 102144); bf16_t* rawZ = (bf16_t*)(lds + 118528); float* rawDt = (float*)(lds + 126720);
    const char* gx = (const char*)(proj + PC_XBC + hd * 64); const char* gb = (const char*)(proj + PC_XBC + 1024 + g * 128); const char* gc = (const char*)(proj + PC_XBC + 1536 + g * 128); const char* gz = (const char*)(proj + PC_Z + hd * 64);
    asm volatile("s_waitcnt vmcnt(0)" ::: "memory");
    {   const size_t ro = (size_t)sq.row0 * NPROJ * 2;
        stage_raw<128>(gx + ro, (size_t)NPROJ * 2, (char*)rawX, tid); stage_raw<256>(gb + ro, (size_t)NPROJ * 2, (char*)rawB, tid); stage_raw<256>(gc + ro, (size_t)NPROJ * 2, (char*)rawC, tid);
        stage_raw<128>(gz + ro, (size_t)NPROJ * 2, (char*)rawZ, tid); stage_raw<64>((const char*)(dtb + (size_t)sq.row0 * 16), 64, (char*)rawDt, tid); }
    for (int c = 0; c < sq.nchunk; ++c) {
        const int tid = tidx(wv_), lane = tid & 63, w = tid >> 6, fr = lane & 15, fq = lane >> 4;
        const int rowc = sq.row0 + c * 64; const bool lastc = (c == sq.nchunk - 1);
        const float* hlr = hl + (c & 1) * 960; float* hlw = hl + ((c + 1) & 1) * 960;
        asm volatile("s_waitcnt vmcnt(0)" ::: "memory");
        __syncthreads();
        if (w == 0) {
            float dt = lane < sq.Q ? rawDt[lane * 16 + hd] : 0.f; float v = dt * a;
#pragma unroll
            for (int o = 1; o < 64; o <<= 1) { float t = shfli(v, lane - o); if (lane >= o) v += t; }
            float last = shfli(v, 63);
            fl[lane] = v; fl[64 + lane] = dt; fl[128 + lane] = __expf(last - v) * dt; fl[192 + lane] = __expf(v);
        }
        __syncthreads();
        const float elast = __expf(fl[63]);
#pragma unroll
        for (int i = 0; i < 2; ++i) { int it = tid + 256 * i, t = it >> 3, c8 = (it & 7) * 8; float o[8], raw[8]; int ch = hd * 64 + c8; const bool tv = t < sq.Q;
            conv_lds(rawX, 64, t, c8, hlr, cwl, 320, c8, o, raw);
#pragma unroll
            for (int e = 0; e < 8; ++e) { float s_ = silu(o[e]); o[e] = tv ? s_ : 0.f; }
            if (t >= 61) {
#pragma unroll
                for (int e = 0; e < 8; ++e) hlw[(t - 61) * 320 + c8 + e] = raw[e]; }
            if (lastc && tv && t >= sq.Q - 3) {
#pragma unroll
                for (int e = 0; e < 8; ++e) { hist_out[(t - (sq.Q - 3)) * 2048 + ch + e] = raw[e]; if (hist_out2) hist_out2[(t - (sq.Q - 3)) * 2048 + ch + e] = raw[e]; } }
#pragma unroll
            for (int e = 0; e < 8; ++e) xT[(c8 + e) * 72 + t] = f2bf(o[e]); }
#pragma unroll
        for (int i = 0; i < 4; ++i) { int it = tid + 256 * i, t = it >> 4, c8 = (it & 15) * 8; float o[8], raw[8]; int ch = 1024 + g * 128 + c8; const bool tv = t < sq.Q;
            conv_lds(rawB, 128, t, c8, hlr, cwl, 320, 64 + c8, o, raw);
#pragma unroll
            for (int e = 0; e < 8; ++e) { float s_ = silu(o[e]); o[e] = tv ? s_ : 0.f; }
            if (t >= 61) {
#pragma unroll
                for (int e = 0; e < 8; ++e) hlw[(t - 61) * 320 + 64 + c8 + e] = raw[e]; }
            if (lastc && tv && (hd & 3) == 0 && t >= sq.Q - 3) {
#pragma unroll
                for (int e = 0; e < 8; ++e) { hist_out[(t - (sq.Q - 3)) * 2048 + ch + e] = raw[e]; if (hist_out2) hist_out2[(t - (sq.Q - 3)) * 2048 + ch + e] = raw[e]; } }
            us8 ov; float we = fl[128 + t];
#pragma unroll
            for (int e = 0; e < 8; ++e) { ov[e] = f2bf(o[e]); R2[(c8 + e) * 72 + t] = f2bf(o[e] * we); }
            *(us8*)(Bm + t * 136 + c8) = ov; }
        __syncthreads();
#pragma unroll
        for (int nf = 0; nf < 8; ++nf) hacc[nf] *= elast;
        lds_mma<8, 2>(hacc, xT, 72, 16 * w, R2, 72, 0, wv_);
        __syncthreads();
#pragma unroll
        for (int i = 0; i < 4; ++i) { int it = tid + 256 * i, t = it >> 4, c8 = (it & 15) * 8; float o[8], raw[8]; int ch = 1536 + g * 128 + c8; const bool tv = t < sq.Q;
            conv_lds(rawC, 128, t, c8, hlr, cwl, 320, 192 + c8, o, raw);
#pragma unroll
            for (int e = 0; e < 8; ++e) { float s_ = silu(o[e]); o[e] = tv ? s_ : 0.f; }
            if (t >= 61) {
#pragma unroll
                for (int e = 0; e < 8; ++e) hlw[(t - 61) * 320 + 192 + c8 + e] = raw[e]; }
            if (lastc && tv && (hd & 3) == 0 && t >= sq.Q - 3) {
#pragma unroll
                for (int e = 0; e < 8; ++e) { hist_out[(t - (sq.Q - 3)) * 2048 + ch + e] = raw[e]; if (hist_out2) hist_out2[(t - (sq.Q - 3)) * 2048 + ch + e] = raw[e]; } }
            us8 ov;
#pragma unroll
            for (int e = 0; e < 8; ++e) ov[e] = f2bf(o[e]);
            *(us8*)(R2 + t * 136 + c8) = ov; }
        us4 zr[4];
#pragma unroll
        for (int nf = 0; nf < 4; ++nf) zr[nf] = *(const us4*)(rawZ + (16 * nf + fr) * 64 + 16 * w + 4 * fq);
        __syncthreads();
        if (!lastc) { const size_t ro = (size_t)(rowc + 64) * NPROJ * 2;
            stage_raw<128>(gx + ro, (size_t)NPROJ * 2, (char*)rawX, tid); stage_raw<256>(gb + ro, (size_t)NPROJ * 2, (char*)rawB, tid); stage_raw<256>(gc + ro, (size_t)NPROJ * 2, (char*)rawC, tid);
            stage_raw<128>(gz + ro, (size_t)NPROJ * 2, (char*)rawZ, tid); stage_raw<64>((const char*)(dtb + (size_t)(rowc + 64) * 16), 64, (char*)rawDt, tid); }
        f32x4 cbv[4];
#pragma unroll
        for (int nf = 0; nf < 4; ++nf) cbv[nf] = (f32x4){0.f, 0.f, 0.f, 0.f};
        lds_mma<4, 4>(cbv, Bm, 136, 16 * w, R2, 136, 0, wv_);
        __syncthreads();
#pragma unroll
        for (int nf = 0; nf < 4; ++nf) { int i = 16 * nf + fr; float ai = fl[i]; us4 o;
#pragma unroll
            for (int r = 0; r < 4; ++r) { int j = 16 * w + 4 * fq + r; float v = (j <= i) ? cbv[nf][r] * __expf(ai - fl[j]) * fl[64 + j] : 0.f; o[r] = f2bf(v); }
            *(us4*)(Bm + i * 72 + 16 * w + 4 * fq) = o; }
        __syncthreads();
        f32x4 ya[4];
#pragma unroll
        for (int nf = 0; nf < 4; ++nf) ya[nf] = (f32x4){0.f, 0.f, 0.f, 0.f};
        lds_mma<4, 4>(ya, hb, 136, 16 * w, R2, 136, 0, wv_);
#pragma unroll
        for (int nf = 0; nf < 4; ++nf) ya[nf] *= fl[192 + 16 * nf + fr];
        lds_mma<4, 2>(ya, xT, 72, 16 * w, Bm, 72, 0, wv_);
#pragma unroll
        for (int nf = 0; nf < 4; ++nf) { int i = 16 * nf + fr, p0 = 16 * w + 4 * fq;
            us4 z = zr[nf];
            if (i < sq.Q) { us4 o;
#pragma unroll
                for (int r = 0; r < 4; ++r) o[r] = f2bf((ya[nf][r] + Dv * bf2f(xT[(p0 + r) * 72 + i])) * bf2f(z[r]));
                *(us4*)(ymb + (size_t)(rowc + i) * LDK + hd * 64 + p0) = o; } }
        __syncthreads();
#pragma unroll
        for (int nf = 0; nf < 8; ++nf)
#pragma unroll
            for (int r = 0; r < 4; ++r) hb[(16 * w + 4 * fq + r) * 136 + 16 * nf + fr] = f2bf(hacc[nf][r]);
    }
#pragma unroll
    for (int nf = 0; nf < 8; ++nf)
#pragma unroll
        for (int r = 0; r < 4; ++r) st_out[(16 * w + 4 * fq + r) * 128 + 16 * nf + fr] = hacc[nf][r];
    __syncthreads();
}

DEVI void hgrn_unit(const Params& p, int l, Seq sq, int h, char* lds, int wv_) {
    bf16_t* sb = (bf16_t*)lds;
    bf16_t* qt = (bf16_t*)(lds + 34816);
    bf16_t* kt = (bf16_t*)(lds + 52224);
    bf16_t* att = (bf16_t*)lds;
    bf16_t* kT = (bf16_t*)(lds + 9216);
    bf16_t* vT = (bf16_t*)(lds + 27648);
    float* T0 = (float*)(lds + 69632); float* T1 = T0 + 128; float* ssq = T0 + 256;
    const int tid = tidx(wv_), lane = tid & 63, w = tid >> 6, fr = lane & 15, fq = lane >> 4;
    const int k = tid & 127, half = tid >> 7;
    const bf16_t* proj = (const bf16_t*)(p.ws + WS_PROJ); bf16_t* yhg = (bf16_t*)(p.ws + WS_YHG);
    float lb = 0.f;
    if (l == 1) { float a0 = p.in[I_LBL][h * 128 + k], a1 = p.in[I_LBL][1024 + h * 128 + k]; lb = 1.f / (1.f + __expf(a0 - a1)); }
    const float* nw = p.in[I_HGNW] + l * 128;
    const float* st_in; float* st_out;
    if (sq.samp) { st_in = p.in[I_HG] + ((size_t)(l * 16 + sq.b) * 8 + h) * 16384; st_out = p.out + O_HG_S + ((size_t)(l * 16 + sq.b) * 8 + h) * 16384; }
    else { st_out = p.out + O_HG_P + ((size_t)(l * 16 + sq.b) * 8 + h) * 16384; st_in = sq.seg ? st_out : nullptr; }
    f32x4 hacc[2][8];
#pragma unroll
    for (int mf = 0; mf < 2; ++mf)
#pragma unroll
        for (int nf = 0; nf < 8; ++nf)
#pragma unroll
            for (int r = 0; r < 4; ++r) hacc[mf][nf][r] = st_in ? st_in[(32 * w + 16 * mf + 4 * fq + r) * 128 + 16 * nf + fr] : 0.f;
    f32x4 nwr[2];
#pragma unroll
    for (int mf = 0; mf < 2; ++mf) nwr[mf] = *(const f32x4*)(nw + 32 * w + 16 * mf + 4 * fq);
    bf16_t* rawF = (bf16_t*)(lds + 71680); bf16_t* rawQ = (bf16_t*)(lds + 88064); bf16_t* rawV = (bf16_t*)(lds + 104448); bf16_t* rawH = (bf16_t*)(lds + 120832);
    const char* gf = (const char*)(proj + PC_HF + h * 128); const char* gq = (const char*)(proj + PC_HQ + h * 128); const char* gv = (const char*)(proj + PC_HI + h * 128); const char* gh = (const char*)(proj + PC_HGATE + h * 128);
    asm volatile("s_waitcnt vmcnt(0)" ::: "memory");
    {   const size_t ro = (size_t)sq.row0 * NPROJ * 2;
        stage_raw<256>(gf + ro, (size_t)NPROJ * 2, (char*)rawF, tid); stage_raw<256>(gq + ro, (size_t)NPROJ * 2, (char*)rawQ, tid); stage_raw<256>(gv + ro, (size_t)NPROJ * 2, (char*)rawV, tid); }
    for (int c = 0; c < sq.nchunk; ++c) {
        const int tid = tidx(wv_), lane = tid & 63, w = tid >> 6, fr = lane & 15, fq = lane >> 4, k = tid & 127, half = tid >> 7;
        const int rowc = sq.row0 + c * 64; const bool lastc = (c == sq.nchunk - 1);
        asm volatile("s_waitcnt vmcnt(0)" ::: "memory");
        __syncthreads();
        stage_raw<256>(gh + (size_t)rowc * NPROJ * 2, (size_t)NPROJ * 2, (char*)rawH, tid);
        {
            unsigned fu[32], qu[32];
#pragma unroll
            for (int jj = 0; jj < 32; ++jj) { fu[jj] = rawF[(32 * half + jj) * 128 + k]; qu[jj] = rawQ[(32 * half + jj) * 128 + k]; }
            if (tid < 64) ssq[tid] = 0.f;
            float run = 0.f;
            if (half == 0) {
#pragma unroll
                for (int jj = 31; jj >= 0; --jj) { bool valid = jj < sq.Q; float f = __uint_as_float(fu[jj] << 16);
                    float sg = __builtin_amdgcn_rcpf(1.f + __expf(-f)); float lg0 = __logf(lb + (1.f - lb) * sg); float lg = valid ? lg0 : 0.f;
                    float kk0 = (1.f - lb) * (1.f - sg); float kk = valid ? kk0 : 0.f; float q0 = __uint_as_float(qu[jj] << 16); float q = valid ? q0 : 0.f;
                    qt[jj * 136 + k] = f2bf(q * cexp(-run)); kt[jj * 136 + k] = f2bf(kk * cexp(run)); run += lg; }
                T0[k] = run;
            } else {
#pragma unroll
                for (int jj = 0; jj < 32; ++jj) { bool valid = (32 + jj) < sq.Q; float f = __uint_as_float(fu[jj] << 16);
                    float sg = __builtin_amdgcn_rcpf(1.f + __expf(-f)); float lg0 = __logf(lb + (1.f - lb) * sg); float lg = valid ? lg0 : 0.f;
                    float kk0 = (1.f - lb) * (1.f - sg); float kk = valid ? kk0 : 0.f; float q0 = __uint_as_float(qu[jj] << 16); float q = valid ? q0 : 0.f;
                    run += lg; qt[(32 + jj) * 136 + k] = f2bf(q * cexp(run)); kt[(32 + jj) * 136 + k] = f2bf(kk * cexp(-run)); }
                T1[k] = run;
            }
        }
        __syncthreads();
#pragma unroll
        for (int mf = 0; mf < 2; ++mf) { int k0 = 32 * w + 16 * mf + 4 * fq; float e0 = __expf(T0[k0]), e1 = __expf(T0[k0 + 1]), e2 = __expf(T0[k0 + 2]), e3 = __expf(T0[k0 + 3]);
#pragma unroll
            for (int nf = 0; nf < 8; ++nf) { hacc[mf][nf][0] *= e0; hacc[mf][nf][1] *= e1; hacc[mf][nf][2] *= e2; hacc[mf][nf][3] *= e3;
                us4 o; o[0] = f2bf(hacc[mf][nf][0]); o[1] = f2bf(hacc[mf][nf][1]); o[2] = f2bf(hacc[mf][nf][2]); o[3] = f2bf(hacc[mf][nf][3]);
                *(us4*)(sb + (16 * nf + fr) * 136 + k0) = o; } }
        f32x4 at[4];
#pragma unroll
        for (int nf = 0; nf < 4; ++nf) at[nf] = (f32x4){0.f, 0.f, 0.f, 0.f};
        lds_mma<4, 4>(at, kt, 136, 16 * w, qt, 136, 0, wv_);
        __syncthreads();
        f32x4 oacc[2][4];
#pragma unroll
        for (int mf = 0; mf < 2; ++mf) {
#pragma unroll
            for (int nf = 0; nf < 4; ++nf) oacc[mf][nf] = (f32x4){0.f, 0.f, 0.f, 0.f};
            lds_mma<4, 4>(oacc[mf], sb, 136, 32 * w + 16 * mf, qt, 136, 0, wv_); }
        __syncthreads();
#pragma unroll
        for (int nf = 0; nf < 4; ++nf) { int i = 16 * nf + fr; us4 o;
#pragma unroll
            for (int r = 0; r < 4; ++r) { int j = 16 * w + 4 * fq + r; o[r] = f2bf(j <= i ? at[nf][r] : 0.f); }
            *(us4*)(att + i * 72 + 16 * w + 4 * fq) = o; }
        {   unsigned vu[32];
#pragma unroll
            for (int jj = 0; jj < 32; ++jj) vu[jj] = rawV[(32 * half + jj) * 128 + k];
#pragma unroll
            for (int q4 = 0; q4 < 4; ++q4) { us8 kv, vv;
#pragma unroll
                for (int e = 0; e < 8; ++e) { int jj = q4 * 8 + e; bool valid = (32 * half + jj) < sq.Q; kv[e] = kt[(32 * half + jj) * 136 + k]; vv[e] = valid ? (bf16_t)vu[jj] : (bf16_t)0; }
                *(us8*)(kT + k * 72 + 32 * half + q4 * 8) = kv; *(us8*)(vT + k * 72 + 32 * half + q4 * 8) = vv; } }
        __syncthreads();
        if (!lastc) { const size_t ro = (size_t)(rowc + 64) * NPROJ * 2;
            stage_raw<256>(gf + ro, (size_t)NPROJ * 2, (char*)rawF, tid); stage_raw<256>(gq + ro, (size_t)NPROJ * 2, (char*)rawQ, tid); stage_raw<256>(gv + ro, (size_t)NPROJ * 2, (char*)rawV, tid); }
#pragma unroll
        for (int mf = 0; mf < 2; ++mf) {
            lds_mma<4, 2>(oacc[mf], vT, 72, 32 * w + 16 * mf, att, 72, 0, wv_);
            lds_mma<8, 2>(hacc[mf], kT, 72, 32 * w + 16 * mf, vT, 72, 0, wv_);
            int k0 = 32 * w + 16 * mf + 4 * fq; float e0 = __expf(T1[k0]), e1 = __expf(T1[k0 + 1]), e2 = __expf(T1[k0 + 2]), e3 = __expf(T1[k0 + 3]);
#pragma unroll
            for (int nf = 0; nf < 8; ++nf) { hacc[mf][nf][0] *= e0; hacc[mf][nf][1] *= e1; hacc[mf][nf][2] *= e2; hacc[mf][nf][3] *= e3; } }
#pragma unroll
        for (int nf = 0; nf < 4; ++nf) { float s = 0.f;
#pragma unroll
            for (int mf = 0; mf < 2; ++mf)
#pragma unroll
                for (int r = 0; r < 4; ++r) s += oacc[mf][nf][r] * oacc[mf][nf][r];
            s += shflx(s, 16, lane); s += shflx(s, 32, lane);
            if (fq == 0) atomicAdd(&ssq[16 * nf + fr], s); }
        if (lastc) asm volatile("s_waitcnt vmcnt(0)" ::: "memory"); else asm volatile("s_waitcnt vmcnt(12)" ::: "memory");
        __syncthreads();
#pragma unroll
        for (int nf = 0; nf < 4; ++nf) { int i = 16 * nf + fr; float rs = rsqrtf(ssq[i] * (1.f / 128.f) + 1e-6f);
#pragma unroll
            for (int mf = 0; mf < 2; ++mf) { int v0 = 32 * w + 16 * mf + 4 * fq; us4 gt = *(const us4*)(rawH + i * 128 + v0); f32x4 wv = nwr[mf]; us4 o;
#pragma unroll
                for (int r = 0; r < 4; ++r) o[r] = f2bf(oacc[mf][nf][r] * rs * wv[r] * bf2f(gt[r]));
                if (i < sq.Q) *(us4*)(yhg + (size_t)(rowc + i) * LDK + h * 128 + v0) = o; } }
        __syncthreads();
    }
#pragma unroll
    for (int mf = 0; mf < 2; ++mf)
#pragma unroll
        for (int nf = 0; nf < 8; ++nf)
#pragma unroll
            for (int r = 0; r < 4; ++r) st_out[(32 * w + 16 * mf + 4 * fq + r) * 128 + 16 * nf + fr] = hacc[mf][nf][r];
}

DEVI void rg_unit(const Params& p, int l, Seq sq, int blk, char* lds, int wv_) {
    bf16_t* waT = (bf16_t*)lds; bf16_t* wiT = (bf16_t*)(lds + 9216); bf16_t* xr = (bf16_t*)(lds + 18432);
    float* av = (float*)(lds + 27648); float* uv = (float*)(lds + 44288); float* Pq = (float*)(lds + 60928); float* Hq = Pq + 256; float* carry = Hq + 256;
    const int tid = tidx(wv_), lane = tid & 63, w = tid >> 6, fr = lane & 15, fq = lane >> 4;
    const bf16_t* proj = (const bf16_t*)(p.ws + WS_PROJ); bf16_t* yrg = (bf16_t*)(p.ws + WS_YRG);
    const int cb0 = blk * 64;
    const float* cw = p.in[I_RCW] + (size_t)l * 4 * 1024; const float* cbias = p.in[I_RCB] + l * 1024;
    const float* st_in; float* st_out; const float* hist; float* hist_out;
    if (sq.samp) { st_in = p.in[I_RG] + (size_t)(l * 16 + sq.b) * 1024; st_out = p.out + O_RG_S + (size_t)(l * 16 + sq.b) * 1024;
        hist = p.in[I_RCV] + (size_t)(l * 16 + sq.b) * 3 * 1024; hist_out = p.out + O_RCV_S + (size_t)(l * 16 + sq.b) * 3 * 1024; }
    else { st_out = p.out + O_RG_P + (size_t)(l * 16 + sq.b) * 1024; st_in = sq.seg ? st_out : nullptr;
        hist_out = p.out + O_RCV_P + (size_t)(l * 16 + sq.b) * 3 * 1024; hist = sq.seg ? hist_out : nullptr; }
    float* cwl = (float*)(lds + 63232);
    float* hl = (float*)(lds + 64512);
    float* hl2 = (float*)(lds + 90112);
    for (int idx = tid; idx < 320; idx += 256) { int k = idx >> 6, cc = idx & 63; cwl[idx] = k < 4 ? cw[k * 1024 + cb0 + cc] : cbias[cb0 + cc]; if (idx < 192) hl[idx] = hist ? hist[k * 1024 + cb0 + cc] : 0.f; }
    {   const float* wa = p.in[I_RWA] + ((size_t)l * 16 + blk) * 4096; const float* wi = p.in[I_RWI] + ((size_t)l * 16 + blk) * 4096;
        float wa_[16], wi_[16];
#pragma unroll
        for (int u = 0; u < 16; ++u) { wa_[u] = wa[tid + 256 * u]; wi_[u] = wi[tid + 256 * u]; }
#pragma unroll
        for (int u = 0; u < 16; ++u) { int e = tid + 256 * u, i = e >> 6, j = e & 63; waT[j * 72 + i] = f2bf(wa_[u]); wiT[j * 72 + i] = f2bf(wi_[u]); }
        if (tid < 64) carry[tid] = st_in ? st_in[cb0 + tid] : 0.f; }
    float cba[4], cbi[4], csp[4];
#pragma unroll
    for (int nf = 0; nf < 4; ++nf) { int cc = cb0 + 16 * nf + fr; cba[nf] = p.in[I_RBA][l * 1024 + cc]; cbi[nf] = p.in[I_RBI][l * 1024 + cc]; csp[nf] = softplus(-p.in[I_RLAM][l * 1024 + cc]); }
    bf16_t* rawR = (bf16_t*)(lds + 65536); bf16_t* rawG = (bf16_t*)(lds + 73728);
    const char* gr = (const char*)(proj + PC_RX + cb0); const char* gg = (const char*)(proj + PC_RGATE + cb0);
    asm volatile("s_waitcnt vmcnt(0)" ::: "memory");
    stage_raw<128>(gr + (size_t)sq.row0 * NPROJ * 2, (size_t)NPROJ * 2, (char*)rawR, tid); stage_raw<128>(gg + (size_t)sq.row0 * NPROJ * 2, (size_t)NPROJ * 2, (char*)rawG, tid);
    for (int c = 0; c < sq.nchunk; ++c) {
        const int tid = tidx(wv_), lane = tid & 63, w = tid >> 6, fr = lane & 15, fq = lane >> 4, j = tid & 63, q = tid >> 6;
        const int rowc = sq.row0 + c * 64; const bool lastc = (c == sq.nchunk - 1);
        const float* hlr = (c & 1) ? hl2 : hl; float* hlw = (c & 1) ? hl : hl2;
        asm volatile("s_waitcnt vmcnt(0)" ::: "memory");
        __syncthreads();
#pragma unroll
        for (int i = 0; i < 2; ++i) { int it = tid + 256 * i, t = it >> 3, c8 = (it & 7) * 8; float o[8], raw[8]; int ch = cb0 + c8; const bool tv = t < sq.Q;
            conv_lds(rawR, 64, t, c8, hlr, cwl, 64, c8, o, raw);
            if (t >= 61) {
#pragma unroll
                for (int e = 0; e < 8; ++e) hlw[(t - 61) * 64 + c8 + e] = raw[e]; }
            if (lastc && tv && t >= sq.Q - 3) {
#pragma unroll
                for (int e = 0; e < 8; ++e) hist_out[(t - (sq.Q - 3)) * 1024 + ch + e] = raw[e]; }
            us8 ov;
#pragma unroll
            for (int e = 0; e < 8; ++e) { float ox = tv ? o[e] : 0.f; ov[e] = f2bf(ox); uv[t * 65 + c8 + e] = ox; }
            *(us8*)(xr + t * 72 + c8) = ov; }
        __syncthreads();
        if (!lastc) { const size_t ro = (size_t)(rowc + 64) * NPROJ * 2; stage_raw<128>(gr + ro, (size_t)NPROJ * 2, (char*)rawR, tid); stage_raw<128>(gg + ro, (size_t)NPROJ * 2, (char*)(rawG + ((c + 1) & 1) * 4096), tid); }
        f32x4 ra[4], ri[4];
#pragma unroll
        for (int nf = 0; nf < 4; ++nf) { ra[nf] = (f32x4){0.f, 0.f, 0.f, 0.f}; ri[nf] = (f32x4){0.f, 0.f, 0.f, 0.f}; }
        lds_mma<4, 2>(ra, xr, 72, 16 * w, waT, 72, 0, wv_);
        lds_mma<4, 2>(ri, xr, 72, 16 * w, wiT, 72, 0, wv_);
#pragma unroll
        for (int nf = 0; nf < 4; ++nf) { int jj = 16 * nf + fr; float ba = cba[nf], bi = cbi[nf], sp = csp[nf];
#pragma unroll
            for (int r = 0; r < 4; ++r) { int t = 16 * w + 4 * fq + r; float rr = sigm(ra[nf][r] + ba), ii = sigm(ri[nf][r] + bi); float la = -8.f * sp * rr; float aa = __expf(la);
                float u = __builtin_sqrtf(fmaxf(1.f - aa * aa, 0.f)) * ii * uv[t * 65 + jj];
                if (t >= sq.Q) { aa = 1.f; u = 0.f; }
                av[t * 65 + jj] = aa; uv[t * 65 + jj] = u; } }
        __syncthreads();
        { float P = 1.f, H = 0.f;
#pragma unroll
          for (int tt = 0; tt < 16; ++tt) { int t = 16 * q + tt; float aa = av[t * 65 + j], u = uv[t * 65 + j]; H = aa * H + u; P *= aa; }
          Pq[q * 64 + j] = P; Hq[q * 64 + j] = H; }
        __syncthreads();
        float hcur = carry[j];
        for (int qq = 0; qq < q; ++qq) hcur = Pq[qq * 64 + j] * hcur + Hq[qq * 64 + j];
        const bf16_t* rg_ = rawG + (c & 1) * 4096;
        bf16_t gts[16];
#pragma unroll
        for (int tt = 0; tt < 16; ++tt) gts[tt] = rg_[(16 * q + tt) * 64 + j];
#pragma unroll
        for (int tt = 0; tt < 16; ++tt) { int t = 16 * q + tt; float aa = av[t * 65 + j], u = uv[t * 65 + j]; hcur = aa * hcur + u;
            if (t < sq.Q) yrg[(size_t)(rowc + t) * LDK + cb0 + j] = f2bf(bf2f(gts[tt]) * hcur); }
        __syncthreads();
        if (q == 3) carry[j] = hcur;
        __syncthreads();
    }
    if (tid < 64) st_out[cb0 + tid] = carry[tid];
    __syncthreads();
}

DEVI void phase_mix(const Params& p, int l, int seg, char* lds, int wv_) {
    const int ngrp = seg == 0 ? 2 : 1; const int NU = ngrp * 640;
    for (int u = blockIdx.x; u < NU; u += gridDim.x) {
        int grp = u / 640, v = u % 640;
        if (v < 128) hgrn_unit(p, l, make_seq(seg, grp * 16 + (v >> 3)), v & 7, lds, wv_);
        else if (v < 384) { v -= 128; ssd_unit(p, l, make_seq(seg, grp * 16 + (v >> 4)), v & 15, lds, wv_); }
        else { v -= 384; rg_unit(p, l, make_seq(seg, grp * 16 + (v >> 4)), v & 15, lds, wv_); }
        __syncthreads();
    }
}

DEVI void gbar(const Params& p, unsigned& epoch_, int wv_) {
    const unsigned epoch = __builtin_amdgcn_readfirstlane(epoch_); epoch_ = epoch + 1u;
    unsigned* bw = (unsigned*)(p.ws + WS_END); asm volatile("" : "+s"(bw));
    asm volatile("s_waitcnt vmcnt(0)" ::: "memory");
    __syncthreads();
    if (tidx(wv_) == 0) {
        if ((wv_ >> 23) & 1) {
            const unsigned x = (wv_ >> 2) & 7, NB = (wv_ >> 14) & 511;
            const unsigned old = __hip_atomic_fetch_add(bw + 32 + x, 1u, __ATOMIC_RELAXED, __HIP_MEMORY_SCOPE_AGENT);
            if (old + 1u == (epoch + 1u) * NB) {
                __builtin_amdgcn_fence(__ATOMIC_RELEASE, "agent");
                asm volatile("s_waitcnt vmcnt(0)" ::: "memory");
                const unsigned og = __hip_atomic_fetch_add(bw + 56, 1u, __ATOMIC_RELAXED, __HIP_MEMORY_SCOPE_AGENT);
                if (og + 1u == (epoch + 1u) * 8u) __hip_atomic_fetch_add(bw + 57, 1u, __ATOMIC_RELAXED, __HIP_MEMORY_SCOPE_AGENT);
                else while (__hip_atomic_load(bw + 57, __ATOMIC_RELAXED, __HIP_MEMORY_SCOPE_AGENT) < epoch + 1u) __builtin_amdgcn_s_sleep(1);
                __builtin_amdgcn_fence(__ATOMIC_ACQUIRE, "agent");
                __hip_atomic_fetch_add(bw + 48 + x, 1u, __ATOMIC_RELAXED, __HIP_MEMORY_SCOPE_AGENT);
                asm volatile("s_waitcnt vmcnt(0)" ::: "memory");
            } else {
                while (__hip_atomic_load(bw + 48 + x, __ATOMIC_RELAXED, __HIP_MEMORY_SCOPE_AGENT) < epoch + 1u) __builtin_amdgcn_s_sleep(1);
                __builtin_amdgcn_fence(__ATOMIC_ACQUIRE, "agent");
                asm volatile("s_waitcnt vmcnt(0)" ::: "memory");
            }
        } else {
            __builtin_amdgcn_fence(__ATOMIC_RELEASE, "agent");
            asm volatile("s_waitcnt vmcnt(0)" ::: "memory");
            __hip_atomic_fetch_add(bw, 1u, __ATOMIC_RELAXED, __HIP_MEMORY_SCOPE_AGENT);
            const unsigned target = (epoch + 1u) * gridDim.x;
            while (__hip_atomic_load(bw, __ATOMIC_RELAXED, __HIP_MEMORY_SCOPE_AGENT) < target) __builtin_amdgcn_s_sleep(1);
            __builtin_amdgcn_fence(__ATOMIC_ACQUIRE, "agent");
            asm volatile("s_waitcnt vmcnt(0)" ::: "memory");
        }
    }
    __syncthreads();
}

__global__ void __launch_bounds__(256) fwd_mega(Params p) {
    extern __shared__ __attribute__((aligned(16))) char lds[];
    int wv_ = __builtin_amdgcn_readfirstlane((int)(__builtin_amdgcn_workitem_id_x() >> 6));
    cg::grid_group grid = cg::this_grid();
    unsigned* xcnt = (unsigned*)(p.ws + WS_END) + 16;
    const int xcc = (int)(__builtin_amdgcn_s_getreg((3 << 11) | 20) & 7u);
    int xrank;
    { int* sh = (int*)lds; if (__builtin_amdgcn_workitem_id_x() == 0) sh[0] = (int)__hip_atomic_fetch_add(xcnt + xcc, 1u, __ATOMIC_RELAXED, __HIP_MEMORY_SCOPE_AGENT); __syncthreads(); xrank = __builtin_amdgcn_readfirstlane(sh[0]); __syncthreads(); }
    unsigned epoch = 0;
    phase_prep(p, lds, wv_);
    grid.sync();
    {   unsigned c[8]; bool ok = true;
#pragma unroll
        for (int i = 0; i < 8; ++i) { c[i] = __hip_atomic_load(xcnt + i, __ATOMIC_RELAXED, __HIP_MEMORY_SCOPE_AGENT); ok = ok && c[i] > 0u && c[i] < 512u; }
        unsigned mine = 0, tot_ = 0;
#pragma unroll
        for (int i = 0; i < 8; ++i) { mine = (i == xcc) ? c[i] : mine; tot_ += c[i]; }
        ok = ok && tot_ == gridDim.x;
        int X = xcc, R = xrank, NB = (int)mine;
        if (!ok) { X = blockIdx.x & 7; R = blockIdx.x >> 3; NB = gridDim.x >> 3; }
        wv_ = __builtin_amdgcn_readfirstlane((wv_ & 3) | (X << 2) | (R << 5) | (NB << 14) | (ok ? (1 << 23) : 0)); }
#pragma unroll 1
    for (int seg = 0; seg < NSEG; ++seg) {
        const int nrows = seg == 0 ? ROWS : ROWS_P, MT = nrows / 256;
#pragma unroll 1
        for (int l = 0; l < 2; ++l) {
            const bf16_t* wl = (const bf16_t*)p.ws + (size_t)l * E_LAYER;
            phase_norm(p, seg, nrows, p.in[I_NMIX] + l * 1024, l == 0, l, lds, wv_);
            gbar(p, epoch, wv_);
            for (int r = 0; r < p.rep[0]; ++r) { phase_proj(p, l, MT, lds, wv_); gbar(p, epoch, wv_); }
            for (int r = 0; r < (seg == 0 ? p.rep[3] : 1); ++r) { phase_mix(p, l, seg, lds, wv_); gbar(p, epoch, wv_); }
            phase_mbnorm(p, l, nrows, wv_);
            gbar(p, epoch, wv_);
            for (int r = 0; r < p.rep[1]; ++r) { phase_merge(p, l, MT, lds, wv_); gbar(p, epoch, wv_); }
            phase_resid(p, seg, MT, (const bf16_t*)(p.ws + WS_MRG), 1024, LDK, wl + E_WIN + E_WBR, l == 0, lds, wv_);
            gbar(p, epoch, wv_);
            phase_norm(p, seg, nrows, p.in[I_NFFN] + l * 1024, false, -1, lds, wv_);
            gbar(p, epoch, wv_);
            for (int r = 0; r < p.rep[2]; ++r) { phase_ffn_in(p, l, MT, lds, wv_); gbar(p, epoch, wv_); }
            phase_resid(p, seg, MT, (const bf16_t*)(p.ws + WS_PROJ), FFH, LDF, wl + E_WIN + E_WBR + E_WOUT + E_WFI, false, lds, wv_);
            gbar(p, epoch, wv_);
        }
        phase_final_norm(p, seg, nrows, wv_);
    }
}

extern "C" void kernel_launch(void* const* d_in, const int* in_sizes, int n_in, void* d_out, int out_size, void* d_ws, size_t ws_size, hipStream_t stream) {
    static int grid_blocks = 0;
    if (!grid_blocks) {
        int dev = 0, cus = 0, per_cu = 0;
        (void)hipGetDevice(&dev);
        (void)hipDeviceGetAttribute(&cus, hipDeviceAttributeMultiprocessorCount, dev);
        (void)hipFuncSetAttribute((const void*)fwd_mega, hipFuncAttributeMaxDynamicSharedMemorySize, LDS_BYTES);
        (void)hipOccupancyMaxActiveBlocksPerMultiprocessor(&per_cu, (const void*)fwd_mega, 256, LDS_BYTES);
        if (per_cu < 1) fprintf(stderr, "occupancy query says %d blocks per CU\n", per_cu);
        grid_blocks = cus;
        if (ws_size < WS_TOTAL) fprintf(stderr, "workspace too small: %zu < %zu\n", ws_size, (size_t)WS_END + 256);
    }
    (void)hipMemsetAsync((char*)d_ws + WS_END, 0, 256, stream);
    Params p{};
    for (int i = 0; i < 30; ++i) p.in[i] = (const float*)d_in[i];
    p.out = (float*)d_out; p.ws = (unsigned char*)d_ws; p.rep[0] = REP0; p.rep[1] = REP1; p.rep[2] = REP2; p.rep[3] = REP3;
    void* args[] = {&p};
    hipError_t e = hipLaunchCooperativeKernel((const void*)fwd_mega, dim3(grid_blocks), dim3(256), args, LDS_BYTES, stream);
    if (e != hipSuccess) fprintf(stderr, "cooperative launch failed: %s (grid %d)\n", hipGetErrorString(e), grid_blocks);
}
```

```cpp
#include <hip/hip_runtime.h>
#include <hip/hip_cooperative_groups.h>
#include <cstdio>
namespace cg = cooperative_groups;

typedef unsigned short bf16_t;
typedef short bf16x8 __attribute__((ext_vector_type(8)));
typedef float f32x4 __attribute__((ext_vector_type(4)));
typedef unsigned short us4 __attribute__((ext_vector_type(4)));
typedef unsigned short us8 __attribute__((ext_vector_type(8)));
#define DEVI __device__ __forceinline__

constexpr int LDK = 1088, LDF = 2880;
constexpr int D = 1024, NPROJ = 12288, SEGT = 512, NSEG = 4, ROWS_P = 8192, ROWS = 8704, FFH = 2816;
constexpr int PC_Z = 0, PC_XBC = 1024, PC_HQ = 3072, PC_HF = 4096, PC_HI = 5120, PC_HGATE = 6144, PC_RGATE = 7168, PC_RX = 8192, PC_MG = 9216, PC_DT = 12288;
constexpr size_t E_WIN = (size_t)NPROJ * LDK, E_WBR = 3u * 1024 * LDK, E_WOUT = 1024u * LDK, E_WFI = 5632u * LDK, E_WFO = 1024u * LDF;
constexpr size_t E_LAYER = E_WIN + E_WBR + E_WOUT + E_WFI + E_WFO;
constexpr size_t WS_PROJ = 2 * E_LAYER * 2;
constexpr size_t WS_DT = WS_PROJ + (size_t)ROWS * NPROJ * 2;
constexpr size_t WS_XB = WS_DT + (size_t)ROWS * 16 * 4;
constexpr size_t WS_YMB = WS_XB + (size_t)ROWS * LDK * 2;
constexpr size_t WS_YHG = WS_YMB + (size_t)ROWS * LDK * 2;
constexpr size_t WS_YRG = WS_YHG + (size_t)ROWS * LDK * 2;
constexpr size_t WS_MRG = WS_YRG + (size_t)ROWS * LDK * 2;
constexpr size_t WS_END = WS_MRG + (size_t)ROWS * LDK * 2;
constexpr size_t WS_HB = WS_END + 256;
constexpr size_t WS_DTW = WS_HB + 2u * 2 * 16 * 3 * 2048 * 4;
constexpr size_t WS_TOTAL = WS_DTW + 2u * 16 * 1024 * 4;
constexpr size_t O_YP = 0, O_YS = 33554432, O_SSM_P = 34078720, O_SCV_P = 38273024, O_HG_P = 38469632, O_RG_P = 42663936, O_RCV_P = 42696704,
                 O_SSM_S = 42795008, O_SCV_S = 46989312, O_HG_S = 47185920, O_RG_S = 51380224, O_RCV_S = 51412992;
constexpr int REP0 = 1, REP1 = 1, REP2 = 1, REP3 = 1;
constexpr int LDS_BYTES = 144 * 1024;

enum { I_XP = 0, I_XS, I_SSM, I_SCV, I_HG, I_RG, I_RCV, I_NMIX, I_WIN, I_MCW, I_MCB, I_DTB, I_ALOG, I_MBD, I_MBNW, I_LBL, I_HGNW, I_RCW, I_RCB, I_RWA, I_RBA, I_RWI, I_RBI, I_RLAM, I_WBR, I_WOUT, I_NFFN, I_WFI, I_WFO, I_NFIN };

struct Params { const float* in[30]; float* out; unsigned char* ws; int rep[4]; };

DEVI int tidx(int wv_) { int t = ((wv_ & 3) << 6) | (int)__builtin_amdgcn_mbcnt_hi(~0u, __builtin_amdgcn_mbcnt_lo(~0u, 0u)); asm volatile("" : "+v"(t)); return t; }
DEVI float shfli(float v, int srcl) { return __int_as_float(__builtin_amdgcn_ds_bpermute(srcl << 2, __float_as_int(v))); }
DEVI float shflx(float v, int m, int lane) { return shfli(v, lane ^ m); }
DEVI bf16_t f2bf(float f) { unsigned u = __float_as_uint(f); u += 0x7fffu + ((u >> 16) & 1u); return (bf16_t)(u >> 16); }
DEVI float bf2f(bf16_t h) { return __uint_as_float(((unsigned)h) << 16); }
DEVI float sigm(float x) { return 1.f / (1.f + __expf(-x)); }
DEVI float silu(float x) { return x / (1.f + __expf(-x)); }
DEVI float softplus(float x) { return x > 20.f ? x : __logf(1.f + __expf(x)); }
DEVI float gelu_t(float x) { float u = 0.7978845608f * (x + 0.044715f * x * x * x); return x * sigm(2.f * u); }
DEVI float cexp(float x) { return __expf(fminf(x, 80.f)); }

DEVI const float* xrow_in(const Params& p, int seg, int r) {
    if (r < ROWS_P) { int b = r >> 9, tt = r & 511; return p.in[I_XP] + ((size_t)(b * 2048 + seg * SEGT + tt)) * D; }
    return p.in[I_XS] + (size_t)(r - ROWS_P) * D;
}
DEVI float* xrow_out(const Params& p, int seg, int r) {
    if (r < ROWS_P) { int b = r >> 9, tt = r & 511; return p.out + O_YP + ((size_t)(b * 2048 + seg * SEGT + tt)) * D; }
    return p.out + O_YS + (size_t)(r - ROWS_P) * D;
}

DEVI int perm32(int rho) { int n = rho >> 4, i = rho & 15; return 8 * (i >> 2) + 4 * n + (i & 3); }
DEVI int map_win(int n) { n = (n & ~31) + perm32(n & 31); return n < 3072 ? n : n + 16; }
DEVI int map_wfi(int n) { int T = n >> 7, nf = (n >> 4) & 7, i = n & 15, G = nf >> 2, h = (nf >> 1) & 1, s = nf & 1; return s * FFH + 64 * T + 32 * G + 8 * (i >> 2) + 4 * h + (i & 3); }

DEVI void transpose_tile(const float* src, int ldsrc, bf16_t* dst, int K, int k0, int n0, int mode, float* tile  , int wv_) {
    const int tid = tidx(wv_), c = tid & 63, rq = tid >> 6;
    int n = n0 + c, sn = mode == 1 ? map_win(n) : (mode == 2 ? map_wfi(n) : (mode == 3 ? (n & ~31) + perm32(n & 31) : n));
#pragma unroll
    for (int rr = 0; rr < 16; ++rr) { int kl = rr * 4 + rq; tile[kl * 65 + c] = sn >= 0 ? src[(size_t)(k0 + kl) * ldsrc + sn] : 0.f; }
    __syncthreads();
#pragma unroll
    for (int rr = 0; rr < 16; ++rr) { int nl = rr * 4 + rq; dst[(size_t)(n0 + nl) * K + k0 + c] = f2bf(tile[c * 65 + nl]); }
    __syncthreads();
}

DEVI void phase_prep(const Params& p, char* lds, int wv_) {
    float* tile = (float*)lds;
    bf16_t* wsb = (bf16_t*)p.ws;
    constexpr int T_WIN = 16 * 192, T_WBR = 3 * 256, T_WOUT = 256, T_WFI = 16 * 88, T_WFO = 44 * 16, T_L = T_WIN + T_WBR + T_WOUT + T_WFI + T_WFO;
    {   float* dtw = (float*)(p.ws + WS_DTW);
        for (int e = blockIdx.x * 256 + tidx(wv_); e < 32768; e += gridDim.x * 256) { int l = e >> 14, j = (e >> 10) & 15, k = e & 1023; dtw[e] = p.in[I_WIN][(size_t)l * 1024 * 12304 + (size_t)k * 12304 + 3072 + j]; } }
    for (int t = blockIdx.x; t < 2 * T_L; t += gridDim.x) {
        int l = t / T_L, j = t % T_L;
        bf16_t* wl = wsb + (size_t)l * E_LAYER;
        if (j < T_WIN) { int kt = j & 15, nt = j >> 4; transpose_tile(p.in[I_WIN] + (size_t)l * 1024 * 12304, 12304, wl, LDK, kt * 64, nt * 64, 1, tile, wv_); continue; }
        j -= T_WIN;
        if (j < T_WBR) { int k = j >> 8, jj = j & 255, kt = jj & 15, nt = jj >> 4;
            transpose_tile(p.in[I_WBR] + ((size_t)l * 3 + k) * 1024 * 1024, 1024, wl + E_WIN + (size_t)k * 1024 * LDK, LDK, kt * 64, nt * 64, 3, tile, wv_); continue; }
        j -= T_WBR;
        if (j < T_WOUT) { int kt = j & 15, nt = j >> 4; transpose_tile(p.in[I_WOUT] + (size_t)l * 1024 * 1024, 1024, wl + E_WIN + E_WBR, LDK, kt * 64, nt * 64, 0, tile, wv_); continue; }
        j -= T_WOUT;
        if (j < T_WFI) { int kt = j & 15, nt = j >> 4; transpose_tile(p.in[I_WFI] + (size_t)l * 1024 * 5632, 5632, wl + E_WIN + E_WBR + E_WOUT, LDK, kt * 64, nt * 64, 2, tile, wv_); continue; }
        j -= T_WFI;
        { int kt = j % 44, nt = j / 44; transpose_tile(p.in[I_WFO] + (size_t)l * 2816 * 1024, 1024, wl + E_WIN + E_WBR + E_WOUT + E_WFI, LDF, kt * 64, nt * 64, 0, tile, wv_); }
    }
}

DEVI void phase_norm(const Params& p, int seg, int nrows, const float* w, bool from_input, int ldt  , char* lds, int wv_) {
    bf16_t* xb = (bf16_t*)(p.ws + WS_XB); float* dtb = (float*)(p.ws + WS_DT);
    const int lane = tidx(wv_) & 63, wv = tidx(wv_) >> 6;
    float* dw = (float*)lds;
    if (ldt >= 0) { const float* dtw = (const float*)(p.ws + WS_DTW) + ldt * 16384; f32x4 t_[16];
#pragma unroll
        for (int u = 0; u < 16; ++u) t_[u] = *(const f32x4*)(dtw + (tidx(wv_) + 256 * u) * 4);
#pragma unroll
        for (int u = 0; u < 16; ++u) *(f32x4*)(dw + (tidx(wv_) + 256 * u) * 4) = t_[u];
        __syncthreads(); }
    for (int r = blockIdx.x * 4 + wv; r < nrows; r += gridDim.x * 4) {
        const float* x = from_input ? xrow_in(p, seg, r) : xrow_out(p, seg, r);
        f32x4 v[4]; float ss = 0.f;
#pragma unroll
        for (int i = 0; i < 4; ++i) { v[i] = *(const f32x4*)(x + i * 256 + lane * 4); ss += v[i][0] * v[i][0] + v[i][1] * v[i][1] + v[i][2] * v[i][2] + v[i][3] * v[i][3]; }
#pragma unroll
        for (int o = 32; o >= 1; o >>= 1) ss += shflx(ss, o, lane);
        float rs = rsqrtf(ss * (1.f / 1024.f) + 1e-6f);
#pragma unroll
        for (int i = 0; i < 4; ++i) { f32x4 wv4 = *(const f32x4*)(w + i * 256 + lane * 4); us4 o;
            v[i][0] *= rs * wv4[0]; v[i][1] *= rs * wv4[1]; v[i][2] *= rs * wv4[2]; v[i][3] *= rs * wv4[3];
            o[0] = f2bf(v[i][0]); o[1] = f2bf(v[i][1]); o[2] = f2bf(v[i][2]); o[3] = f2bf(v[i][3]);
            *(us4*)(xb + (size_t)r * LDK + i * 256 + lane * 4) = o; }
        if (ldt >= 0) {
            float d[16];
#pragma unroll
            for (int j = 0; j < 16; ++j) { float s = 0.f;
#pragma unroll
                for (int i = 0; i < 4; ++i) { f32x4 ww = *(const f32x4*)(dw + j * 1024 + i * 256 + lane * 4); s += v[i][0] * ww[0] + v[i][1] * ww[1] + v[i][2] * ww[2] + v[i][3] * ww[3]; }
                d[j] = s; }
            { const bool hi = lane & 32;
#pragma unroll
              for (int i = 0; i < 8; ++i) { float send = hi ? d[i] : d[i + 8], keep = hi ? d[i + 8] : d[i]; d[i] = keep + shfli(send, lane ^ 32); } }
            { const bool hi = lane & 16;
#pragma unroll
              for (int i = 0; i < 4; ++i) { float send = hi ? d[i] : d[i + 4], keep = hi ? d[i + 4] : d[i]; d[i] = keep + shfli(send, lane ^ 16); } }
            { const bool hi = lane & 8;
#pragma unroll
              for (int i = 0; i < 2; ++i) { float send = hi ? d[i] : d[i + 2], keep = hi ? d[i + 2] : d[i]; d[i] = keep + shfli(send, lane ^ 8); } }
            { const bool hi = lane & 4; float send = hi ? d[0] : d[1], keep = hi ? d[1] : d[0]; d[0] = keep + shfli(send, lane ^ 4); }
            d[0] += shfli(d[0], lane ^ 2); d[0] += shfli(d[0], lane ^ 1);
            if ((lane & 3) == 0) { int j = lane >> 2; dtb[(size_t)r * 16 + j] = softplus(d[0] + p.in[I_DTB][ldt * 16 + j]); }
        }
    }
    if (ldt >= 0) __syncthreads();
}
DEVI void phase_final_norm(const Params& p, int seg, int nrows, int wv_) {
    const float* w = p.in[I_NFIN];
    const int lane = tidx(wv_) & 63, wv = tidx(wv_) >> 6;
    for (int r = blockIdx.x * 4 + wv; r < nrows; r += gridDim.x * 4) {
        float* x = xrow_out(p, seg, r);
        f32x4 v[4]; float ss = 0.f;
#pragma unroll
        for (int i = 0; i < 4; ++i) { v[i] = *(const f32x4*)(x + i * 256 + lane * 4); ss += v[i][0] * v[i][0] + v[i][1] * v[i][1] + v[i][2] * v[i][2] + v[i][3] * v[i][3]; }
#pragma unroll
        for (int o = 32; o >= 1; o >>= 1) ss += shflx(ss, o, lane);
        float rs = rsqrtf(ss * (1.f / 1024.f) + 1e-6f);
#pragma unroll
        for (int i = 0; i < 4; ++i) { f32x4 wv4 = *(const f32x4*)(w + i * 256 + lane * 4); f32x4 o;
            o[0] = v[i][0] * rs * wv4[0]; o[1] = v[i][1] * rs * wv4[1]; o[2] = v[i][2] * rs * wv4[2]; o[3] = v[i][3] * rs * wv4[3];
            *(f32x4*)(x + i * 256 + lane * 4) = o; }
    }
}
DEVI void phase_mbnorm(const Params& p, int l, int nrows, int wv_) {
    bf16_t* y = (bf16_t*)(p.ws + WS_YMB); const float* w = p.in[I_MBNW] + l * 1024;
    const int lane = tidx(wv_) & 63, wv = tidx(wv_) >> 6;
    for (int it = blockIdx.x * 4 + wv; it < nrows * 4; it += gridDim.x * 4) {
        int r = it >> 2, g = it & 3; bf16_t* yp = y + (size_t)r * LDK + g * 256 + lane * 4;
        us4 v = *(const us4*)yp; float f0 = bf2f(v[0]), f1 = bf2f(v[1]), f2 = bf2f(v[2]), f3 = bf2f(v[3]);
        float ss = f0 * f0 + f1 * f1 + f2 * f2 + f3 * f3;
#pragma unroll
        for (int o = 32; o >= 1; o >>= 1) ss += shflx(ss, o, lane);
        float rs = rsqrtf(ss * (1.f / 256.f) + 1e-6f); f32x4 wv4 = *(const f32x4*)(w + g * 256 + lane * 4);
        us4 o; o[0] = f2bf(f0 * rs * wv4[0]); o[1] = f2bf(f1 * rs * wv4[1]); o[2] = f2bf(f2 * rs * wv4[2]); o[3] = f2bf(f3 * rs * wv4[3]);
        *(us4*)yp = o;
    }
}

#define WAIT_V(n) asm volatile("s_waitcnt vmcnt(" #n ")" ::: "memory")
#define RAW_BAR() do { asm volatile("" ::: "memory"); __builtin_amdgcn_s_barrier(); asm volatile("" ::: "memory"); } while (0)
template <int NF>
DEVI void stage_a(const bf16_t* A, int K, int t, char* st, int tid, size_t soff) {
    const size_t o = soff + (size_t)t * 32;
#pragma unroll
    for (int i = 0; i < 4; ++i) __builtin_amdgcn_global_load_lds((const unsigned*)(A + o + (size_t)i * 64 * K), (unsigned*)(st + tid * 16 + i * 4096), 16, 0, 0);
}
template <int NF>
DEVI void stage_b(const bf16_t* Bt, int K, int t, char* st, int tid, size_t soff) {
    const size_t o = soff + (size_t)t * 32;
#pragma unroll
    for (int i = 0; i < NF / 2; ++i) __builtin_amdgcn_global_load_lds((const unsigned*)(Bt + o + (size_t)i * 64 * K), (unsigned*)(st + 16384 + tid * 16 + i * 4096), 16, 0, 0);
}
template <int NF>
DEVI void gemm_kloop(f32x4 (&acc)[8][NF], const bf16_t* A, const bf16_t* Bt, int K, int ld, char* lds, int wv_) {
    constexpr int STAGE = 16384 + NF * 2048;
    const int tid = tidx(wv_), lane = tid & 63, wid = tid >> 6, wr = wid >> 1, wc = wid & 1, fr = lane & 15, fq = lane >> 4;
    const int fo = fr * 64 + ((fq ^ (fr >> 2)) & 3) * 16;
    const int aoff = wr * 8192 + fo, boff = 16384 + wc * NF * 1024 + fo;
    const size_t soff = (size_t)(tid >> 2) * ld + (((tid & 3) ^ ((tid >> 4) & 3)) * 8);
    const int nt = K >> 5;
    WAIT_V(0); RAW_BAR();
    stage_a<NF>(A, ld, 0, lds, tid, soff); stage_b<NF>(Bt, ld, 0, lds, tid, soff);
    stage_a<NF>(A, ld, 1, lds + STAGE, tid, soff); stage_b<NF>(Bt, ld, 1, lds + STAGE, tid, soff);
    stage_a<NF>(A, ld, 2, lds + 2 * STAGE, tid, soff); stage_b<NF>(Bt, ld, 2, lds + 2 * STAGE, tid, soff);
    if (NF == 8) WAIT_V(16); else WAIT_V(12);
    RAW_BAR();
    bf16x8 a[8], a01[2][2], b[2][NF];
    a01[0][0] = *(const bf16x8*)(lds + aoff); a01[0][1] = *(const bf16x8*)(lds + aoff + 1024);
#pragma unroll
    for (int n = 0; n < NF; ++n) b[0][n] = *(const bf16x8*)(lds + boff + n * 1024);
#define MMA_G(g_, P_) _Pragma("unroll") for (int n = 0; n < NF; ++n) acc[g_][n] = __builtin_amdgcn_mfma_f32_16x16x32_bf16(b[P_][n], a[g_], acc[g_][n], 0, 0, 0)
#define KBODY(T_, P_, Q_) do { \
        const int T = (T_); const char* st = lds + (T & 3) * STAGE; const char* stn = lds + ((T + 1) & 3) * STAGE; char* st3 = lds + ((T + 3) & 3) * STAGE; \
        a[0] = a01[P_][0]; a[1] = a01[P_][1]; \
        __builtin_amdgcn_sched_barrier(0); a[2] = *(const bf16x8*)(st + aoff + 2 * 1024); MMA_G(0, P_); \
        __builtin_amdgcn_sched_barrier(0); a[3] = *(const bf16x8*)(st + aoff + 3 * 1024); MMA_G(1, P_); \
        __builtin_amdgcn_sched_barrier(0); a[4] = *(const bf16x8*)(st + aoff + 4 * 1024); MMA_G(2, P_); \
        __builtin_amdgcn_sched_barrier(0); a[5] = *(const bf16x8*)(st + aoff + 5 * 1024); MMA_G(3, P_); \
        __builtin_amdgcn_sched_barrier(0); \
        if (T + 2 < nt) { if (NF == 8) WAIT_V(8); else WAIT_V(6); } else WAIT_V(0); \
        RAW_BAR(); \
        __builtin_amdgcn_sched_barrier(0); a[6] = *(const bf16x8*)(st + aoff + 6 * 1024); \
        if (T + 3 < nt) stage_a<NF>(A, ld, T + 3, st3, tid, soff); \
        _Pragma("unroll") for (int n = 0; n < NF / 2; ++n) b[Q_][n] = *(const bf16x8*)(stn + boff + n * 1024); \
        MMA_G(4, P_); \
        __builtin_amdgcn_sched_barrier(0); a[7] = *(const bf16x8*)(st + aoff + 7 * 1024); \
        if (T + 3 < nt) stage_b<NF>(Bt, ld, T + 3, st3, tid, soff); \
        _Pragma("unroll") for (int n = NF / 2; n < NF; ++n) b[Q_][n] = *(const bf16x8*)(stn + boff + n * 1024); \
        MMA_G(5, P_); \
        __builtin_amdgcn_sched_barrier(0); a01[Q_][0] = *(const bf16x8*)(stn + aoff); MMA_G(6, P_); \
        __builtin_amdgcn_sched_barrier(0); a01[Q_][1] = *(const bf16x8*)(stn + aoff + 1024); MMA_G(7, P_); \
        __builtin_amdgcn_sched_barrier(0); } while (0)
    for (int t = 0; t < nt; t += 2) { KBODY(t, 0, 1); KBODY(t + 1, 1, 0); }
#undef KBODY
#undef MMA_G
}
DEVI bool next_tile(int it, int MT, int NT, int& mt, int& nt, int wv_) {
    const int x = (wv_ >> 2) & 7, bl = (wv_ >> 5) & 511, G8 = (wv_ >> 14) & 511;
    int nI = (MT - x + 7) >> 3; long j = (long)it * G8 + bl;
    if (j >= (long)nI * NT) return false;
    int i = (int)(j % nI); nt = (int)(j / nI); mt = x + 8 * i; return true;
}
#define ZERO_ACC(a, NF_) _Pragma("unroll") for (int m_ = 0; m_ < 8; ++m_) _Pragma("unroll") for (int n_ = 0; n_ < NF_; ++n_) a[m_][n_] = (f32x4){0.f, 0.f, 0.f, 0.f}
#define EPI_IDS const int lane = tidx(wv_) & 63, wid = tidx(wv_) >> 6, wr = wid >> 1, wc = wid & 1, fr = lane & 15, fq = lane >> 4

DEVI void proj_store_row(const f32x4 (&accm)[8], bf16_t* prow, float c1, float c3, bool issig, bool isact) {
#pragma unroll
    for (int q = 0; q < 4; ++q) { __builtin_amdgcn_sched_barrier(0); us8 o;
#pragma unroll
        for (int s = 0; s < 2; ++s)
#pragma unroll
            for (int j = 0; j < 4; ++j) { float x = accm[2 * q + s][j];
                float u = x * (c1 + c3 * x * x); float sg = __builtin_amdgcn_rcpf(1.f + __expf(-u)); float y = sg * (issig ? 1.f : x);
                o[4 * s + j] = f2bf(isact ? y : x); }
        *(us8*)(prow + q * 32) = o; }
}
DEVI void phase_proj(const Params& p, int l, int MT, char* lds, int wv_) {
    const bf16_t* xb = (const bf16_t*)(p.ws + WS_XB); const bf16_t* wt = (const bf16_t*)p.ws + (size_t)l * E_LAYER;
    bf16_t* proj = (bf16_t*)(p.ws + WS_PROJ);
    int mt, nt;
    for (int it = 0; next_tile(it, MT, 48, mt, nt, wv_); ++it) {
        f32x4 acc[8][8]; ZERO_ACC(acc, 8);
        gemm_kloop<8>(acc, xb + (size_t)mt * 256 * LDK, wt + (size_t)nt * 256 * LDK, 1024, LDK, lds, wv_);
        EPI_IDS;
        const int sg = nt >> 2;
        const int ty = (sg == 0 || sg == 3 || sg == 6) ? 1 : (sg == 7 ? 2 : (sg >= 9 ? 3 : 0));
        bf16_t* pbase = proj + (size_t)(mt * 256 + wr * 128 + fr) * NPROJ + nt * 256 + wc * 128 + fq * 8;
        const float c1 = ty == 2 ? 1.5957691216f : 1.f, c3 = ty == 2 ? 0.0713548163f : 0.f;
#pragma unroll
        for (int m = 0; m < 8; ++m) {
#pragma unroll
            for (int n = 0; n < 8; ++n) asm volatile("" : "+v"(acc[m][n]) :: "memory");
            proj_store_row(acc[m], pbase + (size_t)m * 16 * NPROJ, c1, c3, ty == 3, ty != 0); }
    }
}
DEVI void phase_merge(const Params& p, int l, int MT, char* lds, int wv_) {
    const bf16_t* wt = (const bf16_t*)p.ws + (size_t)l * E_LAYER + E_WIN; const bf16_t* proj = (const bf16_t*)(p.ws + WS_PROJ);
    bf16_t* mrg = (bf16_t*)(p.ws + WS_MRG);
    int mt, nt;
    for (int it = 0; next_tile(it, MT, 8, mt, nt, wv_); ++it) {
        f32x4 tot[8][4]; ZERO_ACC(tot, 4);
#pragma unroll 1
        for (int k = 0; k < 3; ++k) {
            const bf16_t* y = (const bf16_t*)(p.ws + WS_YMB + (size_t)k * ROWS * LDK * 2);
            f32x4 acc[8][4]; ZERO_ACC(acc, 4);
            gemm_kloop<4>(acc, y + (size_t)mt * 256 * LDK, wt + (size_t)k * 1024 * LDK + (size_t)nt * 128 * LDK, 1024, LDK, lds, wv_);
            EPI_IDS;
#pragma unroll
            for (int m = 0; m < 8; ++m) { int row = mt * 256 + wr * 128 + m * 16 + fr; asm volatile("" ::: "memory");
#pragma unroll
                for (int q = 0; q < 2; ++q) { int col = nt * 128 + wc * 64 + 32 * q + fq * 8; us8 g = *(const us8*)(proj + (size_t)row * NPROJ + PC_MG + k * 1024 + col);
#pragma unroll
                    for (int s = 0; s < 2; ++s)
#pragma unroll
                        for (int j = 0; j < 4; ++j) tot[m][2 * q + s][j] += acc[m][2 * q + s][j] * bf2f(g[4 * s + j]); } }
        }
        EPI_IDS;
#pragma unroll
        for (int m = 0; m < 8; ++m) { int row = mt * 256 + wr * 128 + m * 16 + fr;
#pragma unroll
            for (int q = 0; q < 2; ++q) { int col = nt * 128 + wc * 64 + 32 * q + fq * 8; us8 o;
#pragma unroll
                for (int s = 0; s < 2; ++s)
#pragma unroll
                    for (int j = 0; j < 4; ++j) o[4 * s + j] = f2bf(tot[m][2 * q + s][j]);
                *(us8*)(mrg + (size_t)row * LDK + col) = o; } }
    }
}
DEVI void phase_resid(const Params& p, int seg, int MT, const bf16_t* A, int K, int ld, const bf16_t* Bt, bool from_input, char* lds, int wv_) {
    int mt, nt;
    for (int it = 0; next_tile(it, MT, 8, mt, nt, wv_); ++it) {
        f32x4 acc[8][4]; ZERO_ACC(acc, 4);
        gemm_kloop<4>(acc, A + (size_t)mt * 256 * ld, Bt + (size_t)nt * 128 * ld, K, ld, lds, wv_);
        EPI_IDS;
#pragma unroll
        for (int m = 0; m < 8; ++m) { int row = mt * 256 + wr * 128 + m * 16 + fr;
            const float* xi = from_input ? xrow_in(p, seg, row) : xrow_out(p, seg, row); float* xo = xrow_out(p, seg, row);
#pragma unroll
            for (int n = 0; n < 4; ++n) { int col = nt * 128 + wc * 64 + n * 16 + fq * 4; f32x4 v = *(const f32x4*)(xi + col); *(f32x4*)(xo + col) = v + acc[m][n]; } }
    }
}
DEVI void phase_ffn_in(const Params& p, int l, int MT, char* lds, int wv_) {
    const bf16_t* xb = (const bf16_t*)(p.ws + WS_XB); const bf16_t* wt = (const bf16_t*)p.ws + (size_t)l * E_LAYER + E_WIN + E_WBR + E_WOUT;
    bf16_t* act = (bf16_t*)(p.ws + WS_PROJ);
    int mt, nt;
    for (int it = 0; next_tile(it, MT, 22, mt, nt, wv_); ++it) {
        f32x4 acc[8][8]; ZERO_ACC(acc, 8);
        gemm_kloop<8>(acc, xb + (size_t)mt * 256 * LDK, wt + (size_t)nt * 256 * LDK, 1024, LDK, lds, wv_);
        EPI_IDS;
#pragma unroll
        for (int m = 0; m < 8; ++m) { int row = mt * 256 + wr * 128 + m * 16 + fr;
#pragma unroll
            for (int n = 0; n < 8; ++n) asm volatile("" : "+v"(acc[m][n]) :: "memory");
#pragma unroll
            for (int G = 0; G < 2; ++G) { int col = (nt * 2 + wc) * 64 + 32 * G + fq * 8; us8 o;
#pragma unroll
                for (int h = 0; h < 2; ++h)
#pragma unroll
                    for (int j = 0; j < 4; ++j) o[4 * h + j] = f2bf(silu(acc[m][4 * G + 2 * h][j]) * acc[m][4 * G + 2 * h + 1][j]);
                *(us8*)(act + (size_t)row * LDF + col) = o; } }
    }
}

struct Seq { int row0, nchunk, Q, b, samp, seg; };
DEVI Seq make_seq(int seg, int sq) { Seq s; s.seg = seg; if (sq < 16) { s.row0 = sq * SEGT; s.nchunk = 8; s.Q = 64; s.b = sq; s.samp = 0; } else { s.b = sq - 16; s.row0 = ROWS_P + s.b * 32; s.nchunk = 1; s.Q = 32; s.samp = 1; } return s; }

template <int NF, int KS>
DEVI void lds_mma(f32x4* acc, const bf16_t* X, int ldx, int m0, const bf16_t* Y, int ldy, int n0, int wv_) {
    const int lane = tidx(wv_) & 63, fr = lane & 15, fq = lane >> 4;
#pragma unroll
    for (int ks = 0; ks < KS; ++ks) {
        bf16x8 a = *(const bf16x8*)(X + (m0 + fr) * ldx + ks * 32 + fq * 8);
#pragma unroll
        for (int nf = 0; nf < NF; ++nf) { bf16x8 b = *(const bf16x8*)(Y + (n0 + nf * 16 + fr) * ldy + ks * 32 + fq * 8); acc[nf] = __builtin_amdgcn_mfma_f32_16x16x32_bf16(a, b, acc[nf], 0, 0, 0); }
    }
}

DEVI void conv_load(uint4 (&r)[4], const bf16_t* proj, int row0, int tq, int pcol) {
#pragma unroll
    for (int k = 0; k < 4; ++k) { int ts = tq - 3 + k; ts = ts < 0 ? 0 : ts; r[k] = *(const uint4*)(proj + (size_t)(row0 + ts) * NPROJ + pcol); }
}
DEVI void touch4(uint4& v) { asm volatile("" : "+v"(v.x), "+v"(v.y), "+v"(v.z), "+v"(v.w)); }
DEVI void conv_compute(const uint4 (&r)[4], int tq, const float* hl, const float* cwl, int HC, int cl, float (&out)[8], float (&raw)[8]) {
    { f32x4 b0 = *(const f32x4*)(cwl + 4 * HC + cl), b1 = *(const f32x4*)(cwl + 4 * HC + cl + 4);
      out[0] = b0[0]; out[1] = b0[1]; out[2] = b0[2]; out[3] = b0[3]; out[4] = b1[0]; out[5] = b1[1]; out[6] = b1[2]; out[7] = b1[3]; }
#pragma unroll
    for (int k = 0; k < 4; ++k) {
        const int ts = tq - 3 + k; float v[8];
        v[0] = __uint_as_float(r[k].x << 16); v[1] = __uint_as_float(r[k].x & 0xffff0000u); v[2] = __uint_as_float(r[k].y << 16); v[3] = __uint_as_float(r[k].y & 0xffff0000u);
        v[4] = __uint_as_float(r[k].z << 16); v[5] = __uint_as_float(r[k].z & 0xffff0000u); v[6] = __uint_as_float(r[k].w << 16); v[7] = __uint_as_float(r[k].w & 0xffff0000u);
        if (k < 3) { int hi = 3 + ts; hi = hi < 0 ? 0 : (hi > 2 ? 2 : hi); const bool uh = ts < 0;
            f32x4 h0 = *(const f32x4*)(hl + hi * HC + cl), h1 = *(const f32x4*)(hl + hi * HC + cl + 4);
            v[0] = uh ? h0[0] : v[0]; v[1] = uh ? h0[1] : v[1]; v[2] = uh ? h0[2] : v[2]; v[3] = uh ? h0[3] : v[3];
            v[4] = uh ? h1[0] : v[4]; v[5] = uh ? h1[1] : v[5]; v[6] = uh ? h1[2] : v[6]; v[7] = uh ? h1[3] : v[7]; }
        f32x4 w0 = *(const f32x4*)(cwl + k * HC + cl), w1 = *(const f32x4*)(cwl + k * HC + cl + 4);
        out[0] += v[0] * w0[0]; out[1] += v[1] * w0[1]; out[2] += v[2] * w0[2]; out[3] += v[3] * w0[3];
        out[4] += v[4] * w1[0]; out[5] += v[5] * w1[1]; out[6] += v[6] * w1[2]; out[7] += v[7] * w1[3];
        if (k == 3) {
#pragma unroll
            for (int e = 0; e < 8; ++e) raw[e] = v[e]; }
    }
}

template <int ROWB>
DEVI void stage_raw(const char* g0, size_t ldgB, char* dst, int tid) {
#pragma unroll
    for (int i = 0; i < ROWB / 64; ++i) { int b = tid * 16 + i * 4096, row = b / ROWB, cb = b % ROWB;
        __builtin_amdgcn_global_load_lds((const unsigned*)(g0 + (size_t)row * ldgB + cb), (unsigned*)(dst + b), 16, 0, 0); }
}
DEVI void conv_lds(const bf16_t* rawt, int RS, int t, int cloc, const float* hl, const float* cwl, int HC, int cl, float (&out)[8], float (&raw)[8]) {
    { f32x4 b0 = *(const f32x4*)(cwl + 4 * HC + cl), b1 = *(const f32x4*)(cwl + 4 * HC + cl + 4);
      out[0] = b0[0]; out[1] = b0[1]; out[2] = b0[2]; out[3] = b0[3]; out[4] = b1[0]; out[5] = b1[1]; out[6] = b1[2]; out[7] = b1[3]; }
#pragma unroll
    for (int k = 0; k < 4; ++k) {
        const int tt = t - 3 + k; const int tc = tt < 0 ? 0 : tt; float v[8];
        const uint4 r = *(const uint4*)(rawt + tc * RS + cloc);
        v[0] = __uint_as_float(r.x << 16); v[1] = __uint_as_float(r.x & 0xffff0000u); v[2] = __uint_as_float(r.y << 16); v[3] = __uint_as_float(r.y & 0xffff0000u);
        v[4] = __uint_as_float(r.z << 16); v[5] = __uint_as_float(r.z & 0xffff0000u); v[6] = __uint_as_float(r.w << 16); v[7] = __uint_as_float(r.w & 0xffff0000u);
        if (k < 3) { int hi = 3 + tt; hi = hi < 0 ? 0 : (hi > 2 ? 2 : hi); const bool uh = tt < 0;
            f32x4 h0 = *(const f32x4*)(hl + hi * HC + cl), h1 = *(const f32x4*)(hl + hi * HC + cl + 4);
            v[0] = uh ? h0[0] : v[0]; v[1] = uh ? h0[1] : v[1]; v[2] = uh ? h0[2] : v[2]; v[3] = uh ? h0[3] : v[3];
            v[4] = uh ? h1[0] : v[4]; v[5] = uh ? h1[1] : v[5]; v[6] = uh ? h1[2] : v[6]; v[7] = uh ? h1[3] : v[7]; }
        f32x4 w0 = *(const f32x4*)(cwl + k * HC + cl), w1 = *(const f32x4*)(cwl + k * HC + cl + 4);
        out[0] += v[0] * w0[0]; out[1] += v[1] * w0[1]; out[2] += v[2] * w0[2]; out[3] += v[3] * w0[3];
        out[4] += v[4] * w1[0]; out[5] += v[5] * w1[1]; out[6] += v[6] * w1[2]; out[7] += v[7] * w1[3];
        if (k == 3) {
#pragma unroll
            for (int e = 0; e < 8; ++e) raw[e] = v[e]; }
    }
}

DEVI void ssd_unit(const Params& p, int l, Seq sq, int hd, char* lds, int wv_) {
    bf16_t* Bm = (bf16_t*)lds;
    bf16_t* R2 = (bf16_t*)(lds + 17408);
    bf16_t* xT = (bf16_t*)(lds + 35840);
    bf16_t* hb = (bf16_t*)(lds + 45056);
    float* fl = (float*)(lds + 62464);
    const int tid = tidx(wv_), lane = tid & 63, w = tid >> 6, fr = lane & 15, fq = lane >> 4;
    const bf16_t* proj = (const bf16_t*)(p.ws + WS_PROJ); const float* dtb = (const float*)(p.ws + WS_DT); bf16_t* ymb = (bf16_t*)(p.ws + WS_YMB);
    const int g = hd >> 2;
    const float a = -__expf(p.in[I_ALOG][l * 16 + hd]), Dv = p.in[I_MBD][l * 16 + hd];
    const float* cw = p.in[I_MCW] + (size_t)l * 4 * 2048; const float* cbias = p.in[I_MCB] + l * 2048;
    float* cwl = (float*)(lds + 63488);
    float* hl = (float*)(lds + 69888);
    const float* st_in; float* st_out; const float* hist; float* hist_out; float* hist_out2 = nullptr;
    float* hbuf = (float*)(p.ws + WS_HB);
    if (sq.samp) { st_in = p.in[I_SSM] + ((size_t)(l * 16 + sq.b) * 16 + hd) * 8192; st_out = p.out + O_SSM_S + ((size_t)(l * 16 + sq.b) * 16 + hd) * 8192;
        hist = p.in[I_SCV] + (size_t)(l * 16 + sq.b) * 3 * 2048; hist_out = p.out + O_SCV_S + (size_t)(l * 16 + sq.b) * 3 * 2048; }
    else { st_out = p.out + O_SSM_P + ((size_t)(l * 16 + sq.b) * 16 + hd) * 8192; st_in = sq.seg ? st_out : nullptr;
        hist_out = hbuf + ((size_t)((sq.seg & 1) * 2 + l) * 16 + sq.b) * 3 * 2048; hist = sq.seg ? hbuf + ((size_t)(((sq.seg + 1) & 1) * 2 + l) * 16 + sq.b) * 3 * 2048 : nullptr;
        if (sq.seg == NSEG - 1) hist_out2 = p.out + O_SCV_P + (size_t)(l * 16 + sq.b) * 3 * 2048; }
    for (int idx = tid; idx < 1600; idx += 256) { int k = idx / 320, cc = idx - k * 320; int ch = cc < 64 ? hd * 64 + cc : (cc < 192 ? 1024 + g * 128 + (cc - 64) : 1536 + g * 128 + (cc - 192));
        cwl[idx] = k < 4 ? cw[k * 2048 + ch] : cbias[ch];
        if (idx < 960) hl[idx] = hist ? hist[k * 2048 + ch] : 0.f; }
    f32x4 hacc[8];
#pragma unroll
    for (int nf = 0; nf < 8; ++nf)
#pragma unroll
        for (int r = 0; r < 4; ++r) { int pp = 16 * w + 4 * fq + r, n = 16 * nf + fr; float v = st_in ? st_in[pp * 128 + n] : 0.f; hacc[nf][r] = v; hb[pp * 136 + n] = f2bf(v); }
    bf16_t* rawX = (bf16_t*)(lds + 77568); bf16_t* rawB = (bf16_t*)(lds + 85760); bf16_t* rawC = (bf16_t*)(lds + 102144); bf16_t* rawZ = (bf16_t*)(lds + 118528); float* rawDt = (float*)(lds + 126720);
    const char* gx = (const char*)(proj + PC_XBC + hd * 64); const char* gb = (const char*)(proj + PC_XBC + 1024 + g * 128); const char* gc = (const char*)(proj + PC_XBC + 1536 + g * 128); const char* gz = (const char*)(proj + PC_Z + hd * 64);
    asm volatile("s_waitcnt vmcnt(0)" ::: "memory");
    {   const size_t ro = (size_t)sq.row0 * NPROJ * 2;
        stage_raw<128>(gx + ro, (size_t)NPROJ * 2, (char*)rawX, tid); stage_raw<256>(gb + ro, (size_t)NPROJ * 2, (char*)rawB, tid); stage_raw<256>(gc + ro, (size_t)NPROJ * 2, (char*)rawC, tid);
        stage_raw<128>(gz + ro, (size_t)NPROJ * 2, (char*)rawZ, tid); stage_raw<64>((const char*)(dtb + (size_t)sq.row0 * 16), 64, (char*)rawDt, tid); }
    for (int c = 0; c < sq.nchunk; ++c) {
        const int tid = tidx(wv_), lane = tid & 63, w = tid >> 6, fr = lane & 15, fq = lane >> 4;
        const int rowc = sq.row0 + c * 64; const bool lastc = (c == sq.nchunk - 1);
        const float* hlr = hl + (c & 1) * 960; float* hlw = hl + ((c + 1) & 1) * 960;
        asm volatile("s_waitcnt vmcnt(0)" ::: "memory");
        __syncthreads();
        if (w == 0) {
            float dt = lane < sq.Q ? rawDt[lane * 16 + hd] : 0.f; float v = dt * a;
#pragma unroll
            for (int o = 1; o < 64; o <<= 1) { float t = shfli(v, lane - o); if (lane >= o) v += t; }
            float last = shfli(v, 63);
            fl[lane] = v; fl[64 + lane] = dt; fl[128 + lane] = __expf(last - v) * dt; fl[192 + lane] = __expf(v);
        }
        __syncthreads();
        const float elast = __expf(fl[63]);
#pragma unroll
        for (int i = 0; i < 2; ++i) { int it = tid + 256 * i, t = it >> 3, c8 = (it & 7) * 8; float o[8], raw[8]; int ch = hd * 64 + c8; const bool tv = t < sq.Q;
            conv_lds(rawX, 64, t, c8, hlr, cwl, 320, c8, o, raw);
#pragma unroll
            for (int e = 0; e < 8; ++e) { float s_ = silu(o[e]); o[e] = tv ? s_ : 0.f; }
            if (t >= 61) {
#pragma unroll
                for (int e = 0; e < 8; ++e) hlw[(t - 61) * 320 + c8 + e] = raw[e]; }
            if (lastc && tv && t >= sq.Q - 3) {
#pragma unroll
                for (int e = 0; e < 8; ++e) { hist_out[(t - (sq.Q - 3)) * 2048 + ch + e] = raw[e]; if (hist_out2) hist_out2[(t - (sq.Q - 3)) * 2048 + ch + e] = raw[e]; } }
#pragma unroll
            for (int e = 0; e < 8; ++e) xT[(c8 + e) * 72 + t] = f2bf(o[e]); }
#pragma unroll
        for (int i = 0; i < 4; ++i) { int it = tid + 256 * i, t = it >> 4, c8 = (it & 15) * 8; float o[8], raw[8]; int ch = 1024 + g * 128 + c8; const bool tv = t < sq.Q;
            conv_lds(rawB, 128, t, c8, hlr, cwl, 320, 64 + c8, o, raw);
#pragma unroll
            for (int e = 0; e < 8; ++e) { float s_ = silu(o[e]); o[e] = tv ? s_ : 0.f; }
            if (t >= 61) {
#pragma unroll
                for (int e = 0; e < 8; ++e) hlw[(t - 61) * 320 + 64 + c8 + e] = raw[e]; }
            if (lastc && tv && (hd & 3) == 0 && t >= sq.Q - 3) {
#pragma unroll
                for (int e = 0; e < 8; ++e) { hist_out[(t - (sq.Q - 3)) * 2048 + ch + e] = raw[e]; if (hist_out2) hist_out2[(t - (sq.Q - 3)) * 2048 + ch + e] = raw[e]; } }
            us8 ov; float we = fl[128 + t];
#pragma unroll
            for (int e = 0; e < 8; ++e) { ov[e] = f2bf(o[e]); R2[(c8 + e) * 72 + t] = f2bf(o[e] * we); }
            *(us8*)(Bm + t * 136 + c8) = ov; }
        __syncthreads();
#pragma unroll
        for (int nf = 0; nf < 8; ++nf) hacc[nf] *= elast;
        lds_mma<8, 2>(hacc, xT, 72, 16 * w, R2, 72, 0, wv_);
        __syncthreads();
#pragma unroll
        for (int i = 0; i < 4; ++i) { int it = tid + 256 * i, t = it >> 4, c8 = (it & 15) * 8; float o[8], raw[8]; int ch = 1536 + g * 128 + c8; const bool tv = t < sq.Q;
            conv_lds(rawC, 128, t, c8, hlr, cwl, 320, 192 + c8, o, raw);
#pragma unroll
            for (int e = 0; e < 8; ++e) { float s_ = silu(o[e]); o[e] = tv ? s_ : 0.f; }
            if (t >= 61) {
#pragma unroll
                for (int e = 0; e < 8; ++e) hlw[(t - 61) * 320 + 192 + c8 + e] = raw[e]; }
            if (lastc && tv && (hd & 3) == 0 && t >= sq.Q - 3) {
#pragma unroll
                for (int e = 0; e < 8; ++e) { hist_out[(t - (sq.Q - 3)) * 2048 + ch + e] = raw[e]; if (hist_out2) hist_out2[(t - (sq.Q - 3)) * 2048 + ch + e] = raw[e]; } }
            us8 ov;
#pragma unroll
            for (int e = 0; e < 8; ++e) ov[e] = f2bf(o[e]);
            *(us8*)(R2 + t * 136 + c8) = ov; }
        us4 zr[4];
#pragma unroll
        for (int nf = 0; nf < 4; ++nf) zr[nf] = *(const us4*)(rawZ + (16 * nf + fr) * 64 + 16 * w + 4 * fq);
        __syncthreads();
        if (!lastc) { const size_t ro = (size_t)(rowc + 64) * NPROJ * 2;
            stage_raw<128>(gx + ro, (size_t)NPROJ * 2, (char*)rawX, tid); stage_raw<256>(gb + ro, (size_t)NPROJ * 2, (char*)rawB, tid); stage_raw<256>(gc + ro, (size_t)NPROJ * 2, (char*)rawC, tid);
            stage_raw<128>(gz + ro, (size_t)NPROJ * 2, (char*)rawZ, tid); stage_raw<64>((const char*)(dtb + (size_t)(rowc + 64) * 16), 64, (char*)rawDt, tid); }
        f32x4 cbv[4];
#pragma unroll
        for (int nf = 0; nf < 4; ++nf) cbv[nf] = (f32x4){0.f, 0.f, 0.f, 0.f};
        lds_mma<4, 4>(cbv, Bm, 136, 16 * w, R2, 136, 0, wv_);
        __syncthreads();
#pragma unroll
        for (int nf = 0; nf < 4; ++nf) { int i = 16 * nf + fr; float ai = fl[i]; us4 o;
#pragma unroll
            for (int r = 0; r < 4; ++r) { int j = 16 * w + 4 * fq + r; float v = (j <= i) ? cbv[nf][r] * __expf(ai - fl[j]) * fl[64 + j] : 0.f; o[r] = f2bf(v); }
            *(us4*)(Bm + i * 72 + 16 * w + 4 * fq) = o; }
        __syncthreads();
        f32x4 ya[4];
#pragma unroll
        for (int nf = 0; nf < 4; ++nf) ya[nf] = (f32x4){0.f, 0.f, 0.f, 0.f};
        lds_mma<4, 4>(ya, hb, 136, 16 * w, R2, 136, 0, wv_);
#pragma unroll
        for (int nf = 0; nf < 4; ++nf) ya[nf] *= fl[192 + 16 * nf + fr];
        lds_mma<4, 2>(ya, xT, 72, 16 * w, Bm, 72, 0, wv_);
#pragma unroll
        for (int nf = 0; nf < 4; ++nf) { int i = 16 * nf + fr, p0 = 16 * w + 4 * fq;
            us4 z = zr[nf];
            if (i < sq.Q) { us4 o;
#pragma unroll
                for (int r = 0; r < 4; ++r) o[r] = f2bf((ya[nf][r] + Dv * bf2f(xT[(p0 + r) * 72 + i])) * bf2f(z[r]));
                *(us4*)(ymb + (size_t)(rowc + i) * LDK + hd * 64 + p0) = o; } }
        __syncthreads();
#pragma unroll
        for (int nf = 0; nf < 8; ++nf)
#pragma unroll
            for (int r = 0; r < 4; ++r) hb[(16 * w + 4 * fq + r) * 136 + 16 * nf + fr] = f2bf(hacc[nf][r]);
    }
#pragma unroll
    for (int nf = 0; nf < 8; ++nf)
#pragma unroll
        for (int r = 0; r < 4; ++r) st_out[(16 * w + 4 * fq + r) * 128 + 16 * nf + fr] = hacc[nf][r];
    __syncthreads();
}

DEVI void hgrn_unit(const Params& p, int l, Seq sq, int h, char* lds, int wv_) {
    bf16_t* sb = (bf16_t*)lds;
    bf16_t* qt = (bf16_t*)(lds + 34816);
    bf16_t* kt = (bf16_t*)(lds + 52224);
    bf16_t* att = (bf16_t*)lds;
    bf16_t* kT = (bf16_t*)(lds + 9216);
    bf16_t* vT = (bf16_t*)(lds + 27648);
    float* T0 = (float*)(lds + 69632); float* T1 = T0 + 128; float* ssq = T0 + 256;
    const int tid = tidx(wv_), lane = tid & 63, w = tid >> 6, fr = lane & 15, fq = lane >> 4;
    const int k = tid & 127, half = tid >> 7;
    const bf16_t* proj = (const bf16_t*)(p.ws + WS_PROJ); bf16_t* yhg = (bf16_t*)(p.ws + WS_YHG);
    float lb = 0.f;
    if (l == 1) { float a0 = p.in[I_LBL][h * 128 + k], a1 = p.in[I_LBL][1024 + h * 128 + k]; lb = 1.f / (1.f + __expf(a0 - a1)); }
    const float* nw = p.in[I_HGNW] + l * 128;
    const float* st_in; float* st_out;
    if (sq.samp) { st_in = p.in[I_HG] + ((size_t)(l * 16 + sq.b) * 8 + h) * 16384; st_out = p.out + O_HG_S + ((size_t)(l * 16 + sq.b) * 8 + h) * 16384; }
    else { st_out = p.out + O_HG_P + ((size_t)(l * 16 + sq.b) * 8 + h) * 16384; st_in = sq.seg ? st_out : nullptr; }
    f32x4 hacc[2][8];
#pragma unroll
    for (int mf = 0; mf < 2; ++mf)
#pragma unroll
        for (int nf = 0; nf < 8; ++nf)
#pragma unroll
            for (int r = 0; r < 4; ++r) hacc[mf][nf][r] = st_in ? st_in[(32 * w + 16 * mf + 4 * fq + r) * 128 + 16 * nf + fr] : 0.f;
    f32x4 nwr[2];
#pragma unroll
    for (int mf = 0; mf < 2; ++mf) nwr[mf] = *(const f32x4*)(nw + 32 * w + 16 * mf + 4 * fq);
    bf16_t* rawF = (bf16_t*)(lds + 71680); bf16_t* rawQ = (bf16_t*)(lds + 88064); bf16_t* rawV = (bf16_t*)(lds + 104448); bf16_t* rawH = (bf16_t*)(lds + 120832);
    const char* gf = (const char*)(proj + PC_HF + h * 128); const char* gq = (const char*)(proj + PC_HQ + h * 128); const char* gv = (const char*)(proj + PC_HI + h * 128); const char* gh = (const char*)(proj + PC_HGATE + h * 128);
    asm volatile("s_waitcnt vmcnt(0)" ::: "memory");
    {   const size_t ro = (size_t)sq.row0 * NPROJ * 2;
        stage_raw<256>(gf + ro, (size_t)NPROJ * 2, (char*)rawF, tid); stage_raw<256>(gq + ro, (size_t)NPROJ * 2, (char*)rawQ, tid); stage_raw<256>(gv + ro, (size_t)NPROJ * 2, (char*)rawV, tid); }
    for (int c = 0; c < sq.nchunk; ++c) {
        const int tid = tidx(wv_), lane = tid & 63, w = tid >> 6, fr = lane & 15, fq = lane >> 4, k = tid & 127, half = tid >> 7;
        const int rowc = sq.row0 + c * 64; const bool lastc = (c == sq.nchunk - 1);
        asm volatile("s_waitcnt vmcnt(0)" ::: "memory");
        __syncthreads();
        stage_raw<256>(gh + (size_t)rowc * NPROJ * 2, (size_t)NPROJ * 2, (char*)rawH, tid);
        {
            unsigned fu[32], qu[32];
#pragma unroll
            for (int jj = 0; jj < 32; ++jj) { fu[jj] = rawF[(32 * half + jj) * 128 + k]; qu[jj] = rawQ[(32 * half + jj) * 128 + k]; }
            if (tid < 64) ssq[tid] = 0.f;
            float run = 0.f;
            if (half == 0) {
#pragma unroll
                for (int jj = 31; jj >= 0; --jj) { bool valid = jj < sq.Q; float f = __uint_as_float(fu[jj] << 16);
                    float sg = __builtin_amdgcn_rcpf(1.f + __expf(-f)); float lg0 = __logf(lb + (1.f - lb) * sg); float lg = valid ? lg0 : 0.f;
                    float kk0 = (1.f - lb) * (1.f - sg); float kk = valid ? kk0 : 0.f; float q0 = __uint_as_float(qu[jj] << 16); float q = valid ? q0 : 0.f;
                    qt[jj * 136 + k] = f2bf(q * cexp(-run)); kt[jj * 136 + k] = f2bf(kk * cexp(run)); run += lg; }
                T0[k] = run;
            } else {
#pragma unroll
                for (int jj = 0; jj < 32; ++jj) { bool valid = (32 + jj) < sq.Q; float f = __uint_as_float(fu[jj] << 16);
                    float sg = __builtin_amdgcn_rcpf(1.f + __expf(-f)); float lg0 = __logf(lb + (1.f - lb) * sg); float lg = valid ? lg0 : 0.f;
                    float kk0 = (1.f - lb) * (1.f - sg); float kk = valid ? kk0 : 0.f; float q0 = __uint_as_float(qu[jj] << 16); float q = valid ? q0 : 0.f;
                    run += lg; qt[(32 + jj) * 136 + k] = f2bf(q * cexp(run)); kt[(32 + jj) * 136 + k] = f2bf(kk * cexp(-run)); }
                T1[k] = run;
            }
        }
        __syncthreads();
#pragma unroll
        for (int mf = 0; mf < 2; ++mf) { int k0 = 32 * w + 16 * mf + 4 * fq; float e0 = __expf(T0[k0]), e1 = __expf(T0[k0 + 1]), e2 = __expf(T0[k0 + 2]), e3 = __expf(T0[k0 + 3]);
#pragma unroll
            for (int nf = 0; nf < 8; ++nf) { hacc[mf][nf][0] *= e0; hacc[mf][nf][1] *= e1; hacc[mf][nf][2] *= e2; hacc[mf][nf][3] *= e3;
                us4 o; o[0] = f2bf(hacc[mf][nf][0]); o[1] = f2bf(hacc[mf][nf][1]); o[2] = f2bf(hacc[mf][nf][2]); o[3] = f2bf(hacc[mf][nf][3]);
                *(us4*)(sb + (16 * nf + fr) * 136 + k0) = o; } }
        f32x4 at[4];
#pragma unroll
        for (int nf = 0; nf < 4; ++nf) at[nf] = (f32x4){0.f, 0.f, 0.f, 0.f};
        lds_mma<4, 4>(at, kt, 136, 16 * w, qt, 136, 0, wv_);
        __syncthreads();
        f32x4 oacc[2][4];
#pragma unroll
        for (int mf = 0; mf < 2; ++mf) {
#pragma unroll
            for (int nf = 0; nf < 4; ++nf) oacc[mf][nf] = (f32x4){0.f, 0.f, 0.f, 0.f};
            lds_mma<4, 4>(oacc[mf], sb, 136, 32 * w + 16 * mf, qt, 136, 0, wv_); }
        __syncthreads();
#pragma unroll
        for (int nf = 0; nf < 4; ++nf) { int i = 16 * nf + fr; us4 o;
#pragma unroll
            for (int r = 0; r < 4; ++r) { int j = 16 * w + 4 * fq + r; o[r] = f2bf(j <= i ? at[nf][r] : 0.f); }
            *(us4*)(att + i * 72 + 16 * w + 4 * fq) = o; }
        {   unsigned vu[32];
#pragma unroll
            for (int jj = 0; jj < 32; ++jj) vu[jj] = rawV[(32 * half + jj) * 128 + k];
#pragma unroll
            for (int q4 = 0; q4 < 4; ++q4) { us8 kv, vv;
#pragma unroll
                for (int e = 0; e < 8; ++e) { int jj = q4 * 8 + e; bool valid = (32 * half + jj) < sq.Q; kv[e] = kt[(32 * half + jj) * 136 + k]; vv[e] = valid ? (bf16_t)vu[jj] : (bf16_t)0; }
                *(us8*)(kT + k * 72 + 32 * half + q4 * 8) = kv; *(us8*)(vT + k * 72 + 32 * half + q4 * 8) = vv; } }
        __syncthreads();
        if (!lastc) { const size_t ro = (size_t)(rowc + 64) * NPROJ * 2;
            stage_raw<256>(gf + ro, (size_t)NPROJ * 2, (char*)rawF, tid); stage_raw<256>(gq + ro, (size_t)NPROJ * 2, (char*)rawQ, tid); stage_raw<256>(gv + ro, (size_t)NPROJ * 2, (char*)rawV, tid); }
#pragma unroll
        for (int mf = 0; mf < 2; ++mf) {
            lds_mma<4, 2>(oacc[mf], vT, 72, 32 * w + 16 * mf, att, 72, 0, wv_);
            lds_mma<8, 2>(hacc[mf], kT, 72, 32 * w + 16 * mf, vT, 72, 0, wv_);
            int k0 = 32 * w + 16 * mf + 4 * fq; float e0 = __expf(T1[k0]), e1 = __expf(T1[k0 + 1]), e2 = __expf(T1[k0 + 2]), e3 = __expf(T1[k0 + 3]);
#pragma unroll
            for (int nf = 0; nf < 8; ++nf) { hacc[mf][nf][0] *= e0; hacc[mf][nf][1] *= e1; hacc[mf][nf][2] *= e2; hacc[mf][nf][3] *= e3; } }
#pragma unroll
        for (int nf = 0; nf < 4; ++nf) { float s = 0.f;
#pragma unroll
            for (int mf = 0; mf < 2; ++mf)
#pragma unroll
                for (int r = 0; r < 4; ++r) s += oacc[mf][nf][r] * oacc[mf][nf][r];
            s += shflx(s, 16, lane); s += shflx(s, 32, lane);
            if (fq == 0) atomicAdd(&ssq[16 * nf + fr], s); }
        if (lastc) asm volatile("s_waitcnt vmcnt(0)" ::: "memory"); else asm volatile("s_waitcnt vmcnt(12)" ::: "memory");
        __syncthreads();
#pragma unroll
        for (int nf = 0; nf < 4; ++nf) { int i = 16 * nf + fr; float rs = rsqrtf(ssq[i] * (1.f / 128.f) + 1e-6f);
#pragma unroll
            for (int mf = 0; mf < 2; ++mf) { int v0 = 32 * w + 16 * mf + 4 * fq; us4 gt = *(const us4*)(rawH + i * 128 + v0); f32x4 wv = nwr[mf]; us4 o;
#pragma unroll
                for (int r = 0; r < 4; ++r) o[r] = f2bf(oacc[mf][nf][r] * rs * wv[r] * bf2f(gt[r]));
                if (i < sq.Q) *(us4*)(yhg + (size_t)(rowc + i) * LDK + h * 128 + v0) = o; } }
        __syncthreads();
    }
#pragma unroll
    for (int mf = 0; mf < 2; ++mf)
#pragma unroll
        for (int nf = 0; nf < 8; ++nf)
#pragma unroll
            for (int r = 0; r < 4; ++r) st_out[(32 * w + 16 * mf + 4 * fq + r) * 128 + 16 * nf + fr] = hacc[mf][nf][r];
}

DEVI void rg_unit(const Params& p, int l, Seq sq, int blk, char* lds, int wv_) {
    bf16_t* waT = (bf16_t*)lds; bf16_t* wiT = (bf16_t*)(lds + 9216); bf16_t* xr = (bf16_t*)(lds + 18432);
    float* av = (float*)(lds + 27648); float* uv = (float*)(lds + 44288); float* Pq = (float*)(lds + 60928); float* Hq = Pq + 256; float* carry = Hq + 256;
    const int tid = tidx(wv_), lane = tid & 63, w = tid >> 6, fr = lane & 15, fq = lane >> 4;
    const bf16_t* proj = (const bf16_t*)(p.ws + WS_PROJ); bf16_t* yrg = (bf16_t*)(p.ws + WS_YRG);
    const int cb0 = blk * 64;
    const float* cw = p.in[I_RCW] + (size_t)l * 4 * 1024; const float* cbias = p.in[I_RCB] + l * 1024;
    const float* st_in; float* st_out; const float* hist; float* hist_out;
    if (sq.samp) { st_in = p.in[I_RG] + (size_t)(l * 16 + sq.b) * 1024; st_out = p.out + O_RG_S + (size_t)(l * 16 + sq.b) * 1024;
        hist = p.in[I_RCV] + (size_t)(l * 16 + sq.b) * 3 * 1024; hist_out = p.out + O_RCV_S + (size_t)(l * 16 + sq.b) * 3 * 1024; }
    else { st_out = p.out + O_RG_P + (size_t)(l * 16 + sq.b) * 1024; st_in = sq.seg ? st_out : nullptr;
        hist_out = p.out + O_RCV_P + (size_t)(l * 16 + sq.b) * 3 * 1024; hist = sq.seg ? hist_out : nullptr; }
    float* cwl = (float*)(lds + 63232);
    float* hl = (float*)(lds + 64512);
    float* hl2 = (float*)(lds + 90112);
    for (int idx = tid; idx < 320; idx += 256) { int k = idx >> 6, cc = idx & 63; cwl[idx] = k < 4 ? cw[k * 1024 + cb0 + cc] : cbias[cb0 + cc]; if (idx < 192) hl[idx] = hist ? hist[k * 1024 + cb0 + cc] : 0.f; }
    {   const float* wa = p.in[I_RWA] + ((size_t)l * 16 + blk) * 4096; const float* wi = p.in[I_RWI] + ((size_t)l * 16 + blk) * 4096;
        float wa_[16], wi_[16];
#pragma unroll
        for (int u = 0; u < 16; ++u) { wa_[u] = wa[tid + 256 * u]; wi_[u] = wi[tid + 256 * u]; }
#pragma unroll
        for (int u = 0; u < 16; ++u) { int e = tid + 256 * u, i = e >> 6, j = e & 63; waT[j * 72 + i] = f2bf(wa_[u]); wiT[j * 72 + i] = f2bf(wi_[u]); }
        if (tid < 64) carry[tid] = st_in ? st_in[cb0 + tid] : 0.f; }
    float cba[4], cbi[4], csp[4];
#pragma unroll
    for (int nf = 0; nf < 4; ++nf) { int cc = cb0 + 16 * nf + fr; cba[nf] = p.in[I_RBA][l * 1024 + cc]; cbi[nf] = p.in[I_RBI][l * 1024 + cc]; csp[nf] = softplus(-p.in[I_RLAM][l * 1024 + cc]); }
    bf16_t* rawR = (bf16_t*)(lds + 65536); bf16_t* rawG = (bf16_t*)(lds + 73728);
    const char* gr = (const char*)(proj + PC_RX + cb0); const char* gg = (const char*)(proj + PC_RGATE + cb0);
    asm volatile("s_waitcnt vmcnt(0)" ::: "memory");
    stage_raw<128>(gr + (size_t)sq.row0 * NPROJ * 2, (size_t)NPROJ * 2, (char*)rawR, tid); stage_raw<128>(gg + (size_t)sq.row0 * NPROJ * 2, (size_t)NPROJ * 2, (char*)rawG, tid);
    for (int c = 0; c < sq.nchunk; ++c) {
        const int tid = tidx(wv_), lane = tid & 63, w = tid >> 6, fr = lane & 15, fq = lane >> 4, j = tid & 63, q = tid >> 6;
        const int rowc = sq.row0 + c * 64; const bool lastc = (c == sq.nchunk - 1);
        const float* hlr = (c & 1) ? hl2 : hl; float* hlw = (c & 1) ? hl : hl2;
        asm volatile("s_waitcnt vmcnt(0)" ::: "memory");
        __syncthreads();
#pragma unroll
        for (int i = 0; i < 2; ++i) { int it = tid + 256 * i, t = it >> 3, c8 = (it & 7) * 8; float o[8], raw[8]; int ch = cb0 + c8; const bool tv = t < sq.Q;
            conv_lds(rawR, 64, t, c8, hlr, cwl, 64, c8, o, raw);
            if (t >= 61) {
#pragma unroll
                for (int e = 0; e < 8; ++e) hlw[(t - 61) * 64 + c8 + e] = raw[e]; }
            if (lastc && tv && t >= sq.Q - 3) {
#pragma unroll
                for (int e = 0; e < 8; ++e) hist_out[(t - (sq.Q - 3)) * 1024 + ch + e] = raw[e]; }
            us8 ov;
#pragma unroll
            for (int e = 0; e < 8; ++e) { float ox = tv ? o[e] : 0.f; ov[e] = f2bf(ox); uv[t * 65 + c8 + e] = ox; }
            *(us8*)(xr + t * 72 + c8) = ov; }
        __syncthreads();
        if (!lastc) { const size_t ro = (size_t)(rowc + 64) * NPROJ * 2; stage_raw<128>(gr + ro, (size_t)NPROJ * 2, (char*)rawR, tid); stage_raw<128>(gg + ro, (size_t)NPROJ * 2, (char*)(rawG + ((c + 1) & 1) * 4096), tid); }
        f32x4 ra[4], ri[4];
#pragma unroll
        for (int nf = 0; nf < 4; ++nf) { ra[nf] = (f32x4){0.f, 0.f, 0.f, 0.f}; ri[nf] = (f32x4){0.f, 0.f, 0.f, 0.f}; }
        lds_mma<4, 2>(ra, xr, 72, 16 * w, waT, 72, 0, wv_);
        lds_mma<4, 2>(ri, xr, 72, 16 * w, wiT, 72, 0, wv_);
#pragma unroll
        for (int nf = 0; nf < 4; ++nf) { int jj = 16 * nf + fr; float ba = cba[nf], bi = cbi[nf], sp = csp[nf];
#pragma unroll
            for (int r = 0; r < 4; ++r) { int t = 16 * w + 4 * fq + r; float rr = sigm(ra[nf][r] + ba), ii = sigm(ri[nf][r] + bi); float la = -8.f * sp * rr; float aa = __expf(la);
                float u = __builtin_sqrtf(fmaxf(1.f - aa * aa, 0.f)) * ii * uv[t * 65 + jj];
                if (t >= sq.Q) { aa = 1.f; u = 0.f; }
                av[t * 65 + jj] = aa; uv[t * 65 + jj] = u; } }
        __syncthreads();
        { float P = 1.f, H = 0.f;
#pragma unroll
          for (int tt = 0; tt < 16; ++tt) { int t = 16 * q + tt; float aa = av[t * 65 + j], u = uv[t * 65 + j]; H = aa * H + u; P *= aa; }
          Pq[q * 64 + j] = P; Hq[q * 64 + j] = H; }
        __syncthreads();
        float hcur = carry[j];
        for (int qq = 0; qq < q; ++qq) hcur = Pq[qq * 64 + j] * hcur + Hq[qq * 64 + j];
        const bf16_t* rg_ = rawG + (c & 1) * 4096;
        bf16_t gts[16];
#pragma unroll
        for (int tt = 0; tt < 16; ++tt) gts[tt] = rg_[(16 * q + tt) * 64 + j];
#pragma unroll
        for (int tt = 0; tt < 16; ++tt) { int t = 16 * q + tt; float aa = av[t * 65 + j], u = uv[t * 65 + j]; hcur = aa * hcur + u;
            if (t < sq.Q) yrg[(size_t)(rowc + t) * LDK + cb0 + j] = f2bf(bf2f(gts[tt]) * hcur); }
        __syncthreads();
        if (q == 3) carry[j] = hcur;
        __syncthreads();
    }
    if (tid < 64) st_out[cb0 + tid] = carry[tid];
    __syncthreads();
}

DEVI void phase_mix(const Params& p, int l, int seg, char* lds, int wv_) {
    const int ngrp = seg == 0 ? 2 : 1; const int NU = ngrp * 640;
    for (int u = blockIdx.x; u < NU; u += gridDim.x) {
        int grp = u / 640, v = u % 640;
        if (v < 128) hgrn_unit(p, l, make_seq(seg, grp * 16 + (v >> 3)), v & 7, lds, wv_);
        else if (v < 384) { v -= 128; ssd_unit(p, l, make_seq(seg, grp * 16 + (v >> 4)), v & 15, lds, wv_); }
        else { v -= 384; rg_unit(p, l, make_seq(seg, grp * 16 + (v >> 4)), v & 15, lds, wv_); }
        __syncthreads();
    }
}

DEVI void gbar(const Params& p, unsigned& epoch_, int wv_) {
    const unsigned epoch = __builtin_amdgcn_readfirstlane(epoch_); epoch_ = epoch + 1u;
    unsigned* bw = (unsigned*)(p.ws + WS_END); asm volatile("" : "+s"(bw));
    asm volatile("s_waitcnt vmcnt(0)" ::: "memory");
    __syncthreads();
    if (tidx(wv_) == 0) {
        if ((wv_ >> 23) & 1) {
            const unsigned x = (wv_ >> 2) & 7, NB = (wv_ >> 14) & 511;
            const unsigned old = __hip_atomic_fetch_add(bw + 32 + x, 1u, __ATOMIC_RELAXED, __HIP_MEMORY_SCOPE_AGENT);
            if (old + 1u == (epoch + 1u) * NB) {
                __builtin_amdgcn_fence(__ATOMIC_RELEASE, "agent");
                asm volatile("s_waitcnt vmcnt(0)" ::: "memory");
                const unsigned og = __hip_atomic_fetch_add(bw + 56, 1u, __ATOMIC_RELAXED, __HIP_MEMORY_SCOPE_AGENT);
                if (og + 1u == (epoch + 1u) * 8u) __hip_atomic_fetch_add(bw + 57, 1u, __ATOMIC_RELAXED, __HIP_MEMORY_SCOPE_AGENT);
                else while (__hip_atomic_load(bw + 57, __ATOMIC_RELAXED, __HIP_MEMORY_SCOPE_AGENT) < epoch + 1u) __builtin_amdgcn_s_sleep(1);
                __builtin_amdgcn_fence(__ATOMIC_ACQUIRE, "agent");
                __hip_atomic_fetch_add(bw + 48 + x, 1u, __ATOMIC_RELAXED, __HIP_MEMORY_SCOPE_AGENT);
                asm volatile("s_waitcnt vmcnt(0)" ::: "memory");
            } else {
                while (__hip_atomic_load(bw + 48 + x, __ATOMIC_RELAXED, __HIP_MEMORY_SCOPE_AGENT) < epoch + 1u) __builtin_amdgcn_s_sleep(1);
                __builtin_amdgcn_fence(__ATOMIC_ACQUIRE, "agent");
                asm volatile("s_waitcnt vmcnt(0)" ::: "memory");
            }
        } else {
            __builtin_amdgcn_fence(__ATOMIC_RELEASE, "agent");
            asm volatile("s_waitcnt vmcnt(0)" ::: "memory");
            __hip_atomic_fetch_add(bw, 1u, __ATOMIC_RELAXED, __HIP_MEMORY_SCOPE_AGENT);
            const unsigned target = (epoch + 1u) * gridDim.x;
            while (__hip_atomic_load(bw, __ATOMIC_RELAXED, __HIP_MEMORY_SCOPE_AGENT) < target) __builtin_amdgcn_s_sleep(1);
            __builtin_amdgcn_fence(__ATOMIC_ACQUIRE, "agent");
            asm volatile("s_waitcnt vmcnt(0)" ::: "memory");
        }
    }
    __syncthreads();
}

__global__ void __launch_bounds__(256) fwd_mega(Params p) {
    extern __shared__ __attribute__((aligned(16))) char lds[];
    int wv_ = __builtin_amdgcn_readfirstlane((int)(__builtin_amdgcn_workitem_id_x() >> 6));
    cg::grid_group grid = cg::this_grid();
    unsigned* xcnt = (unsigned*)(p.ws + WS_END) + 16;
    const int xcc = (int)(__builtin_amdgcn_s_getreg((3 << 11) | 20) & 7u);
    int xrank;
    { int* sh = (int*)lds; if (__builtin_amdgcn_workitem_id_x() == 0) sh[0] = (int)__hip_atomic_fetch_add(xcnt + xcc, 1u, __ATOMIC_RELAXED, __HIP_MEMORY_SCOPE_AGENT); __syncthreads(); xrank = __builtin_amdgcn_readfirstlane(sh[0]); __syncthreads(); }
    unsigned epoch = 0;
    phase_prep(p, lds, wv_);
    grid.sync();
    {   unsigned c[8]; bool ok = true;
#pragma unroll
        for (int i = 0; i < 8; ++i) { c[i] = __hip_atomic_load(xcnt + i, __ATOMIC_RELAXED, __HIP_MEMORY_SCOPE_AGENT); ok = ok && c[i] > 0u && c[i] < 512u; }
        unsigned mine = 0, tot_ = 0;
#pragma unroll
        for (int i = 0; i < 8; ++i) { mine = (i == xcc) ? c[i] : mine; tot_ += c[i]; }
        ok = ok && tot_ == gridDim.x;
        int X = xcc, R = xrank, NB = (int)mine;
        if (!ok) { X = blockIdx.x & 7; R = blockIdx.x >> 3; NB = gridDim.x >> 3; }
        wv_ = __builtin_amdgcn_readfirstlane((wv_ & 3) | (X << 2) | (R << 5) | (NB << 14) | (ok ? (1 << 23) : 0)); }
#pragma unroll 1
    for (int seg = 0; seg < NSEG; ++seg) {
        const int nrows = seg == 0 ? ROWS : ROWS_P, MT = nrows / 256;
#pragma unroll 1
        for (int l = 0; l < 2; ++l) {
            const bf16_t* wl = (const bf16_t*)p.ws + (size_t)l * E_LAYER;
            phase_norm(p, seg, nrows, p.in[I_NMIX] + l * 1024, l == 0, l, lds, wv_);
            gbar(p, epoch, wv_);
            for (int r = 0; r < p.rep[0]; ++r) { phase_proj(p, l, MT, lds, wv_); gbar(p, epoch, wv_); }
            for (int r = 0; r < (seg == 0 ? p.rep[3] : 1); ++r) { phase_mix(p, l, seg, lds, wv_); gbar(p, epoch, wv_); }
            phase_mbnorm(p, l, nrows, wv_);
            gbar(p, epoch, wv_);
            for (int r = 0; r < p.rep[1]; ++r) { phase_merge(p, l, MT, lds, wv_); gbar(p, epoch, wv_); }
            phase_resid(p, seg, MT, (const bf16_t*)(p.ws + WS_MRG), 1024, LDK, wl + E_WIN + E_WBR, l == 0, lds, wv_);
            gbar(p, epoch, wv_);
            phase_norm(p, seg, nrows, p.in[I_NFFN] + l * 1024, false, -1, lds, wv_);
            gbar(p, epoch, wv_);
            for (int r = 0; r < p.rep[2]; ++r) { phase_ffn_in(p, l, MT, lds, wv_); gbar(p, epoch, wv_); }
            phase_resid(p, seg, MT, (const bf16_t*)(p.ws + WS_PROJ), FFH, LDF, wl + E_WIN + E_WBR + E_WOUT + E_WFI, false, lds, wv_);
            gbar(p, epoch, wv_);
        }
        phase_final_norm(p, seg, nrows, wv_);
    }
}

extern "C" void kernel_launch(void* const* d_in, const int* in_sizes, int n_in, void* d_out, int out_size, void* d_ws, size_t ws_size, hipStream_t stream) {
    static int grid_blocks = 0;
    if (!grid_blocks) {
        int dev = 0, cus = 0, per_cu = 0;
        (void)hipGetDevice(&dev);
        (void)hipDeviceGetAttribute(&cus, hipDeviceAttributeMultiprocessorCount, dev);
        (void)hipFuncSetAttribute((const void*)fwd_mega, hipFuncAttributeMaxDynamicSharedMemorySize, LDS_BYTES);
        (void)hipOccupancyMaxActiveBlocksPerMultiprocessor(&per_cu, (const void*)fwd_mega, 256, LDS_BYTES);
        if (per_cu < 1) fprintf(stderr, "occupancy query says %d blocks per CU\n", per_cu);
        grid_blocks = cus;
        if (ws_size < WS_TOTAL) fprintf(stderr, "workspace too small: %zu < %zu\n", ws_size, (size_t)WS_END + 256);
    }
    (void)hipMemsetAsync((char*)d_ws + WS_END, 0, 256, stream);
    Params p{};
    for (int i = 0; i < 30; ++i) p.in[i] = (const float*)d_in[i];
    p.out = (float*)d_out; p.ws = (unsigned char*)d_ws; p.rep[0] = REP0; p.rep[1] = REP1; p.rep[2] = REP2; p.rep[3] = REP3;
    void* args[] = {&p};
    hipError_t e = hipLaunchCooperativeKernel((const void*)fwd_mega, dim3(grid_blocks), dim3(256), args, LDS_BYTES, stream);
    if (e != hipSuccess) fprintf(stderr, "cooperative launch failed: %s (grid %d)\n", hipGetErrorString(e), grid_blocks);
}
```

```cpp
#include <hip/hip_runtime.h>
#include <hip/hip_cooperative_groups.h>
#include <cstdio>
namespace cg = cooperative_groups;

typedef unsigned short bf16_t;
typedef short bf16x8 __attribute__((ext_vector_type(8)));
typedef float f32x4 __attribute__((ext_vector_type(4)));
typedef unsigned short us4 __attribute__((ext_vector_type(4)));
typedef unsigned short us8 __attribute__((ext_vector_type(8)));
#define DEVI __device__ __forceinline__

constexpr int LDK = 1088, LDF = 2880;
constexpr int D = 1024, NPROJ = 12288, SEGT = 512, NSEG = 4, ROWS_P = 8192, ROWS = 8704, FFH = 2816;
constexpr int PC_Z = 0, PC_XBC = 1024, PC_HQ = 3072, PC_HF = 4096, PC_HI = 5120, PC_HGATE = 6144, PC_RGATE = 7168, PC_RX = 8192, PC_MG = 9216, PC_DT = 12288;
constexpr size_t E_WIN = (size_t)NPROJ * LDK, E_WBR = 3u * 1024 * LDK, E_WOUT = 1024u * LDK, E_WFI = 5632u * LDK, E_WFO = 1024u * LDF;
constexpr size_t E_LAYER = E_WIN + E_WBR + E_WOUT + E_WFI + E_WFO;
constexpr size_t WS_PROJ = 2 * E_LAYER * 2;
constexpr size_t WS_DT = WS_PROJ + (size_t)ROWS * NPROJ * 2;
constexpr size_t WS_XB = WS_DT + (size_t)ROWS * 16 * 4;
constexpr size_t WS_YMB = WS_XB + (size_t)ROWS * LDK * 2;
constexpr size_t WS_YHG = WS_YMB + (size_t)ROWS * LDK * 2;
constexpr size_t WS_YRG = WS_YHG + (size_t)ROWS * LDK * 2;
constexpr size_t WS_MRG = WS_YRG + (size_t)ROWS * LDK * 2;
constexpr size_t WS_END = WS_MRG + (size_t)ROWS * LDK * 2;
constexpr size_t WS_HB = WS_END + 256;
constexpr size_t WS_DTW = WS_HB + 2u * 2 * 16 * 3 * 2048 * 4;
constexpr size_t WS_TOTAL = WS_DTW + 2u * 16 * 1024 * 4;
constexpr size_t O_YP = 0, O_YS = 33554432, O_SSM_P = 34078720, O_SCV_P = 38273024, O_HG_P = 38469632, O_RG_P = 42663936, O_RCV_P = 42696704,
                 O_SSM_S = 42795008, O_SCV_S = 46989312, O_HG_S = 47185920, O_RG_S = 51380224, O_RCV_S = 51412992;
constexpr int REP0 = 1, REP1 = 1, REP2 = 1, REP3 = 1;
constexpr int LDS_BYTES = 144 * 1024;

enum { I_XP = 0, I_XS, I_SSM, I_SCV, I_HG, I_RG, I_RCV, I_NMIX, I_WIN, I_MCW, I_MCB, I_DTB, I_ALOG, I_MBD, I_MBNW, I_LBL, I_HGNW, I_RCW, I_RCB, I_RWA, I_RBA, I_RWI, I_RBI, I_RLAM, I_WBR, I_WOUT, I_NFFN, I_WFI, I_WFO, I_NFIN };

struct Params { const float* in[30]; float* out; unsigned char* ws; int rep[4]; };

DEVI int tidx(int wv_) { int t = ((wv_ & 3) << 6) | (int)__builtin_amdgcn_mbcnt_hi(~0u, __builtin_amdgcn_mbcnt_lo(~0u, 0u)); asm volatile("" : "+v"(t)); return t; }
DEVI float shfli(float v, int srcl) { return __int_as_float(__builtin_amdgcn_ds_bpermute(srcl << 2, __float_as_int(v))); }
DEVI float shflx(float v, int m, int lane) { return shfli(v, lane ^ m); }
DEVI bf16_t f2bf(float f) { unsigned u = __float_as_uint(f); u += 0x7fffu + ((u >> 16) & 1u); return (bf16_t)(u >> 16); }
DEVI float bf2f(bf16_t h) { return __uint_as_float(((unsigned)h) << 16); }
DEVI float sigm(float x) { return 1.f / (1.f + __expf(-x)); }
DEVI float silu(float x) { return x / (1.f + __expf(-x)); }
DEVI float softplus(float x) { return x > 20.f ? x : __logf(1.f + __expf(x)); }
DEVI float gelu_t(float x) { float u = 0.7978845608f * (x + 0.044715f * x * x * x); return x * sigm(2.f * u); }
DEVI float cexp(float x) { return __expf(fminf(x, 80.f)); }

DEVI const float* xrow_in(const Params& p, int seg, int r) {
    if (r < ROWS_P) { int b = r >> 9, tt = r & 511; return p.in[I_XP] + ((size_t)(b * 2048 + seg * SEGT + tt)) * D; }
    return p.in[I_XS] + (size_t)(r - ROWS_P) * D;
}
DEVI float* xrow_out(const Params& p, int seg, int r) {
    if (r < ROWS_P) { int b = r >> 9, tt = r & 511; return p.out + O_YP + ((size_t)(b * 2048 + seg * SEGT + tt)) * D; }
    return p.out + O_YS + (size_t)(r - ROWS_P) * D;
}

DEVI int perm32(int rho) { int n = rho >> 4, i = rho & 15; return 8 * (i >> 2) + 4 * n + (i & 3); }
DEVI int map_win(int n) { n = (n & ~31) + perm32(n & 31); return n < 3072 ? n : n + 16; }
DEVI int map_wfi(int n) { int T = n >> 7, nf = (n >> 4) & 7, i = n & 15, G = nf >> 2, h = (nf >> 1) & 1, s = nf & 1; return s * FFH + 64 * T + 32 * G + 8 * (i >> 2) + 4 * h + (i & 3); }

DEVI void transpose_tile(const float* src, int ldsrc, bf16_t* dst, int K, int k0, int n0, int mode, float* tile  , int wv_) {
    const int tid = tidx(wv_), c = tid & 63, rq = tid >> 6;
    int n = n0 + c, sn = mode == 1 ? map_win(n) : (mode == 2 ? map_wfi(n) : (mode == 3 ? (n & ~31) + perm32(n & 31) : n));
#pragma unroll
    for (int rr = 0; rr < 16; ++rr) { int kl = rr * 4 + rq; tile[kl * 65 + c] = sn >= 0 ? src[(size_t)(k0 + kl) * ldsrc + sn] : 0.f; }
    __syncthreads();
#pragma unroll
    for (int rr = 0; rr < 16; ++rr) { int nl = rr * 4 + rq; dst[(size_t)(n0 + nl) * K + k0 + c] = f2bf(tile[c * 65 + nl]); }
    __syncthreads();
}

DEVI void phase_prep(const Params& p, char* lds, int wv_) {
    float* tile = (float*)lds;
    bf16_t* wsb = (bf16_t*)p.ws;
    constexpr int T_WIN = 16 * 192, T_WBR = 3 * 256, T_WOUT = 256, T_WFI = 16 * 88, T_WFO = 44 * 16, T_L = T_WIN + T_WBR + T_WOUT + T_WFI + T_WFO;
    {   float* dtw = (float*)(p.ws + WS_DTW);
        for (int e = blockIdx.x * 256 + tidx(wv_); e < 32768; e += gridDim.x * 256) { int l = e >> 14, j = (e >> 10) & 15, k = e & 1023; dtw[e] = p.in[I_WIN][(size_t)l * 1024 * 12304 + (size_t)k * 12304 + 3072 + j]; } }
    for (int t = blockIdx.x; t < 2 * T_L; t += gridDim.x) {
        int l = t / T_L, j = t % T_L;
        bf16_t* wl = wsb + (size_t)l * E_LAYER;
        if (j < T_WIN) { int kt = j & 15, nt = j >> 4; transpose_tile(p.in[I_WIN] + (size_t)l * 1024 * 12304, 12304, wl, LDK, kt * 64, nt * 64, 1, tile, wv_); continue; }
        j -= T_WIN;
        if (j < T_WBR) { int k = j >> 8, jj = j & 255, kt = jj & 15, nt = jj >> 4;
            transpose_tile(p.in[I_WBR] + ((size_t)l * 3 + k) * 1024 * 1024, 1024, wl + E_WIN + (size_t)k * 1024 * LDK, LDK, kt * 64, nt * 64, 3, tile, wv_); continue; }
        j -= T_WBR;
        if (j < T_WOUT) { int kt = j & 15, nt = j >> 4; transpose_tile(p.in[I_WOUT] + (size_t)l * 1024 * 1024, 1024, wl + E_WIN + E_WBR, LDK, kt * 64, nt * 64, 0, tile, wv_); continue; }
        j -= T_WOUT;
        if (j < T_WFI) { int kt = j & 15, nt = j >> 4; transpose_tile(p.in[I_WFI] + (size_t)l * 1024 * 5632, 5632, wl + E_WIN + E_WBR + E_WOUT, LDK, kt * 64, nt * 64, 2, tile, wv_); continue; }
        j -= T_WFI;
        { int kt = j % 44, nt = j / 44; transpose_tile(p.in[I_WFO] + (size_t)l * 2816 * 1024, 1024, wl + E_WIN + E_WBR + E_WOUT + E_WFI, LDF, kt * 64, nt * 64, 0, tile, wv_); }
    }
}

DEVI void phase_norm(const Params& p, int seg, int nrows, const float* w, bool from_input, int ldt  , char* lds, int wv_) {
    bf16_t* xb = (bf16_t*)(p.ws + WS_XB); float* dtb = (float*)(p.ws + WS_DT);
    const int lane = tidx(wv_) & 63, wv = tidx(wv_) >> 6;
    float* dw = (float*)lds;
    if (ldt >= 0) { const float* dtw = (const float*)(p.ws + WS_DTW) + ldt * 16384; f32x4 t_[16];
#pragma unroll
        for (int u = 0; u < 16; ++u) t_[u] = *(const f32x4*)(dtw + (tidx(wv_) + 256 * u) * 4);
#pragma unroll
        for (int u = 0; u < 16; ++u) *(f32x4*)(dw + (tidx(wv_) + 256 * u) * 4) = t_[u];
        __syncthreads(); }
    for (int r = blockIdx.x * 4 + wv; r < nrows; r += gridDim.x * 4) {
        const float* x = from_input ? xrow_in(p, seg, r) : xrow_out(p, seg, r);
        f32x4 v[4]; float ss = 0.f;
#pragma unroll
        for (int i = 0; i < 4; ++i) { v[i] = *(const f32x4*)(x + i * 256 + lane * 4); ss += v[i][0] * v[i][0] + v[i][1] * v[i][1] + v[i][2] * v[i][2] + v[i][3] * v[i][3]; }
#pragma unroll
        for (int o = 32; o >= 1; o >>= 1) ss += shflx(ss, o, lane);
        float rs = rsqrtf(ss * (1.f / 1024.f) + 1e-6f);
#pragma unroll
        for (int i = 0; i < 4; ++i) { f32x4 wv4 = *(const f32x4*)(w + i * 256 + lane * 4); us4 o;
            v[i][0] *= rs * wv4[0]; v[i][1] *= rs * wv4[1]; v[i][2] *= rs * wv4[2]; v[i][3] *= rs * wv4[3];
            o[0] = f2bf(v[i][0]); o[1] = f2bf(v[i][1]); o[2] = f2bf(v[i][2]); o[3] = f2bf(v[i][3]);
            *(us4*)(xb + (size_t)r * LDK + i * 256 + lane * 4) = o; }
        if (ldt >= 0) {
            float d[16];
#pragma unroll
            for (int j = 0; j < 16; ++j) { float s = 0.f;
#pragma unroll
                for (int i = 0; i < 4; ++i) { f32x4 ww = *(const f32x4*)(dw + j * 1024 + i * 256 + lane * 4); s += v[i][0] * ww[0] + v[i][1] * ww[1] + v[i][2] * ww[2] + v[i][3] * ww[3]; }
                d[j] = s; }
            { const bool hi = lane & 32;
#pragma unroll
              for (int i = 0; i < 8; ++i) { float send = hi ? d[i] : d[i + 8], keep = hi ? d[i + 8] : d[i]; d[i] = keep + shfli(send, lane ^ 32); } }
            { const bool hi = lane & 16;
#pragma unroll
              for (int i = 0; i < 4; ++i) { float send = hi ? d[i] : d[i + 4], keep = hi ? d[i + 4] : d[i]; d[i] = keep + shfli(send, lane ^ 16); } }
            { const bool hi = lane & 8;
#pragma unroll
              for (int i = 0; i < 2; ++i) { float send = hi ? d[i] : d[i + 2], keep = hi ? d[i + 2] : d[i]; d[i] = keep + shfli(send, lane ^ 8); } }
            { const bool hi = lane & 4; float send = hi ? d[0] : d[1], keep = hi ? d[1] : d[0]; d[0] = keep + shfli(send, lane ^ 4); }
            d[0] += shfli(d[0], lane ^ 2); d[0] += shfli(d[0], lane ^ 1);
            if ((lane & 3) == 0) { int j = lane >> 2; dtb[(size_t)r * 16 + j] = softplus(d[0] + p.in[I_DTB][ldt * 16 + j]); }
        }
    }
    if (ldt >= 0) __syncthreads();
}
DEVI void phase_final_norm(const Params& p, int seg, int nrows, int wv_) {
    const float* w = p.in[I_NFIN];
    const int lane = tidx(wv_) & 63, wv = tidx(wv_) >> 6;
    for (int r = blockIdx.x * 4 + wv; r < nrows; r += gridDim.x * 4) {
        float* x = xrow_out(p, seg, r);
        f32x4 v[4]; float ss = 0.f;
#pragma unroll
        for (int i = 0; i < 4; ++i) { v[i] = *(const f32x4*)(x + i * 256 + lane * 4); ss += v[i][0] * v[i][0] + v[i][1] * v[i][1] + v[i][2] * v[i][2] + v[i][3] * v[i][3]; }
#pragma unroll
        for (int o = 32; o >= 1; o >>= 1) ss += shflx(ss, o, lane);
        float rs = rsqrtf(ss * (1.f / 1024.f) + 1e-6f);
#pragma unroll
        for (int i = 0; i < 4; ++i) { f32x4 wv4 = *(const f32x4*)(w + i * 256 + lane * 4); f32x4 o;
            o[0] = v[i][0] * rs * wv4[0]; o[1] = v[i][1] * rs * wv4[1]; o[2] = v[i][2] * rs * wv4[2]; o[3] = v[i][3] * rs * wv4[3];
            *(f32x4*)(x + i * 256 + lane * 4) = o; }
    }
}
DEVI void phase_mbnorm(const Params& p, int l, int nrows, int wv_) {
    bf16_t* y = (bf16_t*)(p.ws + WS_YMB); const float* w = p.in[I_MBNW] + l * 1024;
    const int lane = tidx(wv_) & 63, wv = tidx(wv_) >> 6;
    for (int it = blockIdx.x * 4 + wv; it < nrows * 4; it += gridDim.x * 4) {
        int r = it >> 2, g = it & 3; bf16_t* yp = y + (size_t)r * LDK + g * 256 + lane * 4;
        us4 v = *(const us4*)yp; float f0 = bf2f(v[0]), f1 = bf2f(v[1]), f2 = bf2f(v[2]), f3 = bf2f(v[3]);
        float ss = f0 * f0 + f1 * f1 + f2 * f2 + f3 * f3;
#pragma unroll
        for (int o = 32; o >= 1; o >>= 1) ss += shflx(ss, o, lane);
        float rs = rsqrtf(ss * (1.f / 256.f) + 1e-6f); f32x4 wv4 = *(const f32x4*)(w + g * 256 + lane * 4);
        us4 o; o[0] = f2bf(f0 * rs * wv4[0]); o[1] = f2bf(f1 * rs * wv4[1]); o[2] = f2bf(f2 * rs * wv4[2]); o[3] = f2bf(f3 * rs * wv4[3]);
        *(us4*)yp = o;
    }
}

#define WAIT_V(n) asm volatile("s_waitcnt vmcnt(" #n ")" ::: "memory")
#define RAW_BAR() do { asm volatile("" ::: "memory"); __builtin_amdgcn_s_barrier(); asm volatile("" ::: "memory"); } while (0)
template <int NF>
DEVI void stage_a(const bf16_t* A, int K, int t, char* st, int tid, size_t soff) {
    const size_t o = soff + (size_t)t * 32;
#pragma unroll
    for (int i = 0; i < 4; ++i) __builtin_amdgcn_global_load_lds((const unsigned*)(A + o + (size_t)i * 64 * K), (unsigned*)(st + tid * 16 + i * 4096), 16, 0, 0);
}
template <int NF>
DEVI void stage_b(const bf16_t* Bt, int K, int t, char* st, int tid, size_t soff) {
    const size_t o = soff + (size_t)t * 32;
#pragma unroll
    for (int i = 0; i < NF / 2; ++i) __builtin_amdgcn_global_load_lds((const unsigned*)(Bt + o + (size_t)i * 64 * K), (unsigned*)(st + 16384 + tid * 16 + i * 4096), 16, 0, 0);
}
template <int NF>
DEVI void gemm_kloop(f32x4 (&acc)[8][NF], const bf16_t* A, const bf16_t* Bt, int K, int ld, char* lds, int wv_) {
    constexpr int STAGE = 16384 + NF * 2048;
    const int tid = tidx(wv_), lane = tid & 63, wid = tid >> 6, wr = wid >> 1, wc = wid & 1, fr = lane & 15, fq = lane >> 4;
    const int fo = fr * 64 + ((fq ^ (0x1320 >> (4 * (fr >> 2)))) & 3) * 16;
    const int aoff = wr * 8192 + fo, boff = 16384 + wc * NF * 1024 + fo;
    const size_t soff = (size_t)(tid >> 2) * ld + ((((tid & 3) ^ (0x1320 >> (4 * ((tid >> 4) & 3)))) & 3) * 8);
    const int nt = K >> 5;
    WAIT_V(0); RAW_BAR();
    stage_a<NF>(A, ld, 0, lds, tid, soff); stage_b<NF>(Bt, ld, 0, lds, tid, soff);
    stage_a<NF>(A, ld, 1, lds + STAGE, tid, soff); stage_b<NF>(Bt, ld, 1, lds + STAGE, tid, soff);
    stage_a<NF>(A, ld, 2, lds + 2 * STAGE, tid, soff); stage_b<NF>(Bt, ld, 2, lds + 2 * STAGE, tid, soff);
    if (NF == 8) WAIT_V(16); else WAIT_V(12);
    RAW_BAR();
    bf16x8 a[8], a01[2][2], b[2][NF];
    a01[0][0] = *(const bf16x8*)(lds + aoff); a01[0][1] = *(const bf16x8*)(lds + aoff + 1024);
#pragma unroll
    for (int n = 0; n < NF; ++n) b[0][n] = *(const bf16x8*)(lds + boff + n * 1024);
#define MMA_G(g_, P_) _Pragma("unroll") for (int n = 0; n < NF; ++n) acc[g_][n] = __builtin_amdgcn_mfma_f32_16x16x32_bf16(b[P_][n], a[g_], acc[g_][n], 0, 0, 0)
#define KBODY(T_, P_, Q_) do { \
        const int T = (T_); const char* st = lds + (T & 3) * STAGE; const char* stn = lds + ((T + 1) & 3) * STAGE; char* st3 = lds + ((T + 3) & 3) * STAGE; \
        a[0] = a01[P_][0]; a[1] = a01[P_][1]; \
        __builtin_amdgcn_sched_barrier(0); a[2] = *(const bf16x8*)(st + aoff + 2 * 1024); MMA_G(0, P_); \
        __builtin_amdgcn_sched_barrier(0); a[3] = *(const bf16x8*)(st + aoff + 3 * 1024); MMA_G(1, P_); \
        __builtin_amdgcn_sched_barrier(0); a[4] = *(const bf16x8*)(st + aoff + 4 * 1024); MMA_G(2, P_); \
        __builtin_amdgcn_sched_barrier(0); a[5] = *(const bf16x8*)(st + aoff + 5 * 1024); MMA_G(3, P_); \
        __builtin_amdgcn_sched_barrier(0); \
        if (T + 2 < nt) { if (NF == 8) WAIT_V(8); else WAIT_V(6); } else WAIT_V(0); \
        RAW_BAR(); \
        __builtin_amdgcn_sched_barrier(0); a[6] = *(const bf16x8*)(st + aoff + 6 * 1024); \
        if (T + 3 < nt) stage_a<NF>(A, ld, T + 3, st3, tid, soff); \
        _Pragma("unroll") for (int n = 0; n < NF / 2; ++n) b[Q_][n] = *(const bf16x8*)(stn + boff + n * 1024); \
        MMA_G(4, P_); \
        __builtin_amdgcn_sched_barrier(0); a[7] = *(const bf16x8*)(st + aoff + 7 * 1024); \
        if (T + 3 < nt) stage_b<NF>(Bt, ld, T + 3, st3, tid, soff); \
        _Pragma("unroll") for (int n = NF / 2; n < NF; ++n) b[Q_][n] = *(const bf16x8*)(stn + boff + n * 1024); \
        MMA_G(5, P_); \
        __builtin_amdgcn_sched_barrier(0); a01[Q_][0] = *(const bf16x8*)(stn + aoff); MMA_G(6, P_); \
        __builtin_amdgcn_sched_barrier(0); a01[Q_][1] = *(const bf16x8*)(stn + aoff + 1024); MMA_G(7, P_); \
        __builtin_amdgcn_sched_barrier(0); } while (0)
    for (int t = 0; t < nt; t += 2) { KBODY(t, 0, 1); KBODY(t + 1, 1, 0); }
#undef KBODY
#undef MMA_G
}
DEVI bool next_tile(int it, int MT, int NT, int& mt, int& nt, int wv_) {
    const int x = (wv_ >> 2) & 7, bl = (wv_ >> 5) & 511, G8 = (wv_ >> 14) & 511;
    int nI = (MT - x + 7) >> 3; long j = (long)it * G8 + bl;
    if (j >= (long)nI * NT) return false;
    int i = (int)(j % nI); nt = (int)(j / nI); mt = x + 8 * i; return true;
}
#define ZERO_ACC(a, NF_) _Pragma("unroll") for (int m_ = 0; m_ < 8; ++m_) _Pragma("unroll") for (int n_ = 0; n_ < NF_; ++n_) a[m_][n_] = (f32x4){0.f, 0.f, 0.f, 0.f}
#define EPI_IDS const int lane = tidx(wv_) & 63, wid = tidx(wv_) >> 6, wr = wid >> 1, wc = wid & 1, fr = lane & 15, fq = lane >> 4

DEVI void proj_store_row(const f32x4 (&accm)[8], bf16_t* prow, float c1, float c3, bool issig, bool isact) {
#pragma unroll
    for (int q = 0; q < 4; ++q) { __builtin_amdgcn_sched_barrier(0); us8 o;
#pragma unroll
        for (int s = 0; s < 2; ++s)
#pragma unroll
            for (int j = 0; j < 4; ++j) { float x = accm[2 * q + s][j];
                float u = x * (c1 + c3 * x * x); float sg = __builtin_amdgcn_rcpf(1.f + __expf(-u)); float y = sg * (issig ? 1.f : x);
                o[4 * s + j] = f2bf(isact ? y : x); }
        *(us8*)(prow + q * 32) = o; }
}
DEVI void phase_proj(const Params& p, int l, int MT, char* lds, int wv_) {
    const bf16_t* xb = (const bf16_t*)(p.ws + WS_XB); const bf16_t* wt = (const bf16_t*)p.ws + (size_t)l * E_LAYER;
    bf16_t* proj = (bf16_t*)(p.ws + WS_PROJ);
    int mt, nt;
    for (int it = 0; next_tile(it, MT, 48, mt, nt, wv_); ++it) {
        f32x4 acc[8][8]; ZERO_ACC(acc, 8);
        gemm_kloop<8>(acc, xb + (size_t)mt * 256 * LDK, wt + (size_t)nt * 256 * LDK, 1024, LDK, lds, wv_);
        EPI_IDS;
        const int sg = nt >> 2;
        const int ty = (sg == 0 || sg == 3 || sg == 6) ? 1 : (sg == 7 ? 2 : (sg >= 9 ? 3 : 0));
        bf16_t* pbase = proj + (size_t)(mt * 256 + wr * 128 + fr) * NPROJ + nt * 256 + wc * 128 + fq * 8;
        const float c1 = ty == 2 ? 1.5957691216f : 1.f, c3 = ty == 2 ? 0.0713548163f : 0.f;
#pragma unroll
        for (int m = 0; m < 8; ++m) {
#pragma unroll
            for (int n = 0; n < 8; ++n) asm volatile("" : "+v"(acc[m][n]) :: "memory");
            proj_store_row(acc[m], pbase + (size_t)m * 16 * NPROJ, c1, c3, ty == 3, ty != 0); }
    }
}
DEVI void phase_merge(const Params& p, int l, int MT, char* lds, int wv_) {
    const bf16_t* wt = (const bf16_t*)p.ws + (size_t)l * E_LAYER + E_WIN; const bf16_t* proj = (const bf16_t*)(p.ws + WS_PROJ);
    bf16_t* mrg = (bf16_t*)(p.ws + WS_MRG);
    int mt, nt;
    for (int it = 0; next_tile(it, MT, 8, mt, nt, wv_); ++it) {
        f32x4 tot[8][4]; ZERO_ACC(tot, 4);
#pragma unroll 1
        for (int k = 0; k < 3; ++k) {
            const bf16_t* y = (const bf16_t*)(p.ws + WS_YMB + (size_t)k * ROWS * LDK * 2);
            f32x4 acc[8][4]; ZERO_ACC(acc, 4);
            gemm_kloop<4>(acc, y + (size_t)mt * 256 * LDK, wt + (size_t)k * 1024 * LDK + (size_t)nt * 128 * LDK, 1024, LDK, lds, wv_);
            EPI_IDS;
#pragma unroll
            for (int m = 0; m < 8; ++m) { int row = mt * 256 + wr * 128 + m * 16 + fr; asm volatile("" ::: "memory");
#pragma unroll
                for (int q = 0; q < 2; ++q) { int col = nt * 128 + wc * 64 + 32 * q + fq * 8; us8 g = *(const us8*)(proj + (size_t)row * NPROJ + PC_MG + k * 1024 + col);
#pragma unroll
                    for (int s = 0; s < 2; ++s)
#pragma unroll
                        for (int j = 0; j < 4; ++j) tot[m][2 * q + s][j] += acc[m][2 * q + s][j] * bf2f(g[4 * s + j]); } }
        }
        EPI_IDS;
#pragma unroll
        for (int m = 0; m < 8; ++m) { int row = mt * 256 + wr * 128 + m * 16 + fr;
#pragma unroll
            for (int q = 0; q < 2; ++q) { int col = nt * 128 + wc * 64 + 32 * q + fq * 8; us8 o;
#pragma unroll
                for (int s = 0; s < 2; ++s)
#pragma unroll
                    for (int j = 0; j < 4; ++j) o[4 * s + j] = f2bf(tot[m][2 * q + s][j]);
                *(us8*)(mrg + (size_t)row * LDK + col) = o; } }
    }
}
DEVI void phase_resid(const Params& p, int seg, int MT, const bf16_t* A, int K, int ld, const bf16_t* Bt, bool from_input, char* lds, int wv_) {
    int mt, nt;
    for (int it = 0; next_tile(it, MT, 8, mt, nt, wv_); ++it) {
        f32x4 acc[8][4]; ZERO_ACC(acc, 4);
        gemm_kloop<4>(acc, A + (size_t)mt * 256 * ld, Bt + (size_t)nt * 128 * ld, K, ld, lds, wv_);
        EPI_IDS;
#pragma unroll
        for (int m = 0; m < 8; ++m) { int row = mt * 256 + wr * 128 + m * 16 + fr;
            const float* xi = from_input ? xrow_in(p, seg, row) : xrow_out(p, seg, row); float* xo = xrow_out(p, seg, row);
#pragma unroll
            for (int n = 0; n < 4; ++n) { int col = nt * 128 + wc * 64 + n * 16 + fq * 4; f32x4 v = *(const f32x4*)(xi + col); *(f32x4*)(xo + col) = v + acc[m][n]; } }
    }
}
DEVI void phase_ffn_in(const Params& p, int l, int MT, char* lds, int wv_) {
    const bf16_t* xb = (const bf16_t*)(p.ws + WS_XB); const bf16_t* wt = (const bf16_t*)p.ws + (size_t)l * E_LAYER + E_WIN + E_WBR + E_WOUT;
    bf16_t* act = (bf16_t*)(p.ws + WS_PROJ);
    int mt, nt;
    for (int it = 0; next_tile(it, MT, 22, mt, nt, wv_); ++it) {
        f32x4 acc[8][8]; ZERO_ACC(acc, 8);
        gemm_kloop<8>(acc, xb + (size_t)mt * 256 * LDK, wt + (size_t)nt * 256 * LDK, 1024, LDK, lds, wv_);
        EPI_IDS;
#pragma unroll
        for (int m = 0; m < 8; ++m) { int row = mt * 256 + wr * 128 + m * 16 + fr;
#pragma unroll
            for (int n = 0; n < 8; ++n) asm volatile("" : "+v"(acc[m][n]) :: "memory");
#pragma unroll
            for (int G = 0; G < 2; ++G) { int col = (nt * 2 + wc) * 64 + 32 * G + fq * 8; us8 o;
#pragma unroll
                for (int h = 0; h < 2; ++h)
#pragma unroll
                    for (int j = 0; j < 4; ++j) o[4 * h + j] = f2bf(silu(acc[m][4 * G + 2 * h][j]) * acc[m][4 * G + 2 * h + 1][j]);
                *(us8*)(act + (size_t)row * LDF + col) = o; } }
    }
}

struct Seq { int row0, nchunk, Q, b, samp, seg; };
DEVI Seq make_seq(int seg, int sq) { Seq s; s.seg = seg; if (sq < 16) { s.row0 = sq * SEGT; s.nchunk = 8; s.Q = 64; s.b = sq; s.samp = 0; } else { s.b = sq - 16; s.row0 = ROWS_P + s.b * 32; s.nchunk = 1; s.Q = 32; s.samp = 1; } return s; }

template <int NF, int KS>
DEVI void lds_mma(f32x4* acc, const bf16_t* X, int ldx, int m0, const bf16_t* Y, int ldy, int n0, int wv_) {
    const int lane = tidx(wv_) & 63, fr = lane & 15, fq = lane >> 4;
#pragma unroll
    for (int ks = 0; ks < KS; ++ks) {
        bf16x8 a = *(const bf16x8*)(X + (m0 + fr) * ldx + ks * 32 + fq * 8);
#pragma unroll
        for (int nf = 0; nf < NF; ++nf) { bf16x8 b = *(const bf16x8*)(Y + (n0 + nf * 16 + fr) * ldy + ks * 32 + fq * 8); acc[nf] = __builtin_amdgcn_mfma_f32_16x16x32_bf16(a, b, acc[nf], 0, 0, 0); }
    }
}

DEVI void conv_load(uint4 (&r)[4], const bf16_t* proj, int row0, int tq, int pcol) {
#pragma unroll
    for (int k = 0; k < 4; ++k) { int ts = tq - 3 + k; ts = ts < 0 ? 0 : ts; r[k] = *(const uint4*)(proj + (size_t)(row0 + ts) * NPROJ + pcol); }
}
DEVI void touch4(uint4& v) { asm volatile("" : "+v"(v.x), "+v"(v.y), "+v"(v.z), "+v"(v.w)); }
DEVI void conv_compute(const uint4 (&r)[4], int tq, const float* hl, const float* cwl, int HC, int cl, float (&out)[8], float (&raw)[8]) {
    { f32x4 b0 = *(const f32x4*)(cwl + 4 * HC + cl), b1 = *(const f32x4*)(cwl + 4 * HC + cl + 4);
      out[0] = b0[0]; out[1] = b0[1]; out[2] = b0[2]; out[3] = b0[3]; out[4] = b1[0]; out[5] = b1[1]; out[6] = b1[2]; out[7] = b1[3]; }
#pragma unroll
    for (int k = 0; k < 4; ++k) {
        const int ts = tq - 3 + k; float v[8];
        v[0] = __uint_as_float(r[k].x << 16); v[1] = __uint_as_float(r[k].x & 0xffff0000u); v[2] = __uint_as_float(r[k].y << 16); v[3] = __uint_as_float(r[k].y & 0xffff0000u);
        v[4] = __uint_as_float(r[k].z << 16); v[5] = __uint_as_float(r[k].z & 0xffff0000u); v[6] = __uint_as_float(r[k].w << 16); v[7] = __uint_as_float(r[k].w & 0xffff0000u);
        if (k < 3) { int hi = 3 + ts; hi = hi < 0 ? 0 : (hi > 2 ? 2 : hi); const bool uh = ts < 0;
            f32x4 h0 = *(const f32x4*)(hl + hi * HC + cl), h1 = *(const f32x4*)(hl + hi * HC + cl + 4);
            v[0] = uh ? h0[0] : v[0]; v[1] = uh ? h0[1] : v[1]; v[2] = uh ? h0[2] : v[2]; v[3] = uh ? h0[3] : v[3];
            v[4] = uh ? h1[0] : v[4]; v[5] = uh ? h1[1] : v[5]; v[6] = uh ? h1[2] : v[6]; v[7] = uh ? h1[3] : v[7]; }
        f32x4 w0 = *(const f32x4*)(cwl + k * HC + cl), w1 = *(const f32x4*)(cwl + k * HC + cl + 4);
        out[0] += v[0] * w0[0]; out[1] += v[1] * w0[1]; out[2] += v[2] * w0[2]; out[3] += v[3] * w0[3];
        out[4] += v[4] * w1[0]; out[5] += v[5] * w1[1]; out[6] += v[6] * w1[2]; out[7] += v[7] * w1[3];
        if (k == 3) {
#pragma unroll
            for (int e = 0; e < 8; ++e) raw[e] = v[e]; }
    }
}

template <int ROWB>
DEVI void stage_raw(const char* g0, size_t ldgB, char* dst, int tid) {
#pragma unroll
    for (int i = 0; i < ROWB / 64; ++i) { int b = tid * 16 + i * 4096, row = b / ROWB, cb = b % ROWB;
        __builtin_amdgcn_global_load_lds((const unsigned*)(g0 + (size_t)row * ldgB + cb), (unsigned*)(dst + b), 16, 0, 0); }
}
DEVI void conv_lds(const bf16_t* rawt, int RS, int t, int cloc, const float* hl, const float* cwl, int HC, int cl, float (&out)[8], float (&raw)[8]) {
    { f32x4 b0 = *(const f32x4*)(cwl + 4 * HC + cl), b1 = *(const f32x4*)(cwl + 4 * HC + cl + 4);
      out[0] = b0[0]; out[1] = b0[1]; out[2] = b0[2]; out[3] = b0[3]; out[4] = b1[0]; out[5] = b1[1]; out[6] = b1[2]; out[7] = b1[3]; }
#pragma unroll
    for (int k = 0; k < 4; ++k) {
        const int tt = t - 3 + k; const int tc = tt < 0 ? 0 : tt; float v[8];
        const uint4 r = *(const uint4*)(rawt + tc * RS + cloc);
        v[0] = __uint_as_float(r.x << 16); v[1] = __uint_as_float(r.x & 0xffff0000u); v[2] = __uint_as_float(r.y << 16); v[3] = __uint_as_float(r.y & 0xffff0000u);
        v[4] = __uint_as_float(r.z << 16); v[5] = __uint_as_float(r.z & 0xffff0000u); v[6] = __uint_as_float(r.w << 16); v[7] = __uint_as_float(r.w & 0xffff0000u);
        if (k < 3) { int hi = 3 + tt; hi = hi < 0 ? 0 : (hi > 2 ? 2 : hi); const bool uh = tt < 0;
            f32x4 h0 = *(const f32x4*)(hl + hi * HC + cl), h1 = *(const f32x4*)(hl + hi * HC + cl + 4);
            v[0] = uh ? h0[0] : v[0]; v[1] = uh ? h0[1] : v[1]; v[2] = uh ? h0[2] : v[2]; v[3] = uh ? h0[3] : v[3];
            v[4] = uh ? h1[0] : v[4]; v[5] = uh ? h1[1] : v[5]; v[6] = uh ? h1[2] : v[6]; v[7] = uh ? h1[3] : v[7]; }
        f32x4 w0 = *(const f32x4*)(cwl + k * HC + cl), w1 = *(const f32x4*)(cwl + k * HC + cl + 4);
        out[0] += v[0] * w0[0]; out[1] += v[1] * w0[1]; out[2] += v[2] * w0[2]; out[3] += v[3] * w0[3];
        out[4] += v[4] * w1[0]; out[5] += v[5] * w1[1]; out[6] += v[6] * w1[2]; out[7] += v[7] * w1[3];
        if (k == 3) {
#pragma unroll
            for (int e = 0; e < 8; ++e) raw[e] = v[e]; }
    }
}

DEVI void ssd_unit(const Params& p, int l, Seq sq, int hd, char* lds, int wv_) {
    bf16_t* Bm = (bf16_t*)lds;
    bf16_t* R2 = (bf16_t*)(lds + 17408);
    bf16_t* xT = (bf16_t*)(lds + 35840);
    bf16_t* hb = (bf16_t*)(lds + 45056);
    float* fl = (float*)(lds + 62464);
    const int tid = tidx(wv_), lane = tid & 63, w = tid >> 6, fr = lane & 15, fq = lane >> 4;
    const bf16_t* proj = (const bf16_t*)(p.ws + WS_PROJ); const float* dtb = (const float*)(p.ws + WS_DT); bf16_t* ymb = (bf16_t*)(p.ws + WS_YMB);
    const int g = hd >> 2;
    const float a = -__expf(p.in[I_ALOG][l * 16 + hd]), Dv = p.in[I_MBD][l * 16 + hd];
    const float* cw = p.in[I_MCW] + (size_t)l * 4 * 2048; const float* cbias = p.in[I_MCB] + l * 2048;
    float* cwl = (float*)(lds + 63488);
    float* hl = (float*)(lds + 69888);
    const float* st_in; float* st_out; const float* hist; float* hist_out; float* hist_out2 = nullptr;
    float* hbuf = (float*)(p.ws + WS_HB);
    if (sq.samp) { st_in = p.in[I_SSM] + ((size_t)(l * 16 + sq.b) * 16 + hd) * 8192; st_out = p.out + O_SSM_S + ((size_t)(l * 16 + sq.b) * 16 + hd) * 8192;
        hist = p.in[I_SCV] + (size_t)(l * 16 + sq.b) * 3 * 2048; hist_out = p.out + O_SCV_S + (size_t)(l * 16 + sq.b) * 3 * 2048; }
    else { st_out = p.out + O_SSM_P + ((size_t)(l * 16 + sq.b) * 16 + hd) * 8192; st_in = sq.seg ? st_out : nullptr;
        hist_out = hbuf + ((size_t)((sq.seg & 1) * 2 + l) * 16 + sq.b) * 3 * 2048; hist = sq.seg ? hbuf + ((size_t)(((sq.seg + 1) & 1) * 2 + l) * 16 + sq.b) * 3 * 2048 : nullptr;
        if (sq.seg == NSEG - 1) hist_out2 = p.out + O_SCV_P + (size_t)(l * 16 + sq.b) * 3 * 2048; }
    for (int idx = tid; idx < 1600; idx += 256) { int k = idx / 320, cc = idx - k * 320; int ch = cc < 64 ? hd * 64 + cc : (cc < 192 ? 1024 + g * 128 + (cc - 64) : 1536 + g * 128 + (cc - 192));
        cwl[idx] = k < 4 ? cw[k * 2048 + ch] : cbias[ch];
        if (idx < 960) hl[idx] = hist ? hist[k * 2048 + ch] : 0.f; }
    f32x4 hacc[8];
#pragma unroll
    for (int nf = 0; nf < 8; ++nf)
#pragma unroll
        for (int r = 0; r < 4; ++r) { int pp = 16 * w + 4 * fq + r, n = 16 * nf + fr; float v = st_in ? st_in[pp * 128 + n] : 0.f; hacc[nf][r] = v; hb[pp * 136 + n] = f2bf(v); }
    bf16_t* rawX = (bf16_t*)(lds + 77568); bf16_t* rawB = (bf16_t*)(lds + 85760); bf16_t* rawC = (bf16_t*)(lds + 102144); bf16_t* rawZ = (bf16_t*)(lds + 118528); float* rawDt = (float*)(lds + 126720);
    const char* gx = (const char*)(proj + PC_XBC + hd * 64); const char* gb = (const char*)(proj + PC_XBC + 1024 + g * 128); const char* gc = (const char*)(proj + PC_XBC + 1536 + g * 128); const char* gz = (const char*)(proj + PC_Z + hd * 64);
    asm volatile("s_waitcnt vmcnt(0)" ::: "memory");
    {   const size_t ro = (size_t)sq.row0 * NPROJ * 2;
        stage_raw<128>(gx + ro, (size_t)NPROJ * 2, (char*)rawX, tid); stage_raw<256>(gb + ro, (size_t)NPROJ * 2, (char*)rawB, tid); stage_raw<256>(gc + ro, (size_t)NPROJ * 2, (char*)rawC, tid);
        stage_raw<128>(gz + ro, (size_t)NPROJ * 2, (char*)rawZ, tid); stage_raw<64>((const char*)(dtb + (size_t)sq.row0 * 16), 64, (char*)rawDt, tid); }
    for (int c = 0; c < sq.nchunk; ++c) {
        const int tid = tidx(wv_), lane = tid & 63, w = tid >> 6, fr = lane & 15, fq = lane >> 4;
        const int rowc = sq.row0 + c * 64; const bool lastc = (c == sq.nchunk - 1);
        const float* hlr = hl + (c & 1) * 960; float* hlw = hl + ((c + 1) & 1) * 960;
        asm volatile("s_waitcnt vmcnt(0)" ::: "memory");
        __syncthreads();
        if (w == 0) {
            float dt = lane < sq.Q ? rawDt[lane * 16 + hd] : 0.f; float v = dt * a;
#pragma unroll
            for (int o = 1; o < 64; o <<= 1) { float t = shfli(v, lane - o); if (lane >= o) v += t; }
            float last = shfli(v, 63);
            fl[lane] = v; fl[64 + lane] = dt; fl[128 + lane] = __expf(last - v) * dt; fl[192 + lane] = __expf(v);
        }
        __syncthreads();
        const float elast = __expf(fl[63]);
#pragma unroll
        for (int i = 0; i < 2; ++i) { int it = tid + 256 * i, t = it >> 3, c8 = (it & 7) * 8; float o[8], raw[8]; int ch = hd * 64 + c8; const bool tv = t < sq.Q;
            conv_lds(rawX, 64, t, c8, hlr, cwl, 320, c8, o, raw);
#pragma unroll
            for (int e = 0; e < 8; ++e) { float s_ = silu(o[e]); o[e] = tv ? s_ : 0.f; }
            if (t >= 61) {
#pragma unroll
                for (int e = 0; e < 8; ++e) hlw[(t - 61) * 320 + c8 + e] = raw[e]; }
            if (lastc && tv && t >= sq.Q - 3) {
#pragma unroll
                for (int e = 0; e < 8; ++e) { hist_out[(t - (sq.Q - 3)) * 2048 + ch + e] = raw[e]; if (hist_out2) hist_out2[(t - (sq.Q - 3)) * 2048 + ch + e] = raw[e]; } }
#pragma unroll
            for (int e = 0; e < 8; ++e) xT[(c8 + e) * 72 + t] = f2bf(o[e]); }
#pragma unroll
        for (int i = 0; i < 4; ++i) { int it = tid + 256 * i, t = it >> 4, c8 = (it & 15) * 8; float o[8], raw[8]; int ch = 1024 + g * 128 + c8; const bool tv = t < sq.Q;
            conv_lds(rawB, 128, t, c8, hlr, cwl, 320, 64 + c8, o, raw);
#pragma unroll
            for (int e = 0; e < 8; ++e) { float s_ = silu(o[e]); o[e] = tv ? s_ : 0.f; }
            if (t >= 61) {
#pragma unroll
                for (int e = 0; e < 8; ++e) hlw[(t - 61) * 320 + 64 + c8 + e] = raw[e]; }
            if (lastc && tv && (hd & 3) == 0 && t >= sq.Q - 3) {
#pragma unroll
                for (int e = 0; e < 8; ++e) { hist_out[(t - (sq.Q - 3)) * 2048 + ch + e] = raw[e]; if (hist_out2) hist_out2[(t - (sq.Q - 3)) * 2048 + ch + e] = raw[e]; } }
            us8 ov; float we = fl[128 + t];
#pragma unroll
            for (int e = 0; e < 8; ++e) { ov[e] = f2bf(o[e]); R2[(c8 + e) * 72 + t] = f2bf(o[e] * we); }
            *(us8*)(Bm + t * 136 + c8) = ov; }
        __syncthreads();
#pragma unroll
        for (int nf = 0; nf < 8; ++nf) hacc[nf] *= elast;
        lds_mma<8, 2>(hacc, xT, 72, 16 * w, R2, 72, 0, wv_);
        __syncthreads();
#pragma unroll
        for (int i = 0; i < 4; ++i) { int it = tid + 256 * i, t = it >> 4, c8 = (it & 15) * 8; float o[8], raw[8]; int ch = 1536 + g * 128 + c8; const bool tv = t < sq.Q;
            conv_lds(rawC, 128, t, c8, hlr, cwl, 320, 192 + c8, o, raw);
#pragma unroll
            for (int e = 0; e < 8; ++e) { float s_ = silu(o[e]); o[e] = tv ? s_ : 0.f; }
            if (t >= 61) {
#pragma unroll
                for (int e = 0; e < 8; ++e) hlw[(t - 61) * 320 + 192 + c8 + e] = raw[e]; }
            if (lastc && tv && (hd & 3) == 0 && t >= sq.Q - 3) {
#pragma unroll
                for (int e = 0; e < 8; ++e) { hist_out[(t - (sq.Q - 3)) * 2048 + ch + e] = raw[e]; if (hist_out2) hist_out2[(t - (sq.Q - 3)) * 2048 + ch + e] = raw[e]; } }
            us8 ov;
#pragma unroll
            for (int e = 0; e < 8; ++e) ov[e] = f2bf(o[e]);
            *(us8*)(R2 + t * 136 + c8) = ov; }
        us4 zr[4];
#pragma unroll
        for (int nf = 0; nf < 4; ++nf) zr[nf] = *(const us4*)(rawZ + (16 * nf + fr) * 64 + 16 * w + 4 * fq);
        __syncthreads();
        if (!lastc) { const size_t ro = (size_t)(rowc + 64) * NPROJ * 2;
            stage_raw<128>(gx + ro, (size_t)NPROJ * 2, (char*)rawX, tid); stage_raw<256>(gb + ro, (size_t)NPROJ * 2, (char*)rawB, tid); stage_raw<256>(gc + ro, (size_t)NPROJ * 2, (char*)rawC, tid);
            stage_raw<128>(gz + ro, (size_t)NPROJ * 2, (char*)rawZ, tid); stage_raw<64>((const char*)(dtb + (size_t)(rowc + 64) * 16), 64, (char*)rawDt, tid); }
        f32x4 cbv[4];
#pragma unroll
        for (int nf = 0; nf < 4; ++nf) cbv[nf] = (f32x4){0.f, 0.f, 0.f, 0.f};
        lds_mma<4, 4>(cbv, Bm, 136, 16 * w, R2, 136, 0, wv_);
        __syncthreads();
#pragma unroll
        for (int nf = 0; nf < 4; ++nf) { int i = 16 * nf + fr; float ai = fl[i]; us4 o;
#pragma unroll
            for (int r = 0; r < 4; ++r) { int j = 16 * w + 4 * fq + r; float v = (j <= i) ? cbv[nf][r] * __expf(ai - fl[j]) * fl[64 + j] : 0.f; o[r] = f2bf(v); }
            *(us4*)(Bm + i * 72 + 16 * w + 4 * fq) = o; }
        __syncthreads();
        f32x4 ya[4];
#pragma unroll
        for (int nf = 0; nf < 4; ++nf) ya[nf] = (f32x4){0.f, 0.f, 0.f, 0.f};
        lds_mma<4, 4>(ya, hb, 136, 16 * w, R2, 136, 0, wv_);
#pragma unroll
        for (int nf = 0; nf < 4; ++nf) ya[nf] *= fl[192 + 16 * nf + fr];
        lds_mma<4, 2>(ya, xT, 72, 16 * w, Bm, 72, 0, wv_);
#pragma unroll
        for (int nf = 0; nf < 4; ++nf) { int i = 16 * nf + fr, p0 = 16 * w + 4 * fq;
            us4 z = zr[nf];
            if (i < sq.Q) { us4 o;
#pragma unroll
                for (int r = 0; r < 4; ++r) o[r] = f2bf((ya[nf][r] + Dv * bf2f(xT[(p0 + r) * 72 + i])) * bf2f(z[r]));
                *(us4*)(ymb + (size_t)(rowc + i) * LDK + hd * 64 + p0) = o; } }
        __syncthreads();
#pragma unroll
        for (int nf = 0; nf < 8; ++nf)
#pragma unroll
            for (int r = 0; r < 4; ++r) hb[(16 * w + 4 * fq + r) * 136 + 16 * nf + fr] = f2bf(hacc[nf][r]);
    }
#pragma unroll
    for (int nf = 0; nf < 8; ++nf)
#pragma unroll
        for (int r = 0; r < 4; ++r) st_out[(16 * w + 4 * fq + r) * 128 + 16 * nf + fr] = hacc[nf][r];
    __syncthreads();
}

DEVI void hgrn_unit(const Params& p, int l, Seq sq, int h, char* lds, int wv_) {
    bf16_t* sb = (bf16_t*)lds;
    bf16_t* qt = (bf16_t*)(lds + 34816);
    bf16_t* kt = (bf16_t*)(lds + 52224);
    bf16_t* att = (bf16_t*)lds;
    bf16_t* kT = (bf16_t*)(lds + 9216);
    bf16_t* vT = (bf16_t*)(lds + 27648);
    float* T0 = (float*)(lds + 69632); float* T1 = T0 + 128; float* ssq = T0 + 256;
    const int tid = tidx(wv_), lane = tid & 63, w = tid >> 6, fr = lane & 15, fq = lane >> 4;
    const int k = tid & 127, half = tid >> 7;
    const bf16_t* proj = (const bf16_t*)(p.ws + WS_PROJ); bf16_t* yhg = (bf16_t*)(p.ws + WS_YHG);
    float lb = 0.f;
    if (l == 1) { float a0 = p.in[I_LBL][h * 128 + k], a1 = p.in[I_LBL][1024 + h * 128 + k]; lb = 1.f / (1.f + __expf(a0 - a1)); }
    const float* nw = p.in[I_HGNW] + l * 128;
    const float* st_in; float* st_out;
    if (sq.samp) { st_in = p.in[I_HG] + ((size_t)(l * 16 + sq.b) * 8 + h) * 16384; st_out = p.out + O_HG_S + ((size_t)(l * 16 + sq.b) * 8 + h) * 16384; }
    else { st_out = p.out + O_HG_P + ((size_t)(l * 16 + sq.b) * 8 + h) * 16384; st_in = sq.seg ? st_out : nullptr; }
    f32x4 hacc[2][8];
#pragma unroll
    for (int mf = 0; mf < 2; ++mf)
#pragma unroll
        for (int nf = 0; nf < 8; ++nf)
#pragma unroll
            for (int r = 0; r < 4; ++r) hacc[mf][nf][r] = st_in ? st_in[(32 * w + 16 * mf + 4 * fq + r) * 128 + 16 * nf + fr] : 0.f;
    f32x4 nwr[2];
#pragma unroll
    for (int mf = 0; mf < 2; ++mf) nwr[mf] = *(const f32x4*)(nw + 32 * w + 16 * mf + 4 * fq);
    bf16_t* rawF = (bf16_t*)(lds + 71680); bf16_t* rawQ = (bf16_t*)(lds + 88064); bf16_t* rawV = (bf16_t*)(lds + 104448); bf16_t* rawH = (bf16_t*)(lds + 120832);
    const char* gf = (const char*)(proj + PC_HF + h * 128); const char* gq = (const char*)(proj + PC_HQ + h * 128); const char* gv = (const char*)(proj + PC_HI + h * 128); const char* gh = (const char*)(proj + PC_HGATE + h * 128);
    asm volatile("s_waitcnt vmcnt(0)" ::: "memory");
    {   const size_t ro = (size_t)sq.row0 * NPROJ * 2;
        stage_raw<256>(gf + ro, (size_t)NPROJ * 2, (char*)rawF, tid); stage_raw<256>(gq + ro, (size_t)NPROJ * 2, (char*)rawQ, tid); stage_raw<256>(gv + ro, (size_t)NPROJ * 2, (char*)rawV, tid); }
    for (int c = 0; c < sq.nchunk; ++c) {
        const int tid = tidx(wv_), lane = tid & 63, w = tid >> 6, fr = lane & 15, fq = lane >> 4, k = tid & 127, half = tid >> 7;
        const int rowc = sq.row0 + c * 64; const bool lastc = (c == sq.nchunk - 1);
        asm volatile("s_waitcnt vmcnt(0)" ::: "memory");
        __syncthreads();
        stage_raw<256>(gh + (size_t)rowc * NPROJ * 2, (size_t)NPROJ * 2, (char*)rawH, tid);
        {
            unsigned fu[32], qu[32];
#pragma unroll
            for (int jj = 0; jj < 32; ++jj) { fu[jj] = rawF[(32 * half + jj) * 128 + k]; qu[jj] = rawQ[(32 * half + jj) * 128 + k]; }
            if (tid < 64) ssq[tid] = 0.f;
            float run = 0.f;
            if (half == 0) {
#pragma unroll
                for (int jj = 31; jj >= 0; --jj) { bool valid = jj < sq.Q; float f = __uint_as_float(fu[jj] << 16);
                    float sg = __builtin_amdgcn_rcpf(1.f + __expf(-f)); float lg0 = __logf(lb + (1.f - lb) * sg); float lg = valid ? lg0 : 0.f;
                    float kk0 = (1.f - lb) * (1.f - sg); float kk = valid ? kk0 : 0.f; float q0 = __uint_as_float(qu[jj] << 16); float q = valid ? q0 : 0.f;
                    qt[jj * 136 + k] = f2bf(q * cexp(-run)); kt[jj * 136 + k] = f2bf(kk * cexp(run)); run += lg; }
                T0[k] = run;
            } else {
#pragma unroll
                for (int jj = 0; jj < 32; ++jj) { bool valid = (32 + jj) < sq.Q; float f = __uint_as_float(fu[jj] << 16);
                    float sg = __builtin_amdgcn_rcpf(1.f + __expf(-f)); float lg0 = __logf(lb + (1.f - lb) * sg); float lg = valid ? lg0 : 0.f;
                    float kk0 = (1.f - lb) * (1.f - sg); float kk = valid ? kk0 : 0.f; float q0 = __uint_as_float(qu[jj] << 16); float q = valid ? q0 : 0.f;
                    run += lg; qt[(32 + jj) * 136 + k] = f2bf(q * cexp(run)); kt[(32 + jj) * 136 + k] = f2bf(kk * cexp(-run)); }
                T1[k] = run;
            }
        }
        __syncthreads();
#pragma unroll
        for (int mf = 0; mf < 2; ++mf) { int k0 = 32 * w + 16 * mf + 4 * fq; float e0 = __expf(T0[k0]), e1 = __expf(T0[k0 + 1]), e2 = __expf(T0[k0 + 2]), e3 = __expf(T0[k0 + 3]);
#pragma unroll
            for (int nf = 0; nf < 8; ++nf) { hacc[mf][nf][0] *= e0; hacc[mf][nf][1] *= e1; hacc[mf][nf][2] *= e2; hacc[mf][nf][3] *= e3;
                us4 o; o[0] = f2bf(hacc[mf][nf][0]); o[1] = f2bf(hacc[mf][nf][1]); o[2] = f2bf(hacc[mf][nf][2]); o[3] = f2bf(hacc[mf][nf][3]);
                *(us4*)(sb + (16 * nf + fr) * 136 + k0) = o; } }
        f32x4 at[4];
#pragma unroll
        for (int nf = 0; nf < 4; ++nf) at[nf] = (f32x4){0.f, 0.f, 0.f, 0.f};
        lds_mma<4, 4>(at, kt, 136, 16 * w, qt, 136, 0, wv_);
        __syncthreads();
        f32x4 oacc[2][4];
#pragma unroll
        for (int mf = 0; mf < 2; ++mf) {
#pragma unroll
            for (int nf = 0; nf < 4; ++nf) oacc[mf][nf] = (f32x4){0.f, 0.f, 0.f, 0.f};
            lds_mma<4, 4>(oacc[mf], sb, 136, 32 * w + 16 * mf, qt, 136, 0, wv_); }
        __syncthreads();
#pragma unroll
        for (int nf = 0; nf < 4; ++nf) { int i = 16 * nf + fr; us4 o;
#pragma unroll
            for (int r = 0; r < 4; ++r) { int j = 16 * w + 4 * fq + r; o[r] = f2bf(j <= i ? at[nf][r] : 0.f); }
            *(us4*)(att + i * 72 + 16 * w + 4 * fq) = o; }
        {   unsigned vu[32];
#pragma unroll
            for (int jj = 0; jj < 32; ++jj) vu[jj] = rawV[(32 * half + jj) * 128 + k];
#pragma unroll
            for (int q4 = 0; q4 < 4; ++q4) { us8 kv, vv;
#pragma unroll
                for (int e = 0; e < 8; ++e) { int jj = q4 * 8 + e; bool valid = (32 * half + jj) < sq.Q; kv[e] = kt[(32 * half + jj) * 136 + k]; vv[e] = valid ? (bf16_t)vu[jj] : (bf16_t)0; }
                *(us8*)(kT + k * 72 + 32 * half + q4 * 8) = kv; *(us8*)(vT + k * 72 + 32 * half + q4 * 8) = vv; } }
        __syncthreads();
        if (!lastc) { const size_t ro = (size_t)(rowc + 64) * NPROJ * 2;
            stage_raw<256>(gf + ro, (size_t)NPROJ * 2, (char*)rawF, tid); stage_raw<256>(gq + ro, (size_t)NPROJ * 2, (char*)rawQ, tid); stage_raw<256>(gv + ro, (size_t)NPROJ * 2, (char*)rawV, tid); }
#pragma unroll
        for (int mf = 0; mf < 2; ++mf) {
            lds_mma<4, 2>(oacc[mf], vT, 72, 32 * w + 16 * mf, att, 72, 0, wv_);
            lds_mma<8, 2>(hacc[mf], kT, 72, 32 * w + 16 * mf, vT, 72, 0, wv_);
            int k0 = 32 * w + 16 * mf + 4 * fq; float e0 = __expf(T1[k0]), e1 = __expf(T1[k0 + 1]), e2 = __expf(T1[k0 + 2]), e3 = __expf(T1[k0 + 3]);
#pragma unroll
            for (int nf = 0; nf < 8; ++nf) { hacc[mf][nf][0] *= e0; hacc[mf][nf][1] *= e1; hacc[mf][nf][2] *= e2; hacc[mf][nf][3] *= e3; } }
#pragma unroll
        for (int nf = 0; nf < 4; ++nf) { float s = 0.f;
#pragma unroll
            for (int mf = 0; mf < 2; ++mf)
#pragma unroll
                for (int r = 0; r < 4; ++r) s += oacc[mf][nf][r] * oacc[mf][nf][r];
            s += shflx(s, 16, lane); s += shflx(s, 32, lane);
            if (fq == 0) atomicAdd(&ssq[16 * nf + fr], s); }
        if (lastc) asm volatile("s_waitcnt vmcnt(0)" ::: "memory"); else asm volatile("s_waitcnt vmcnt(12)" ::: "memory");
        __syncthreads();
#pragma unroll
        for (int nf = 0; nf < 4; ++nf) { int i = 16 * nf + fr; float rs = rsqrtf(ssq[i] * (1.f / 128.f) + 1e-6f);
#pragma unroll
            for (int mf = 0; mf < 2; ++mf) { int v0 = 32 * w + 16 * mf + 4 * fq; us4 gt = *(const us4*)(rawH + i * 128 + v0); f32x4 wv = nwr[mf]; us4 o;
#pragma unroll
                for (int r = 0; r < 4; ++r) o[r] = f2bf(oacc[mf][nf][r] * rs * wv[r] * bf2f(gt[r]));
                if (i < sq.Q) *(us4*)(yhg + (size_t)(rowc + i) * LDK + h * 128 + v0) = o; } }
        __syncthreads();
    }
#pragma unroll
    for (int mf = 0; mf < 2; ++mf)
#pragma unroll
        for (int nf = 0; nf < 8; ++nf)
#pragma unroll
            for (int r = 0; r < 4; ++r) st_out[(32 * w + 16 * mf + 4 * fq + r) * 128 + 16 * nf + fr] = hacc[mf][nf][r];
}

DEVI void rg_unit(const Params& p, int l, Seq sq, int blk, char* lds, int wv_) {
    bf16_t* waT = (bf16_t*)lds; bf16_t* wiT = (bf16_t*)(lds + 9216); bf16_t* xr = (bf16_t*)(lds + 18432);
    float* av = (float*)(lds + 27648); float* uv = (float*)(lds + 44288); float* Pq = (float*)(lds + 60928); float* Hq = Pq + 256; float* carry = Hq + 256;
    const int tid = tidx(wv_), lane = tid & 63, w = tid >> 6, fr = lane & 15, fq = lane >> 4;
    const bf16_t* proj = (const bf16_t*)(p.ws + WS_PROJ); bf16_t* yrg = (bf16_t*)(p.ws + WS_YRG);
    const int cb0 = blk * 64;
    const float* cw = p.in[I_RCW] + (size_t)l * 4 * 1024; const float* cbias = p.in[I_RCB] + l * 1024;
    const float* st_in; float* st_out; const float* hist; float* hist_out;
    if (sq.samp) { st_in = p.in[I_RG] + (size_t)(l * 16 + sq.b) * 1024; st_out = p.out + O_RG_S + (size_t)(l * 16 + sq.b) * 1024;
        hist = p.in[I_RCV] + (size_t)(l * 16 + sq.b) * 3 * 1024; hist_out = p.out + O_RCV_S + (size_t)(l * 16 + sq.b) * 3 * 1024; }
    else { st_out = p.out + O_RG_P + (size_t)(l * 16 + sq.b) * 1024; st_in = sq.seg ? st_out : nullptr;
        hist_out = p.out + O_RCV_P + (size_t)(l * 16 + sq.b) * 3 * 1024; hist = sq.seg ? hist_out : nullptr; }
    float* cwl = (float*)(lds + 63232);
    float* hl = (float*)(lds + 64512);
    float* hl2 = (float*)(lds + 90112);
    for (int idx = tid; idx < 320; idx += 256) { int k = idx >> 6, cc = idx & 63; cwl[idx] = k < 4 ? cw[k * 1024 + cb0 + cc] : cbias[cb0 + cc]; if (idx < 192) hl[idx] = hist ? hist[k * 1024 + cb0 + cc] : 0.f; }
    {   const float* wa = p.in[I_RWA] + ((size_t)l * 16 + blk) * 4096; const float* wi = p.in[I_RWI] + ((size_t)l * 16 + blk) * 4096;
        float wa_[16], wi_[16];
#pragma unroll
        for (int u = 0; u < 16; ++u) { wa_[u] = wa[tid + 256 * u]; wi_[u] = wi[tid + 256 * u]; }
#pragma unroll
        for (int u = 0; u < 16; ++u) { int e = tid + 256 * u, i = e >> 6, j = e & 63; waT[j * 72 + i] = f2bf(wa_[u]); wiT[j * 72 + i] = f2bf(wi_[u]); }
        if (tid < 64) carry[tid] = st_in ? st_in[cb0 + tid] : 0.f; }
    float cba[4], cbi[4], csp[4];
#pragma unroll
    for (int nf = 0; nf < 4; ++nf) { int cc = cb0 + 16 * nf + fr; cba[nf] = p.in[I_RBA][l * 1024 + cc]; cbi[nf] = p.in[I_RBI][l * 1024 + cc]; csp[nf] = softplus(-p.in[I_RLAM][l * 1024 + cc]); }
    bf16_t* rawR = (bf16_t*)(lds + 65536); bf16_t* rawG = (bf16_t*)(lds + 73728);
    const char* gr = (const char*)(proj + PC_RX + cb0); const char* gg = (const char*)(proj + PC_RGATE + cb0);
    asm volatile("s_waitcnt vmcnt(0)" ::: "memory");
    stage_raw<128>(gr + (size_t)sq.row0 * NPROJ * 2, (size_t)NPROJ * 2, (char*)rawR, tid); stage_raw<128>(gg + (size_t)sq.row0 * NPROJ * 2, (size_t)NPROJ * 2, (char*)rawG, tid);
    for (int c = 0; c < sq.nchunk; ++c) {
        const int tid = tidx(wv_), lane = tid & 63, w = tid >> 6, fr = lane & 15, fq = lane >> 4, j = tid & 63, q = tid >> 6;
        const int rowc = sq.row0 + c * 64; const bool lastc = (c == sq.nchunk - 1);
        const float* hlr = (c & 1) ? hl2 : hl; float* hlw = (c & 1) ? hl : hl2;
        asm volatile("s_waitcnt vmcnt(0)" ::: "memory");
        __syncthreads();
#pragma unroll
        for (int i = 0; i < 2; ++i) { int it = tid + 256 * i, t = it >> 3, c8 = (it & 7) * 8; float o[8], raw[8]; int ch = cb0 + c8; const bool tv = t < sq.Q;
            conv_lds(rawR, 64, t, c8, hlr, cwl, 64, c8, o, raw);
            if (t >= 61) {
#pragma unroll
                for (int e = 0; e < 8; ++e) hlw[(t - 61) * 64 + c8 + e] = raw[e]; }
            if (lastc && tv && t >= sq.Q - 3) {
#pragma unroll
                for (int e = 0; e < 8; ++e) hist_out[(t - (sq.Q - 3)) * 1024 + ch + e] = raw[e]; }
            us8 ov;
#pragma unroll
            for (int e = 0; e < 8; ++e) { float ox = tv ? o[e] : 0.f; ov[e] = f2bf(ox); uv[t * 65 + c8 + e] = ox; }
            *(us8*)(xr + t * 72 + c8) = ov; }
        __syncthreads();
        if (!lastc) { const size_t ro = (size_t)(rowc + 64) * NPROJ * 2; stage_raw<128>(gr + ro, (size_t)NPROJ * 2, (char*)rawR, tid); stage_raw<128>(gg + ro, (size_t)NPROJ * 2, (char*)(rawG + ((c + 1) & 1) * 4096), tid); }
        f32x4 ra[4], ri[4];
#pragma unroll
        for (int nf = 0; nf < 4; ++nf) { ra[nf] = (f32x4){0.f, 0.f, 0.f, 0.f}; ri[nf] = (f32x4){0.f, 0.f, 0.f, 0.f}; }
        lds_mma<4, 2>(ra, xr, 72, 16 * w, waT, 72, 0, wv_);
        lds_mma<4, 2>(ri, xr, 72, 16 * w, wiT, 72, 0, wv_);
#pragma unroll
        for (int nf = 0; nf < 4; ++nf) { int jj = 16 * nf + fr; float ba = cba[nf], bi = cbi[nf], sp = csp[nf];
#pragma unroll
            for (int r = 0; r < 4; ++r) { int t = 16 * w + 4 * fq + r; float rr = sigm(ra[nf][r] + ba), ii = sigm(ri[nf][r] + bi); float la = -8.f * sp * rr; float aa = __expf(la);
                float u = __builtin_sqrtf(fmaxf(1.f - aa * aa, 0.f)) * ii * uv[t * 65 + jj];
                if (t >= sq.Q) { aa = 1.f; u = 0.f; }
                av[t * 65 + jj] = aa; uv[t * 65 + jj] = u; } }
        __syncthreads();
        { float P = 1.f, H = 0.f;
#pragma unroll
          for (int tt = 0; tt < 16; ++tt) { int t = 16 * q + tt; float aa = av[t * 65 + j], u = uv[t * 65 + j]; H = aa * H + u; P *= aa; }
          Pq[q * 64 + j] = P; Hq[q * 64 + j] = H; }
        __syncthreads();
        float hcur = carry[j];
        for (int qq = 0; qq < q; ++qq) hcur = Pq[qq * 64 + j] * hcur + Hq[qq * 64 + j];
        const bf16_t* rg_ = rawG + (c & 1) * 4096;
        bf16_t gts[16];
#pragma unroll
        for (int tt = 0; tt < 16; ++tt) gts[tt] = rg_[(16 * q + tt) * 64 + j];
#pragma unroll
        for (int tt = 0; tt < 16; ++tt) { int t = 16 * q + tt; float aa = av[t * 65 + j], u = uv[t * 65 + j]; hcur = aa * hcur + u;
            if (t < sq.Q) yrg[(size_t)(rowc + t) * LDK + cb0 + j] = f2bf(bf2f(gts[tt]) * hcur); }
        __syncthreads();
        if (q == 3) carry[j] = hcur;
        __syncthreads();
    }
    if (tid < 64) st_out[cb0 + tid] = carry[tid];
    __syncthreads();
}

DEVI void phase_mix(const Params& p, int l, int seg, char* lds, int wv_) {
    const int ngrp = seg == 0 ? 2 : 1; const int NU = ngrp * 640;
    for (int u = blockIdx.x; u < NU; u += gridDim.x) {
        int grp = u / 640, v = u % 640;
        if (v < 128) hgrn_unit(p, l, make_seq(seg, grp * 16 + (v >> 3)), v & 7, lds, wv_);
        else if (v < 384) { v -= 128; ssd_unit(p, l, make_seq(seg, grp * 16 + (v >> 4)), v & 15, lds, wv_); }
        else { v -= 384; rg_unit(p, l, make_seq(seg, grp * 16 + (v >> 4)), v & 15, lds, wv_); }
        __syncthreads();
    }
}

DEVI void gbar(const Params& p, unsigned& epoch_, int wv_) {
    const unsigned epoch = __builtin_amdgcn_readfirstlane(epoch_); epoch_ = epoch + 1u;
    unsigned* bw = (unsigned*)(p.ws + WS_END); asm volatile("" : "+s"(bw));
    asm volatile("s_waitcnt vmcnt(0)" ::: "memory");
    __syncthreads();
    if (tidx(wv_) == 0) {
        if ((wv_ >> 23) & 1) {
            const unsigned x = (wv_ >> 2) & 7, NB = (wv_ >> 14) & 511;
            const unsigned old = __hip_atomic_fetch_add(bw + 32 + x, 1u, __ATOMIC_RELAXED, __HIP_MEMORY_SCOPE_AGENT);
            if (old + 1u == (epoch + 1u) * NB) {
                __builtin_amdgcn_fence(__ATOMIC_RELEASE, "agent");
                asm volatile("s_waitcnt vmcnt(0)" ::: "memory");
                const unsigned og = __hip_atomic_fetch_add(bw + 56, 1u, __ATOMIC_RELAXED, __HIP_MEMORY_SCOPE_AGENT);
                if (og + 1u == (epoch + 1u) * 8u) __hip_atomic_fetch_add(bw + 57, 1u, __ATOMIC_RELAXED, __HIP_MEMORY_SCOPE_AGENT);
                else while (__hip_atomic_load(bw + 57, __ATOMIC_RELAXED, __HIP_MEMORY_SCOPE_AGENT) < epoch + 1u) __builtin_amdgcn_s_sleep(1);
                __builtin_amdgcn_fence(__ATOMIC_ACQUIRE, "agent");
                __hip_atomic_fetch_add(bw + 48 + x, 1u, __ATOMIC_RELAXED, __HIP_MEMORY_SCOPE_AGENT);
                asm volatile("s_waitcnt vmcnt(0)" ::: "memory");
            } else {
                while (__hip_atomic_load(bw + 48 + x, __ATOMIC_RELAXED, __HIP_MEMORY_SCOPE_AGENT) < epoch + 1u) __builtin_amdgcn_s_sleep(1);
                __builtin_amdgcn_fence(__ATOMIC_ACQUIRE, "agent");
                asm volatile("s_waitcnt vmcnt(0)" ::: "memory");
            }
        } else {
            __builtin_amdgcn_fence(__ATOMIC_RELEASE, "agent");
            asm volatile("s_waitcnt vmcnt(0)" ::: "memory");
            __hip_atomic_fetch_add(bw, 1u, __ATOMIC_RELAXED, __HIP_MEMORY_SCOPE_AGENT);
            const unsigned target = (epoch + 1u) * gridDim.x;
            while (__hip_atomic_load(bw, __ATOMIC_RELAXED, __HIP_MEMORY_SCOPE_AGENT) < target) __builtin_amdgcn_s_sleep(1);
            __builtin_amdgcn_fence(__ATOMIC_ACQUIRE, "agent");
            asm volatile("s_waitcnt vmcnt(0)" ::: "memory");
        }
    }
    __syncthreads();
}

__global__ void __launch_bounds__(256) fwd_mega(Params p) {
    extern __shared__ __attribute__((aligned(16))) char lds[];
    int wv_ = __builtin_amdgcn_readfirstlane((int)(__builtin_amdgcn_workitem_id_x() >> 6));
    cg::grid_group grid = cg::this_grid();
    unsigned* xcnt = (unsigned*)(p.ws + WS_END) + 16;
    const int xcc = (int)(__builtin_amdgcn_s_getreg((3 << 11) | 20) & 7u);
    int xrank;
    { int* sh = (int*)lds; if (__builtin_amdgcn_workitem_id_x() == 0) sh[0] = (int)__hip_atomic_fetch_add(xcnt + xcc, 1u, __ATOMIC_RELAXED, __HIP_MEMORY_SCOPE_AGENT); __syncthreads(); xrank = __builtin_amdgcn_readfirstlane(sh[0]); __syncthreads(); }
    unsigned epoch = 0;
    phase_prep(p, lds, wv_);
    grid.sync();
    {   unsigned c[8]; bool ok = true;
#pragma unroll
        for (int i = 0; i < 8; ++i) { c[i] = __hip_atomic_load(xcnt + i, __ATOMIC_RELAXED, __HIP_MEMORY_SCOPE_AGENT); ok = ok && c[i] > 0u && c[i] < 512u; }
        unsigned mine = 0, tot_ = 0;
#pragma unroll
        for (int i = 0; i < 8; ++i) { mine = (i == xcc) ? c[i] : mine; tot_ += c[i]; }
        ok = ok && tot_ == gridDim.x;
        int X = xcc, R = xrank, NB = (int)mine;
        if (!ok) { X = blockIdx.x & 7; R = blockIdx.x >> 3; NB = gridDim.x >> 3; }
        wv_ = __builtin_amdgcn_readfirstlane((wv_ & 3) | (X << 2) | (R << 5) | (NB << 14) | (ok ? (1 << 23) : 0)); }
#pragma unroll 1
    for (int seg = 0; seg < NSEG; ++seg) {
        const int nrows = seg == 0 ? ROWS : ROWS_P, MT = nrows / 256;
#pragma unroll 1
        for (int l = 0; l < 2; ++l) {
            const bf16_t* wl = (const bf16_t*)p.ws + (size_t)l * E_LAYER;
            phase_norm(p, seg, nrows, p.in[I_NMIX] + l * 1024, l == 0, l, lds, wv_);
            gbar(p, epoch, wv_);
            for (int r = 0; r < p.rep[0]; ++r) { phase_proj(p, l, MT, lds, wv_); gbar(p, epoch, wv_); }
            for (int r = 0; r < (seg == 0 ? p.rep[3] : 1); ++r) { phase_mix(p, l, seg, lds, wv_); gbar(p, epoch, wv_); }
            phase_mbnorm(p, l, nrows, wv_);
            gbar(p, epoch, wv_);
            for (int r = 0; r < p.rep[1]; ++r) { phase_merge(p, l, MT, lds, wv_); gbar(p, epoch, wv_); }
            phase_resid(p, seg, MT, (const bf16_t*)(p.ws + WS_MRG), 1024, LDK, wl + E_WIN + E_WBR, l == 0, lds, wv_);
            gbar(p, epoch, wv_);
            phase_norm(p, seg, nrows, p.in[I_NFFN] + l * 1024, false, -1, lds, wv_);
            gbar(p, epoch, wv_);
            for (int r = 0; r < p.rep[2]; ++r) { phase_ffn_in(p, l, MT, lds, wv_); gbar(p, epoch, wv_); }
            phase_resid(p, seg, MT, (const bf16_t*)(p.ws + WS_PROJ), FFH, LDF, wl + E_WIN + E_WBR + E_WOUT + E_WFI, false, lds, wv_);
            gbar(p, epoch, wv_);
        }
        phase_final_norm(p, seg, nrows, wv_);
    }
}

extern "C" void kernel_launch(void* const* d_in, const int* in_sizes, int n_in, void* d_out, int out_size, void* d_ws, size_t ws_size, hipStream_t stream) {
    static int grid_blocks = 0;
    if (!grid_blocks) {
        int dev = 0, cus = 0, per_cu = 0;
        (void)hipGetDevice(&dev);
        (void)hipDeviceGetAttribute(&cus, hipDeviceAttributeMultiprocessorCount, dev);
        (void)hipFuncSetAttribute((const void*)fwd_mega, hipFuncAttributeMaxDynamicSharedMemorySize, LDS_BYTES);
        (void)hipOccupancyMaxActiveBlocksPerMultiprocessor(&per_cu, (const void*)fwd_mega, 256, LDS_BYTES);
        if (per_cu < 1) fprintf(stderr, "occupancy query says %d blocks per CU\n", per_cu);
        grid_blocks = cus;
        if (ws_size < WS_TOTAL) fprintf(stderr, "workspace too small: %zu < %zu\n", ws_size, (size_t)WS_END + 256);
    }
    (void)hipMemsetAsync((char*)d_ws + WS_END, 0, 256, stream);
    Params p{};
    for (int i = 0; i < 30; ++i) p.in[i] = (const float*)d_in[i];
    p.out = (float*)d_out; p.ws = (unsigned char*)d_ws; p.rep[0] = REP0; p.rep[1] = REP1; p.rep[2] = REP2; p.rep[3] = REP3;
    void* args[] = {&p};
    hipError_t e = hipLaunchCooperativeKernel((const void*)fwd_mega, dim3(grid_blocks), dim3(256), args, LDS_BYTES, stream);
    if (e != hipSuccess) fprintf(stderr, "cooperative launch failed: %s (grid %d)\n", hipGetErrorString(e), grid_blocks);
}
```

```cpp
#include <hip/hip_runtime.h>
#include <hip/hip_cooperative_groups.h>
#include <cstdio>
namespace cg = cooperative_groups;

typedef unsigned short bf16_t;
typedef short bf16x8 __attribute__((ext_vector_type(8)));
typedef float f32x4 __attribute__((ext_vector_type(4)));
typedef unsigned short us4 __attribute__((ext_vector_type(4)));
typedef unsigned short us8 __attribute__((ext_vector_type(8)));
#define DEVI __device__ __forceinline__

constexpr int LDK = 1088, LDF = 2880;
constexpr int D = 1024, NPROJ = 12288, SEGT = 512, NSEG = 4, ROWS_P = 8192, ROWS = 8704, FFH = 2816;
constexpr int PC_Z = 0, PC_XBC = 1024, PC_HQ = 3072, PC_HF = 4096, PC_HI = 5120, PC_HGATE = 6144, PC_RGATE = 7168, PC_RX = 8192, PC_MG = 9216, PC_DT = 12288;
constexpr size_t E_WIN = (size_t)NPROJ * LDK, E_WBR = 3u * 1024 * LDK, E_WOUT = 1024u * LDK, E_WFI = 5632u * LDK, E_WFO = 1024u * LDF;
constexpr size_t E_LAYER = E_WIN + E_WBR + E_WOUT + E_WFI + E_WFO;
constexpr size_t WS_PROJ = 2 * E_LAYER * 2;
constexpr size_t WS_DT = WS_PROJ + (size_t)ROWS * NPROJ * 2;
constexpr size_t WS_XB = WS_DT + (size_t)ROWS * 16 * 4;
constexpr size_t WS_YMB = WS_XB + (size_t)ROWS * LDK * 2;
constexpr size_t WS_YHG = WS_YMB + (size_t)ROWS * LDK * 2;
constexpr size_t WS_YRG = WS_YHG + (size_t)ROWS * LDK * 2;
constexpr size_t WS_MRG = WS_YRG + (size_t)ROWS * LDK * 2;
constexpr size_t WS_END = WS_MRG + (size_t)ROWS * LDK * 2;
constexpr size_t WS_HB = WS_END + 256;
constexpr size_t WS_DTW = WS_HB + 2u * 2 * 16 * 3 * 2048 * 4;
constexpr size_t WS_TOTAL = WS_DTW + 2u * 16 * 1024 * 4;
constexpr size_t O_YP = 0, O_YS = 33554432, O_SSM_P = 34078720, O_SCV_P = 38273024, O_HG_P = 38469632, O_RG_P = 42663936, O_RCV_P = 42696704,
                 O_SSM_S = 42795008, O_SCV_S = 46989312, O_HG_S = 47185920, O_RG_S = 51380224, O_RCV_S = 51412992;
constexpr int REP0 = 1, REP1 = 1, REP2 = 1, REP3 = 1;
constexpr int LDS_BYTES = 144 * 1024;

enum { I_XP = 0, I_XS, I_SSM, I_SCV, I_HG, I_RG, I_RCV, I_NMIX, I_WIN, I_MCW, I_MCB, I_DTB, I_ALOG, I_MBD, I_MBNW, I_LBL, I_HGNW, I_RCW, I_RCB, I_RWA, I_RBA, I_RWI, I_RBI, I_RLAM, I_WBR, I_WOUT, I_NFFN, I_WFI, I_WFO, I_NFIN };

struct Params { const float* in[30]; float* out; unsigned char* ws; int rep[4]; };

DEVI int tidx(int wv_) { int t = ((wv_ & 3) << 6) | (int)__builtin_amdgcn_mbcnt_hi(~0u, __builtin_amdgcn_mbcnt_lo(~0u, 0u)); asm volatile("" : "+v"(t)); return t; }
DEVI float shfli(float v, int srcl) { return __int_as_float(__builtin_amdgcn_ds_bpermute(srcl << 2, __float_as_int(v))); }
DEVI float shflx(float v, int m, int lane) { return shfli(v, lane ^ m); }
DEVI bf16_t f2bf(float f) { unsigned u = __float_as_uint(f); u += 0x7fffu + ((u >> 16) & 1u); return (bf16_t)(u >> 16); }
DEVI float bf2f(bf16_t h) { return __uint_as_float(((unsigned)h) << 16); }
DEVI float sigm(float x) { return 1.f / (1.f + __expf(-x)); }
DEVI float silu(float x) { return x / (1.f + __expf(-x)); }
DEVI float softplus(float x) { return x > 20.f ? x : __logf(1.f + __expf(x)); }
DEVI float gelu_t(float x) { float u = 0.7978845608f * (x + 0.044715f * x * x * x); return x * sigm(2.f * u); }
DEVI float cexp(float x) { return __expf(fminf(x, 80.f)); }

DEVI const float* xrow_in(const Params& p, int seg, int r) {
    if (r < ROWS_P) { int b = r >> 9, tt = r & 511; return p.in[I_XP] + ((size_t)(b * 2048 + seg * SEGT + tt)) * D; }
    return p.in[I_XS] + (size_t)(r - ROWS_P) * D;
}
DEVI float* xrow_out(const Params& p, int seg, int r) {
    if (r < ROWS_P) { int b = r >> 9, tt = r & 511; return p.out + O_YP + ((size_t)(b * 2048 + seg * SEGT + tt)) * D; }
    return p.out + O_YS + (size_t)(r - ROWS_P) * D;
}

DEVI int perm32(int rho) { int n = rho >> 4, i = rho & 15; return 8 * (i >> 2) + 4 * n + (i & 3); }
DEVI int map_win(int n) { n = (n & ~31) + perm32(n & 31); return n < 3072 ? n : n + 16; }
DEVI int map_wfi(int n) { int T = n >> 7, nf = (n >> 4) & 7, i = n & 15, G = nf >> 2, h = (nf >> 1) & 1, s = nf & 1; return s * FFH + 64 * T + 32 * G + 8 * (i >> 2) + 4 * h + (i & 3); }

DEVI void transpose_tile(const float* src, int ldsrc, bf16_t* dst, int K, int k0, int n0, int mode, float* tile  , int wv_) {
    const int tid = tidx(wv_), c = tid & 63, rq = tid >> 6;
    int n = n0 + c, sn = mode == 1 ? map_win(n) : (mode == 2 ? map_wfi(n) : (mode == 3 ? (n & ~31) + perm32(n & 31) : n));
#pragma unroll
    for (int rr = 0; rr < 16; ++rr) { int kl = rr * 4 + rq; tile[kl * 65 + c] = sn >= 0 ? src[(size_t)(k0 + kl) * ldsrc + sn] : 0.f; }
    __syncthreads();
#pragma unroll
    for (int rr = 0; rr < 16; ++rr) { int nl = rr * 4 + rq; dst[(size_t)(n0 + nl) * K + k0 + c] = f2bf(tile[c * 65 + nl]); }
    __syncthreads();
}

DEVI void phase_prep(const Params& p, char* lds, int wv_) {
    float* tile = (float*)lds;
    bf16_t* wsb = (bf16_t*)p.ws;
    constexpr int T_WIN = 16 * 192, T_WBR = 3 * 256, T_WOUT = 256, T_WFI = 16 * 88, T_WFO = 44 * 16, T_L = T_WIN + T_WBR + T_WOUT + T_WFI + T_WFO;
    {   float* dtw = (float*)(p.ws + WS_DTW);
        for (int e = blockIdx.x * 256 + tidx(wv_); e < 32768; e += gridDim.x * 256) { int l = e >> 14, j = (e >> 10) & 15, k = e & 1023; dtw[e] = p.in[I_WIN][(size_t)l * 1024 * 12304 + (size_t)k * 12304 + 3072 + j]; } }
    for (int t = blockIdx.x; t < 2 * T_L; t += gridDim.x) {
        int l = t / T_L, j = t % T_L;
        bf16_t* wl = wsb + (size_t)l * E_LAYER;
        if (j < T_WIN) { int kt = j & 15, nt = j >> 4; transpose_tile(p.in[I_WIN] + (size_t)l * 1024 * 12304, 12304, wl, LDK, kt * 64, nt * 64, 1, tile, wv_); continue; }
        j -= T_WIN;
        if (j < T_WBR) { int k = j >> 8, jj = j & 255, kt = jj & 15, nt = jj >> 4;
            transpose_tile(p.in[I_WBR] + ((size_t)l * 3 + k) * 1024 * 1024, 1024, wl + E_WIN + (size_t)k * 1024 * LDK, LDK, kt * 64, nt * 64, 3, tile, wv_); continue; }
        j -= T_WBR;
        if (j < T_WOUT) { int kt = j & 15, nt = j >> 4; transpose_tile(p.in[I_WOUT] + (size_t)l * 1024 * 1024, 1024, wl + E_WIN + E_WBR, LDK, kt * 64, nt * 64, 0, tile, wv_); continue; }
        j -= T_WOUT;
        if (j < T_WFI) { int kt = j & 15, nt = j >> 4; transpose_tile(p.in[I_WFI] + (size_t)l * 1024 * 5632, 5632, wl + E_WIN + E_WBR + E_WOUT, LDK, kt * 64, nt * 64, 2, tile, wv_); continue; }
        j -= T_WFI;
        { int kt = j % 44, nt = j / 44; transpose_tile(p.in[I_WFO] + (size_t)l * 2816 * 1024, 1024, wl + E_WIN + E_WBR + E_WOUT + E_WFI, LDF, kt * 64, nt * 64, 0, tile, wv_); }
    }
}

DEVI void phase_norm(const Params& p, int seg, int nrows, const float* w, bool from_input, int ldt  , char* lds, int wv_) {
    bf16_t* xb = (bf16_t*)(p.ws + WS_XB); float* dtb = (float*)(p.ws + WS_DT);
    const int lane = tidx(wv_) & 63, wv = tidx(wv_) >> 6;
    float* dw = (float*)lds;
    if (ldt >= 0) { const float* dtw = (const float*)(p.ws + WS_DTW) + ldt * 16384; f32x4 t_[16];
#pragma unroll
        for (int u = 0; u < 16; ++u) t_[u] = *(const f32x4*)(dtw + (tidx(wv_) + 256 * u) * 4);
#pragma unroll
        for (int u = 0; u < 16; ++u) *(f32x4*)(dw + (tidx(wv_) + 256 * u) * 4) = t_[u];
        __syncthreads(); }
    for (int r = blockIdx.x * 4 + wv; r < nrows; r += gridDim.x * 4) {
        const float* x = from_input ? xrow_in(p, seg, r) : xrow_out(p, seg, r);
        f32x4 v[4]; float ss = 0.f;
#pragma unroll
        for (int i = 0; i < 4; ++i) { v[i] = *(const f32x4*)(x + i * 256 + lane * 4); ss += v[i][0] * v[i][0] + v[i][1] * v[i][1] + v[i][2] * v[i][2] + v[i][3] * v[i][3]; }
#pragma unroll
        for (int o = 32; o >= 1; o >>= 1) ss += shflx(ss, o, lane);
        float rs = rsqrtf(ss * (1.f / 1024.f) + 1e-6f);
#pragma unroll
        for (int i = 0; i < 4; ++i) { f32x4 wv4 = *(const f32x4*)(w + i * 256 + lane * 4); us4 o;
            v[i][0] *= rs * wv4[0]; v[i][1] *= rs * wv4[1]; v[i][2] *= rs * wv4[2]; v[i][3] *= rs * wv4[3];
            o[0] = f2bf(v[i][0]); o[1] = f2bf(v[i][1]); o[2] = f2bf(v[i][2]); o[3] = f2bf(v[i][3]);
            *(us4*)(xb + (size_t)r * LDK + i * 256 + lane * 4) = o; }
        if (ldt >= 0) {
            float d[16];
#pragma unroll
            for (int j = 0; j < 16; ++j) { float s = 0.f;
#pragma unroll
                for (int i = 0; i < 4; ++i) { f32x4 ww = *(const f32x4*)(dw + j * 1024 + i * 256 + lane * 4); s += v[i][0] * ww[0] + v[i][1] * ww[1] + v[i][2] * ww[2] + v[i][3] * ww[3]; }
                d[j] = s; }
            { const bool hi = lane & 32;
#pragma unroll
              for (int i = 0; i < 8; ++i) { float send = hi ? d[i] : d[i + 8], keep = hi ? d[i + 8] : d[i]; d[i] = keep + shfli(send, lane ^ 32); } }
            { const bool hi = lane & 16;
#pragma unroll
              for (int i = 0; i < 4; ++i) { float send = hi ? d[i] : d[i + 4], keep = hi ? d[i + 4] : d[i]; d[i] = keep + shfli(send, lane ^ 16); } }
            { const bool hi = lane & 8;
#pragma unroll
              for (int i = 0; i < 2; ++i) { float send = hi ? d[i] : d[i + 2], keep = hi ? d[i + 2] : d[i]; d[i] = keep + shfli(send, lane ^ 8); } }
            { const bool hi = lane & 4; float send = hi ? d[0] : d[1], keep = hi ? d[1] : d[0]; d[0] = keep + shfli(send, lane ^ 4); }
            d[0] += shfli(d[0], lane ^ 2); d[0] += shfli(d[0], lane ^ 1);
            if ((lane & 3) == 0) { int j = lane >> 2; dtb[(size_t)r * 16 + j] = softplus(d[0] + p.in[I_DTB][ldt * 16 + j]); }
        }
    }
    if (ldt >= 0) __syncthreads();
}
DEVI void phase_final_norm(const Params& p, int seg, int nrows, int wv_) {
    const float* w = p.in[I_NFIN];
    const int lane = tidx(wv_) & 63, wv = tidx(wv_) >> 6;
    for (int r = blockIdx.x * 4 + wv; r < nrows; r += gridDim.x * 4) {
        float* x = xrow_out(p, seg, r);
        f32x4 v[4]; float ss = 0.f;
#pragma unroll
        for (int i = 0; i < 4; ++i) { v[i] = *(const f32x4*)(x + i * 256 + lane * 4); ss += v[i][0] * v[i][0] + v[i][1] * v[i][1] + v[i][2] * v[i][2] + v[i][3] * v[i][3]; }
#pragma unroll
        for (int o = 32; o >= 1; o >>= 1) ss += shflx(ss, o, lane);
        float rs = rsqrtf(ss * (1.f / 1024.f) + 1e-6f);
#pragma unroll
        for (int i = 0; i < 4; ++i) { f32x4 wv4 = *(const f32x4*)(w + i * 256 + lane * 4); f32x4 o;
            o[0] = v[i][0] * rs * wv4[0]; o[1] = v[i][1] * rs * wv4[1]; o[2] = v[i][2] * rs * wv4[2]; o[3] = v[i][3] * rs * wv4[3];
            *(f32x4*)(x + i * 256 + lane * 4) = o; }
    }
}
DEVI void phase_mbnorm(const Params& p, int l, int nrows, int wv_) {
    bf16_t* y = (bf16_t*)(p.ws + WS_YMB); const float* w = p.in[I_MBNW] + l * 1024;
    const int lane = tidx(wv_) & 63, wv = tidx(wv_) >> 6;
    for (int it = blockIdx.x * 4 + wv; it < nrows * 4; it += gridDim.x * 4) {
        int r = it >> 2, g = it & 3; bf16_t* yp = y + (size_t)r * LDK + g * 256 + lane * 4;
        us4 v = *(const us4*)yp; float f0 = bf2f(v[0]), f1 = bf2f(v[1]), f2 = bf2f(v[2]), f3 = bf2f(v[3]);
        float ss = f0 * f0 + f1 * f1 + f2 * f2 + f3 * f3;
#pragma unroll
        for (int o = 32; o >= 1; o >>= 1) ss += shflx(ss, o, lane);
        float rs = rsqrtf(ss * (1.f / 256.f) + 1e-6f); f32x4 wv4 = *(const f32x4*)(w + g * 256 + lane * 4);
        us4 o; o[0] = f2bf(f0 * rs * wv4[0]); o[1] = f2bf(f1 * rs * wv4[1]); o[2] = f2bf(f2 * rs * wv4[2]); o[3] = f2bf(f3 * rs * wv4[3]);
        *(us4*)yp = o;
    }
}

#define WAIT_V(n) asm volatile("s_waitcnt vmcnt(" #n ")" ::: "memory")
#define RAW_BAR() do { asm volatile("" ::: "memory"); __builtin_amdgcn_s_barrier(); asm volatile("" ::: "memory"); } while (0)
template <int NF>
DEVI void stage_a(const bf16_t* A, int K, int t, char* st, int tid, size_t soff) {
    const size_t o = soff + (size_t)t * 32;
#pragma unroll
    for (int i = 0; i < 4; ++i) __builtin_amdgcn_global_load_lds((const unsigned*)(A + o + (size_t)i * 64 * K), (unsigned*)(st + tid * 16 + i * 4096), 16, 0, 0);
}
template <int NF>
DEVI void stage_b(const bf16_t* Bt, int K, int t, char* st, int tid, size_t soff) {
    const size_t o = soff + (size_t)t * 32;
#pragma unroll
    for (int i = 0; i < NF / 2; ++i) __builtin_amdgcn_global_load_lds((const unsigned*)(Bt + o + (size_t)i * 64 * K), (unsigned*)(st + 16384 + tid * 16 + i * 4096), 16, 0, 0);
}
template <int NF>
DEVI void gemm_kloop(f32x4 (&acc)[8][NF], const bf16_t* A, const bf16_t* Bt, int K, int ld, char* lds, int wv_) {
    constexpr int STAGE = 16384 + NF * 2048;
    const int tid = tidx(wv_), lane = tid & 63, wid = tid >> 6, wr = wid >> 1, wc = wid & 1, fr = lane & 15, fq = lane >> 4;
    const int fo = fr * 64 + ((fq ^ (0x1320 >> (4 * (fr >> 2)))) & 3) * 16;
    const int aoff = wr * 8192 + fo, boff = 16384 + wc * NF * 1024 + fo;
    const size_t soff = (size_t)(tid >> 2) * ld + ((((tid & 3) ^ (0x1320 >> (4 * ((tid >> 4) & 3)))) & 3) * 8);
    const int nt = K >> 5;
    WAIT_V(0); RAW_BAR();
    stage_a<NF>(A, ld, 0, lds, tid, soff); stage_b<NF>(Bt, ld, 0, lds, tid, soff);
    stage_a<NF>(A, ld, 1, lds + STAGE, tid, soff); stage_b<NF>(Bt, ld, 1, lds + STAGE, tid, soff);
    stage_a<NF>(A, ld, 2, lds + 2 * STAGE, tid, soff); stage_b<NF>(Bt, ld, 2, lds + 2 * STAGE, tid, soff);
    if (NF == 8) WAIT_V(16); else WAIT_V(12);
    RAW_BAR();
    bf16x8 a[8], a01[2][2], b[2][NF];
    a01[0][0] = *(const bf16x8*)(lds + aoff); a01[0][1] = *(const bf16x8*)(lds + aoff + 1024);
#pragma unroll
    for (int n = 0; n < NF; ++n) b[0][n] = *(const bf16x8*)(lds + boff + n * 1024);
#define MMA_G(g_, P_) _Pragma("unroll") for (int n = 0; n < NF; ++n) acc[g_][n] = __builtin_amdgcn_mfma_f32_16x16x32_bf16(b[P_][n], a[g_], acc[g_][n], 0, 0, 0)
#define KBODY(T_, P_, Q_) do { \
        const int T = (T_); const char* st = lds + (T & 3) * STAGE; const char* stn = lds + ((T + 1) & 3) * STAGE; char* st3 = lds + ((T + 3) & 3) * STAGE; \
        a[0] = a01[P_][0]; a[1] = a01[P_][1]; \
        __builtin_amdgcn_sched_barrier(0); a[2] = *(const bf16x8*)(st + aoff + 2 * 1024); MMA_G(0, P_); \
        __builtin_amdgcn_sched_barrier(0); a[3] = *(const bf16x8*)(st + aoff + 3 * 1024); MMA_G(1, P_); \
        __builtin_amdgcn_sched_barrier(0); a[4] = *(const bf16x8*)(st + aoff + 4 * 1024); MMA_G(2, P_); \
        __builtin_amdgcn_sched_barrier(0); a[5] = *(const bf16x8*)(st + aoff + 5 * 1024); MMA_G(3, P_); \
        __builtin_amdgcn_sched_barrier(0); \
        if (T + 2 < nt) { if (NF == 8) WAIT_V(8); else WAIT_V(6); } else WAIT_V(0); \
        RAW_BAR(); \
        __builtin_amdgcn_sched_barrier(0); a[6] = *(const bf16x8*)(st + aoff + 6 * 1024); \
        if (T + 3 < nt) stage_a<NF>(A, ld, T + 3, st3, tid, soff); \
        _Pragma("unroll") for (int n = 0; n < NF / 2; ++n) b[Q_][n] = *(const bf16x8*)(stn + boff + n * 1024); \
        MMA_G(4, P_); \
        __builtin_amdgcn_sched_barrier(0); a[7] = *(const bf16x8*)(st + aoff + 7 * 1024); \
        if (T + 3 < nt) stage_b<NF>(Bt, ld, T + 3, st3, tid, soff); \
        _Pragma("unroll") for (int n = NF / 2; n < NF; ++n) b[Q_][n] = *(const bf16x8*)(stn + boff + n * 1024); \
        MMA_G(5, P_); \
        __builtin_amdgcn_sched_barrier(0); a01[Q_][0] = *(const bf16x8*)(stn + aoff); MMA_G(6, P_); \
        __builtin_amdgcn_sched_barrier(0); a01[Q_][1] = *(const bf16x8*)(stn + aoff + 1024); MMA_G(7, P_); \
        __builtin_amdgcn_sched_barrier(0); } while (0)
    for (int t = 0; t < nt; t += 2) { KBODY(t, 0, 1); KBODY(t + 1, 1, 0); }
#undef KBODY
#undef MMA_G
}
DEVI bool next_tile(int it, int MT, int NT, int& mt, int& nt, int wv_) {
    const int x = (wv_ >> 2) & 7, bl = (wv_ >> 5) & 511, G8 = (wv_ >> 14) & 511;
    int nI = (MT - x + 7) >> 3; long j = (long)it * G8 + bl;
    if (j >= (long)nI * NT) return false;
    int i = (int)(j % nI); nt = (int)(j / nI); mt = x + 8 * i; return true;
}
#define ZERO_ACC(a, NF_) _Pragma("unroll") for (int m_ = 0; m_ < 8; ++m_) _Pragma("unroll") for (int n_ = 0; n_ < NF_; ++n_) a[m_][n_] = (f32x4){0.f, 0.f, 0.f, 0.f}
#define EPI_IDS const int lane = tidx(wv_) & 63, wid = tidx(wv_) >> 6, wr = wid >> 1, wc = wid & 1, fr = lane & 15, fq = lane >> 4

DEVI void proj_store_row(const f32x4 (&accm)[8], bf16_t* prow, float c1, float c3, bool issig, bool isact) {
#pragma unroll
    for (int q = 0; q < 4; ++q) { __builtin_amdgcn_sched_barrier(0); us8 o;
#pragma unroll
        for (int s = 0; s < 2; ++s)
#pragma unroll
            for (int j = 0; j < 4; ++j) { float x = accm[2 * q + s][j];
                float u = x * (c1 + c3 * x * x); float sg = __builtin_amdgcn_rcpf(1.f + __expf(-u)); float y = sg * (issig ? 1.f : x);
                o[4 * s + j] = f2bf(isact ? y : x); }
        *(us8*)(prow + q * 32) = o; }
}
DEVI void phase_proj(const Params& p, int l, int MT, char* lds, int wv_) {
    const bf16_t* xb = (const bf16_t*)(p.ws + WS_XB); const bf16_t* wt = (const bf16_t*)p.ws + (size_t)l * E_LAYER;
    bf16_t* proj = (bf16_t*)(p.ws + WS_PROJ);
    int mt, nt;
    for (int it = 0; next_tile(it, MT, 48, mt, nt, wv_); ++it) {
        f32x4 acc[8][8]; ZERO_ACC(acc, 8);
        gemm_kloop<8>(acc, xb + (size_t)mt * 256 * LDK, wt + (size_t)nt * 256 * LDK, 1024, LDK, lds, wv_);
        EPI_IDS;
        const int sg = nt >> 2;
        const int ty = (sg == 0 || sg == 3 || sg == 6) ? 1 : (sg == 7 ? 2 : (sg >= 9 ? 3 : 0));
        bf16_t* pbase = proj + (size_t)(mt * 256 + wr * 128 + fr) * NPROJ + nt * 256 + wc * 128 + fq * 8;
        const float c1 = ty == 2 ? 1.5957691216f : 1.f, c3 = ty == 2 ? 0.0713548163f : 0.f;
#pragma unroll
        for (int m = 0; m < 8; ++m) {
#pragma unroll
            for (int n = 0; n < 8; ++n) asm volatile("" : "+v"(acc[m][n]) :: "memory");
            proj_store_row(acc[m], pbase + (size_t)m * 16 * NPROJ, c1, c3, ty == 3, ty != 0); }
    }
}
DEVI void phase_merge(const Params& p, int l, int MT, char* lds, int wv_) {
    const bf16_t* wt = (const bf16_t*)p.ws + (size_t)l * E_LAYER + E_WIN; const bf16_t* proj = (const bf16_t*)(p.ws + WS_PROJ);
    bf16_t* mrg = (bf16_t*)(p.ws + WS_MRG);
    int mt, nt;
    for (int it = 0; next_tile(it, MT, 8, mt, nt, wv_); ++it) {
        f32x4 tot[8][4]; ZERO_ACC(tot, 4);
#pragma unroll 1
        for (int k = 0; k < 3; ++k) {
            const bf16_t* y = (const bf16_t*)(p.ws + WS_YMB + (size_t)k * ROWS * LDK * 2);
            f32x4 acc[8][4]; ZERO_ACC(acc, 4);
            gemm_kloop<4>(acc, y + (size_t)mt * 256 * LDK, wt + (size_t)k * 1024 * LDK + (size_t)nt * 128 * LDK, 1024, LDK, lds, wv_);
            EPI_IDS;
#pragma unroll
            for (int m = 0; m < 8; ++m) { int row = mt * 256 + wr * 128 + m * 16 + fr; asm volatile("" ::: "memory");
#pragma unroll
                for (int q = 0; q < 2; ++q) { int col = nt * 128 + wc * 64 + 32 * q + fq * 8; us8 g = *(const us8*)(proj + (size_t)row * NPROJ + PC_MG + k * 1024 + col);
#pragma unroll
                    for (int s = 0; s < 2; ++s)
#pragma unroll
                        for (int j = 0; j < 4; ++j) tot[m][2 * q + s][j] += acc[m][2 * q + s][j] * bf2f(g[4 * s + j]); } }
        }
        EPI_IDS;
#pragma unroll
        for (int m = 0; m < 8; ++m) { int row = mt * 256 + wr * 128 + m * 16 + fr;
#pragma unroll
            for (int q = 0; q < 2; ++q) { int col = nt * 128 + wc * 64 + 32 * q + fq * 8; us8 o;
#pragma unroll
                for (int s = 0; s < 2; ++s)
#pragma unroll
                    for (int j = 0; j < 4; ++j) o[4 * s + j] = f2bf(tot[m][2 * q + s][j]);
                *(us8*)(mrg + (size_t)row * LDK + col) = o; } }
    }
}
DEVI void phase_resid(const Params& p, int seg, int MT, const bf16_t* A, int K, int ld, const bf16_t* Bt, bool from_input, char* lds, int wv_) {
    int mt, nt;
    for (int it = 0; next_tile(it, MT, 8, mt, nt, wv_); ++it) {
        f32x4 acc[8][4]; ZERO_ACC(acc, 4);
        gemm_kloop<4>(acc, A + (size_t)mt * 256 * ld, Bt + (size_t)nt * 128 * ld, K, ld, lds, wv_);
        EPI_IDS;
#pragma unroll
        for (int m = 0; m < 8; ++m) { int row = mt * 256 + wr * 128 + m * 16 + fr;
            const float* xi = from_input ? xrow_in(p, seg, row) : xrow_out(p, seg, row); float* xo = xrow_out(p, seg, row);
#pragma unroll
            for (int n = 0; n < 4; ++n) { int col = nt * 128 + wc * 64 + n * 16 + fq * 4; f32x4 v = *(const f32x4*)(xi + col); *(f32x4*)(xo + col) = v + acc[m][n]; } }
    }
}
DEVI void phase_ffn_in(const Params& p, int l, int MT, char* lds, int wv_) {
    const bf16_t* xb = (const bf16_t*)(p.ws + WS_XB); const bf16_t* wt = (const bf16_t*)p.ws + (size_t)l * E_LAYER + E_WIN + E_WBR + E_WOUT;
    bf16_t* act = (bf16_t*)(p.ws + WS_PROJ);
    int mt, nt;
    for (int it = 0; next_tile(it, MT, 22, mt, nt, wv_); ++it) {
        f32x4 acc[8][8]; ZERO_ACC(acc, 8);
        gemm_kloop<8>(acc, xb + (size_t)mt * 256 * LDK, wt + (size_t)nt * 256 * LDK, 1024, LDK, lds, wv_);
        EPI_IDS;
#pragma unroll
        for (int m = 0; m < 8; ++m) { int row = mt * 256 + wr * 128 + m * 16 + fr;
#pragma unroll
            for (int n = 0; n < 8; ++n) asm volatile("" : "+v"(acc[m][n]) :: "memory");
#pragma unroll
            for (int G = 0; G < 2; ++G) { int col = (nt * 2 + wc) * 64 + 32 * G + fq * 8; us8 o;
#pragma unroll
                for (int h = 0; h < 2; ++h)
#pragma unroll
                    for (int j = 0; j < 4; ++j) o[4 * h + j] = f2bf(silu(acc[m][4 * G + 2 * h][j]) * acc[m][4 * G + 2 * h + 1][j]);
                *(us8*)(act + (size_t)row * LDF + col) = o; } }
    }
}

struct Seq { int row0, nchunk, Q, b, samp, seg; };
DEVI Seq make_seq(int seg, int sq) { Seq s; s.seg = seg; if (sq < 16) { s.row0 = sq * SEGT; s.nchunk = 8; s.Q = 64; s.b = sq; s.samp = 0; } else { s.b = sq - 16; s.row0 = ROWS_P + s.b * 32; s.nchunk = 1; s.Q = 32; s.samp = 1; } return s; }

template <int NF, int KS>
DEVI void lds_mma(f32x4* acc, const bf16_t* X, int ldx, int m0, const bf16_t* Y, int ldy, int n0, int wv_) {
    const int lane = tidx(wv_) & 63, fr = lane & 15, fq = lane >> 4;
#pragma unroll
    for (int ks = 0; ks < KS; ++ks) {
        bf16x8 a = *(const bf16x8*)(X + (m0 + fr) * ldx + ks * 32 + fq * 8);
#pragma unroll
        for (int nf = 0; nf < NF; ++nf) { bf16x8 b = *(const bf16x8*)(Y + (n0 + nf * 16 + fr) * ldy + ks * 32 + fq * 8); acc[nf] = __builtin_amdgcn_mfma_f32_16x16x32_bf16(a, b, acc[nf], 0, 0, 0); }
    }
}

DEVI void conv_load(uint4 (&r)[4], const bf16_t* proj, int row0, int tq, int pcol) {
#pragma unroll
    for (int k = 0; k < 4; ++k) { int ts = tq - 3 + k; ts = ts < 0 ? 0 : ts; r[k] = *(const uint4*)(proj + (size_t)(row0 + ts) * NPROJ + pcol); }
}
DEVI void touch4(uint4& v) { asm volatile("" : "+v"(v.x), "+v"(v.y), "+v"(v.z), "+v"(v.w)); }
DEVI void conv_compute(const uint4 (&r)[4], int tq, const float* hl, const float* cwl, int HC, int cl, float (&out)[8], float (&raw)[8]) {
    { f32x4 b0 = *(const f32x4*)(cwl + 4 * HC + cl), b1 = *(const f32x4*)(cwl + 4 * HC + cl + 4);
      out[0] = b0[0]; out[1] = b0[1]; out[2] = b0[2]; out[3] = b0[3]; out[4] = b1[0]; out[5] = b1[1]; out[6] = b1[2]; out[7] = b1[3]; }
#pragma unroll
    for (int k = 0; k < 4; ++k) {
        const int ts = tq - 3 + k; float v[8];
        v[0] = __uint_as_float(r[k].x << 16); v[1] = __uint_as_float(r[k].x & 0xffff0000u); v[2] = __uint_as_float(r[k].y << 16); v[3] = __uint_as_float(r[k].y & 0xffff0000u);
        v[4] = __uint_as_float(r[k].z << 16); v[5] = __uint_as_float(r[k].z & 0xffff0000u); v[6] = __uint_as_float(r[k].w << 16); v[7] = __uint_as_float(r[k].w & 0xffff0000u);
        if (k < 3) { int hi = 3 + ts; hi = hi < 0 ? 0 : (hi > 2 ? 2 : hi); const bool uh = ts < 0;
            f32x4 h0 = *(const f32x4*)(hl + hi * HC + cl), h1 = *(const f32x4*)(hl + hi * HC + cl + 4);
            v[0] = uh ? h0[0] : v[0]; v[1] = uh ? h0[1] : v[1]; v[2] = uh ? h0[2] : v[2]; v[3] = uh ? h0[3] : v[3];
            v[4] = uh ? h1[0] : v[4]; v[5] = uh ? h1[1] : v[5]; v[6] = uh ? h1[2] : v[6]; v[7] = uh ? h1[3] : v[7]; }
        f32x4 w0 = *(const f32x4*)(cwl + k * HC + cl), w1 = *(const f32x4*)(cwl + k * HC + cl + 4);
        out[0] += v[0] * w0[0]; out[1] += v[1] * w0[1]; out[2] += v[2] * w0[2]; out[3] += v[3] * w0[3];
        out[4] += v[4] * w1[0]; out[5] += v[5] * w1[1]; out[6] += v[6] * w1[2]; out[7] += v[7] * w1[3];
        if (k == 3) {
#pragma unroll
            for (int e = 0; e < 8; ++e) raw[e] = v[e]; }
    }
}

template <int ROWB>
DEVI void stage_raw(const char* g0, size_t ldgB, char* dst, int tid) {
#pragma unroll
    for (int i = 0; i < ROWB / 64; ++i) { int b = tid * 16 + i * 4096, row = b / ROWB, cb = b % ROWB;
        __builtin_amdgcn_global_load_lds((const unsigned*)(g0 + (size_t)row * ldgB + cb), (unsigned*)(dst + b), 16, 0, 0); }
}
DEVI void conv_lds(const bf16_t* rawt, int RS, int t, int cloc, const float* hl, const float* cwl, int HC, int cl, float (&out)[8], float (&raw)[8]) {
    { f32x4 b0 = *(const f32x4*)(cwl + 4 * HC + cl), b1 = *(const f32x4*)(cwl + 4 * HC + cl + 4);
      out[0] = b0[0]; out[1] = b0[1]; out[2] = b0[2]; out[3] = b0[3]; out[4] = b1[0]; out[5] = b1[1]; out[6] = b1[2]; out[7] = b1[3]; }
#pragma unroll
    for (int k = 0; k < 4; ++k) {
        const int tt = t - 3 + k; const int tc = tt < 0 ? 0 : tt; float v[8];
        const uint4 r = *(const uint4*)(rawt + tc * RS + cloc);
        v[0] = __uint_as_float(r.x << 16); v[1] = __uint_as_float(r.x & 0xffff0000u); v[2] = __uint_as_float(r.y << 16); v[3] = __uint_as_float(r.y & 0xffff0000u);
        v[4] = __uint_as_float(r.z << 16); v[5] = __uint_as_float(r.z & 0xffff0000u); v[6] = __uint_as_float(r.w << 16); v[7] = __uint_as_float(r.w & 0xffff0000u);
        if (k < 3) { int hi = 3 + tt; hi = hi < 0 ? 0 : (hi > 2 ? 2 : hi); const bool uh = tt < 0;
            f32x4 h0 = *(const f32x4*)(hl + hi * HC + cl), h1 = *(const f32x4*)(hl + hi * HC + cl + 4);
            v[0] = uh ? h0[0] : v[0]; v[1] = uh ? h0[1] : v[1]; v[2] = uh ? h0[2] : v[2]; v[3] = uh ? h0[3] : v[3];
            v[4] = uh ? h1[0] : v[4]; v[5] = uh ? h1[1] : v[5]; v[6] = uh ? h1[2] : v[6]; v[7] = uh ? h1[3] : v[7]; }
        f32x4 w0 = *(const f32x4*)(cwl + k * HC + cl), w1 = *(const f32x4*)(cwl + k * HC + cl + 4);
        out[0] += v[0] * w0[0]; out[1] += v[1] * w0[1]; out[2] += v[2] * w0[2]; out[3] += v[3] * w0[3];
        out[4] += v[4] * w1[0]; out[5] += v[5] * w1[1]; out[6] += v[6] * w1[2]; out[7] += v[7] * w1[3];
        if (k == 3) {
#pragma unroll
            for (int e = 0; e < 8; ++e) raw[e] = v[e]; }
    }
}

DEVI void ssd_unit(const Params& p, int l, Seq sq, int hd, char* lds, int wv_) {
    bf16_t* Bm = (bf16_t*)lds;
    bf16_t* R2 = (bf16_t*)(lds + 17408);
    bf16_t* xT = (bf16_t*)(lds + 35840);
    bf16_t* hb = (bf16_t*)(lds + 45056);
    float* fl = (float*)(lds + 62464);
    const int tid = tidx(wv_), lane = tid & 63, w = tid >> 6, fr = lane & 15, fq = lane >> 4;
    const bf16_t* proj = (const bf16_t*)(p.ws + WS_PROJ); const float* dtb = (const float*)(p.ws + WS_DT); bf16_t* ymb = (bf16_t*)(p.ws + WS_YMB);
    const int g = hd >> 2;
    const float a = -__expf(p.in[I_ALOG][l * 16 + hd]), Dv = p.in[I_MBD][l * 16 + hd];
    const float* cw = p.in[I_MCW] + (size_t)l * 4 * 2048; const float* cbias = p.in[I_MCB] + l * 2048;
    float* cwl = (float*)(lds + 63488);
    float* hl = (float*)(lds + 69888);
    const float* st_in; float* st_out; const float* hist; float* hist_out; float* hist_out2 = nullptr;
    float* hbuf = (float*)(p.ws + WS_HB);
    if (sq.samp) { st_in = p.in[I_SSM] + ((size_t)(l * 16 + sq.b) * 16 + hd) * 8192; st_out = p.out + O_SSM_S + ((size_t)(l * 16 + sq.b) * 16 + hd) * 8192;
        hist = p.in[I_SCV] + (size_t)(l * 16 + sq.b) * 3 * 2048; hist_out = p.out + O_SCV_S + (size_t)(l * 16 + sq.b) * 3 * 2048; }
    else { st_out = p.out + O_SSM_P + ((size_t)(l * 16 + sq.b) * 16 + hd) * 8192; st_in = sq.seg ? st_out : nullptr;
        hist_out = hbuf + ((size_t)((sq.seg & 1) * 2 + l) * 16 + sq.b) * 3 * 2048; hist = sq.seg ? hbuf + ((size_t)(((sq.seg + 1) & 1) * 2 + l) * 16 + sq.b) * 3 * 2048 : nullptr;
        if (sq.seg == NSEG - 1) hist_out2 = p.out + O_SCV_P + (size_t)(l * 16 + sq.b) * 3 * 2048; }
    for (int idx = tid; idx < 1600; idx += 256) { int k = idx / 320, cc = idx - k * 320; int ch = cc < 64 ? hd * 64 + cc : (cc < 192 ? 1024 + g * 128 + (cc - 64) : 1536 + g * 128 + (cc - 192));
        cwl[idx] = k < 4 ? cw[k * 2048 + ch] : cbias[ch];
        if (idx < 960) hl[idx] = hist ? hist[k * 2048 + ch] : 0.f; }
    f32x4 hacc[8];
#pragma unroll
    for (int nf = 0; nf < 8; ++nf)
#pragma unroll
        for (int r = 0; r < 4; ++r) { int pp = 16 * w + 4 * fq + r, n = 16 * nf + fr; float v = st_in ? st_in[pp * 128 + n] : 0.f; hacc[nf][r] = v; hb[pp * 136 + n] = f2bf(v); }
    bf16_t* rawX = (bf16_t*)(lds + 77568); bf16_t* rawB = (bf16_t*)(lds + 85760); bf16_t* rawC = (bf16_t*)(lds + 102144); bf16_t* rawZ = (bf16_t*)(lds + 118528); float* rawDt = (float*)(lds + 126720);
    const char* gx = (const char*)(proj + PC_XBC + hd * 64); const char* gb = (const char*)(proj + PC_XBC + 1024 + g * 128); const char* gc = (const char*)(proj + PC_XBC + 1536 + g * 128); const char* gz = (const char*)(proj + PC_Z + hd * 64);
    asm volatile("s_waitcnt vmcnt(0)" ::: "memory");
    {   const size_t ro = (size_t)sq.row0 * NPROJ * 2;
        stage_raw<128>(gx + ro, (size_t)NPROJ * 2, (char*)rawX, tid); stage_raw<256>(gb + ro, (size_t)NPROJ * 2, (char*)rawB, tid); stage_raw<256>(gc + ro, (size_t)NPROJ * 2, (char*)rawC, tid);
        stage_raw<128>(gz + ro, (size_t)NPROJ * 2, (char*)rawZ, tid); stage_raw<64>((const char*)(dtb + (size_t)sq.row0 * 16), 64, (char*)rawDt, tid); }
    for (int c = 0; c < sq.nchunk; ++c) {
        const int tid = tidx(wv_), lane = tid & 63, w = tid >> 6, fr = lane & 15, fq = lane >> 4;
        const int rowc = sq.row0 + c * 64; const bool lastc = (c == sq.nchunk - 1);
        const float* hlr = hl + (c & 1) * 960; float* hlw = hl + ((c + 1) & 1) * 960;
        asm volatile("s_waitcnt vmcnt(0)" ::: "memory");
        __syncthreads();
        if (w == 0) {
            float dt = lane < sq.Q ? rawDt[lane * 16 + hd] : 0.f; float v = dt * a;
#pragma unroll
            for (int o = 1; o < 64; o <<= 1) { float t = shfli(v, lane - o); if (lane >= o) v += t; }
            float last = shfli(v, 63);
            fl[lane] = v; fl[64 + lane] = dt; fl[128 + lane] = __expf(last - v) * dt; fl[192 + lane] = __expf(v);
        }
        __syncthreads();
        const float elast = __expf(fl[63]);
#pragma unroll
        for (int i = 0; i < 2; ++i) { int it = tid + 256 * i, t = it >> 3, c8 = (it & 7) * 8; float o[8], raw[8]; int ch = hd * 64 + c8; const bool tv = t < sq.Q;
            conv_lds(rawX, 64, t, c8, hlr, cwl, 320, c8, o, raw);
#pragma unroll
            for (int e = 0; e < 8; ++e) { float s_ = silu(o[e]); o[e] = tv ? s_ : 0.f; }
            if (t >= 61) {
#pragma unroll
                for (int e = 0; e < 8; ++e) hlw[(t - 61) * 320 + c8 + e] = raw[e]; }
            if (lastc && tv && t >= sq.Q - 3) {
#pragma unroll
                for (int e = 0; e < 8; ++e) { hist_out[(t - (sq.Q - 3)) * 2048 + ch + e] = raw[e]; if (hist_out2) hist_out2[(t - (sq.Q - 3)) * 2048 + ch + e] = raw[e]; } }
#pragma unroll
            for (int e = 0; e < 8; ++e) xT[(c8 + e) * 72 + t] = f2bf(o[e]); }
#pragma unroll
        for (int i = 0; i < 4; ++i) { int it = tid + 256 * i, t = it >> 4, c8 = (it & 15) * 8; float o[8], raw[8]; int ch = 1024 + g * 128 + c8; const bool tv = t < sq.Q;
            conv_lds(rawB, 128, t, c8, hlr, cwl, 320, 64 + c8, o, raw);
#pragma unroll
            for (int e = 0; e < 8; ++e) { float s_ = silu(o[e]); o[e] = tv ? s_ : 0.f; }
            if (t >= 61) {
#pragma unroll
                for (int e = 0; e < 8; ++e) hlw[(t - 61) * 320 + 64 + c8 + e] = raw[e]; }
            if (lastc && tv && (hd & 3) == 0 && t >= sq.Q - 3) {
#pragma unroll
                for (int e = 0; e < 8; ++e) { hist_out[(t - (sq.Q - 3)) * 2048 + ch + e] = raw[e]; if (hist_out2) hist_out2[(t - (sq.Q - 3)) * 2048 + ch + e] = raw[e]; } }
            us8 ov; float we = fl[128 + t];
#pragma unroll
            for (int e = 0; e < 8; ++e) { ov[e] = f2bf(o[e]); R2[(c8 + e) * 72 + t] = f2bf(o[e] * we); }
            *(us8*)(Bm + t * 136 + c8) = ov; }
        __syncthreads();
#pragma unroll
        for (int nf = 0; nf < 8; ++nf) hacc[nf] *= elast;
        lds_mma<8, 2>(hacc, xT, 72, 16 * w, R2, 72, 0, wv_);
        __syncthreads();
#pragma unroll
        for (int i = 0; i < 4; ++i) { int it = tid + 256 * i, t = it >> 4, c8 = (it & 15) * 8; float o[8], raw[8]; int ch = 1536 + g * 128 + c8; const bool tv = t < sq.Q;
            conv_lds(rawC, 128, t, c8, hlr, cwl, 320, 192 + c8, o, raw);
#pragma unroll
            for (int e = 0; e < 8; ++e) { float s_ = silu(o[e]); o[e] = tv ? s_ : 0.f; }
            if (t >= 61) {
#pragma unroll
                for (int e = 0; e < 8; ++e) hlw[(t - 61) * 320 + 192 + c8 + e] = raw[e]; }
            if (lastc && tv && (hd & 3) == 0 && t >= sq.Q - 3) {
#pragma unroll
                for (int e = 0; e < 8; ++e) { hist_out[(t - (sq.Q - 3)) * 2048 + ch + e] = raw[e]; if (hist_out2) hist_out2[(t - (sq.Q - 3)) * 2048 + ch + e] = raw[e]; } }
            us8 ov;
#pragma unroll
            for (int e = 0; e < 8; ++e) ov[e] = f2bf(o[e]);
            *(us8*)(R2 + t * 136 + c8) = ov; }
        us4 zr[4];
#pragma unroll
        for (int nf = 0; nf < 4; ++nf) zr[nf] = *(const us4*)(rawZ + (16 * nf + fr) * 64 + 16 * w + 4 * fq);
        __syncthreads();
        if (!lastc) { const size_t ro = (size_t)(rowc + 64) * NPROJ * 2;
            stage_raw<128>(gx + ro, (size_t)NPROJ * 2, (char*)rawX, tid); stage_raw<256>(gb + ro, (size_t)NPROJ * 2, (char*)rawB, tid); stage_raw<256>(gc + ro, (size_t)NPROJ * 2, (char*)rawC, tid);
            stage_raw<128>(gz + ro, (size_t)NPROJ * 2, (char*)rawZ, tid); stage_raw<64>((const char*)(dtb + (size_t)(rowc + 64) * 16), 64, (char*)rawDt, tid); }
        f32x4 cbv[4];
#pragma unroll
        for (int nf = 0; nf < 4; ++nf) cbv[nf] = (f32x4){0.f, 0.f, 0.f, 0.f};
        lds_mma<4, 4>(cbv, Bm, 136, 16 * w, R2, 136, 0, wv_);
        __syncthreads();
#pragma unroll
        for (int nf = 0; nf < 4; ++nf) { int i = 16 * nf + fr; float ai = fl[i]; us4 o;
#pragma unroll
            for (int r = 0; r < 4; ++r) { int j = 16 * w + 4 * fq + r; float v = (j <= i) ? cbv[nf][r] * __expf(ai - fl[j]) * fl[64 + j] : 0.f; o[r] = f2bf(v); }
            *(us4*)(Bm + i * 72 + 16 * w + 4 * fq) = o; }
        __syncthreads();
        f32x4 ya[4];
#pragma unroll
        for (int nf = 0; nf < 4; ++nf) ya[nf] = (f32x4){0.f, 0.f, 0.f, 0.f};
        lds_mma<4, 4>(ya, hb, 136, 16 * w, R2, 136, 0, wv_);
#pragma unroll
        for (int nf = 0; nf < 4; ++nf) ya[nf] *= fl[192 + 16 * nf + fr];
        lds_mma<4, 2>(ya, xT, 72, 16 * w, Bm, 72, 0, wv_);
#pragma unroll
        for (int nf = 0; nf < 4; ++nf) { int i = 16 * nf + fr, p0 = 16 * w + 4 * fq;
            us4 z = zr[nf];
            if (i < sq.Q) { us4 o;
#pragma unroll
                for (int r = 0; r < 4; ++r) o[r] = f2bf((ya[nf][r] + Dv * bf2f(xT[(p0 + r) * 72 + i])) * bf2f(z[r]));
                *(us4*)(ymb + (size_t)(rowc + i) * LDK + hd * 64 + p0) = o; } }
        __syncthreads();
#pragma unroll
        for (int nf = 0; nf < 8; ++nf)
#pragma unroll
            for (int r = 0; r < 4; ++r) hb[(16 * w + 4 * fq + r) * 136 + 16 * nf + fr] = f2bf(hacc[nf][r]);
    }
#pragma unroll
    for (int nf = 0; nf < 8; ++nf)
#pragma unroll
        for (int r = 0; r < 4; ++r) st_out[(16 * w + 4 * fq + r) * 128 + 16 * nf + fr] = hacc[nf][r];
    __syncthreads();
}

DEVI void hgrn_unit(const Params& p, int l, Seq sq, int h, char* lds, int wv_) {
    bf16_t* sb = (bf16_t*)lds;
    bf16_t* qt = (bf16_t*)(lds + 34816);
    bf16_t* kt = (bf16_t*)(lds + 52224);
    bf16_t* att = (bf16_t*)lds;
    bf16_t* kT = (bf16_t*)(lds + 9216);
    bf16_t* vT = (bf16_t*)(lds + 27648);
    float* T0 = (float*)(lds + 69632); float* T1 = T0 + 128; float* ssq = T0 + 256;
    const int tid = tidx(wv_), lane = tid & 63, w = tid >> 6, fr = lane & 15, fq = lane >> 4;
    const int k = tid & 127, half = tid >> 7;
    const bf16_t* proj = (const bf16_t*)(p.ws + WS_PROJ); bf16_t* yhg = (bf16_t*)(p.ws + WS_YHG);
    float lb = 0.f;
    if (l == 1) { float a0 = p.in[I_LBL][h * 128 + k], a1 = p.in[I_LBL][1024 + h * 128 + k]; lb = 1.f / (1.f + __expf(a0 - a1)); }
    const float* nw = p.in[I_HGNW] + l * 128;
    const float* st_in; float* st_out;
    if (sq.samp) { st_in = p.in[I_HG] + ((size_t)(l * 16 + sq.b) * 8 + h) * 16384; st_out = p.out + O_HG_S + ((size_t)(l * 16 + sq.b) * 8 + h) * 16384; }
    else { st_out = p.out + O_HG_P + ((size_t)(l * 16 + sq.b) * 8 + h) * 16384; st_in = sq.seg ? st_out : nullptr; }
    f32x4 hacc[2][8];
#pragma unroll
    for (int mf = 0; mf < 2; ++mf)
#pragma unroll
        for (int nf = 0; nf < 8; ++nf)
#pragma unroll
            for (int r = 0; r < 4; ++r) hacc[mf][nf][r] = st_in ? st_in[(32 * w + 16 * mf + 4 * fq + r) * 128 + 16 * nf + fr] : 0.f;
    f32x4 nwr[2];
#pragma unroll
    for (int mf = 0; mf < 2; ++mf) nwr[mf] = *(const f32x4*)(nw + 32 * w + 16 * mf + 4 * fq);
    bf16_t* rawF = (bf16_t*)(lds + 71680); bf16_t* rawQ = (bf16_t*)(lds + 88064); bf16_t* rawV = (bf16_t*)(lds + 104448); bf16_t* rawH = (bf16_t*)(lds + 120832);
    const char* gf = (const char*)(proj + PC_HF + h * 128); const char* gq = (const char*)(proj + PC_HQ + h * 128); const char* gv = (const char*)(proj + PC_HI + h * 128); const char* gh = (const char*)(proj + PC_HGATE + h * 128);
    asm volatile("s_waitcnt vmcnt(0)" ::: "memory");
    {   const size_t ro = (size_t)sq.row0 * NPROJ * 2;
        stage_raw<256>(gf + ro, (size_t)NPROJ * 2, (char*)rawF, tid); stage_raw<256>(gq + ro, (size_t)NPROJ * 2, (char*)rawQ, tid); stage_raw<256>(gv + ro, (size_t)NPROJ * 2, (char*)rawV, tid); }
    for (int c = 0; c < sq.nchunk; ++c) {
        const int tid = tidx(wv_), lane = tid & 63, w = tid >> 6, fr = lane & 15, fq = lane >> 4, k = tid & 127, half = tid >> 7;
        const int rowc = sq.row0 + c * 64; const bool lastc = (c == sq.nchunk - 1);
        asm volatile("s_waitcnt vmcnt(0)" ::: "memory");
        __syncthreads();
        stage_raw<256>(gh + (size_t)rowc * NPROJ * 2, (size_t)NPROJ * 2, (char*)rawH, tid);
        {
            unsigned fu[32], qu[32];
#pragma unroll
            for (int jj = 0; jj < 32; ++jj) { fu[jj] = rawF[(32 * half + jj) * 128 + k]; qu[jj] = rawQ[(32 * half + jj) * 128 + k]; }
            if (tid < 64) ssq[tid] = 0.f;
            float run = 0.f;
            if (half == 0) {
#pragma unroll
                for (int jj = 31; jj >= 0; --jj) { bool valid = jj < sq.Q; float f = __uint_as_float(fu[jj] << 16);
                    float sg = __builtin_amdgcn_rcpf(1.f + __expf(-f)); float lg0 = __logf(lb + (1.f - lb) * sg); float lg = valid ? lg0 : 0.f;
                    float kk0 = (1.f - lb) * (1.f - sg); float kk = valid ? kk0 : 0.f; float q0 = __uint_as_float(qu[jj] << 16); float q = valid ? q0 : 0.f;
                    qt[jj * 136 + k] = f2bf(q * cexp(-run)); kt[jj * 136 + k] = f2bf(kk * cexp(run)); run += lg; }
                T0[k] = run;
            } else {
#pragma unroll
                for (int jj = 0; jj < 32; ++jj) { bool valid = (32 + jj) < sq.Q; float f = __uint_as_float(fu[jj] << 16);
                    float sg = __builtin_amdgcn_rcpf(1.f + __expf(-f)); float lg0 = __logf(lb + (1.f - lb) * sg); float lg = valid ? lg0 : 0.f;
                    float kk0 = (1.f - lb) * (1.f - sg); float kk = valid ? kk0 : 0.f; float q0 = __uint_as_float(qu[jj] << 16); float q = valid ? q0 : 0.f;
                    run += lg; qt[(32 + jj) * 136 + k] = f2bf(q * cexp(run)); kt[(32 + jj) * 136 + k] = f2bf(kk * cexp(-run)); }
                T1[k] = run;
            }
        }
        __syncthreads();
#pragma unroll
        for (int mf = 0; mf < 2; ++mf) { int k0 = 32 * w + 16 * mf + 4 * fq; float e0 = __expf(T0[k0]), e1 = __expf(T0[k0 + 1]), e2 = __expf(T0[k0 + 2]), e3 = __expf(T0[k0 + 3]);
#pragma unroll
            for (int nf = 0; nf < 8; ++nf) { hacc[mf][nf][0] *= e0; hacc[mf][nf][1] *= e1; hacc[mf][nf][2] *= e2; hacc[mf][nf][3] *= e3;
                us4 o; o[0] = f2bf(hacc[mf][nf][0]); o[1] = f2bf(hacc[mf][nf][1]); o[2] = f2bf(hacc[mf][nf][2]); o[3] = f2bf(hacc[mf][nf][3]);
                *(us4*)(sb + (16 * nf + fr) * 136 + k0) = o; } }
        f32x4 at[4];
#pragma unroll
        for (int nf = 0; nf < 4; ++nf) at[nf] = (f32x4){0.f, 0.f, 0.f, 0.f};
        lds_mma<4, 4>(at, kt, 136, 16 * w, qt, 136, 0, wv_);
        __syncthreads();
        f32x4 oacc[2][4];
#pragma unroll
        for (int mf = 0; mf < 2; ++mf) {
#pragma unroll
            for (int nf = 0; nf < 4; ++nf) oacc[mf][nf] = (f32x4){0.f, 0.f, 0.f, 0.f};
            lds_mma<4, 4>(oacc[mf], sb, 136, 32 * w + 16 * mf, qt, 136, 0, wv_); }
        __syncthreads();
#pragma unroll
        for (int nf = 0; nf < 4; ++nf) { int i = 16 * nf + fr; us4 o;
#pragma unroll
            for (int r = 0; r < 4; ++r) { int j = 16 * w + 4 * fq + r; o[r] = f2bf(j <= i ? at[nf][r] : 0.f); }
            *(us4*)(att + i * 72 + 16 * w + 4 * fq) = o; }
        {   unsigned vu[32];
#pragma unroll
            for (int jj = 0; jj < 32; ++jj) vu[jj] = rawV[(32 * half + jj) * 128 + k];
#pragma unroll
            for (int q4 = 0; q4 < 4; ++q4) { us8 kv, vv;
#pragma unroll
                for (int e = 0; e < 8; ++e) { int jj = q4 * 8 + e; bool valid = (32 * half + jj) < sq.Q; kv[e] = kt[(32 * half + jj) * 136 + k]; vv[e] = valid ? (bf16_t)vu[jj] : (bf16_t)0; }
                *(us8*)(kT + k * 72 + 32 * half + q4 * 8) = kv; *(us8*)(vT + k * 72 + 32 * half + q4 * 8) = vv; } }
        __syncthreads();
        if (!lastc) { const size_t ro = (size_t)(rowc + 64) * NPROJ * 2;
            stage_raw<256>(gf + ro, (size_t)NPROJ * 2, (char*)rawF, tid); stage_raw<256>(gq + ro, (size_t)NPROJ * 2, (char*)rawQ, tid); stage_raw<256>(gv + ro, (size_t)NPROJ * 2, (char*)rawV, tid); }
#pragma unroll
        for (int mf = 0; mf < 2; ++mf) {
            lds_mma<4, 2>(oacc[mf], vT, 72, 32 * w + 16 * mf, att, 72, 0, wv_);
            lds_mma<8, 2>(hacc[mf], kT, 72, 32 * w + 16 * mf, vT, 72, 0, wv_);
            int k0 = 32 * w + 16 * mf + 4 * fq; float e0 = __expf(T1[k0]), e1 = __expf(T1[k0 + 1]), e2 = __expf(T1[k0 + 2]), e3 = __expf(T1[k0 + 3]);
#pragma unroll
            for (int nf = 0; nf < 8; ++nf) { hacc[mf][nf][0] *= e0; hacc[mf][nf][1] *= e1; hacc[mf][nf][2] *= e2; hacc[mf][nf][3] *= e3; } }
#pragma unroll
        for (int nf = 0; nf < 4; ++nf) { float s = 0.f;
#pragma unroll
            for (int mf = 0; mf < 2; ++mf)
#pragma unroll
                for (int r = 0; r < 4; ++r) s += oacc[mf][nf][r] * oacc[mf][nf][r];
            s += shflx(s, 16, lane); s += shflx(s, 32, lane);
            if (fq == 0) atomicAdd(&ssq[16 * nf + fr], s); }
        if (lastc) asm volatile("s_waitcnt vmcnt(0)" ::: "memory"); else asm volatile("s_waitcnt vmcnt(12)" ::: "memory");
        __syncthreads();
#pragma unroll
        for (int nf = 0; nf < 4; ++nf) { int i = 16 * nf + fr; float rs = rsqrtf(ssq[i] * (1.f / 128.f) + 1e-6f);
#pragma unroll
            for (int mf = 0; mf < 2; ++mf) { int v0 = 32 * w + 16 * mf + 4 * fq; us4 gt = *(const us4*)(rawH + i * 128 + v0); f32x4 wv = nwr[mf]; us4 o;
#pragma unroll
                for (int r = 0; r < 4; ++r) o[r] = f2bf(oacc[mf][nf][r] * rs * wv[r] * bf2f(gt[r]));
                if (i < sq.Q) *(us4*)(yhg + (size_t)(rowc + i) * LDK + h * 128 + v0) = o; } }
        __syncthreads();
    }
#pragma unroll
    for (int mf = 0; mf < 2; ++mf)
#pragma unroll
        for (int nf = 0; nf < 8; ++nf)
#pragma unroll
            for (int r = 0; r < 4; ++r) st_out[(32 * w + 16 * mf + 4 * fq + r) * 128 + 16 * nf + fr] = hacc[mf][nf][r];
}

DEVI void rg_unit(const Params& p, int l, Seq sq, int blk, char* lds, int wv_) {
    bf16_t* waT = (bf16_t*)lds; bf16_t* wiT = (bf16_t*)(lds + 9216); bf16_t* xr = (bf16_t*)(lds + 18432);
    float* av = (float*)(lds + 27648); float* uv = (float*)(lds + 44288); float* Pq = (float*)(lds + 60928); float* Hq = Pq + 256; float* carry = Hq + 256;
    const int tid = tidx(wv_), lane = tid & 63, w = tid >> 6, fr = lane & 15, fq = lane >> 4;
    const bf16_t* proj = (const bf16_t*)(p.ws + WS_PROJ); bf16_t* yrg = (bf16_t*)(p.ws + WS_YRG);
    const int cb0 = blk * 64;
    const float* cw = p.in[I_RCW] + (size_t)l * 4 * 1024; const float* cbias = p.in[I_RCB] + l * 1024;
    const float* st_in; float* st_out; const float* hist; float* hist_out;
    if (sq.samp) { st_in = p.in[I_RG] + (size_t)(l * 16 + sq.b) * 1024; st_out = p.out + O_RG_S + (size_t)(l * 16 + sq.b) * 1024;
        hist = p.in[I_RCV] + (size_t)(l * 16 + sq.b) * 3 * 1024; hist_out = p.out + O_RCV_S + (size_t)(l * 16 + sq.b) * 3 * 1024; }
    else { st_out = p.out + O_RG_P + (size_t)(l * 16 + sq.b) * 1024; st_in = sq.seg ? st_out : nullptr;
        hist_out = p.out + O_RCV_P + (size_t)(l * 16 + sq.b) * 3 * 1024; hist = sq.seg ? hist_out : nullptr; }
    float* cwl = (float*)(lds + 63232);
    float* hl = (float*)(lds + 64512);
    float* hl2 = (float*)(lds + 90112);
    for (int idx = tid; idx < 320; idx += 256) { int k = idx >> 6, cc = idx & 63; cwl[idx] = k < 4 ? cw[k * 1024 + cb0 + cc] : cbias[cb0 + cc]; if (idx < 192) hl[idx] = hist ? hist[k * 1024 + cb0 + cc] : 0.f; }
    {   const float* wa = p.in[I_RWA] + ((size_t)l * 16 + blk) * 4096; const float* wi = p.in[I_RWI] + ((size_t)l * 16 + blk) * 4096;
        float wa_[16], wi_[16];
#pragma unroll
        for (int u = 0; u < 16; ++u) { wa_[u] = wa[tid + 256 * u]; wi_[u] = wi[tid + 256 * u]; }
#pragma unroll
        for (int u = 0; u < 16; ++u) { int e = tid + 256 * u, i = e >> 6, j = e & 63; waT[j * 72 + i] = f2bf(wa_[u]); wiT[j * 72 + i] = f2bf(wi_[u]); }
        if (tid < 64) carry[tid] = st_in ? st_in[cb0 + tid] : 0.f; }
    float cba[4], cbi[4], csp[4];
#pragma unroll
    for (int nf = 0; nf < 4; ++nf) { int cc = cb0 + 16 * nf + fr; cba[nf] = p.in[I_RBA][l * 1024 + cc]; cbi[nf] = p.in[I_RBI][l * 1024 + cc]; csp[nf] = softplus(-p.in[I_RLAM][l * 1024 + cc]); }
    bf16_t* rawR = (bf16_t*)(lds + 65536); bf16_t* rawG = (bf16_t*)(lds + 73728);
    const char* gr = (const char*)(proj + PC_RX + cb0); const char* gg = (const char*)(proj + PC_RGATE + cb0);
    asm volatile("s_waitcnt vmcnt(0)" ::: "memory");
    stage_raw<128>(gr + (size_t)sq.row0 * NPROJ * 2, (size_t)NPROJ * 2, (char*)rawR, tid); stage_raw<128>(gg + (size_t)sq.row0 * NPROJ * 2, (size_t)NPROJ * 2, (char*)rawG, tid);
    for (int c = 0; c < sq.nchunk; ++c) {
        const int tid = tidx(wv_), lane = tid & 63, w = tid >> 6, fr = lane & 15, fq = lane >> 4, j = tid & 63, q = tid >> 6;
        const int rowc = sq.row0 + c * 64; const bool lastc = (c == sq.nchunk - 1);
        const float* hlr = (c & 1) ? hl2 : hl; float* hlw = (c & 1) ? hl : hl2;
        asm volatile("s_waitcnt vmcnt(0)" ::: "memory");
        __syncthreads();
#pragma unroll
        for (int i = 0; i < 2; ++i) { int it = tid + 256 * i, t = it >> 3, c8 = (it & 7) * 8; float o[8], raw[8]; int ch = cb0 + c8; const bool tv = t < sq.Q;
            conv_lds(rawR, 64, t, c8, hlr, cwl, 64, c8, o, raw);
            if (t >= 61) {
#pragma unroll
                for (int e = 0; e < 8; ++e) hlw[(t - 61) * 64 + c8 + e] = raw[e]; }
            if (lastc && tv && t >= sq.Q - 3) {
#pragma unroll
                for (int e = 0; e < 8; ++e) hist_out[(t - (sq.Q - 3)) * 1024 + ch + e] = raw[e]; }
            us8 ov;
#pragma unroll
            for (int e = 0; e < 8; ++e) { float ox = tv ? o[e] : 0.f; ov[e] = f2bf(ox); uv[t * 65 + c8 + e] = ox; }
            *(us8*)(xr + t * 72 + c8) = ov; }
        __syncthreads();
        if (!lastc) { const size_t ro = (size_t)(rowc + 64) * NPROJ * 2; stage_raw<128>(gr + ro, (size_t)NPROJ * 2, (char*)rawR, tid); stage_raw<128>(gg + ro, (size_t)NPROJ * 2, (char*)(rawG + ((c + 1) & 1) * 4096), tid); }
        f32x4 ra[4], ri[4];
#pragma unroll
        for (int nf = 0; nf < 4; ++nf) { ra[nf] = (f32x4){0.f, 0.f, 0.f, 0.f}; ri[nf] = (f32x4){0.f, 0.f, 0.f, 0.f}; }
        lds_mma<4, 2>(ra, xr, 72, 16 * w, waT, 72, 0, wv_);
        lds_mma<4, 2>(ri, xr, 72, 16 * w, wiT, 72, 0, wv_);
#pragma unroll
        for (int nf = 0; nf < 4; ++nf) { int jj = 16 * nf + fr; float ba = cba[nf], bi = cbi[nf], sp = csp[nf];
#pragma unroll
            for (int r = 0; r < 4; ++r) { int t = 16 * w + 4 * fq + r; float rr = sigm(ra[nf][r] + ba), ii = sigm(ri[nf][r] + bi); float la = -8.f * sp * rr; float aa = __expf(la);
                float u = __builtin_sqrtf(fmaxf(1.f - aa * aa, 0.f)) * ii * uv[t * 65 + jj];
                if (t >= sq.Q) { aa = 1.f; u = 0.f; }
                av[t * 65 + jj] = aa; uv[t * 65 + jj] = u; } }
        __syncthreads();
        { float P = 1.f, H = 0.f;
#pragma unroll
          for (int tt = 0; tt < 16; ++tt) { int t = 16 * q + tt; float aa = av[t * 65 + j], u = uv[t * 65 + j]; H = aa * H + u; P *= aa; }
          Pq[q * 64 + j] = P; Hq[q * 64 + j] = H; }
        __syncthreads();
        float hcur = carry[j];
        for (int qq = 0; qq < q; ++qq) hcur = Pq[qq * 64 + j] * hcur + Hq[qq * 64 + j];
        const bf16_t* rg_ = rawG + (c & 1) * 4096;
        bf16_t gts[16];
#pragma unroll
        for (int tt = 0; tt < 16; ++tt) gts[tt] = rg_[(16 * q + tt) * 64 + j];
#pragma unroll
        for (int tt = 0; tt < 16; ++tt) { int t = 16 * q + tt; float aa = av[t * 65 + j], u = uv[t * 65 + j]; hcur = aa * hcur + u;
            if (t < sq.Q) yrg[(size_t)(rowc + t) * LDK + cb0 + j] = f2bf(bf2f(gts[tt]) * hcur); }
        __syncthreads();
        if (q == 3) carry[j] = hcur;
        __syncthreads();
    }
    if (tid < 64) st_out[cb0 + tid] = carry[tid];
    __syncthreads();
}

DEVI void phase_mix(const Params& p, int l, int seg, char* lds, int wv_) {
    const int ngrp = seg == 0 ? 2 : 1; const int NU = ngrp * 640;
    unsigned* qctr = (unsigned*)(p.ws + WS_END) + 1 + (seg * 2 + l);
    volatile int* sh = (volatile int*)(lds + 147440);
    for (;;) {
        if (tidx(wv_) == 0) sh[0] = (int)__hip_atomic_fetch_add(qctr, 1u, __ATOMIC_RELAXED, __HIP_MEMORY_SCOPE_AGENT);
        __syncthreads();
        const int u = __builtin_amdgcn_readfirstlane(sh[0]);
        __syncthreads();
        if (u >= NU) break;
        int grp = u / 640, v = u % 640;
        if (v < 128) hgrn_unit(p, l, make_seq(seg, grp * 16 + (v >> 3)), v & 7, lds, wv_);
        else if (v < 384) { v -= 128; ssd_unit(p, l, make_seq(seg, grp * 16 + (v >> 4)), v & 15, lds, wv_); }
        else { v -= 384; rg_unit(p, l, make_seq(seg, grp * 16 + (v >> 4)), v & 15, lds, wv_); }
        __syncthreads();
    }
}

DEVI void gbar(const Params& p, unsigned& epoch_, int wv_) {
    const unsigned epoch = __builtin_amdgcn_readfirstlane(epoch_); epoch_ = epoch + 1u;
    unsigned* bw = (unsigned*)(p.ws + WS_END); asm volatile("" : "+s"(bw));
    asm volatile("s_waitcnt vmcnt(0)" ::: "memory");
    __syncthreads();
    if (tidx(wv_) == 0) {
        if ((wv_ >> 23) & 1) {
            const unsigned x = (wv_ >> 2) & 7, NB = (wv_ >> 14) & 511;
            const unsigned old = __hip_atomic_fetch_add(bw + 32 + x, 1u, __ATOMIC_RELAXED, __HIP_MEMORY_SCOPE_AGENT);
            if (old + 1u == (epoch + 1u) * NB) {
                __builtin_amdgcn_fence(__ATOMIC_RELEASE, "agent");
                asm volatile("s_waitcnt vmcnt(0)" ::: "memory");
                const unsigned og = __hip_atomic_fetch_add(bw + 56, 1u, __ATOMIC_RELAXED, __HIP_MEMORY_SCOPE_AGENT);
                if (og + 1u == (epoch + 1u) * 8u) __hip_atomic_fetch_add(bw + 57, 1u, __ATOMIC_RELAXED, __HIP_MEMORY_SCOPE_AGENT);
                else while (__hip_atomic_load(bw + 57, __ATOMIC_RELAXED, __HIP_MEMORY_SCOPE_AGENT) < epoch + 1u) __builtin_amdgcn_s_sleep(1);
                __builtin_amdgcn_fence(__ATOMIC_ACQUIRE, "agent");
                __hip_atomic_fetch_add(bw + 48 + x, 1u, __ATOMIC_RELAXED, __HIP_MEMORY_SCOPE_AGENT);
                asm volatile("s_waitcnt vmcnt(0)" ::: "memory");
            } else {
                while (__hip_atomic_load(bw + 48 + x, __ATOMIC_RELAXED, __HIP_MEMORY_SCOPE_AGENT) < epoch + 1u) __builtin_amdgcn_s_sleep(1);
                __builtin_amdgcn_fence(__ATOMIC_ACQUIRE, "agent");
                asm volatile("s_waitcnt vmcnt(0)" ::: "memory");
            }
        } else {
            __builtin_amdgcn_fence(__ATOMIC_RELEASE, "agent");
            asm volatile("s_waitcnt vmcnt(0)" ::: "memory");
            __hip_atomic_fetch_add(bw, 1u, __ATOMIC_RELAXED, __HIP_MEMORY_SCOPE_AGENT);
            const unsigned target = (epoch + 1u) * gridDim.x;
            while (__hip_atomic_load(bw, __ATOMIC_RELAXED, __HIP_MEMORY_SCOPE_AGENT) < target) __builtin_amdgcn_s_sleep(1);
            __builtin_amdgcn_fence(__ATOMIC_ACQUIRE, "agent");
            asm volatile("s_waitcnt vmcnt(0)" ::: "memory");
        }
    }
    __syncthreads();
}

__global__ void __launch_bounds__(256) fwd_mega(Params p) {
    extern __shared__ __attribute__((aligned(16))) char lds[];
    int wv_ = __builtin_amdgcn_readfirstlane((int)(__builtin_amdgcn_workitem_id_x() >> 6));
    cg::grid_group grid = cg::this_grid();
    unsigned* xcnt = (unsigned*)(p.ws + WS_END) + 16;
    const int xcc = (int)(__builtin_amdgcn_s_getreg((3 << 11) | 20) & 7u);
    int xrank;
    { int* sh = (int*)lds; if (__builtin_amdgcn_workitem_id_x() == 0) sh[0] = (int)__hip_atomic_fetch_add(xcnt + xcc, 1u, __ATOMIC_RELAXED, __HIP_MEMORY_SCOPE_AGENT); __syncthreads(); xrank = __builtin_amdgcn_readfirstlane(sh[0]); __syncthreads(); }
    unsigned epoch = 0;
    phase_prep(p, lds, wv_);
    grid.sync();
    {   unsigned c[8]; bool ok = true;
#pragma unroll
        for (int i = 0; i < 8; ++i) { c[i] = __hip_atomic_load(xcnt + i, __ATOMIC_RELAXED, __HIP_MEMORY_SCOPE_AGENT); ok = ok && c[i] > 0u && c[i] < 512u; }
        unsigned mine = 0, tot_ = 0;
#pragma unroll
        for (int i = 0; i < 8; ++i) { mine = (i == xcc) ? c[i] : mine; tot_ += c[i]; }
        ok = ok && tot_ == gridDim.x;
        int X = xcc, R = xrank, NB = (int)mine;
        if (!ok) { X = blockIdx.x & 7; R = blockIdx.x >> 3; NB = gridDim.x >> 3; }
        wv_ = __builtin_amdgcn_readfirstlane((wv_ & 3) | (X << 2) | (R << 5) | (NB << 14) | (ok ? (1 << 23) : 0)); }
#pragma unroll 1
    for (int seg = 0; seg < NSEG; ++seg) {
        const int nrows = seg == 0 ? ROWS : ROWS_P, MT = nrows / 256;
#pragma unroll 1
        for (int l = 0; l < 2; ++l) {
            const bf16_t* wl = (const bf16_t*)p.ws + (size_t)l * E_LAYER;
            phase_norm(p, seg, nrows, p.in[I_NMIX] + l * 1024, l == 0, l, lds, wv_);
            gbar(p, epoch, wv_);
            for (int r = 0; r < p.rep[0]; ++r) { phase_proj(p, l, MT, lds, wv_); gbar(p, epoch, wv_); }
            phase_mix(p, l, seg, lds, wv_); gbar(p, epoch, wv_);
            phase_mbnorm(p, l, nrows, wv_);
            gbar(p, epoch, wv_);
            for (int r = 0; r < p.rep[1]; ++r) { phase_merge(p, l, MT, lds, wv_); gbar(p, epoch, wv_); }
            phase_resid(p, seg, MT, (const bf16_t*)(p.ws + WS_MRG), 1024, LDK, wl + E_WIN + E_WBR, l == 0, lds, wv_);
            gbar(p, epoch, wv_);
            phase_norm(p, seg, nrows, p.in[I_NFFN] + l * 1024, false, -1, lds, wv_);
            gbar(p, epoch, wv_);
            for (int r = 0; r < p.rep[2]; ++r) { phase_ffn_in(p, l, MT, lds, wv_); gbar(p, epoch, wv_); }
            phase_resid(p, seg, MT, (const bf16_t*)(p.ws + WS_PROJ), FFH, LDF, wl + E_WIN + E_WBR + E_WOUT + E_WFI, false, lds, wv_);
            gbar(p, epoch, wv_);
        }
        phase_final_norm(p, seg, nrows, wv_);
    }
}

extern "C" void kernel_launch(void* const* d_in, const int* in_sizes, int n_in, void* d_out, int out_size, void* d_ws, size_t ws_size, hipStream_t stream) {
    static int grid_blocks = 0;
    if (!grid_blocks) {
        int dev = 0, cus = 0, per_cu = 0;
        (void)hipGetDevice(&dev);
        (void)hipDeviceGetAttribute(&cus, hipDeviceAttributeMultiprocessorCount, dev);
        (void)hipFuncSetAttribute((const void*)fwd_mega, hipFuncAttributeMaxDynamicSharedMemorySize, LDS_BYTES);
        (void)hipOccupancyMaxActiveBlocksPerMultiprocessor(&per_cu, (const void*)fwd_mega, 256, LDS_BYTES);
        if (per_cu < 1) fprintf(stderr, "occupancy query says %d blocks per CU\n", per_cu);
        grid_blocks = cus;
        if (ws_size < WS_TOTAL) fprintf(stderr, "workspace too small: %zu < %zu\n", ws_size, (size_t)WS_END + 256);
    }
    (void)hipMemsetAsync((char*)d_ws + WS_END, 0, 256, stream);
    Params p{};
    for (int i = 0; i < 30; ++i) p.in[i] = (const float*)d_in[i];
    p.out = (float*)d_out; p.ws = (unsigned char*)d_ws; p.rep[0] = REP0; p.rep[1] = REP1; p.rep[2] = REP2; p.rep[3] = REP3;
    void* args[] = {&p};
    hipError_t e = hipLaunchCooperativeKernel((const void*)fwd_mega, dim3(grid_blocks), dim3(256), args, LDS_BYTES, stream);
    if (e != hipSuccess) fprintf(stderr, "cooperative launch failed: %s (grid %d)\n", hipGetErrorString(e), grid_blocks);
}
```

```cpp
#include <hip/hip_runtime.h>
#include <hip/hip_cooperative_groups.h>
#include <cstdio>
namespace cg = cooperative_groups;

typedef unsigned short bf16_t;
typedef short bf16x8 __attribute__((ext_vector_type(8)));
typedef float f32x4 __attribute__((ext_vector_type(4)));
typedef unsigned short us4 __attribute__((ext_vector_type(4)));
typedef unsigned short us8 __attribute__((ext_vector_type(8)));
#define DEVI __device__ __forceinline__

constexpr int LDK = 1088, LDF = 2880;
constexpr int D = 1024, NPROJ = 12288, SEGT = 512, NSEG = 4, ROWS_P = 8192, ROWS = 8704, FFH = 2816;
constexpr int PC_Z = 0, PC_XBC = 1024, PC_HQ = 3072, PC_HF = 4096, PC_HI = 5120, PC_HGATE = 6144, PC_RGATE = 7168, PC_RX = 8192, PC_MG = 9216, PC_DT = 12288;
constexpr size_t E_WIN = (size_t)NPROJ * LDK, E_WBR = 3u * 1024 * LDK, E_WOUT = 1024u * LDK, E_WFI = 5632u * LDK, E_WFO = 1024u * LDF;
constexpr size_t E_LAYER = E_WIN + E_WBR + E_WOUT + E_WFI + E_WFO;
constexpr size_t WS_PROJ = 2 * E_LAYER * 2;
constexpr size_t WS_DT = WS_PROJ + (size_t)ROWS * NPROJ * 2;
constexpr size_t WS_XB = WS_DT + (size_t)ROWS * 16 * 4;
constexpr size_t WS_YMB = WS_XB + (size_t)ROWS * LDK * 2;
constexpr size_t WS_YHG = WS_YMB + (size_t)ROWS * LDK * 2;
constexpr size_t WS_YRG = WS_YHG + (size_t)ROWS * LDK * 2;
constexpr size_t WS_MRG = WS_YRG + (size_t)ROWS * LDK * 2;
constexpr size_t WS_END = WS_MRG + (size_t)ROWS * LDK * 2;
constexpr size_t WS_HB = WS_END + 256;
constexpr size_t WS_DTW = WS_HB + 2u * 2 * 16 * 3 * 2048 * 4;
constexpr size_t WS_TOTAL = WS_DTW + 2u * 16 * 1024 * 4;
constexpr size_t O_YP = 0, O_YS = 33554432, O_SSM_P = 34078720, O_SCV_P = 38273024, O_HG_P = 38469632, O_RG_P = 42663936, O_RCV_P = 42696704,
                 O_SSM_S = 42795008, O_SCV_S = 46989312, O_HG_S = 47185920, O_RG_S = 51380224, O_RCV_S = 51412992;
constexpr int REP0 = 1, REP1 = 1, REP2 = 1, REP3 = 1;
constexpr int LDS_BYTES = 144 * 1024;

enum { I_XP = 0, I_XS, I_SSM, I_SCV, I_HG, I_RG, I_RCV, I_NMIX, I_WIN, I_MCW, I_MCB, I_DTB, I_ALOG, I_MBD, I_MBNW, I_LBL, I_HGNW, I_RCW, I_RCB, I_RWA, I_RBA, I_RWI, I_RBI, I_RLAM, I_WBR, I_WOUT, I_NFFN, I_WFI, I_WFO, I_NFIN };

struct Params { const float* in[30]; float* out; unsigned char* ws; int rep[4]; };

DEVI int tidx(int wv_) { int t = ((wv_ & 3) << 6) | (int)__builtin_amdgcn_mbcnt_hi(~0u, __builtin_amdgcn_mbcnt_lo(~0u, 0u)); asm volatile("" : "+v"(t)); return t; }
DEVI float shfli(float v, int srcl) { return __int_as_float(__builtin_amdgcn_ds_bpermute(srcl << 2, __float_as_int(v))); }
DEVI float shflx(float v, int m, int lane) { return shfli(v, lane ^ m); }
DEVI bf16_t f2bf(float f) { unsigned u = __float_as_uint(f); u += 0x7fffu + ((u >> 16) & 1u); return (bf16_t)(u >> 16); }
DEVI float bf2f(bf16_t h) { return __uint_as_float(((unsigned)h) << 16); }
DEVI float sigm(float x) { return 1.f / (1.f + __expf(-x)); }
DEVI float silu(float x) { return x / (1.f + __expf(-x)); }
DEVI float softplus(float x) { return x > 20.f ? x : __logf(1.f + __expf(x)); }
DEVI float gelu_t(float x) { float u = 0.7978845608f * (x + 0.044715f * x * x * x); return x * sigm(2.f * u); }
DEVI float cexp(float x) { return __expf(fminf(x, 80.f)); }

DEVI const float* xrow_in(const Params& p, int seg, int r) {
    if (r < ROWS_P) { int b = r >> 9, tt = r & 511; return p.in[I_XP] + ((size_t)(b * 2048 + seg * SEGT + tt)) * D; }
    return p.in[I_XS] + (size_t)(r - ROWS_P) * D;
}
DEVI float* xrow_out(const Params& p, int seg, int r) {
    if (r < ROWS_P) { int b = r >> 9, tt = r & 511; return p.out + O_YP + ((size_t)(b * 2048 + seg * SEGT + tt)) * D; }
    return p.out + O_YS + (size_t)(r - ROWS_P) * D;
}

DEVI int perm32(int rho) { int n = rho >> 4, i = rho & 15; return 8 * (i >> 2) + 4 * n + (i & 3); }
DEVI int map_win(int n) { n = (n & ~31) + perm32(n & 31); return n < 3072 ? n : n + 16; }
DEVI int map_wfi(int n) { int T = n >> 7, nf = (n >> 4) & 7, i = n & 15, G = nf >> 2, h = (nf >> 1) & 1, s = nf & 1; return s * FFH + 64 * T + 32 * G + 8 * (i >> 2) + 4 * h + (i & 3); }

DEVI void transpose_tile(const float* src, int ldsrc, bf16_t* dst, int K, int k0, int n0, int mode, float* tile  , int wv_) {
    const int tid = tidx(wv_), c = tid & 63, rq = tid >> 6;
    int n = n0 + c, sn = mode == 1 ? map_win(n) : (mode == 2 ? map_wfi(n) : (mode == 3 ? (n & ~31) + perm32(n & 31) : n));
#pragma unroll
    for (int rr = 0; rr < 16; ++rr) { int kl = rr * 4 + rq; tile[kl * 65 + c] = sn >= 0 ? src[(size_t)(k0 + kl) * ldsrc + sn] : 0.f; }
    __syncthreads();
#pragma unroll
    for (int rr = 0; rr < 16; ++rr) { int nl = rr * 4 + rq; dst[(size_t)(n0 + nl) * K + k0 + c] = f2bf(tile[c * 65 + nl]); }
    __syncthreads();
}

DEVI void phase_prep(const Params& p, char* lds, int wv_) {
    float* tile = (float*)lds;
    bf16_t* wsb = (bf16_t*)p.ws;
    constexpr int T_WIN = 16 * 192, T_WBR = 3 * 256, T_WOUT = 256, T_WFI = 16 * 88, T_WFO = 44 * 16, T_L = T_WIN + T_WBR + T_WOUT + T_WFI + T_WFO;
    {   float* dtw = (float*)(p.ws + WS_DTW);
        for (int e = blockIdx.x * 256 + tidx(wv_); e < 32768; e += gridDim.x * 256) { int l = e >> 14, j = (e >> 10) & 15, k = e & 1023; dtw[e] = p.in[I_WIN][(size_t)l * 1024 * 12304 + (size_t)k * 12304 + 3072 + j]; } }
    for (int t = blockIdx.x; t < 2 * T_L; t += gridDim.x) {
        int l = t / T_L, j = t % T_L;
        bf16_t* wl = wsb + (size_t)l * E_LAYER;
        if (j < T_WIN) { int kt = j & 15, nt = j >> 4; transpose_tile(p.in[I_WIN] + (size_t)l * 1024 * 12304, 12304, wl, LDK, kt * 64, nt * 64, 1, tile, wv_); continue; }
        j -= T_WIN;
        if (j < T_WBR) { int k = j >> 8, jj = j & 255, kt = jj & 15, nt = jj >> 4;
            transpose_tile(p.in[I_WBR] + ((size_t)l * 3 + k) * 1024 * 1024, 1024, wl + E_WIN + (size_t)k * 1024 * LDK, LDK, kt * 64, nt * 64, 3, tile, wv_); continue; }
        j -= T_WBR;
        if (j < T_WOUT) { int kt = j & 15, nt = j >> 4; transpose_tile(p.in[I_WOUT] + (size_t)l * 1024 * 1024, 1024, wl + E_WIN + E_WBR, LDK, kt * 64, nt * 64, 0, tile, wv_); continue; }
        j -= T_WOUT;
        if (j < T_WFI) { int kt = j & 15, nt = j >> 4; transpose_tile(p.in[I_WFI] + (size_t)l * 1024 * 5632, 5632, wl + E_WIN + E_WBR + E_WOUT, LDK, kt * 64, nt * 64, 2, tile, wv_); continue; }
        j -= T_WFI;
        { int kt = j % 44, nt = j / 44; transpose_tile(p.in[I_WFO] + (size_t)l * 2816 * 1024, 1024, wl + E_WIN + E_WBR + E_WOUT + E_WFI, LDF, kt * 64, nt * 64, 0, tile, wv_); }
    }
}

DEVI void phase_norm(const Params& p, int seg, int nrows, const float* w, bool from_input, int ldt  , char* lds, int wv_) {
    bf16_t* xb = (bf16_t*)(p.ws + WS_XB); float* dtb = (float*)(p.ws + WS_DT);
    const int lane = tidx(wv_) & 63, wv = tidx(wv_) >> 6;
    float* dw = (float*)lds;
    if (ldt >= 0) { const float* dtw = (const float*)(p.ws + WS_DTW) + ldt * 16384; f32x4 t_[16];
#pragma unroll
        for (int u = 0; u < 16; ++u) t_[u] = *(const f32x4*)(dtw + (tidx(wv_) + 256 * u) * 4);
#pragma unroll
        for (int u = 0; u < 16; ++u) *(f32x4*)(dw + (tidx(wv_) + 256 * u) * 4) = t_[u];
        __syncthreads(); }
    for (int r = blockIdx.x * 4 + wv; r < nrows; r += gridDim.x * 4) {
        const float* x = from_input ? xrow_in(p, seg, r) : xrow_out(p, seg, r);
        f32x4 v[4]; float ss = 0.f;
#pragma unroll
        for (int i = 0; i < 4; ++i) { v[i] = *(const f32x4*)(x + i * 256 + lane * 4); ss += v[i][0] * v[i][0] + v[i][1] * v[i][1] + v[i][2] * v[i][2] + v[i][3] * v[i][3]; }
#pragma unroll
        for (int o = 32; o >= 1; o >>= 1) ss += shflx(ss, o, lane);
        float rs = rsqrtf(ss * (1.f / 1024.f) + 1e-6f);
#pragma unroll
        for (int i = 0; i < 4; ++i) { f32x4 wv4 = *(const f32x4*)(w + i * 256 + lane * 4); us4 o;
            v[i][0] *= rs * wv4[0]; v[i][1] *= rs * wv4[1]; v[i][2] *= rs * wv4[2]; v[i][3] *= rs * wv4[3];
            o[0] = f2bf(v[i][0]); o[1] = f2bf(v[i][1]); o[2] = f2bf(v[i][2]); o[3] = f2bf(v[i][3]);
            *(us4*)(xb + (size_t)r * LDK + i * 256 + lane * 4) = o; }
        if (ldt >= 0) {
            float d[16];
#pragma unroll
            for (int j = 0; j < 16; ++j) { float s = 0.f;
#pragma unroll
                for (int i = 0; i < 4; ++i) { f32x4 ww = *(const f32x4*)(dw + j * 1024 + i * 256 + lane * 4); s += v[i][0] * ww[0] + v[i][1] * ww[1] + v[i][2] * ww[2] + v[i][3] * ww[3]; }
                d[j] = s; }
            { const bool hi = lane & 32;
#pragma unroll
              for (int i = 0; i < 8; ++i) { float send = hi ? d[i] : d[i + 8], keep = hi ? d[i + 8] : d[i]; d[i] = keep + shfli(send, lane ^ 32); } }
            { const bool hi = lane & 16;
#pragma unroll
              for (int i = 0; i < 4; ++i) { float send = hi ? d[i] : d[i + 4], keep = hi ? d[i + 4] : d[i]; d[i] = keep + shfli(send, lane ^ 16); } }
            { const bool hi = lane & 8;
#pragma unroll
              for (int i = 0; i < 2; ++i) { float send = hi ? d[i] : d[i + 2], keep = hi ? d[i + 2] : d[i]; d[i] = keep + shfli(send, lane ^ 8); } }
            { const bool hi = lane & 4; float send = hi ? d[0] : d[1], keep = hi ? d[1] : d[0]; d[0] = keep + shfli(send, lane ^ 4); }
            d[0] += shfli(d[0], lane ^ 2); d[0] += shfli(d[0], lane ^ 1);
            if ((lane & 3) == 0) { int j = lane >> 2; dtb[(size_t)r * 16 + j] = softplus(d[0] + p.in[I_DTB][ldt * 16 + j]); }
        }
    }
    if (ldt >= 0) __syncthreads();
}
DEVI void phase_final_norm(const Params& p, int seg, int nrows, int wv_) {
    const float* w = p.in[I_NFIN];
    const int lane = tidx(wv_) & 63, wv = tidx(wv_) >> 6;
    for (int r = blockIdx.x * 4 + wv; r < nrows; r += gridDim.x * 4) {
        float* x = xrow_out(p, seg, r);
        f32x4 v[4]; float ss = 0.f;
#pragma unroll
        for (int i = 0; i < 4; ++i) { v[i] = *(const f32x4*)(x + i * 256 + lane * 4); ss += v[i][0] * v[i][0] + v[i][1] * v[i][1] + v[i][2] * v[i][2] + v[i][3] * v[i][3]; }
#pragma unroll
        for (int o = 32; o >= 1; o >>= 1) ss += shflx(ss, o, lane);
        float rs = rsqrtf(ss * (1.f / 1024.f) + 1e-6f);
#pragma unroll
        for (int i = 0; i < 4; ++i) { f32x4 wv4 = *(const f32x4*)(w + i * 256 + lane * 4); f32x4 o;
            o[0] = v[i][0] * rs * wv4[0]; o[1] = v[i][1] * rs * wv4[1]; o[2] = v[i][2] * rs * wv4[2]; o[3] = v[i][3] * rs * wv4[3];
            *(f32x4*)(x + i * 256 + lane * 4) = o; }
    }
}
DEVI void phase_mbnorm(const Params& p, int l, int nrows, int wv_) {
    bf16_t* y = (bf16_t*)(p.ws + WS_YMB); const float* w = p.in[I_MBNW] + l * 1024;
    const int lane = tidx(wv_) & 63, wv = tidx(wv_) >> 6;
    for (int it = blockIdx.x * 4 + wv; it < nrows * 4; it += gridDim.x * 4) {
        int r = it >> 2, g = it & 3; bf16_t* yp = y + (size_t)r * LDK + g * 256 + lane * 4;
        us4 v = *(const us4*)yp; float f0 = bf2f(v[0]), f1 = bf2f(v[1]), f2 = bf2f(v[2]), f3 = bf2f(v[3]);
        float ss = f0 * f0 + f1 * f1 + f2 * f2 + f3 * f3;
#pragma unroll
        for (int o = 32; o >= 1; o >>= 1) ss += shflx(ss, o, lane);
        float rs = rsqrtf(ss * (1.f / 256.f) + 1e-6f); f32x4 wv4 = *(const f32x4*)(w + g * 256 + lane * 4);
        us4 o; o[0] = f2bf(f0 * rs * wv4[0]); o[1] = f2bf(f1 * rs * wv4[1]); o[2] = f2bf(f2 * rs * wv4[2]); o[3] = f2bf(f3 * rs * wv4[3]);
        *(us4*)yp = o;
    }
}

#define WAIT_V(n) asm volatile("s_waitcnt vmcnt(" #n ")" ::: "memory")
#define RAW_BAR() do { asm volatile("" ::: "memory"); __builtin_amdgcn_s_barrier(); asm volatile("" ::: "memory"); } while (0)
template <int NF>
DEVI void stage_a(const bf16_t* A, int K, int t, char* st, int tid, size_t soff) {
    const size_t o = soff + (size_t)t * 32;
#pragma unroll
    for (int i = 0; i < 4; ++i) __builtin_amdgcn_global_load_lds((const unsigned*)(A + o + (size_t)i * 64 * K), (unsigned*)(st + tid * 16 + i * 4096), 16, 0, 0);
}
template <int NF>
DEVI void stage_b(const bf16_t* Bt, int K, int t, char* st, int tid, size_t soff) {
    const size_t o = soff + (size_t)t * 32;
#pragma unroll
    for (int i = 0; i < NF / 2; ++i) __builtin_amdgcn_global_load_lds((const unsigned*)(Bt + o + (size_t)i * 64 * K), (unsigned*)(st + 16384 + tid * 16 + i * 4096), 16, 0, 0);
}
template <int NF>
DEVI void gemm_kloop(f32x4 (&acc)[8][NF], const bf16_t* A, const bf16_t* Bt, int K, int ld, char* lds, int wv_) {
    constexpr int STAGE = 16384 + NF * 2048;
    const int tid = tidx(wv_), lane = tid & 63, wid = tid >> 6, wr = wid >> 1, wc = wid & 1, fr = lane & 15, fq = lane >> 4;
    const int fo = fr * 64 + ((fq ^ (0x1320 >> (4 * (fr >> 2)))) & 3) * 16;
    const int aoff = wr * 8192 + fo, boff = 16384 + wc * NF * 1024 + fo;
    const size_t soff = (size_t)(tid >> 2) * ld + ((((tid & 3) ^ (0x1320 >> (4 * ((tid >> 4) & 3)))) & 3) * 8);
    const int nt = K >> 5;
    WAIT_V(0); RAW_BAR();
    stage_a<NF>(A, ld, 0, lds, tid, soff); stage_b<NF>(Bt, ld, 0, lds, tid, soff);
    stage_a<NF>(A, ld, 1, lds + STAGE, tid, soff); stage_b<NF>(Bt, ld, 1, lds + STAGE, tid, soff);
    stage_a<NF>(A, ld, 2, lds + 2 * STAGE, tid, soff); stage_b<NF>(Bt, ld, 2, lds + 2 * STAGE, tid, soff);
    if (NF == 8) WAIT_V(16); else WAIT_V(12);
    RAW_BAR();
    bf16x8 a[8], a01[2][2], b[2][NF];
    a01[0][0] = *(const bf16x8*)(lds + aoff); a01[0][1] = *(const bf16x8*)(lds + aoff + 1024);
#pragma unroll
    for (int n = 0; n < NF; ++n) b[0][n] = *(const bf16x8*)(lds + boff + n * 1024);
#define MMA_G(g_, P_) _Pragma("unroll") for (int n = 0; n < NF; ++n) acc[g_][n] = __builtin_amdgcn_mfma_f32_16x16x32_bf16(b[P_][n], a[g_], acc[g_][n], 0, 0, 0)
#define KBODY(T_, P_, Q_) do { \
        const int T = (T_); const char* st = lds + (T & 3) * STAGE; const char* stn = lds + ((T + 1) & 3) * STAGE; char* st3 = lds + ((T + 3) & 3) * STAGE; \
        a[0] = a01[P_][0]; a[1] = a01[P_][1]; \
        __builtin_amdgcn_sched_barrier(0); a[2] = *(const bf16x8*)(st + aoff + 2 * 1024); MMA_G(0, P_); \
        __builtin_amdgcn_sched_barrier(0); a[3] = *(const bf16x8*)(st + aoff + 3 * 1024); MMA_G(1, P_); \
        __builtin_amdgcn_sched_barrier(0); a[4] = *(const bf16x8*)(st + aoff + 4 * 1024); MMA_G(2, P_); \
        __builtin_amdgcn_sched_barrier(0); a[5] = *(const bf16x8*)(st + aoff + 5 * 1024); MMA_G(3, P_); \
        __builtin_amdgcn_sched_barrier(0); \
        if (T + 2 < nt) { if (NF == 8) WAIT_V(8); else WAIT_V(6); } else WAIT_V(0); \
        RAW_BAR(); \
        __builtin_amdgcn_sched_barrier(0); a[6] = *(const bf16x8*)(st + aoff + 6 * 1024); \
        if (T + 3 < nt) stage_a<NF>(A, ld, T + 3, st3, tid, soff); \
        _Pragma("unroll") for (int n = 0; n < NF / 2; ++n) b[Q_][n] = *(const bf16x8*)(stn + boff + n * 1024); \
        MMA_G(4, P_); \
        __builtin_amdgcn_sched_barrier(0); a[7] = *(const bf16x8*)(st + aoff + 7 * 1024); \
        if (T + 3 < nt) stage_b<NF>(Bt, ld, T + 3, st3, tid, soff); \
        _Pragma("unroll") for (int n = NF / 2; n < NF; ++n) b[Q_][n] = *(const bf16x8*)(stn + boff + n * 1024); \
        MMA_G(5, P_); \
        __builtin_amdgcn_sched_barrier(0); a01[Q_][0] = *(const bf16x8*)(stn + aoff); MMA_G(6, P_); \
        __builtin_amdgcn_sched_barrier(0); a01[Q_][1] = *(const bf16x8*)(stn + aoff + 1024); MMA_G(7, P_); \
        __builtin_amdgcn_sched_barrier(0); } while (0)
    for (int t = 0; t < nt; t += 2) { KBODY(t, 0, 1); KBODY(t + 1, 1, 0); }
#undef KBODY
#undef MMA_G
}
DEVI bool next_tile(int it, int MT, int NT, int& mt, int& nt, int wv_) {
    const int x = (wv_ >> 2) & 7, bl = (wv_ >> 5) & 511, G8 = (wv_ >> 14) & 511;
    int j = it * G8 + bl;
    const int nb = 4 * NT;
    if (j < nb) { nt = j >> 2; mt = x + 8 * (j & 3); return true; }
    if (MT == 32) return false;
    j -= nb;
    const int ne = (NT - x + 7) >> 3;
    if (j >= 2 * ne) return false;
    mt = 32 + (j & 1); nt = x + 8 * (j >> 1); return true;
}
#define ZERO_ACC(a, NF_) _Pragma("unroll") for (int m_ = 0; m_ < 8; ++m_) _Pragma("unroll") for (int n_ = 0; n_ < NF_; ++n_) a[m_][n_] = (f32x4){0.f, 0.f, 0.f, 0.f}
#define EPI_IDS const int lane = tidx(wv_) & 63, wid = tidx(wv_) >> 6, wr = wid >> 1, wc = wid & 1, fr = lane & 15, fq = lane >> 4

DEVI void proj_store_row(const f32x4 (&accm)[8], bf16_t* prow, float c1, float c3, bool issig, bool isact) {
#pragma unroll
    for (int q = 0; q < 4; ++q) { __builtin_amdgcn_sched_barrier(0); us8 o;
#pragma unroll
        for (int s = 0; s < 2; ++s)
#pragma unroll
            for (int j = 0; j < 4; ++j) { float x = accm[2 * q + s][j];
                float u = x * (c1 + c3 * x * x); float sg = __builtin_amdgcn_rcpf(1.f + __expf(-u)); float y = sg * (issig ? 1.f : x);
                o[4 * s + j] = f2bf(isact ? y : x); }
        *(us8*)(prow + q * 32) = o; }
}
DEVI void phase_proj(const Params& p, int l, int MT, char* lds, int wv_) {
    const bf16_t* xb = (const bf16_t*)(p.ws + WS_XB); const bf16_t* wt = (const bf16_t*)p.ws + (size_t)l * E_LAYER;
    bf16_t* proj = (bf16_t*)(p.ws + WS_PROJ);
    int mt, nt;
    for (int it = 0; next_tile(it, MT, 48, mt, nt, wv_); ++it) {
        f32x4 acc[8][8]; ZERO_ACC(acc, 8);
        gemm_kloop<8>(acc, xb + (size_t)mt * 256 * LDK, wt + (size_t)nt * 256 * LDK, 1024, LDK, lds, wv_);
        EPI_IDS;
        const int sg = nt >> 2;
        const int ty = (sg == 0 || sg == 3 || sg == 6) ? 1 : (sg == 7 ? 2 : (sg >= 9 ? 3 : 0));
        bf16_t* pbase = proj + (size_t)(mt * 256 + wr * 128 + fr) * NPROJ + nt * 256 + wc * 128 + fq * 8;
        const float c1 = ty == 2 ? 1.5957691216f : 1.f, c3 = ty == 2 ? 0.0713548163f : 0.f;
#pragma unroll
        for (int m = 0; m < 8; ++m) {
#pragma unroll
            for (int n = 0; n < 8; ++n) asm volatile("" : "+v"(acc[m][n]) :: "memory");
            proj_store_row(acc[m], pbase + (size_t)m * 16 * NPROJ, c1, c3, ty == 3, ty != 0); }
    }
}
DEVI void phase_merge(const Params& p, int l, int MT, char* lds, int wv_) {
    const bf16_t* wt = (const bf16_t*)p.ws + (size_t)l * E_LAYER + E_WIN; const bf16_t* proj = (const bf16_t*)(p.ws + WS_PROJ);
    bf16_t* mrg = (bf16_t*)(p.ws + WS_MRG);
    int mt, nt;
    for (int it = 0; next_tile(it, MT, 8, mt, nt, wv_); ++it) {
        f32x4 tot[8][4]; ZERO_ACC(tot, 4);
#pragma unroll 1
        for (int k = 0; k < 3; ++k) {
            const bf16_t* y = (const bf16_t*)(p.ws + WS_YMB + (size_t)k * ROWS * LDK * 2);
            f32x4 acc[8][4]; ZERO_ACC(acc, 4);
            gemm_kloop<4>(acc, y + (size_t)mt * 256 * LDK, wt + (size_t)k * 1024 * LDK + (size_t)nt * 128 * LDK, 1024, LDK, lds, wv_);
            EPI_IDS;
#pragma unroll
            for (int m = 0; m < 8; ++m) { int row = mt * 256 + wr * 128 + m * 16 + fr; asm volatile("" ::: "memory");
#pragma unroll
                for (int q = 0; q < 2; ++q) { int col = nt * 128 + wc * 64 + 32 * q + fq * 8; us8 g = *(const us8*)(proj + (size_t)row * NPROJ + PC_MG + k * 1024 + col);
#pragma unroll
                    for (int s = 0; s < 2; ++s)
#pragma unroll
                        for (int j = 0; j < 4; ++j) tot[m][2 * q + s][j] += acc[m][2 * q + s][j] * bf2f(g[4 * s + j]); } }
        }
        EPI_IDS;
#pragma unroll
        for (int m = 0; m < 8; ++m) { int row = mt * 256 + wr * 128 + m * 16 + fr;
#pragma unroll
            for (int q = 0; q < 2; ++q) { int col = nt * 128 + wc * 64 + 32 * q + fq * 8; us8 o;
#pragma unroll
                for (int s = 0; s < 2; ++s)
#pragma unroll
                    for (int j = 0; j < 4; ++j) o[4 * s + j] = f2bf(tot[m][2 * q + s][j]);
                *(us8*)(mrg + (size_t)row * LDK + col) = o; } }
    }
}
DEVI void phase_resid(const Params& p, int seg, int MT, const bf16_t* A, int K, int ld, const bf16_t* Bt, bool from_input, char* lds, int wv_) {
    int mt, nt;
    for (int it = 0; next_tile(it, MT, 8, mt, nt, wv_); ++it) {
        f32x4 acc[8][4]; ZERO_ACC(acc, 4);
        gemm_kloop<4>(acc, A + (size_t)mt * 256 * ld, Bt + (size_t)nt * 128 * ld, K, ld, lds, wv_);
        EPI_IDS;
#pragma unroll
        for (int m = 0; m < 8; ++m) { int row = mt * 256 + wr * 128 + m * 16 + fr;
            const float* xi = from_input ? xrow_in(p, seg, row) : xrow_out(p, seg, row); float* xo = xrow_out(p, seg, row);
#pragma unroll
            for (int n = 0; n < 4; ++n) { int col = nt * 128 + wc * 64 + n * 16 + fq * 4; f32x4 v = *(const f32x4*)(xi + col); *(f32x4*)(xo + col) = v + acc[m][n]; } }
    }
}
DEVI void phase_ffn_in(const Params& p, int l, int MT, char* lds, int wv_) {
    const bf16_t* xb = (const bf16_t*)(p.ws + WS_XB); const bf16_t* wt = (const bf16_t*)p.ws + (size_t)l * E_LAYER + E_WIN + E_WBR + E_WOUT;
    bf16_t* act = (bf16_t*)(p.ws + WS_PROJ);
    int mt, nt;
    for (int it = 0; next_tile(it, MT, 22, mt, nt, wv_); ++it) {
        f32x4 acc[8][8]; ZERO_ACC(acc, 8);
        gemm_kloop<8>(acc, xb + (size_t)mt * 256 * LDK, wt + (size_t)nt * 256 * LDK, 1024, LDK, lds, wv_);
        EPI_IDS;
#pragma unroll
        for (int m = 0; m < 8; ++m) { int row = mt * 256 + wr * 128 + m * 16 + fr;
#pragma unroll
            for (int n = 0; n < 8; ++n) asm volatile("" : "+v"(acc[m][n]) :: "memory");
#pragma unroll
            for (int G = 0; G < 2; ++G) { int col = (nt * 2 + wc) * 64 + 32 * G + fq * 8; us8 o;
#pragma unroll
                for (int h = 0; h < 2; ++h)
#pragma unroll
                    for (int j = 0; j < 4; ++j) o[4 * h + j] = f2bf(silu(acc[m][4 * G + 2 * h][j]) * acc[m][4 * G + 2 * h + 1][j]);
                *(us8*)(act + (size_t)row * LDF + col) = o; } }
    }
}

struct Seq { int row0, nchunk, Q, b, samp, seg; };
DEVI Seq make_seq(int seg, int sq) { Seq s; s.seg = seg; if (sq < 16) { s.row0 = sq * SEGT; s.nchunk = 8; s.Q = 64; s.b = sq; s.samp = 0; } else { s.b = sq - 16; s.row0 = ROWS_P + s.b * 32; s.nchunk = 1; s.Q = 32; s.samp = 1; } return s; }

template <int NF, int KS>
DEVI void lds_mma(f32x4* acc, const bf16_t* X, int ldx, int m0, const bf16_t* Y, int ldy, int n0, int wv_) {
    const int lane = tidx(wv_) & 63, fr = lane & 15, fq = lane >> 4;
#pragma unroll
    for (int ks = 0; ks < KS; ++ks) {
        bf16x8 a = *(const bf16x8*)(X + (m0 + fr) * ldx + ks * 32 + fq * 8);
#pragma unroll
        for (int nf = 0; nf < NF; ++nf) { bf16x8 b = *(const bf16x8*)(Y + (n0 + nf * 16 + fr) * ldy + ks * 32 + fq * 8); acc[nf] = __builtin_amdgcn_mfma_f32_16x16x32_bf16(a, b, acc[nf], 0, 0, 0); }
    }
}

DEVI void conv_load(uint4 (&r)[4], const bf16_t* proj, int row0, int tq, int pcol) {
#pragma unroll
    for (int k = 0; k < 4; ++k) { int ts = tq - 3 + k; ts = ts < 0 ? 0 : ts; r[k] = *(const uint4*)(proj + (size_t)(row0 + ts) * NPROJ + pcol); }
}
DEVI void touch4(uint4& v) { asm volatile("" : "+v"(v.x), "+v"(v.y), "+v"(v.z), "+v"(v.w)); }
DEVI void conv_compute(const uint4 (&r)[4], int tq, const float* hl, const float* cwl, int HC, int cl, float (&out)[8], float (&raw)[8]) {
    { f32x4 b0 = *(const f32x4*)(cwl + 4 * HC + cl), b1 = *(const f32x4*)(cwl + 4 * HC + cl + 4);
      out[0] = b0[0]; out[1] = b0[1]; out[2] = b0[2]; out[3] = b0[3]; out[4] = b1[0]; out[5] = b1[1]; out[6] = b1[2]; out[7] = b1[3]; }
#pragma unroll
    for (int k = 0; k < 4; ++k) {
        const int ts = tq - 3 + k; float v[8];
        v[0] = __uint_as_float(r[k].x << 16); v[1] = __uint_as_float(r[k].x & 0xffff0000u); v[2] = __uint_as_float(r[k].y << 16); v[3] = __uint_as_float(r[k].y & 0xffff0000u);
        v[4] = __uint_as_float(r[k].z << 16); v[5] = __uint_as_float(r[k].z & 0xffff0000u); v[6] = __uint_as_float(r[k].w << 16); v[7] = __uint_as_float(r[k].w & 0xffff0000u);
        if (k < 3) { int hi = 3 + ts; hi = hi < 0 ? 0 : (hi > 2 ? 2 : hi); const bool uh = ts < 0;
            f32x4 h0 = *(const f32x4*)(hl + hi * HC + cl), h1 = *(const f32x4*)(hl + hi * HC + cl + 4);
            v[0] = uh ? h0[0] : v[0]; v[1] = uh ? h0[1] : v[1]; v[2] = uh ? h0[2] : v[2]; v[3] = uh ? h0[3] : v[3];
            v[4] = uh ? h1[0] : v[4]; v[5] = uh ? h1[1] : v[5]; v[6] = uh ? h1[2] : v[6]; v[7] = uh ? h1[3] : v[7]; }
        f32x4 w0 = *(const f32x4*)(cwl + k * HC + cl), w1 = *(const f32x4*)(cwl + k * HC + cl + 4);
        out[0] += v[0] * w0[0]; out[1] += v[1] * w0[1]; out[2] += v[2] * w0[2]; out[3] += v[3] * w0[3];
        out[4] += v[4] * w1[0]; out[5] += v[5] * w1[1]; out[6] += v[6] * w1[2]; out[7] += v[7] * w1[3];
        if (k == 3) {
#pragma unroll
            for (int e = 0; e < 8; ++e) raw[e] = v[e]; }
    }
}

template <int ROWB>
DEVI void stage_raw(const char* g0, size_t ldgB, char* dst, int tid) {
#pragma unroll
    for (int i = 0; i < ROWB / 64; ++i) { int b = tid * 16 + i * 4096, row = b / ROWB, cb = b % ROWB;
        __builtin_amdgcn_global_load_lds((const unsigned*)(g0 + (size_t)row * ldgB + cb), (unsigned*)(dst + b), 16, 0, 0); }
}
DEVI void conv_lds(const bf16_t* rawt, int RS, int t, int cloc, const float* hl, const float* cwl, int HC, int cl, float (&out)[8], float (&raw)[8]) {
    { f32x4 b0 = *(const f32x4*)(cwl + 4 * HC + cl), b1 = *(const f32x4*)(cwl + 4 * HC + cl + 4);
      out[0] = b0[0]; out[1] = b0[1]; out[2] = b0[2]; out[3] = b0[3]; out[4] = b1[0]; out[5] = b1[1]; out[6] = b1[2]; out[7] = b1[3]; }
#pragma unroll
    for (int k = 0; k < 4; ++k) {
        const int tt = t - 3 + k; const int tc = tt < 0 ? 0 : tt; float v[8];
        const uint4 r = *(const uint4*)(rawt + tc * RS + cloc);
        v[0] = __uint_as_float(r.x << 16); v[1] = __uint_as_float(r.x & 0xffff0000u); v[2] = __uint_as_float(r.y << 16); v[3] = __uint_as_float(r.y & 0xffff0000u);
        v[4] = __uint_as_float(r.z << 16); v[5] = __uint_as_float(r.z & 0xffff0000u); v[6] = __uint_as_float(r.w << 16); v[7] = __uint_as_float(r.w & 0xffff0000u);
        if (k < 3) { int hi = 3 + tt; hi = hi < 0 ? 0 : (hi > 2 ? 2 : hi); const bool uh = tt < 0;
            f32x4 h0 = *(const f32x4*)(hl + hi * HC + cl), h1 = *(const f32x4*)(hl + hi * HC + cl + 4);
            v[0] = uh ? h0[0] : v[0]; v[1] = uh ? h0[1] : v[1]; v[2] = uh ? h0[2] : v[2]; v[3] = uh ? h0[3] : v[3];
            v[4] = uh ? h1[0] : v[4]; v[5] = uh ? h1[1] : v[5]; v[6] = uh ? h1[2] : v[6]; v[7] = uh ? h1[3] : v[7]; }
        f32x4 w0 = *(const f32x4*)(cwl + k * HC + cl), w1 = *(const f32x4*)(cwl + k * HC + cl + 4);
        out[0] += v[0] * w0[0]; out[1] += v[1] * w0[1]; out[2] += v[2] * w0[2]; out[3] += v[3] * w0[3];
        out[4] += v[4] * w1[0]; out[5] += v[5] * w1[1]; out[6] += v[6] * w1[2]; out[7] += v[7] * w1[3];
        if (k == 3) {
#pragma unroll
            for (int e = 0; e < 8; ++e) raw[e] = v[e]; }
    }
}

DEVI void ssd_unit(const Params& p, int l, Seq sq, int hd, char* lds, int wv_) {
    bf16_t* Bm = (bf16_t*)lds;
    bf16_t* R2 = (bf16_t*)(lds + 17408);
    bf16_t* xT = (bf16_t*)(lds + 35840);
    bf16_t* hb = (bf16_t*)(lds + 45056);
    float* fl = (float*)(lds + 62464);
    const int tid = tidx(wv_), lane = tid & 63, w = tid >> 6, fr = lane & 15, fq = lane >> 4;
    const bf16_t* proj = (const bf16_t*)(p.ws + WS_PROJ); const float* dtb = (const float*)(p.ws + WS_DT); bf16_t* ymb = (bf16_t*)(p.ws + WS_YMB);
    const int g = hd >> 2;
    const float a = -__expf(p.in[I_ALOG][l * 16 + hd]), Dv = p.in[I_MBD][l * 16 + hd];
    const float* cw = p.in[I_MCW] + (size_t)l * 4 * 2048; const float* cbias = p.in[I_MCB] + l * 2048;
    float* cwl = (float*)(lds + 63488);
    float* hl = (float*)(lds + 69888);
    const float* st_in; float* st_out; const float* hist; float* hist_out; float* hist_out2 = nullptr;
    float* hbuf = (float*)(p.ws + WS_HB);
    if (sq.samp) { st_in = p.in[I_SSM] + ((size_t)(l * 16 + sq.b) * 16 + hd) * 8192; st_out = p.out + O_SSM_S + ((size_t)(l * 16 + sq.b) * 16 + hd) * 8192;
        hist = p.in[I_SCV] + (size_t)(l * 16 + sq.b) * 3 * 2048; hist_out = p.out + O_SCV_S + (size_t)(l * 16 + sq.b) * 3 * 2048; }
    else { st_out = p.out + O_SSM_P + ((size_t)(l * 16 + sq.b) * 16 + hd) * 8192; st_in = sq.seg ? st_out : nullptr;
        hist_out = hbuf + ((size_t)((sq.seg & 1) * 2 + l) * 16 + sq.b) * 3 * 2048; hist = sq.seg ? hbuf + ((size_t)(((sq.seg + 1) & 1) * 2 + l) * 16 + sq.b) * 3 * 2048 : nullptr;
        if (sq.seg == NSEG - 1) hist_out2 = p.out + O_SCV_P + (size_t)(l * 16 + sq.b) * 3 * 2048; }
    for (int idx = tid; idx < 1600; idx += 256) { int k = idx / 320, cc = idx - k * 320; int ch = cc < 64 ? hd * 64 + cc : (cc < 192 ? 1024 + g * 128 + (cc - 64) : 1536 + g * 128 + (cc - 192));
        cwl[idx] = k < 4 ? cw[k * 2048 + ch] : cbias[ch];
        if (idx < 960) hl[idx] = hist ? hist[k * 2048 + ch] : 0.f; }
    f32x4 hacc[8];
#pragma unroll
    for (int nf = 0; nf < 8; ++nf)
#pragma unroll
        for (int r = 0; r < 4; ++r) { int pp = 16 * w + 4 * fq + r, n = 16 * nf + fr; float v = st_in ? st_in[pp * 128 + n] : 0.f; hacc[nf][r] = v; hb[pp * 136 + n] = f2bf(v); }
    bf16_t* rawX = (bf16_t*)(lds + 77568); bf16_t* rawB = (bf16_t*)(lds + 85760); bf16_t* rawC = (bf16_t*)(lds + 102144); bf16_t* rawZ = (bf16_t*)(lds + 118528); float* rawDt = (float*)(lds + 126720);
    const char* gx = (const char*)(proj + PC_XBC + hd * 64); const char* gb = (const char*)(proj + PC_XBC + 1024 + g * 128); const char* gc = (const char*)(proj + PC_XBC + 1536 + g * 128); const char* gz = (const char*)(proj + PC_Z + hd * 64);
    asm volatile("s_waitcnt vmcnt(0)" ::: "memory");
    {   const size_t ro = (size_t)sq.row0 * NPROJ * 2;
        stage_raw<128>(gx + ro, (size_t)NPROJ * 2, (char*)rawX, tid); stage_raw<256>(gb + ro, (size_t)NPROJ * 2, (char*)rawB, tid); stage_raw<256>(gc + ro, (size_t)NPROJ * 2, (char*)rawC, tid);
        stage_raw<128>(gz + ro, (size_t)NPROJ * 2, (char*)rawZ, tid); stage_raw<64>((const char*)(dtb + (size_t)sq.row0 * 16), 64, (char*)rawDt, tid); }
    for (int c = 0; c < sq.nchunk; ++c) {
        const int tid = tidx(wv_), lane = tid & 63, w = tid >> 6, fr = lane & 15, fq = lane >> 4;
        const int rowc = sq.row0 + c * 64; const bool lastc = (c == sq.nchunk - 1);
        const float* hlr = hl + (c & 1) * 960; float* hlw = hl + ((c + 1) & 1) * 960;
        asm volatile("s_waitcnt vmcnt(0)" ::: "memory");
        __syncthreads();
        if (w == 0) {
            float dt = lane < sq.Q ? rawDt[lane * 16 + hd] : 0.f; float v = dt * a;
#pragma unroll
            for (int o = 1; o < 64; o <<= 1) { float t = shfli(v, lane - o); if (lane >= o) v += t; }
            float last = shfli(v, 63);
            fl[lane] = v; fl[64 + lane] = dt; fl[128 + lane] = __expf(last - v) * dt; fl[192 + lane] = __expf(v);
        }
        __syncthreads();
        const float elast = __expf(fl[63]);
#pragma unroll
        for (int i = 0; i < 2; ++i) { int it = tid + 256 * i, t = it >> 3, c8 = (it & 7) * 8; float o[8], raw[8]; int ch = hd * 64 + c8; const bool tv = t < sq.Q;
            conv_lds(rawX, 64, t, c8, hlr, cwl, 320, c8, o, raw);
#pragma unroll
            for (int e = 0; e < 8; ++e) { float s_ = silu(o[e]); o[e] = tv ? s_ : 0.f; }
            if (t >= 61) {
#pragma unroll
                for (int e = 0; e < 8; ++e) hlw[(t - 61) * 320 + c8 + e] = raw[e]; }
            if (lastc && tv && t >= sq.Q - 3) {
#pragma unroll
                for (int e = 0; e < 8; ++e) { hist_out[(t - (sq.Q - 3)) * 2048 + ch + e] = raw[e]; if (hist_out2) hist_out2[(t - (sq.Q - 3)) * 2048 + ch + e] = raw[e]; } }
#pragma unroll
            for (int e = 0; e < 8; ++e) xT[(c8 + e) * 72 + t] = f2bf(o[e]); }
#pragma unroll
        for (int i = 0; i < 4; ++i) { int it = tid + 256 * i, t = it >> 4, c8 = (it & 15) * 8; float o[8], raw[8]; int ch = 1024 + g * 128 + c8; const bool tv = t < sq.Q;
            conv_lds(rawB, 128, t, c8, hlr, cwl, 320, 64 + c8, o, raw);
#pragma unroll
            for (int e = 0; e < 8; ++e) { float s_ = silu(o[e]); o[e] = tv ? s_ : 0.f; }
            if (t >= 61) {
#pragma unroll
                for (int e = 0; e < 8; ++e) hlw[(t - 61) * 320 + 64 + c8 + e] = raw[e]; }
            if (lastc && tv && (hd & 3) == 0 && t >= sq.Q - 3) {
#pragma unroll
                for (int e = 0; e < 8; ++e) { hist_out[(t - (sq.Q - 3)) * 2048 + ch + e] = raw[e]; if (hist_out2) hist_out2[(t - (sq.Q - 3)) * 2048 + ch + e] = raw[e]; } }
            us8 ov; float we = fl[128 + t];
#pragma unroll
            for (int e = 0; e < 8; ++e) { ov[e] = f2bf(o[e]); R2[(c8 + e) * 72 + t] = f2bf(o[e] * we); }
            *(us8*)(Bm + t * 136 + c8) = ov; }
        __syncthreads();
#pragma unroll
        for (int nf = 0; nf < 8; ++nf) hacc[nf] *= elast;
        lds_mma<8, 2>(hacc, xT, 72, 16 * w, R2, 72, 0, wv_);
        __syncthreads();
#pragma unroll
        for (int i = 0; i < 4; ++i) { int it = tid + 256 * i, t = it >> 4, c8 = (it & 15) * 8; float o[8], raw[8]; int ch = 1536 + g * 128 + c8; const bool tv = t < sq.Q;
            conv_lds(rawC, 128, t, c8, hlr, cwl, 320, 192 + c8, o, raw);
#pragma unroll
            for (int e = 0; e < 8; ++e) { float s_ = silu(o[e]); o[e] = tv ? s_ : 0.f; }
            if (t >= 61) {
#pragma unroll
                for (int e = 0; e < 8; ++e) hlw[(t - 61) * 320 + 192 + c8 + e] = raw[e]; }
            if (lastc && tv && (hd & 3) == 0 && t >= sq.Q - 3) {
#pragma unroll
                for (int e = 0; e < 8; ++e) { hist_out[(t - (sq.Q - 3)) * 2048 + ch + e] = raw[e]; if (hist_out2) hist_out2[(t - (sq.Q - 3)) * 2048 + ch + e] = raw[e]; } }
            us8 ov;
#pragma unroll
            for (int e = 0; e < 8; ++e) ov[e] = f2bf(o[e]);
            *(us8*)(R2 + t * 136 + c8) = ov; }
        us4 zr[4];
#pragma unroll
        for (int nf = 0; nf < 4; ++nf) zr[nf] = *(const us4*)(rawZ + (16 * nf + fr) * 64 + 16 * w + 4 * fq);
        __syncthreads();
        if (!lastc) { const size_t ro = (size_t)(rowc + 64) * NPROJ * 2;
            stage_raw<128>(gx + ro, (size_t)NPROJ * 2, (char*)rawX, tid); stage_raw<256>(gb + ro, (size_t)NPROJ * 2, (char*)rawB, tid); stage_raw<256>(gc + ro, (size_t)NPROJ * 2, (char*)rawC, tid);
            stage_raw<128>(gz + ro, (size_t)NPROJ * 2, (char*)rawZ, tid); stage_raw<64>((const char*)(dtb + (size_t)(rowc + 64) * 16), 64, (char*)rawDt, tid); }
        f32x4 cbv[4];
#pragma unroll
        for (int nf = 0; nf < 4; ++nf) cbv[nf] = (f32x4){0.f, 0.f, 0.f, 0.f};
        lds_mma<4, 4>(cbv, Bm, 136, 16 * w, R2, 136, 0, wv_);
        __syncthreads();
#pragma unroll
        for (int nf = 0; nf < 4; ++nf) { int i = 16 * nf + fr; float ai = fl[i]; us4 o;
#pragma unroll
            for (int r = 0; r < 4; ++r) { int j = 16 * w + 4 * fq + r; float v = (j <= i) ? cbv[nf][r] * __expf(ai - fl[j]) * fl[64 + j] : 0.f; o[r] = f2bf(v); }
            *(us4*)(Bm + i * 72 + 16 * w + 4 * fq) = o; }
        __syncthreads();
        f32x4 ya[4];
#pragma unroll
        for (int nf = 0; nf < 4; ++nf) ya[nf] = (f32x4){0.f, 0.f, 0.f, 0.f};
        lds_mma<4, 4>(ya, hb, 136, 16 * w, R2, 136, 0, wv_);
#pragma unroll
        for (int nf = 0; nf < 4; ++nf) ya[nf] *= fl[192 + 16 * nf + fr];
        lds_mma<4, 2>(ya, xT, 72, 16 * w, Bm, 72, 0, wv_);
#pragma unroll
        for (int nf = 0; nf < 4; ++nf) { int i = 16 * nf + fr, p0 = 16 * w + 4 * fq;
            us4 z = zr[nf];
            if (i < sq.Q) { us4 o;
#pragma unroll
                for (int r = 0; r < 4; ++r) o[r] = f2bf((ya[nf][r] + Dv * bf2f(xT[(p0 + r) * 72 + i])) * bf2f(z[r]));
                *(us4*)(ymb + (size_t)(rowc + i) * LDK + hd * 64 + p0) = o; } }
        __syncthreads();
#pragma unroll
        for (int nf = 0; nf < 8; ++nf)
#pragma unroll
            for (int r = 0; r < 4; ++r) hb[(16 * w + 4 * fq + r) * 136 + 16 * nf + fr] = f2bf(hacc[nf][r]);
    }
#pragma unroll
    for (int nf = 0; nf < 8; ++nf)
#pragma unroll
        for (int r = 0; r < 4; ++r) st_out[(16 * w + 4 * fq + r) * 128 + 16 * nf + fr] = hacc[nf][r];
    __syncthreads();
}

DEVI void hgrn_unit(const Params& p, int l, Seq sq, int h, char* lds, int wv_) {
    bf16_t* sb = (bf16_t*)lds;
    bf16_t* qt = (bf16_t*)(lds + 34816);
    bf16_t* kt = (bf16_t*)(lds + 52224);
    bf16_t* att = (bf16_t*)lds;
    bf16_t* kT = (bf16_t*)(lds + 9216);
    bf16_t* vT = (bf16_t*)(lds + 27648);
    float* T0 = (float*)(lds + 69632); float* T1 = T0 + 128; float* ssq = T0 + 256;
    const int tid = tidx(wv_), lane = tid & 63, w = tid >> 6, fr = lane & 15, fq = lane >> 4;
    const int k = tid & 127, half = tid >> 7;
    const bf16_t* proj = (const bf16_t*)(p.ws + WS_PROJ); bf16_t* yhg = (bf16_t*)(p.ws + WS_YHG);
    float lb = 0.f;
    if (l == 1) { float a0 = p.in[I_LBL][h * 128 + k], a1 = p.in[I_LBL][1024 + h * 128 + k]; lb = 1.f / (1.f + __expf(a0 - a1)); }
    const float* nw = p.in[I_HGNW] + l * 128;
    const float* st_in; float* st_out;
    if (sq.samp) { st_in = p.in[I_HG] + ((size_t)(l * 16 + sq.b) * 8 + h) * 16384; st_out = p.out + O_HG_S + ((size_t)(l * 16 + sq.b) * 8 + h) * 16384; }
    else { st_out = p.out + O_HG_P + ((size_t)(l * 16 + sq.b) * 8 + h) * 16384; st_in = sq.seg ? st_out : nullptr; }
    f32x4 hacc[2][8];
#pragma unroll
    for (int mf = 0; mf < 2; ++mf)
#pragma unroll
        for (int nf = 0; nf < 8; ++nf)
#pragma unroll
            for (int r = 0; r < 4; ++r) hacc[mf][nf][r] = st_in ? st_in[(32 * w + 16 * mf + 4 * fq + r) * 128 + 16 * nf + fr] : 0.f;
    f32x4 nwr[2];
#pragma unroll
    for (int mf = 0; mf < 2; ++mf) nwr[mf] = *(const f32x4*)(nw + 32 * w + 16 * mf + 4 * fq);
    bf16_t* rawF = (bf16_t*)(lds + 71680); bf16_t* rawQ = (bf16_t*)(lds + 88064); bf16_t* rawV = (bf16_t*)(lds + 104448); bf16_t* rawH = (bf16_t*)(lds + 120832);
    const char* gf = (const char*)(proj + PC_HF + h * 128); const char* gq = (const char*)(proj + PC_HQ + h * 128); const char* gv = (const char*)(proj + PC_HI + h * 128); const char* gh = (const char*)(proj + PC_HGATE + h * 128);
    asm volatile("s_waitcnt vmcnt(0)" ::: "memory");
    {   const size_t ro = (size_t)sq.row0 * NPROJ * 2;
        stage_raw<256>(gf + ro, (size_t)NPROJ * 2, (char*)rawF, tid); stage_raw<256>(gq + ro, (size_t)NPROJ * 2, (char*)rawQ, tid); stage_raw<256>(gv + ro, (size_t)NPROJ * 2, (char*)rawV, tid); }
    for (int c = 0; c < sq.nchunk; ++c) {
        const int tid = tidx(wv_), lane = tid & 63, w = tid >> 6, fr = lane & 15, fq = lane >> 4, k = tid & 127, half = tid >> 7;
        const int rowc = sq.row0 + c * 64; const bool lastc = (c == sq.nchunk - 1);
        asm volatile("s_waitcnt vmcnt(0)" ::: "memory");
        __syncthreads();
        stage_raw<256>(gh + (size_t)rowc * NPROJ * 2, (size_t)NPROJ * 2, (char*)rawH, tid);
        {
            unsigned fu[32], qu[32];
#pragma unroll
            for (int jj = 0; jj < 32; ++jj) { fu[jj] = rawF[(32 * half + jj) * 128 + k]; qu[jj] = rawQ[(32 * half + jj) * 128 + k]; }
            if (tid < 64) ssq[tid] = 0.f;
            float run = 0.f;
            if (half == 0) {
#pragma unroll
                for (int jj = 31; jj >= 0; --jj) { bool valid = jj < sq.Q; float f = __uint_as_float(fu[jj] << 16);
                    float sg = __builtin_amdgcn_rcpf(1.f + __expf(-f)); float lg0 = __logf(lb + (1.f - lb) * sg); float lg = valid ? lg0 : 0.f;
                    float kk0 = (1.f - lb) * (1.f - sg); float kk = valid ? kk0 : 0.f; float q0 = __uint_as_float(qu[jj] << 16); float q = valid ? q0 : 0.f;
                    qt[jj * 136 + k] = f2bf(q * cexp(-run)); kt[jj * 136 + k] = f2bf(kk * cexp(run)); run += lg; }
                T0[k] = run;
            } else {
#pragma unroll
                for (int jj = 0; jj < 32; ++jj) { bool valid = (32 + jj) < sq.Q; float f = __uint_as_float(fu[jj] << 16);
                    float sg = __builtin_amdgcn_rcpf(1.f + __expf(-f)); float lg0 = __logf(lb + (1.f - lb) * sg); float lg = valid ? lg0 : 0.f;
                    float kk0 = (1.f - lb) * (1.f - sg); float kk = valid ? kk0 : 0.f; float q0 = __uint_as_float(qu[jj] << 16); float q = valid ? q0 : 0.f;
                    run += lg; qt[(32 + jj) * 136 + k] = f2bf(q * cexp(run)); kt[(32 + jj) * 136 + k] = f2bf(kk * cexp(-run)); }
                T1[k] = run;
            }
        }
        __syncthreads();
#pragma unroll
        for (int mf = 0; mf < 2; ++mf) { int k0 = 32 * w + 16 * mf + 4 * fq; float e0 = __expf(T0[k0]), e1 = __expf(T0[k0 + 1]), e2 = __expf(T0[k0 + 2]), e3 = __expf(T0[k0 + 3]);
#pragma unroll
            for (int nf = 0; nf < 8; ++nf) { hacc[mf][nf][0] *= e0; hacc[mf][nf][1] *= e1; hacc[mf][nf][2] *= e2; hacc[mf][nf][3] *= e3;
                us4 o; o[0] = f2bf(hacc[mf][nf][0]); o[1] = f2bf(hacc[mf][nf][1]); o[2] = f2bf(hacc[mf][nf][2]); o[3] = f2bf(hacc[mf][nf][3]);
                *(us4*)(sb + (16 * nf + fr) * 136 + k0) = o; } }
        f32x4 at[4];
#pragma unroll
        for (int nf = 0; nf < 4; ++nf) at[nf] = (f32x4){0.f, 0.f, 0.f, 0.f};
        lds_mma<4, 4>(at, kt, 136, 16 * w, qt, 136, 0, wv_);
        __syncthreads();
        f32x4 oacc[2][4];
#pragma unroll
        for (int mf = 0; mf < 2; ++mf) {
#pragma unroll
            for (int nf = 0; nf < 4; ++nf) oacc[mf][nf] = (f32x4){0.f, 0.f, 0.f, 0.f};
            lds_mma<4, 4>(oacc[mf], sb, 136, 32 * w + 16 * mf, qt, 136, 0, wv_); }
        __syncthreads();
#pragma unroll
        for (int nf = 0; nf < 4; ++nf) { int i = 16 * nf + fr; us4 o;
#pragma unroll
            for (int r = 0; r < 4; ++r) { int j = 16 * w + 4 * fq + r; o[r] = f2bf(j <= i ? at[nf][r] : 0.f); }
            *(us4*)(att + i * 72 + 16 * w + 4 * fq) = o; }
        {   unsigned vu[32];
#pragma unroll
            for (int jj = 0; jj < 32; ++jj) vu[jj] = rawV[(32 * half + jj) * 128 + k];
#pragma unroll
            for (int q4 = 0; q4 < 4; ++q4) { us8 kv, vv;
#pragma unroll
                for (int e = 0; e < 8; ++e) { int jj = q4 * 8 + e; bool valid = (32 * half + jj) < sq.Q; kv[e] = kt[(32 * half + jj) * 136 + k]; vv[e] = valid ? (bf16_t)vu[jj] : (bf16_t)0; }
                *(us8*)(kT + k * 72 + 32 * half + q4 * 8) = kv; *(us8*)(vT + k * 72 + 32 * half + q4 * 8) = vv; } }
        __syncthreads();
        if (!lastc) { const size_t ro = (size_t)(rowc + 64) * NPROJ * 2;
            stage_raw<256>(gf + ro, (size_t)NPROJ * 2, (char*)rawF, tid); stage_raw<256>(gq + ro, (size_t)NPROJ * 2, (char*)rawQ, tid); stage_raw<256>(gv + ro, (size_t)NPROJ * 2, (char*)rawV, tid); }
#pragma unroll
        for (int mf = 0; mf < 2; ++mf) {
            lds_mma<4, 2>(oacc[mf], vT, 72, 32 * w + 16 * mf, att, 72, 0, wv_);
            lds_mma<8, 2>(hacc[mf], kT, 72, 32 * w + 16 * mf, vT, 72, 0, wv_);
            int k0 = 32 * w + 16 * mf + 4 * fq; float e0 = __expf(T1[k0]), e1 = __expf(T1[k0 + 1]), e2 = __expf(T1[k0 + 2]), e3 = __expf(T1[k0 + 3]);
#pragma unroll
            for (int nf = 0; nf < 8; ++nf) { hacc[mf][nf][0] *= e0; hacc[mf][nf][1] *= e1; hacc[mf][nf][2] *= e2; hacc[mf][nf][3] *= e3; } }
#pragma unroll
        for (int nf = 0; nf < 4; ++nf) { float s = 0.f;
#pragma unroll
            for (int mf = 0; mf < 2; ++mf)
#pragma unroll
                for (int r = 0; r < 4; ++r) s += oacc[mf][nf][r] * oacc[mf][nf][r];
            s += shflx(s, 16, lane); s += shflx(s, 32, lane);
            if (fq == 0) atomicAdd(&ssq[16 * nf + fr], s); }
        if (lastc) asm volatile("s_waitcnt vmcnt(0)" ::: "memory"); else asm volatile("s_waitcnt vmcnt(12)" ::: "memory");
        __syncthreads();
#pragma unroll
        for (int nf = 0; nf < 4; ++nf) { int i = 16 * nf + fr; float rs = rsqrtf(ssq[i] * (1.f / 128.f) + 1e-6f);
#pragma unroll
            for (int mf = 0; mf < 2; ++mf) { int v0 = 32 * w + 16 * mf + 4 * fq; us4 gt = *(const us4*)(rawH + i * 128 + v0); f32x4 wv = nwr[mf]; us4 o;
#pragma unroll
                for (int r = 0; r < 4; ++r) o[r] = f2bf(oacc[mf][nf][r] * rs * wv[r] * bf2f(gt[r]));
                if (i < sq.Q) *(us4*)(yhg + (size_t)(rowc + i) * LDK + h * 128 + v0) = o; } }
        __syncthreads();
    }
#pragma unroll
    for (int mf = 0; mf < 2; ++mf)
#pragma unroll
        for (int nf = 0; nf < 8; ++nf)
#pragma unroll
            for (int r = 0; r < 4; ++r) st_out[(32 * w + 16 * mf + 4 * fq + r) * 128 + 16 * nf + fr] = hacc[mf][nf][r];
}

DEVI void rg_unit(const Params& p, int l, Seq sq, int blk, char* lds, int wv_) {
    bf16_t* waT = (bf16_t*)lds; bf16_t* wiT = (bf16_t*)(lds + 9216); bf16_t* xr = (bf16_t*)(lds + 18432);
    float* av = (float*)(lds + 27648); float* uv = (float*)(lds + 44288); float* Pq = (float*)(lds + 60928); float* Hq = Pq + 256; float* carry = Hq + 256;
    const int tid = tidx(wv_), lane = tid & 63, w = tid >> 6, fr = lane & 15, fq = lane >> 4;
    const bf16_t* proj = (const bf16_t*)(p.ws + WS_PROJ); bf16_t* yrg = (bf16_t*)(p.ws + WS_YRG);
    const int cb0 = blk * 64;
    const float* cw = p.in[I_RCW] + (size_t)l * 4 * 1024; const float* cbias = p.in[I_RCB] + l * 1024;
    const float* st_in; float* st_out; const float* hist; float* hist_out;
    if (sq.samp) { st_in = p.in[I_RG] + (size_t)(l * 16 + sq.b) * 1024; st_out = p.out + O_RG_S + (size_t)(l * 16 + sq.b) * 1024;
        hist = p.in[I_RCV] + (size_t)(l * 16 + sq.b) * 3 * 1024; hist_out = p.out + O_RCV_S + (size_t)(l * 16 + sq.b) * 3 * 1024; }
    else { st_out = p.out + O_RG_P + (size_t)(l * 16 + sq.b) * 1024; st_in = sq.seg ? st_out : nullptr;
        hist_out = p.out + O_RCV_P + (size_t)(l * 16 + sq.b) * 3 * 1024; hist = sq.seg ? hist_out : nullptr; }
    float* cwl = (float*)(lds + 63232);
    float* hl = (float*)(lds + 64512);
    float* hl2 = (float*)(lds + 90112);
    for (int idx = tid; idx < 320; idx += 256) { int k = idx >> 6, cc = idx & 63; cwl[idx] = k < 4 ? cw[k * 1024 + cb0 + cc] : cbias[cb0 + cc]; if (idx < 192) hl[idx] = hist ? hist[k * 1024 + cb0 + cc] : 0.f; }
    {   const float* wa = p.in[I_RWA] + ((size_t)l * 16 + blk) * 4096; const float* wi = p.in[I_RWI] + ((size_t)l * 16 + blk) * 4096;
        float wa_[16], wi_[16];
#pragma unroll
        for (int u = 0; u < 16; ++u) { wa_[u] = wa[tid + 256 * u]; wi_[u] = wi[tid + 256 * u]; }
#pragma unroll
        for (int u = 0; u < 16; ++u) { int e = tid + 256 * u, i = e >> 6, j = e & 63; waT[j * 72 + i] = f2bf(wa_[u]); wiT[j * 72 + i] = f2bf(wi_[u]); }
        if (tid < 64) carry[tid] = st_in ? st_in[cb0 + tid] : 0.f; }
    float cba[4], cbi[4], csp[4];
#pragma unroll
    for (int nf = 0; nf < 4; ++nf) { int cc = cb0 + 16 * nf + fr; cba[nf] = p.in[I_RBA][l * 1024 + cc]; cbi[nf] = p.in[I_RBI][l * 1024 + cc]; csp[nf] = softplus(-p.in[I_RLAM][l * 1024 + cc]); }
    bf16_t* rawR = (bf16_t*)(lds + 65536); bf16_t* rawG = (bf16_t*)(lds + 73728);
    const char* gr = (const char*)(proj + PC_RX + cb0); const char* gg = (const char*)(proj + PC_RGATE + cb0);
    asm volatile("s_waitcnt vmcnt(0)" ::: "memory");
    stage_raw<128>(gr + (size_t)sq.row0 * NPROJ * 2, (size_t)NPROJ * 2, (char*)rawR, tid); stage_raw<128>(gg + (size_t)sq.row0 * NPROJ * 2, (size_t)NPROJ * 2, (char*)rawG, tid);
    for (int c = 0; c < sq.nchunk; ++c) {
        const int tid = tidx(wv_), lane = tid & 63, w = tid >> 6, fr = lane & 15, fq = lane >> 4, j = tid & 63, q = tid >> 6;
        const int rowc = sq.row0 + c * 64; const bool lastc = (c == sq.nchunk - 1);
        const float* hlr = (c & 1) ? hl2 : hl; float* hlw = (c & 1) ? hl : hl2;
        asm volatile("s_waitcnt vmcnt(0)" ::: "memory");
        __syncthreads();
#pragma unroll
        for (int i = 0; i < 2; ++i) { int it = tid + 256 * i, t = it >> 3, c8 = (it & 7) * 8; float o[8], raw[8]; int ch = cb0 + c8; const bool tv = t < sq.Q;
            conv_lds(rawR, 64, t, c8, hlr, cwl, 64, c8, o, raw);
            if (t >= 61) {
#pragma unroll
                for (int e = 0; e < 8; ++e) hlw[(t - 61) * 64 + c8 + e] = raw[e]; }
            if (lastc && tv && t >= sq.Q - 3) {
#pragma unroll
                for (int e = 0; e < 8; ++e) hist_out[(t - (sq.Q - 3)) * 1024 + ch + e] = raw[e]; }
            us8 ov;
#pragma unroll
            for (int e = 0; e < 8; ++e) { float ox = tv ? o[e] : 0.f; ov[e] = f2bf(ox); uv[t * 65 + c8 + e] = ox; }
            *(us8*)(xr + t * 72 + c8) = ov; }
        __syncthreads();
        if (!lastc) { const size_t ro = (size_t)(rowc + 64) * NPROJ * 2; stage_raw<128>(gr + ro, (size_t)NPROJ * 2, (char*)rawR, tid); stage_raw<128>(gg + ro, (size_t)NPROJ * 2, (char*)(rawG + ((c + 1) & 1) * 4096), tid); }
        f32x4 ra[4], ri[4];
#pragma unroll
        for (int nf = 0; nf < 4; ++nf) { ra[nf] = (f32x4){0.f, 0.f, 0.f, 0.f}; ri[nf] = (f32x4){0.f, 0.f, 0.f, 0.f}; }
        lds_mma<4, 2>(ra, xr, 72, 16 * w, waT, 72, 0, wv_);
        lds_mma<4, 2>(ri, xr, 72, 16 * w, wiT, 72, 0, wv_);
#pragma unroll
        for (int nf = 0; nf < 4; ++nf) { int jj = 16 * nf + fr; float ba = cba[nf], bi = cbi[nf], sp = csp[nf];
#pragma unroll
            for (int r = 0; r < 4; ++r) { int t = 16 * w + 4 * fq + r; float rr = sigm(ra[nf][r] + ba), ii = sigm(ri[nf][r] + bi); float la = -8.f * sp * rr; float aa = __expf(la);
                float u = __builtin_sqrtf(fmaxf(1.f - aa * aa, 0.f)) * ii * uv[t * 65 + jj];
                if (t >= sq.Q) { aa = 1.f; u = 0.f; }
                av[t * 65 + jj] = aa; uv[t * 65 + jj] = u; } }
        __syncthreads();
        { float P = 1.f, H = 0.f;
#pragma unroll
          for (int tt = 0; tt < 16; ++tt) { int t = 16 * q + tt; float aa = av[t * 65 + j], u = uv[t * 65 + j]; H = aa * H + u; P *= aa; }
          Pq[q * 64 + j] = P; Hq[q * 64 + j] = H; }
        __syncthreads();
        float hcur = carry[j];
        for (int qq = 0; qq < q; ++qq) hcur = Pq[qq * 64 + j] * hcur + Hq[qq * 64 + j];
        const bf16_t* rg_ = rawG + (c & 1) * 4096;
        bf16_t gts[16];
#pragma unroll
        for (int tt = 0; tt < 16; ++tt) gts[tt] = rg_[(16 * q + tt) * 64 + j];
#pragma unroll
        for (int tt = 0; tt < 16; ++tt) { int t = 16 * q + tt; float aa = av[t * 65 + j], u = uv[t * 65 + j]; hcur = aa * hcur + u;
            if (t < sq.Q) yrg[(size_t)(rowc + t) * LDK + cb0 + j] = f2bf(bf2f(gts[tt]) * hcur); }
        __syncthreads();
        if (q == 3) carry[j] = hcur;
        __syncthreads();
    }
    if (tid < 64) st_out[cb0 + tid] = carry[tid];
    __syncthreads();
}

DEVI void phase_mix(const Params& p, int l, int seg, char* lds, int wv_) {
    const int ngrp = seg == 0 ? 2 : 1; const int NU = ngrp * 640;
    unsigned* qctr = (unsigned*)(p.ws + WS_END) + 1 + (seg * 2 + l);
    volatile int* sh = (volatile int*)(lds + 147440);
    for (;;) {
        if (tidx(wv_) == 0) sh[0] = (int)__hip_atomic_fetch_add(qctr, 1u, __ATOMIC_RELAXED, __HIP_MEMORY_SCOPE_AGENT);
        __syncthreads();
        const int u = __builtin_amdgcn_readfirstlane(sh[0]);
        __syncthreads();
        if (u >= NU) break;
        int grp = u / 640, v = u % 640;
        if (v < 128) hgrn_unit(p, l, make_seq(seg, grp * 16 + (v >> 3)), v & 7, lds, wv_);
        else if (v < 384) { v -= 128; ssd_unit(p, l, make_seq(seg, grp * 16 + (v >> 4)), v & 15, lds, wv_); }
        else { v -= 384; rg_unit(p, l, make_seq(seg, grp * 16 + (v >> 4)), v & 15, lds, wv_); }
        __syncthreads();
    }
}

DEVI void gbar(const Params& p, unsigned& epoch_, int wv_) {
    const unsigned epoch = __builtin_amdgcn_readfirstlane(epoch_); epoch_ = epoch + 1u;
    unsigned* bw = (unsigned*)(p.ws + WS_END); asm volatile("" : "+s"(bw));
    asm volatile("s_waitcnt vmcnt(0)" ::: "memory");
    __syncthreads();
    if (tidx(wv_) == 0) {
        if ((wv_ >> 23) & 1) {
            const unsigned x = (wv_ >> 2) & 7, NB = (wv_ >> 14) & 511;
            const unsigned old = __hip_atomic_fetch_add(bw + 32 + x, 1u, __ATOMIC_RELAXED, __HIP_MEMORY_SCOPE_AGENT);
            if (old + 1u == (epoch + 1u) * NB) {
                __builtin_amdgcn_fence(__ATOMIC_RELEASE, "agent");
                asm volatile("s_waitcnt vmcnt(0)" ::: "memory");
                const unsigned og = __hip_atomic_fetch_add(bw + 56, 1u, __ATOMIC_RELAXED, __HIP_MEMORY_SCOPE_AGENT);
                if (og + 1u == (epoch + 1u) * 8u) __hip_atomic_fetch_add(bw + 57, 1u, __ATOMIC_RELAXED, __HIP_MEMORY_SCOPE_AGENT);
                else while (__hip_atomic_load(bw + 57, __ATOMIC_RELAXED, __HIP_MEMORY_SCOPE_AGENT) < epoch + 1u) __builtin_amdgcn_s_sleep(1);
                __builtin_amdgcn_fence(__ATOMIC_ACQUIRE, "agent");
                __hip_atomic_fetch_add(bw + 48 + x, 1u, __ATOMIC_RELAXED, __HIP_MEMORY_SCOPE_AGENT);
                asm volatile("s_waitcnt vmcnt(0)" ::: "memory");
            } else {
                while (__hip_atomic_load(bw + 48 + x, __ATOMIC_RELAXED, __HIP_MEMORY_SCOPE_AGENT) < epoch + 1u) __builtin_amdgcn_s_sleep(1);
                __builtin_amdgcn_fence(__ATOMIC_ACQUIRE, "agent");
                asm volatile("s_waitcnt vmcnt(0)" ::: "memory");
            }
        } else {
            __builtin_amdgcn_fence(__ATOMIC_RELEASE, "agent");
            asm volatile("s_waitcnt vmcnt(0)" ::: "memory");
            __hip_atomic_fetch_add(bw, 1u, __ATOMIC_RELAXED, __HIP_MEMORY_SCOPE_AGENT);
            const unsigned target = (epoch + 1u) * gridDim.x;
            while (__hip_atomic_load(bw, __ATOMIC_RELAXED, __HIP_MEMORY_SCOPE_AGENT) < target) __builtin_amdgcn_s_sleep(1);
            __builtin_amdgcn_fence(__ATOMIC_ACQUIRE, "agent");
            asm volatile("s_waitcnt vmcnt(0)" ::: "memory");
        }
    }
    __syncthreads();
}

__global__ void __launch_bounds__(256) fwd_mega(Params p) {
    extern __shared__ __attribute__((aligned(16))) char lds[];
    int wv_ = __builtin_amdgcn_readfirstlane((int)(__builtin_amdgcn_workitem_id_x() >> 6));
    cg::grid_group grid = cg::this_grid();
    unsigned* xcnt = (unsigned*)(p.ws + WS_END) + 16;
    const int xcc = (int)(__builtin_amdgcn_s_getreg((3 << 11) | 20) & 7u);
    int xrank;
    { int* sh = (int*)lds; if (__builtin_amdgcn_workitem_id_x() == 0) sh[0] = (int)__hip_atomic_fetch_add(xcnt + xcc, 1u, __ATOMIC_RELAXED, __HIP_MEMORY_SCOPE_AGENT); __syncthreads(); xrank = __builtin_amdgcn_readfirstlane(sh[0]); __syncthreads(); }
    unsigned epoch = 0;
    phase_prep(p, lds, wv_);
    grid.sync();
    {   unsigned c[8]; bool ok = true;
#pragma unroll
        for (int i = 0; i < 8; ++i) { c[i] = __hip_atomic_load(xcnt + i, __ATOMIC_RELAXED, __HIP_MEMORY_SCOPE_AGENT); ok = ok && c[i] > 0u && c[i] < 512u; }
        unsigned mine = 0, tot_ = 0;
#pragma unroll
        for (int i = 0; i < 8; ++i) { mine = (i == xcc) ? c[i] : mine; tot_ += c[i]; }
        ok = ok && tot_ == gridDim.x;
        int X = xcc, R = xrank, NB = (int)mine;
        if (!ok) { X = blockIdx.x & 7; R = blockIdx.x >> 3; NB = gridDim.x >> 3; }
        wv_ = __builtin_amdgcn_readfirstlane((wv_ & 3) | (X << 2) | (R << 5) | (NB << 14) | (ok ? (1 << 23) : 0)); }
#pragma unroll 1
    for (int seg = 0; seg < NSEG; ++seg) {
        const int nrows = seg == 0 ? ROWS : ROWS_P, MT = nrows / 256;
#pragma unroll 1
        for (int l = 0; l < 2; ++l) {
            const bf16_t* wl = (const bf16_t*)p.ws + (size_t)l * E_LAYER;
            phase_norm(p, seg, nrows, p.in[I_NMIX] + l * 1024, l == 0, l, lds, wv_);
            gbar(p, epoch, wv_);
            for (int r = 0; r < p.rep[0]; ++r) { phase_proj(p, l, MT, lds, wv_); gbar(p, epoch, wv_); }
            phase_mix(p, l, seg, lds, wv_); gbar(p, epoch, wv_);
            phase_mbnorm(p, l, nrows, wv_);
            gbar(p, epoch, wv_);
            for (int r = 0; r < p.rep[1]; ++r) { phase_merge(p, l, MT, lds, wv_); gbar(p, epoch, wv_); }
            phase_resid(p, seg, MT, (const bf16_t*)(p.ws + WS_MRG), 1024, LDK, wl + E_WIN + E_WBR, l == 0, lds, wv_);
            gbar(p, epoch, wv_);
            phase_norm(p, seg, nrows, p.in[I_NFFN] + l * 1024, false, -1, lds, wv_);
            gbar(p, epoch, wv_);
            for (int r = 0; r < p.rep[2]; ++r) { phase_ffn_in(p, l, MT, lds, wv_); gbar(p, epoch, wv_); }
            phase_resid(p, seg, MT, (const bf16_t*)(p.ws + WS_PROJ), FFH, LDF, wl + E_WIN + E_WBR + E_WOUT + E_WFI, false, lds, wv_);
            gbar(p, epoch, wv_);
        }
        phase_final_norm(p, seg, nrows, wv_);
    }
}

extern "C" void kernel_launch(void* const* d_in, const int* in_sizes, int n_in, void* d_out, int out_size, void* d_ws, size_t ws_size, hipStream_t stream) {
    static int grid_blocks = 0;
    if (!grid_blocks) {
        int dev = 0, cus = 0, per_cu = 0;
        (void)hipGetDevice(&dev);
        (void)hipDeviceGetAttribute(&cus, hipDeviceAttributeMultiprocessorCount, dev);
        (void)hipFuncSetAttribute((const void*)fwd_mega, hipFuncAttributeMaxDynamicSharedMemorySize, LDS_BYTES);
        (void)hipOccupancyMaxActiveBlocksPerMultiprocessor(&per_cu, (const void*)fwd_mega, 256, LDS_BYTES);
        if (per_cu < 1) fprintf(stderr, "occupancy query says %d blocks per CU\n", per_cu);
        grid_blocks = cus;
        if (ws_size < WS_TOTAL) fprintf(stderr, "workspace too small: %zu < %zu\n", ws_size, (size_t)WS_END + 256);
    }
    (void)hipMemsetAsync((char*)d_ws + WS_END, 0, 256, stream);
    Params p{};
    for (int i = 0; i < 30; ++i) p.in[i] = (const float*)d_in[i];
    p.out = (float*)d_out; p.ws = (unsigned char*)d_ws; p.rep[0] = REP0; p.rep[1] = REP1; p.rep[2] = REP2; p.rep[3] = REP3;
    void* args[] = {&p};
    hipError_t e = hipLaunchCooperativeKernel((const void*)fwd_mega, dim3(grid_blocks), dim3(256), args, LDS_BYTES, stream);
    if (e != hipSuccess) fprintf(stderr, "cooperative launch failed: %s (grid %d)\n", hipGetErrorString(e), grid_blocks);
}
```

```cpp
#include <hip/hip_runtime.h>
#include <hip/hip_cooperative_groups.h>
#include <cstdio>
namespace cg = cooperative_groups;

typedef unsigned short bf16_t;
typedef short bf16x8 __attribute__((ext_vector_type(8)));
typedef float f32x4 __attribute__((ext_vector_type(4)));
typedef unsigned short us4 __attribute__((ext_vector_type(4)));
typedef unsigned short us8 __attribute__((ext_vector_type(8)));
#define DEVI __device__ __forceinline__

constexpr int LDK = 1088, LDF = 2880;
constexpr int D = 1024, NPROJ = 12288, SEGT = 512, NSEG = 4, ROWS_P = 8192, ROWS = 8704, FFH = 2816;
constexpr int PC_Z = 0, PC_XBC = 1024, PC_HQ = 3072, PC_HF = 4096, PC_HI = 5120, PC_HGATE = 6144, PC_RGATE = 7168, PC_RX = 8192, PC_MG = 9216, PC_DT = 12288;
constexpr size_t E_WIN = (size_t)NPROJ * LDK, E_WBR = 3u * 1024 * LDK, E_WOUT = 1024u * LDK, E_WFI = 5632u * LDK, E_WFO = 1024u * LDF;
constexpr size_t E_LAYER = E_WIN + E_WBR + E_WOUT + E_WFI + E_WFO;
constexpr size_t WS_PROJ = 2 * E_LAYER * 2;
constexpr size_t WS_DT = WS_PROJ + (size_t)ROWS * NPROJ * 2;
constexpr size_t WS_XB = WS_DT + (size_t)ROWS * 16 * 4;
constexpr size_t WS_YMB = WS_XB + (size_t)ROWS * LDK * 2;
constexpr size_t WS_YHG = WS_YMB + (size_t)ROWS * LDK * 2;
constexpr size_t WS_YRG = WS_YHG + (size_t)ROWS * LDK * 2;
constexpr size_t WS_MRG = WS_YRG + (size_t)ROWS * LDK * 2;
constexpr size_t WS_END = WS_MRG + (size_t)ROWS * LDK * 2;
constexpr size_t WS_HB = WS_END + 256;
constexpr size_t WS_DTW = WS_HB + 2u * 2 * 16 * 3 * 2048 * 4;
constexpr size_t WS_TOTAL = WS_DTW + 2u * 16 * 1024 * 4;
constexpr size_t O_YP = 0, O_YS = 33554432, O_SSM_P = 34078720, O_SCV_P = 38273024, O_HG_P = 38469632, O_RG_P = 42663936, O_RCV_P = 42696704,
                 O_SSM_S = 42795008, O_SCV_S = 46989312, O_HG_S = 47185920, O_RG_S = 51380224, O_RCV_S = 51412992;
constexpr int REP0 = 1, REP1 = 1, REP2 = 1, REP3 = 1;
constexpr int LDS_BYTES = 144 * 1024;

enum { I_XP = 0, I_XS, I_SSM, I_SCV, I_HG, I_RG, I_RCV, I_NMIX, I_WIN, I_MCW, I_MCB, I_DTB, I_ALOG, I_MBD, I_MBNW, I_LBL, I_HGNW, I_RCW, I_RCB, I_RWA, I_RBA, I_RWI, I_RBI, I_RLAM, I_WBR, I_WOUT, I_NFFN, I_WFI, I_WFO, I_NFIN };

struct Params { const float* in[30]; float* out; unsigned char* ws; int rep[4]; };

DEVI int tidx(int wv_) { int t = ((wv_ & 3) << 6) | (int)__builtin_amdgcn_mbcnt_hi(~0u, __builtin_amdgcn_mbcnt_lo(~0u, 0u)); asm volatile("" : "+v"(t)); return t; }
DEVI float shfli(float v, int srcl) { return __int_as_float(__builtin_amdgcn_ds_bpermute(srcl << 2, __float_as_int(v))); }
DEVI float shflx(float v, int m, int lane) { return shfli(v, lane ^ m); }
DEVI bf16_t f2bf(float f) { unsigned r; asm("v_cvt_pk_bf16_f32 %0, %1, %1" : "=v"(r) : "v"(f)); return (bf16_t)r; }
DEVI float bf2f(bf16_t h) { return __uint_as_float(((unsigned)h) << 16); }
DEVI float sigm(float x) { return 1.f / (1.f + __expf(-x)); }
DEVI float silu(float x) { return x / (1.f + __expf(-x)); }
DEVI float softplus(float x) { return x > 20.f ? x : __logf(1.f + __expf(x)); }
DEVI float gelu_t(float x) { float u = 0.7978845608f * (x + 0.044715f * x * x * x); return x * sigm(2.f * u); }
DEVI float cexp(float x) { return __expf(fminf(x, 80.f)); }

DEVI const float* xrow_in(const Params& p, int seg, int r) {
    if (r < ROWS_P) { int b = r >> 9, tt = r & 511; return p.in[I_XP] + ((size_t)(b * 2048 + seg * SEGT + tt)) * D; }
    return p.in[I_XS] + (size_t)(r - ROWS_P) * D;
}
DEVI float* xrow_out(const Params& p, int seg, int r) {
    if (r < ROWS_P) { int b = r >> 9, tt = r & 511; return p.out + O_YP + ((size_t)(b * 2048 + seg * SEGT + tt)) * D; }
    return p.out + O_YS + (size_t)(r - ROWS_P) * D;
}

DEVI int perm32(int rho) { int n = rho >> 4, i = rho & 15; return 8 * (i >> 2) + 4 * n + (i & 3); }
DEVI int map_win(int n) { n = (n & ~31) + perm32(n & 31); return n < 3072 ? n : n + 16; }
DEVI int map_wfi(int n) { int T = n >> 7, nf = (n >> 4) & 7, i = n & 15, G = nf >> 2, h = (nf >> 1) & 1, s = nf & 1; return s * FFH + 64 * T + 32 * G + 8 * (i >> 2) + 4 * h + (i & 3); }

DEVI void transpose_tile(const float* src, int ldsrc, bf16_t* dst, int K, int k0, int n0, int mode, float* tile  , int wv_) {
    const int tid = tidx(wv_), c = tid & 63, rq = tid >> 6;
    int n = n0 + c, sn = mode == 1 ? map_win(n) : (mode == 2 ? map_wfi(n) : (mode == 3 ? (n & ~31) + perm32(n & 31) : n));
#pragma unroll
    for (int rr = 0; rr < 16; ++rr) { int kl = rr * 4 + rq; tile[kl * 65 + c] = sn >= 0 ? src[(size_t)(k0 + kl) * ldsrc + sn] : 0.f; }
    __syncthreads();
#pragma unroll
    for (int rr = 0; rr < 16; ++rr) { int nl = rr * 4 + rq; dst[(size_t)(n0 + nl) * K + k0 + c] = f2bf(tile[c * 65 + nl]); }
    __syncthreads();
}

DEVI void phase_prep(const Params& p, char* lds, int wv_) {
    float* tile = (float*)lds;
    bf16_t* wsb = (bf16_t*)p.ws;
    constexpr int T_WIN = 16 * 192, T_WBR = 3 * 256, T_WOUT = 256, T_WFI = 16 * 88, T_WFO = 44 * 16, T_L = T_WIN + T_WBR + T_WOUT + T_WFI + T_WFO;
    {   float* dtw = (float*)(p.ws + WS_DTW);
        for (int e = blockIdx.x * 256 + tidx(wv_); e < 32768; e += gridDim.x * 256) { int l = e >> 14, j = (e >> 10) & 15, k = e & 1023; dtw[e] = p.in[I_WIN][(size_t)l * 1024 * 12304 + (size_t)k * 12304 + 3072 + j]; } }
    for (int t = blockIdx.x; t < 2 * T_L; t += gridDim.x) {
        int l = t / T_L, j = t % T_L;
        bf16_t* wl = wsb + (size_t)l * E_LAYER;
        if (j < T_WIN) { int kt = j & 15, nt = j >> 4; transpose_tile(p.in[I_WIN] + (size_t)l * 1024 * 12304, 12304, wl, LDK, kt * 64, nt * 64, 1, tile, wv_); continue; }
        j -= T_WIN;
        if (j < T_WBR) { int k = j >> 8, jj = j & 255, kt = jj & 15, nt = jj >> 4;
            transpose_tile(p.in[I_WBR] + ((size_t)l * 3 + k) * 1024 * 1024, 1024, wl + E_WIN + (size_t)k * 1024 * LDK, LDK, kt * 64, nt * 64, 3, tile, wv_); continue; }
        j -= T_WBR;
        if (j < T_WOUT) { int kt = j & 15, nt = j >> 4; transpose_tile(p.in[I_WOUT] + (size_t)l * 1024 * 1024, 1024, wl + E_WIN + E_WBR, LDK, kt * 64, nt * 64, 0, tile, wv_); continue; }
        j -= T_WOUT;
        if (j < T_WFI) { int kt = j & 15, nt = j >> 4; transpose_tile(p.in[I_WFI] + (size_t)l * 1024 * 5632, 5632, wl + E_WIN + E_WBR + E_WOUT, LDK, kt * 64, nt * 64, 2, tile, wv_); continue; }
        j -= T_WFI;
        { int kt = j % 44, nt = j / 44; transpose_tile(p.in[I_WFO] + (size_t)l * 2816 * 1024, 1024, wl + E_WIN + E_WBR + E_WOUT + E_WFI, LDF, kt * 64, nt * 64, 0, tile, wv_); }
    }
}

DEVI void phase_norm(const Params& p, int seg, int nrows, const float* w, bool from_input, int ldt  , char* lds, int wv_) {
    bf16_t* xb = (bf16_t*)(p.ws + WS_XB); float* dtb = (float*)(p.ws + WS_DT);
    const int lane = tidx(wv_) & 63, wv = tidx(wv_) >> 6;
    float* dw = (float*)lds;
    if (ldt >= 0) { const float* dtw = (const float*)(p.ws + WS_DTW) + ldt * 16384; f32x4 t_[16];
#pragma unroll
        for (int u = 0; u < 16; ++u) t_[u] = *(const f32x4*)(dtw + (tidx(wv_) + 256 * u) * 4);
#pragma unroll
        for (int u = 0; u < 16; ++u) *(f32x4*)(dw + (tidx(wv_) + 256 * u) * 4) = t_[u];
        __syncthreads(); }
    for (int r = blockIdx.x * 4 + wv; r < nrows; r += gridDim.x * 4) {
        const float* x = from_input ? xrow_in(p, seg, r) : xrow_out(p, seg, r);
        f32x4 v[4]; float ss = 0.f;
#pragma unroll
        for (int i = 0; i < 4; ++i) { v[i] = *(const f32x4*)(x + i * 256 + lane * 4); ss += v[i][0] * v[i][0] + v[i][1] * v[i][1] + v[i][2] * v[i][2] + v[i][3] * v[i][3]; }
#pragma unroll
        for (int o = 32; o >= 1; o >>= 1) ss += shflx(ss, o, lane);
        float rs = rsqrtf(ss * (1.f / 1024.f) + 1e-6f);
#pragma unroll
        for (int i = 0; i < 4; ++i) { f32x4 wv4 = *(const f32x4*)(w + i * 256 + lane * 4); us4 o;
            v[i][0] *= rs * wv4[0]; v[i][1] *= rs * wv4[1]; v[i][2] *= rs * wv4[2]; v[i][3] *= rs * wv4[3];
            o[0] = f2bf(v[i][0]); o[1] = f2bf(v[i][1]); o[2] = f2bf(v[i][2]); o[3] = f2bf(v[i][3]);
            *(us4*)(xb + (size_t)r * LDK + i * 256 + lane * 4) = o; }
        if (ldt >= 0) {
            float d[16];
#pragma unroll
            for (int j = 0; j < 16; ++j) { float s = 0.f;
#pragma unroll
                for (int i = 0; i < 4; ++i) { f32x4 ww = *(const f32x4*)(dw + j * 1024 + i * 256 + lane * 4); s += v[i][0] * ww[0] + v[i][1] * ww[1] + v[i][2] * ww[2] + v[i][3] * ww[3]; }
                d[j] = s; }
            { const bool hi = lane & 32;
#pragma unroll
              for (int i = 0; i < 8; ++i) { float send = hi ? d[i] : d[i + 8], keep = hi ? d[i + 8] : d[i]; d[i] = keep + shfli(send, lane ^ 32); } }
            { const bool hi = lane & 16;
#pragma unroll
              for (int i = 0; i < 4; ++i) { float send = hi ? d[i] : d[i + 4], keep = hi ? d[i + 4] : d[i]; d[i] = keep + shfli(send, lane ^ 16); } }
            { const bool hi = lane & 8;
#pragma unroll
              for (int i = 0; i < 2; ++i) { float send = hi ? d[i] : d[i + 2], keep = hi ? d[i + 2] : d[i]; d[i] = keep + shfli(send, lane ^ 8); } }
            { const bool hi = lane & 4; float send = hi ? d[0] : d[1], keep = hi ? d[1] : d[0]; d[0] = keep + shfli(send, lane ^ 4); }
            d[0] += shfli(d[0], lane ^ 2); d[0] += shfli(d[0], lane ^ 1);
            if ((lane & 3) == 0) { int j = lane >> 2; dtb[(size_t)r * 16 + j] = softplus(d[0] + p.in[I_DTB][ldt * 16 + j]); }
        }
    }
    if (ldt >= 0) __syncthreads();
}
DEVI void phase_final_norm(const Params& p, int seg, int nrows, int wv_) {
    const float* w = p.in[I_NFIN];
    const int lane = tidx(wv_) & 63, wv = tidx(wv_) >> 6;
    for (int r = blockIdx.x * 4 + wv; r < nrows; r += gridDim.x * 4) {
        float* x = xrow_out(p, seg, r);
        f32x4 v[4]; float ss = 0.f;
#pragma unroll
        for (int i = 0; i < 4; ++i) { v[i] = *(const f32x4*)(x + i * 256 + lane * 4); ss += v[i][0] * v[i][0] + v[i][1] * v[i][1] + v[i][2] * v[i][2] + v[i][3] * v[i][3]; }
#pragma unroll
        for (int o = 32; o >= 1; o >>= 1) ss += shflx(ss, o, lane);
        float rs = rsqrtf(ss * (1.f / 1024.f) + 1e-6f);
#pragma unroll
        for (int i = 0; i < 4; ++i) { f32x4 wv4 = *(const f32x4*)(w + i * 256 + lane * 4); f32x4 o;
            o[0] = v[i][0] * rs * wv4[0]; o[1] = v[i][1] * rs * wv4[1]; o[2] = v[i][2] * rs * wv4[2]; o[3] = v[i][3] * rs * wv4[3];
            *(f32x4*)(x + i * 256 + lane * 4) = o; }
    }
}
DEVI void phase_mbnorm(const Params& p, int l, int nrows, int wv_) {
    bf16_t* y = (bf16_t*)(p.ws + WS_YMB); const float* w = p.in[I_MBNW] + l * 1024;
    const int lane = tidx(wv_) & 63, wv = tidx(wv_) >> 6;
    for (int it = blockIdx.x * 4 + wv; it < nrows * 4; it += gridDim.x * 4) {
        int r = it >> 2, g = it & 3; bf16_t* yp = y + (size_t)r * LDK + g * 256 + lane * 4;
        us4 v = *(const us4*)yp; float f0 = bf2f(v[0]), f1 = bf2f(v[1]), f2 = bf2f(v[2]), f3 = bf2f(v[3]);
        float ss = f0 * f0 + f1 * f1 + f2 * f2 + f3 * f3;
#pragma unroll
        for (int o = 32; o >= 1; o >>= 1) ss += shflx(ss, o, lane);
        float rs = rsqrtf(ss * (1.f / 256.f) + 1e-6f); f32x4 wv4 = *(const f32x4*)(w + g * 256 + lane * 4);
        us4 o; o[0] = f2bf(f0 * rs * wv4[0]); o[1] = f2bf(f1 * rs * wv4[1]); o[2] = f2bf(f2 * rs * wv4[2]); o[3] = f2bf(f3 * rs * wv4[3]);
        *(us4*)yp = o;
    }
}

#define WAIT_V(n) asm volatile("s_waitcnt vmcnt(" #n ")" ::: "memory")
#define RAW_BAR() do { asm volatile("" ::: "memory"); __builtin_amdgcn_s_barrier(); asm volatile("" ::: "memory"); } while (0)
template <int NF>
DEVI void stage_a(const bf16_t* A, int K, int t, char* st, int tid, size_t soff) {
    const size_t o = soff + (size_t)t * 32;
#pragma unroll
    for (int i = 0; i < 4; ++i) __builtin_amdgcn_global_load_lds((const unsigned*)(A + o + (size_t)i * 64 * K), (unsigned*)(st + tid * 16 + i * 4096), 16, 0, 0);
}
template <int NF>
DEVI void stage_b(const bf16_t* Bt, int K, int t, char* st, int tid, size_t soff) {
    const size_t o = soff + (size_t)t * 32;
#pragma unroll
    for (int i = 0; i < NF / 2; ++i) __builtin_amdgcn_global_load_lds((const unsigned*)(Bt + o + (size_t)i * 64 * K), (unsigned*)(st + 16384 + tid * 16 + i * 4096), 16, 0, 0);
}
template <int NF>
DEVI void gemm_kloop(f32x4 (&acc)[8][NF], const bf16_t* A, const bf16_t* Bt, int K, int ld, char* lds, int wv_) {
    constexpr int STAGE = 16384 + NF * 2048;
    const int tid = tidx(wv_), lane = tid & 63, wid = tid >> 6, wr = wid >> 1, wc = wid & 1, fr = lane & 15, fq = lane >> 4;
    const int fo = fr * 64 + ((fq ^ (0x1320 >> (4 * (fr >> 2)))) & 3) * 16;
    const int aoff = wr * 8192 + fo, boff = 16384 + wc * NF * 1024 + fo;
    const size_t soff = (size_t)(tid >> 2) * ld + ((((tid & 3) ^ (0x1320 >> (4 * ((tid >> 4) & 3)))) & 3) * 8);
    const int nt = K >> 5;
    WAIT_V(0); RAW_BAR();
    stage_a<NF>(A, ld, 0, lds, tid, soff); stage_b<NF>(Bt, ld, 0, lds, tid, soff);
    stage_a<NF>(A, ld, 1, lds + STAGE, tid, soff); stage_b<NF>(Bt, ld, 1, lds + STAGE, tid, soff);
    stage_a<NF>(A, ld, 2, lds + 2 * STAGE, tid, soff); stage_b<NF>(Bt, ld, 2, lds + 2 * STAGE, tid, soff);
    if (NF == 8) WAIT_V(16); else WAIT_V(12);
    RAW_BAR();
    bf16x8 a[8], a01[2][2], b[2][NF];
    a01[0][0] = *(const bf16x8*)(lds + aoff); a01[0][1] = *(const bf16x8*)(lds + aoff + 1024);
#pragma unroll
    for (int n = 0; n < NF; ++n) b[0][n] = *(const bf16x8*)(lds + boff + n * 1024);
#define MMA_1(g_, P_) acc[g_][0] = __builtin_amdgcn_mfma_f32_16x16x32_bf16(b[P_][0], a[g_], acc[g_][0], 0, 0, 0)
#define MMA_R(g_, P_) _Pragma("unroll") for (int n = 1; n < NF; ++n) acc[g_][n] = __builtin_amdgcn_mfma_f32_16x16x32_bf16(b[P_][n], a[g_], acc[g_][n], 0, 0, 0)
#define KBODY(T_, P_, Q_) do { \
        const int T = (T_); const char* st = lds + (T & 3) * STAGE; const char* stn = lds + ((T + 1) & 3) * STAGE; char* st3 = lds + ((T + 3) & 3) * STAGE; \
        a[0] = a01[P_][0]; a[1] = a01[P_][1]; \
        __builtin_amdgcn_sched_barrier(0); MMA_1(0, P_); __builtin_amdgcn_sched_barrier(0); a[2] = *(const bf16x8*)(st + aoff + 2 * 1024); MMA_R(0, P_); \
        __builtin_amdgcn_sched_barrier(0); MMA_1(1, P_); __builtin_amdgcn_sched_barrier(0); a[3] = *(const bf16x8*)(st + aoff + 3 * 1024); MMA_R(1, P_); \
        __builtin_amdgcn_sched_barrier(0); MMA_1(2, P_); __builtin_amdgcn_sched_barrier(0); a[4] = *(const bf16x8*)(st + aoff + 4 * 1024); MMA_R(2, P_); \
        __builtin_amdgcn_sched_barrier(0); MMA_1(3, P_); __builtin_amdgcn_sched_barrier(0); a[5] = *(const bf16x8*)(st + aoff + 5 * 1024); MMA_R(3, P_); \
        __builtin_amdgcn_sched_barrier(0); \
        if (T + 2 < nt) { if (NF == 8) WAIT_V(8); else WAIT_V(6); } else WAIT_V(0); \
        RAW_BAR(); \
        __builtin_amdgcn_sched_barrier(0); MMA_1(4, P_); __builtin_amdgcn_sched_barrier(0); a[6] = *(const bf16x8*)(st + aoff + 6 * 1024); \
        if (T + 3 < nt) stage_a<NF>(A, ld, T + 3, st3, tid, soff); \
        _Pragma("unroll") for (int n = 0; n < NF / 2; ++n) b[Q_][n] = *(const bf16x8*)(stn + boff + n * 1024); \
        MMA_R(4, P_); \
        __builtin_amdgcn_sched_barrier(0); MMA_1(5, P_); __builtin_amdgcn_sched_barrier(0); a[7] = *(const bf16x8*)(st + aoff + 7 * 1024); \
        if (T + 3 < nt) stage_b<NF>(Bt, ld, T + 3, st3, tid, soff); \
        _Pragma("unroll") for (int n = NF / 2; n < NF; ++n) b[Q_][n] = *(const bf16x8*)(stn + boff + n * 1024); \
        MMA_R(5, P_); \
        __builtin_amdgcn_sched_barrier(0); MMA_1(6, P_); __builtin_amdgcn_sched_barrier(0); a01[Q_][0] = *(const bf16x8*)(stn + aoff); MMA_R(6, P_); \
        __builtin_amdgcn_sched_barrier(0); MMA_1(7, P_); __builtin_amdgcn_sched_barrier(0); a01[Q_][1] = *(const bf16x8*)(stn + aoff + 1024); MMA_R(7, P_); \
        __builtin_amdgcn_sched_barrier(0); } while (0)
    for (int t = 0; t < nt; t += 2) { KBODY(t, 0, 1); KBODY(t + 1, 1, 0); }
#undef KBODY
#undef MMA_1
#undef MMA_R
}
DEVI bool next_tile(int it, int MT, int NT, int& mt, int& nt, int wv_) {
    const int x = (wv_ >> 2) & 7, bl = (wv_ >> 5) & 511, G8 = (wv_ >> 14) & 511;
    int j = it * G8 + bl;
    const int nb = 4 * NT;
    if (j < nb) { nt = j >> 2; mt = x + 8 * (j & 3); return true; }
    if (MT == 32) return false;
    j -= nb;
    const int ne = (NT - x + 7) >> 3;
    if (j >= 2 * ne) return false;
    mt = 32 + (j & 1); nt = x + 8 * (j >> 1); return true;
}
#define ZERO_ACC(a, NF_) _Pragma("unroll") for (int m_ = 0; m_ < 8; ++m_) _Pragma("unroll") for (int n_ = 0; n_ < NF_; ++n_) a[m_][n_] = (f32x4){0.f, 0.f, 0.f, 0.f}
#define EPI_IDS const int lane = tidx(wv_) & 63, wid = tidx(wv_) >> 6, wr = wid >> 1, wc = wid & 1, fr = lane & 15, fq = lane >> 4

DEVI void proj_store_row(const f32x4 (&accm)[8], bf16_t* prow, float c1, float c3, bool issig, bool isact) {
#pragma unroll
    for (int q = 0; q < 4; ++q) { __builtin_amdgcn_sched_barrier(0); us8 o;
#pragma unroll
        for (int s = 0; s < 2; ++s)
#pragma unroll
            for (int j = 0; j < 4; ++j) { float x = accm[2 * q + s][j];
                float u = x * (c1 + c3 * x * x); float sg = __builtin_amdgcn_rcpf(1.f + __expf(-u)); float y = sg * (issig ? 1.f : x);
                o[4 * s + j] = f2bf(isact ? y : x); }
        *(us8*)(prow + q * 32) = o; }
}
DEVI void phase_proj(const Params& p, int l, int MT, char* lds, int wv_) {
    const bf16_t* xb = (const bf16_t*)(p.ws + WS_XB); const bf16_t* wt = (const bf16_t*)p.ws + (size_t)l * E_LAYER;
    bf16_t* proj = (bf16_t*)(p.ws + WS_PROJ);
    int mt, nt;
    for (int it = 0; next_tile(it, MT, 48, mt, nt, wv_); ++it) {
        f32x4 acc[8][8]; ZERO_ACC(acc, 8);
        gemm_kloop<8>(acc, xb + (size_t)mt * 256 * LDK, wt + (size_t)nt * 256 * LDK, 1024, LDK, lds, wv_);
        EPI_IDS;
        const int sg = nt >> 2;
        const int ty = (sg == 0 || sg == 3 || sg == 6) ? 1 : (sg == 7 ? 2 : (sg >= 9 ? 3 : 0));
        bf16_t* pbase = proj + (size_t)(mt * 256 + wr * 128 + fr) * NPROJ + nt * 256 + wc * 128 + fq * 8;
        const float c1 = ty == 2 ? 1.5957691216f : 1.f, c3 = ty == 2 ? 0.0713548163f : 0.f;
#pragma unroll
        for (int m = 0; m < 8; ++m) {
#pragma unroll
            for (int n = 0; n < 8; ++n) asm volatile("" : "+v"(acc[m][n]) :: "memory");
            proj_store_row(acc[m], pbase + (size_t)m * 16 * NPROJ, c1, c3, ty == 3, ty != 0); }
    }
}
DEVI void phase_merge(const Params& p, int l, int MT, char* lds, int wv_) {
    const bf16_t* wt = (const bf16_t*)p.ws + (size_t)l * E_LAYER + E_WIN; const bf16_t* proj = (const bf16_t*)(p.ws + WS_PROJ);
    bf16_t* mrg = (bf16_t*)(p.ws + WS_MRG);
    int mt, nt;
    for (int it = 0; next_tile(it, MT, 8, mt, nt, wv_); ++it) {
        f32x4 tot[8][4]; ZERO_ACC(tot, 4);
#pragma unroll 1
        for (int k = 0; k < 3; ++k) {
            const bf16_t* y = (const bf16_t*)(p.ws + WS_YMB + (size_t)k * ROWS * LDK * 2);
            f32x4 acc[8][4]; ZERO_ACC(acc, 4);
            gemm_kloop<4>(acc, y + (size_t)mt * 256 * LDK, wt + (size_t)k * 1024 * LDK + (size_t)nt * 128 * LDK, 1024, LDK, lds, wv_);
            EPI_IDS;
#pragma unroll
            for (int m = 0; m < 8; ++m) { int row = mt * 256 + wr * 128 + m * 16 + fr; asm volatile("" ::: "memory");
#pragma unroll
                for (int q = 0; q < 2; ++q) { int col = nt * 128 + wc * 64 + 32 * q + fq * 8; us8 g = *(const us8*)(proj + (size_t)row * NPROJ + PC_MG + k * 1024 + col);
#pragma unroll
                    for (int s = 0; s < 2; ++s)
#pragma unroll
                        for (int j = 0; j < 4; ++j) tot[m][2 * q + s][j] += acc[m][2 * q + s][j] * bf2f(g[4 * s + j]); } }
        }
        EPI_IDS;
#pragma unroll
        for (int m = 0; m < 8; ++m) { int row = mt * 256 + wr * 128 + m * 16 + fr;
#pragma unroll
            for (int q = 0; q < 2; ++q) { int col = nt * 128 + wc * 64 + 32 * q + fq * 8; us8 o;
#pragma unroll
                for (int s = 0; s < 2; ++s)
#pragma unroll
                    for (int j = 0; j < 4; ++j) o[4 * s + j] = f2bf(tot[m][2 * q + s][j]);
                *(us8*)(mrg + (size_t)row * LDK + col) = o; } }
    }
}
DEVI void phase_resid(const Params& p, int seg, int MT, const bf16_t* A, int K, int ld, const bf16_t* Bt, bool from_input, char* lds, int wv_) {
    int mt, nt;
    for (int it = 0; next_tile(it, MT, 8, mt, nt, wv_); ++it) {
        f32x4 acc[8][4]; ZERO_ACC(acc, 4);
        gemm_kloop<4>(acc, A + (size_t)mt * 256 * ld, Bt + (size_t)nt * 128 * ld, K, ld, lds, wv_);
        EPI_IDS;
#pragma unroll
        for (int m = 0; m < 8; ++m) { int row = mt * 256 + wr * 128 + m * 16 + fr;
            const float* xi = from_input ? xrow_in(p, seg, row) : xrow_out(p, seg, row); float* xo = xrow_out(p, seg, row);
#pragma unroll
            for (int n = 0; n < 4; ++n) { int col = nt * 128 + wc * 64 + n * 16 + fq * 4; f32x4 v = *(const f32x4*)(xi + col); *(f32x4*)(xo + col) = v + acc[m][n]; } }
    }
}
DEVI void phase_ffn_in(const Params& p, int l, int MT, char* lds, int wv_) {
    const bf16_t* xb = (const bf16_t*)(p.ws + WS_XB); const bf16_t* wt = (const bf16_t*)p.ws + (size_t)l * E_LAYER + E_WIN + E_WBR + E_WOUT;
    bf16_t* act = (bf16_t*)(p.ws + WS_PROJ);
    int mt, nt;
    for (int it = 0; next_tile(it, MT, 22, mt, nt, wv_); ++it) {
        f32x4 acc[8][8]; ZERO_ACC(acc, 8);
        gemm_kloop<8>(acc, xb + (size_t)mt * 256 * LDK, wt + (size_t)nt * 256 * LDK, 1024, LDK, lds, wv_);
        EPI_IDS;
#pragma unroll
        for (int m = 0; m < 8; ++m) { int row = mt * 256 + wr * 128 + m * 16 + fr;
#pragma unroll
            for (int n = 0; n < 8; ++n) asm volatile("" : "+v"(acc[m][n]) :: "memory");
#pragma unroll
            for (int G = 0; G < 2; ++G) { int col = (nt * 2 + wc) * 64 + 32 * G + fq * 8; us8 o;
#pragma unroll
                for (int h = 0; h < 2; ++h)
#pragma unroll
                    for (int j = 0; j < 4; ++j) o[4 * h + j] = f2bf(silu(acc[m][4 * G + 2 * h][j]) * acc[m][4 * G + 2 * h + 1][j]);
                *(us8*)(act + (size_t)row * LDF + col) = o; } }
    }
}

struct Seq { int row0, nchunk, Q, b, samp, seg; };
DEVI Seq make_seq(int seg, int sq) { Seq s; s.seg = seg; if (sq < 16) { s.row0 = sq * SEGT; s.nchunk = 8; s.Q = 64; s.b = sq; s.samp = 0; } else { s.b = sq - 16; s.row0 = ROWS_P + s.b * 32; s.nchunk = 1; s.Q = 32; s.samp = 1; } return s; }

template <int NF, int KS>
DEVI void lds_mma(f32x4* acc, const bf16_t* X, int ldx, int m0, const bf16_t* Y, int ldy, int n0, int wv_) {
    const int lane = tidx(wv_) & 63, fr = lane & 15, fq = lane >> 4;
#pragma unroll
    for (int ks = 0; ks < KS; ++ks) {
        bf16x8 a = *(const bf16x8*)(X + (m0 + fr) * ldx + ks * 32 + fq * 8);
#pragma unroll
        for (int nf = 0; nf < NF; ++nf) { bf16x8 b = *(const bf16x8*)(Y + (n0 + nf * 16 + fr) * ldy + ks * 32 + fq * 8); acc[nf] = __builtin_amdgcn_mfma_f32_16x16x32_bf16(a, b, acc[nf], 0, 0, 0); }
    }
}

DEVI void conv_load(uint4 (&r)[4], const bf16_t* proj, int row0, int tq, int pcol) {
#pragma unroll
    for (int k = 0; k < 4; ++k) { int ts = tq - 3 + k; ts = ts < 0 ? 0 : ts; r[k] = *(const uint4*)(proj + (size_t)(row0 + ts) * NPROJ + pcol); }
}
DEVI void touch4(uint4& v) { asm volatile("" : "+v"(v.x), "+v"(v.y), "+v"(v.z), "+v"(v.w)); }
DEVI void conv_compute(const uint4 (&r)[4], int tq, const float* hl, const float* cwl, int HC, int cl, float (&out)[8], float (&raw)[8]) {
    { f32x4 b0 = *(const f32x4*)(cwl + 4 * HC + cl), b1 = *(const f32x4*)(cwl + 4 * HC + cl + 4);
      out[0] = b0[0]; out[1] = b0[1]; out[2] = b0[2]; out[3] = b0[3]; out[4] = b1[0]; out[5] = b1[1]; out[6] = b1[2]; out[7] = b1[3]; }
#pragma unroll
    for (int k = 0; k < 4; ++k) {
        const int ts = tq - 3 + k; float v[8];
        v[0] = __uint_as_float(r[k].x << 16); v[1] = __uint_as_float(r[k].x & 0xffff0000u); v[2] = __uint_as_float(r[k].y << 16); v[3] = __uint_as_float(r[k].y & 0xffff0000u);
        v[4] = __uint_as_float(r[k].z << 16); v[5] = __uint_as_float(r[k].z & 0xffff0000u); v[6] = __uint_as_float(r[k].w << 16); v[7] = __uint_as_float(r[k].w & 0xffff0000u);
        if (k < 3) { int hi = 3 + ts; hi = hi < 0 ? 0 : (hi > 2 ? 2 : hi); const bool uh = ts < 0;
            f32x4 h0 = *(const f32x4*)(hl + hi * HC + cl), h1 = *(const f32x4*)(hl + hi * HC + cl + 4);
            v[0] = uh ? h0[0] : v[0]; v[1] = uh ? h0[1] : v[1]; v[2] = uh ? h0[2] : v[2]; v[3] = uh ? h0[3] : v[3];
            v[4] = uh ? h1[0] : v[4]; v[5] = uh ? h1[1] : v[5]; v[6] = uh ? h1[2] : v[6]; v[7] = uh ? h1[3] : v[7]; }
        f32x4 w0 = *(const f32x4*)(cwl + k * HC + cl), w1 = *(const f32x4*)(cwl + k * HC + cl + 4);
        out[0] += v[0] * w0[0]; out[1] += v[1] * w0[1]; out[2] += v[2] * w0[2]; out[3] += v[3] * w0[3];
        out[4] += v[4] * w1[0]; out[5] += v[5] * w1[1]; out[6] += v[6] * w1[2]; out[7] += v[7] * w1[3];
        if (k == 3) {
#pragma unroll
            for (int e = 0; e < 8; ++e) raw[e] = v[e]; }
    }
}

template <int ROWB>
DEVI void stage_raw(const char* g0, size_t ldgB, char* dst, int tid) {
#pragma unroll
    for (int i = 0; i < ROWB / 64; ++i) { int b = tid * 16 + i * 4096, row = b / ROWB, cb = b % ROWB;
        __builtin_amdgcn_global_load_lds((const unsigned*)(g0 + (size_t)row * ldgB + cb), (unsigned*)(dst + b), 16, 0, 0); }
}
DEVI void conv_lds(const bf16_t* rawt, int RS, int t, int cloc, const float* hl, const float* cwl, int HC, int cl, float (&out)[8], float (&raw)[8]) {
    { f32x4 b0 = *(const f32x4*)(cwl + 4 * HC + cl), b1 = *(const f32x4*)(cwl + 4 * HC + cl + 4);
      out[0] = b0[0]; out[1] = b0[1]; out[2] = b0[2]; out[3] = b0[3]; out[4] = b1[0]; out[5] = b1[1]; out[6] = b1[2]; out[7] = b1[3]; }
#pragma unroll
    for (int k = 0; k < 4; ++k) {
        const int tt = t - 3 + k; const int tc = tt < 0 ? 0 : tt; float v[8];
        const uint4 r = *(const uint4*)(rawt + tc * RS + cloc);
        v[0] = __uint_as_float(r.x << 16); v[1] = __uint_as_float(r.x & 0xffff0000u); v[2] = __uint_as_float(r.y << 16); v[3] = __uint_as_float(r.y & 0xffff0000u);
        v[4] = __uint_as_float(r.z << 16); v[5] = __uint_as_float(r.z & 0xffff0000u); v[6] = __uint_as_float(r.w << 16); v[7] = __uint_as_float(r.w & 0xffff0000u);
        if (k < 3) { int hi = 3 + tt; hi = hi < 0 ? 0 : (hi > 2 ? 2 : hi); const bool uh = tt < 0;
            f32x4 h0 = *(const f32x4*)(hl + hi * HC + cl), h1 = *(const f32x4*)(hl + hi * HC + cl + 4);
            v[0] = uh ? h0[0] : v[0]; v[1] = uh ? h0[1] : v[1]; v[2] = uh ? h0[2] : v[2]; v[3] = uh ? h0[3] : v[3];
            v[4] = uh ? h1[0] : v[4]; v[5] = uh ? h1[1] : v[5]; v[6] = uh ? h1[2] : v[6]; v[7] = uh ? h1[3] : v[7]; }
        f32x4 w0 = *(const f32x4*)(cwl + k * HC + cl), w1 = *(const f32x4*)(cwl + k * HC + cl + 4);
        out[0] += v[0] * w0[0]; out[1] += v[1] * w0[1]; out[2] += v[2] * w0[2]; out[3] += v[3] * w0[3];
        out[4] += v[4] * w1[0]; out[5] += v[5] * w1[1]; out[6] += v[6] * w1[2]; out[7] += v[7] * w1[3];
        if (k == 3) {
#pragma unroll
            for (int e = 0; e < 8; ++e) raw[e] = v[e]; }
    }
}

DEVI void ssd_unit(const Params& p, int l, Seq sq, int hd, char* lds, int wv_) {
    bf16_t* Bm = (bf16_t*)lds;
    bf16_t* R2 = (bf16_t*)(lds + 17408);
    bf16_t* xT = (bf16_t*)(lds + 35840);
    bf16_t* hb = (bf16_t*)(lds + 45056);
    float* fl = (float*)(lds + 62464);
    const int tid = tidx(wv_), lane = tid & 63, w = tid >> 6, fr = lane & 15, fq = lane >> 4;
    const bf16_t* proj = (const bf16_t*)(p.ws + WS_PROJ); const float* dtb = (const float*)(p.ws + WS_DT); bf16_t* ymb = (bf16_t*)(p.ws + WS_YMB);
    const int g = hd >> 2;
    const float a = -__expf(p.in[I_ALOG][l * 16 + hd]), Dv = p.in[I_MBD][l * 16 + hd];
    const float* cw = p.in[I_MCW] + (size_t)l * 4 * 2048; const float* cbias = p.in[I_MCB] + l * 2048;
    float* cwl = (float*)(lds + 63488);
    float* hl = (float*)(lds + 69888);
    const float* st_in; float* st_out; const float* hist; float* hist_out; float* hist_out2 = nullptr;
    float* hbuf = (float*)(p.ws + WS_HB);
    if (sq.samp) { st_in = p.in[I_SSM] + ((size_t)(l * 16 + sq.b) * 16 + hd) * 8192; st_out = p.out + O_SSM_S + ((size_t)(l * 16 + sq.b) * 16 + hd) * 8192;
        hist = p.in[I_SCV] + (size_t)(l * 16 + sq.b) * 3 * 2048; hist_out = p.out + O_SCV_S + (size_t)(l * 16 + sq.b) * 3 * 2048; }
    else { st_out = p.out + O_SSM_P + ((size_t)(l * 16 + sq.b) * 16 + hd) * 8192; st_in = sq.seg ? st_out : nullptr;
        hist_out = hbuf + ((size_t)((sq.seg & 1) * 2 + l) * 16 + sq.b) * 3 * 2048; hist = sq.seg ? hbuf + ((size_t)(((sq.seg + 1) & 1) * 2 + l) * 16 + sq.b) * 3 * 2048 : nullptr;
        if (sq.seg == NSEG - 1) hist_out2 = p.out + O_SCV_P + (size_t)(l * 16 + sq.b) * 3 * 2048; }
    for (int idx = tid; idx < 1600; idx += 256) { int k = idx / 320, cc = idx - k * 320; int ch = cc < 64 ? hd * 64 + cc : (cc < 192 ? 1024 + g * 128 + (cc - 64) : 1536 + g * 128 + (cc - 192));
        cwl[idx] = k < 4 ? cw[k * 2048 + ch] : cbias[ch];
        if (idx < 960) hl[idx] = hist ? hist[k * 2048 + ch] : 0.f; }
    f32x4 hacc[8];
#pragma unroll
    for (int nf = 0; nf < 8; ++nf)
#pragma unroll
        for (int r = 0; r < 4; ++r) { int pp = 16 * w + 4 * fq + r, n = 16 * nf + fr; float v = st_in ? st_in[pp * 128 + n] : 0.f; hacc[nf][r] = v; hb[pp * 136 + n] = f2bf(v); }
    bf16_t* rawX = (bf16_t*)(lds + 77568); bf16_t* rawB = (bf16_t*)(lds + 85760); bf16_t* rawC = (bf16_t*)(lds + 102144); bf16_t* rawZ = (bf16_t*)(lds + 118528); float* rawDt = (float*)(lds + 126720);
    const char* gx = (const char*)(proj + PC_XBC + hd * 64); const char* gb = (const char*)(proj + PC_XBC + 1024 + g * 128); const char* gc = (const char*)(proj + PC_XBC + 1536 + g * 128); const char* gz = (const char*)(proj + PC_Z + hd * 64);
    asm volatile("s_waitcnt vmcnt(0)" ::: "memory");
    {   const size_t ro = (size_t)sq.row0 * NPROJ * 2;
        stage_raw<128>(gx + ro, (size_t)NPROJ * 2, (char*)rawX, tid); stage_raw<256>(gb + ro, (size_t)NPROJ * 2, (char*)rawB, tid); stage_raw<256>(gc + ro, (size_t)NPROJ * 2, (char*)rawC, tid);
        stage_raw<128>(gz + ro, (size_t)NPROJ * 2, (char*)rawZ, tid); stage_raw<64>((const char*)(dtb + (size_t)sq.row0 * 16), 64, (char*)rawDt, tid); }
    for (int c = 0; c < sq.nchunk; ++c) {
        const int tid = tidx(wv_), lane = tid & 63, w = tid >> 6, fr = lane & 15, fq = lane >> 4;
        const int rowc = sq.row0 + c * 64; const bool lastc = (c == sq.nchunk - 1);
        const float* hlr = hl + (c & 1) * 960; float* hlw = hl + ((c + 1) & 1) * 960;
        asm volatile("s_waitcnt vmcnt(0)" ::: "memory");
        __syncthreads();
        if (w == 0) {
            float dt = lane < sq.Q ? rawDt[lane * 16 + hd] : 0.f; float v = dt * a;
#pragma unroll
            for (int o = 1; o < 64; o <<= 1) { float t = shfli(v, lane - o); if (lane >= o) v += t; }
            float last = shfli(v, 63);
            fl[lane] = v; fl[64 + lane] = dt; fl[128 + lane] = __expf(last - v) * dt; fl[192 + lane] = __expf(v);
        }
        __syncthreads();
        const float elast = __expf(fl[63]);
#pragma unroll
        for (int i = 0; i < 2; ++i) { int it = tid + 256 * i, t = it >> 3, c8 = (it & 7) * 8; float o[8], raw[8]; int ch = hd * 64 + c8; const bool tv = t < sq.Q;
            conv_lds(rawX, 64, t, c8, hlr, cwl, 320, c8, o, raw);
#pragma unroll
            for (int e = 0; e < 8; ++e) { float s_ = silu(o[e]); o[e] = tv ? s_ : 0.f; }
            if (t >= 61) {
#pragma unroll
                for (int e = 0; e < 8; ++e) hlw[(t - 61) * 320 + c8 + e] = raw[e]; }
            if (lastc && tv && t >= sq.Q - 3) {
#pragma unroll
                for (int e = 0; e < 8; ++e) { hist_out[(t - (sq.Q - 3)) * 2048 + ch + e] = raw[e]; if (hist_out2) hist_out2[(t - (sq.Q - 3)) * 2048 + ch + e] = raw[e]; } }
#pragma unroll
            for (int e = 0; e < 8; ++e) xT[(c8 + e) * 72 + t] = f2bf(o[e]); }
#pragma unroll
        for (int i = 0; i < 4; ++i) { int it = tid + 256 * i, t = it >> 4, c8 = (it & 15) * 8; float o[8], raw[8]; int ch = 1024 + g * 128 + c8; const bool tv = t < sq.Q;
            conv_lds(rawB, 128, t, c8, hlr, cwl, 320, 64 + c8, o, raw);
#pragma unroll
            for (int e = 0; e < 8; ++e) { float s_ = silu(o[e]); o[e] = tv ? s_ : 0.f; }
            if (t >= 61) {
#pragma unroll
                for (int e = 0; e < 8; ++e) hlw[(t - 61) * 320 + 64 + c8 + e] = raw[e]; }
            if (lastc && tv && (hd & 3) == 0 && t >= sq.Q - 3) {
#pragma unroll
                for (int e = 0; e < 8; ++e) { hist_out[(t - (sq.Q - 3)) * 2048 + ch + e] = raw[e]; if (hist_out2) hist_out2[(t - (sq.Q - 3)) * 2048 + ch + e] = raw[e]; } }
            us8 ov; float we = fl[128 + t];
#pragma unroll
            for (int e = 0; e < 8; ++e) { ov[e] = f2bf(o[e]); R2[(c8 + e) * 72 + t] = f2bf(o[e] * we); }
            *(us8*)(Bm + t * 136 + c8) = ov; }
        __syncthreads();
#pragma unroll
        for (int nf = 0; nf < 8; ++nf) hacc[nf] *= elast;
        lds_mma<8, 2>(hacc, xT, 72, 16 * w, R2, 72, 0, wv_);
        __syncthreads();
#pragma unroll
        for (int i = 0; i < 4; ++i) { int it = tid + 256 * i, t = it >> 4, c8 = (it & 15) * 8; float o[8], raw[8]; int ch = 1536 + g * 128 + c8; const bool tv = t < sq.Q;
            conv_lds(rawC, 128, t, c8, hlr, cwl, 320, 192 + c8, o, raw);
#pragma unroll
            for (int e = 0; e < 8; ++e) { float s_ = silu(o[e]); o[e] = tv ? s_ : 0.f; }
            if (t >= 61) {
#pragma unroll
                for (int e = 0; e < 8; ++e) hlw[(t - 61) * 320 + 192 + c8 + e] = raw[e]; }
            if (lastc && tv && (hd & 3) == 0 && t >= sq.Q - 3) {
#pragma unroll
                for (int e = 0; e < 8; ++e) { hist_out[(t - (sq.Q - 3)) * 2048 + ch + e] = raw[e]; if (hist_out2) hist_out2[(t - (sq.Q - 3)) * 2048 + ch + e] = raw[e]; } }
            us8 ov;
#pragma unroll
            for (int e = 0; e < 8; ++e) ov[e] = f2bf(o[e]);
            *(us8*)(R2 + t * 136 + c8) = ov; }
        us4 zr[4];
#pragma unroll
        for (int nf = 0; nf < 4; ++nf) zr[nf] = *(const us4*)(rawZ + (16 * nf + fr) * 64 + 16 * w + 4 * fq);
        __syncthreads();
        if (!lastc) { const size_t ro = (size_t)(rowc + 64) * NPROJ * 2;
            stage_raw<128>(gx + ro, (size_t)NPROJ * 2, (char*)rawX, tid); stage_raw<256>(gb + ro, (size_t)NPROJ * 2, (char*)rawB, tid); stage_raw<256>(gc + ro, (size_t)NPROJ * 2, (char*)rawC, tid);
            stage_raw<128>(gz + ro, (size_t)NPROJ * 2, (char*)rawZ, tid); stage_raw<64>((const char*)(dtb + (size_t)(rowc + 64) * 16), 64, (char*)rawDt, tid); }
        f32x4 cbv[4];
#pragma unroll
        for (int nf = 0; nf < 4; ++nf) cbv[nf] = (f32x4){0.f, 0.f, 0.f, 0.f};
        lds_mma<4, 4>(cbv, Bm, 136, 16 * w, R2, 136, 0, wv_);
        __syncthreads();
#pragma unroll
        for (int nf = 0; nf < 4; ++nf) { int i = 16 * nf + fr; float ai = fl[i]; us4 o;
#pragma unroll
            for (int r = 0; r < 4; ++r) { int j = 16 * w + 4 * fq + r; float v = (j <= i) ? cbv[nf][r] * __expf(ai - fl[j]) * fl[64 + j] : 0.f; o[r] = f2bf(v); }
            *(us4*)(Bm + i * 72 + 16 * w + 4 * fq) = o; }
        __syncthreads();
        f32x4 ya[4];
#pragma unroll
        for (int nf = 0; nf < 4; ++nf) ya[nf] = (f32x4){0.f, 0.f, 0.f, 0.f};
        lds_mma<4, 4>(ya, hb, 136, 16 * w, R2, 136, 0, wv_);
#pragma unroll
        for (int nf = 0; nf < 4; ++nf) ya[nf] *= fl[192 + 16 * nf + fr];
        lds_mma<4, 2>(ya, xT, 72, 16 * w, Bm, 72, 0, wv_);
#pragma unroll
        for (int nf = 0; nf < 4; ++nf) { int i = 16 * nf + fr, p0 = 16 * w + 4 * fq;
            us4 z = zr[nf];
            if (i < sq.Q) { us4 o;
#pragma unroll
                for (int r = 0; r < 4; ++r) o[r] = f2bf((ya[nf][r] + Dv * bf2f(xT[(p0 + r) * 72 + i])) * bf2f(z[r]));
                *(us4*)(ymb + (size_t)(rowc + i) * LDK + hd * 64 + p0) = o; } }
        __syncthreads();
#pragma unroll
        for (int nf = 0; nf < 8; ++nf)
#pragma unroll
            for (int r = 0; r < 4; ++r) hb[(16 * w + 4 * fq + r) * 136 + 16 * nf + fr] = f2bf(hacc[nf][r]);
    }
#pragma unroll
    for (int nf = 0; nf < 8; ++nf)
#pragma unroll
        for (int r = 0; r < 4; ++r) st_out[(16 * w + 4 * fq + r) * 128 + 16 * nf + fr] = hacc[nf][r];
    __syncthreads();
}

DEVI void hgrn_unit(const Params& p, int l, Seq sq, int h, char* lds, int wv_) {
    bf16_t* sb = (bf16_t*)lds;
    bf16_t* qt = (bf16_t*)(lds + 34816);
    bf16_t* kt = (bf16_t*)(lds + 52224);
    bf16_t* att = (bf16_t*)lds;
    bf16_t* kT = (bf16_t*)(lds + 9216);
    bf16_t* vT = (bf16_t*)(lds + 27648);
    float* T0 = (float*)(lds + 69632); float* T1 = T0 + 128; float* ssq = T0 + 256;
    const int tid = tidx(wv_), lane = tid & 63, w = tid >> 6, fr = lane & 15, fq = lane >> 4;
    const int k = tid & 127, half = tid >> 7;
    const bf16_t* proj = (const bf16_t*)(p.ws + WS_PROJ); bf16_t* yhg = (bf16_t*)(p.ws + WS_YHG);
    float lb = 0.f;
    if (l == 1) { float a0 = p.in[I_LBL][h * 128 + k], a1 = p.in[I_LBL][1024 + h * 128 + k]; lb = 1.f / (1.f + __expf(a0 - a1)); }
    const float* nw = p.in[I_HGNW] + l * 128;
    const float* st_in; float* st_out;
    if (sq.samp) { st_in = p.in[I_HG] + ((size_t)(l * 16 + sq.b) * 8 + h) * 16384; st_out = p.out + O_HG_S + ((size_t)(l * 16 + sq.b) * 8 + h) * 16384; }
    else { st_out = p.out + O_HG_P + ((size_t)(l * 16 + sq.b) * 8 + h) * 16384; st_in = sq.seg ? st_out : nullptr; }
    f32x4 hacc[2][8];
#pragma unroll
    for (int mf = 0; mf < 2; ++mf)
#pragma unroll
        for (int nf = 0; nf < 8; ++nf)
#pragma unroll
            for (int r = 0; r < 4; ++r) hacc[mf][nf][r] = st_in ? st_in[(32 * w + 16 * mf + 4 * fq + r) * 128 + 16 * nf + fr] : 0.f;
    f32x4 nwr[2];
#pragma unroll
    for (int mf = 0; mf < 2; ++mf) nwr[mf] = *(const f32x4*)(nw + 32 * w + 16 * mf + 4 * fq);
    bf16_t* rawF = (bf16_t*)(lds + 71680); bf16_t* rawQ = (bf16_t*)(lds + 88064); bf16_t* rawV = (bf16_t*)(lds + 104448); bf16_t* rawH = (bf16_t*)(lds + 120832);
    const char* gf = (const char*)(proj + PC_HF + h * 128); const char* gq = (const char*)(proj + PC_HQ + h * 128); const char* gv = (const char*)(proj + PC_HI + h * 128); const char* gh = (const char*)(proj + PC_HGATE + h * 128);
    asm volatile("s_waitcnt vmcnt(0)" ::: "memory");
    {   const size_t ro = (size_t)sq.row0 * NPROJ * 2;
        stage_raw<256>(gf + ro, (size_t)NPROJ * 2, (char*)rawF, tid); stage_raw<256>(gq + ro, (size_t)NPROJ * 2, (char*)rawQ, tid); stage_raw<256>(gv + ro, (size_t)NPROJ * 2, (char*)rawV, tid); }
    for (int c = 0; c < sq.nchunk; ++c) {
        const int tid = tidx(wv_), lane = tid & 63, w = tid >> 6, fr = lane & 15, fq = lane >> 4, k = tid & 127, half = tid >> 7;
        const int rowc = sq.row0 + c * 64; const bool lastc = (c == sq.nchunk - 1);
        asm volatile("s_waitcnt vmcnt(0)" ::: "memory");
        __syncthreads();
        stage_raw<256>(gh + (size_t)rowc * NPROJ * 2, (size_t)NPROJ * 2, (char*)rawH, tid);
        {
            unsigned fu[32], qu[32];
#pragma unroll
            for (int jj = 0; jj < 32; ++jj) { fu[jj] = rawF[(32 * half + jj) * 128 + k]; qu[jj] = rawQ[(32 * half + jj) * 128 + k]; }
            if (tid < 64) ssq[tid] = 0.f;
            float run = 0.f;
            if (half == 0) {
#pragma unroll
                for (int jj = 31; jj >= 0; --jj) { bool valid = jj < sq.Q; float f = __uint_as_float(fu[jj] << 16);
                    float sg = __builtin_amdgcn_rcpf(1.f + __expf(-f)); float lg0 = __logf(lb + (1.f - lb) * sg); float lg = valid ? lg0 : 0.f;
                    float kk0 = (1.f - lb) * (1.f - sg); float kk = valid ? kk0 : 0.f; float q0 = __uint_as_float(qu[jj] << 16); float q = valid ? q0 : 0.f;
                    qt[jj * 136 + k] = f2bf(q * cexp(-run)); kt[jj * 136 + k] = f2bf(kk * cexp(run)); run += lg; }
                T0[k] = run;
            } else {
#pragma unroll
                for (int jj = 0; jj < 32; ++jj) { bool valid = (32 + jj) < sq.Q; float f = __uint_as_float(fu[jj] << 16);
                    float sg = __builtin_amdgcn_rcpf(1.f + __expf(-f)); float lg0 = __logf(lb + (1.f - lb) * sg); float lg = valid ? lg0 : 0.f;
                    float kk0 = (1.f - lb) * (1.f - sg); float kk = valid ? kk0 : 0.f; float q0 = __uint_as_float(qu[jj] << 16); float q = valid ? q0 : 0.f;
                    run += lg; qt[(32 + jj) * 136 + k] = f2bf(q * cexp(run)); kt[(32 + jj) * 136 + k] = f2bf(kk * cexp(-run)); }
                T1[k] = run;
            }
        }
        __syncthreads();
#pragma unroll
        for (int mf = 0; mf < 2; ++mf) { int k0 = 32 * w + 16 * mf + 4 * fq; float e0 = __expf(T0[k0]), e1 = __expf(T0[k0 + 1]), e2 = __expf(T0[k0 + 2]), e3 = __expf(T0[k0 + 3]);
#pragma unroll
            for (int nf = 0; nf < 8; ++nf) { hacc[mf][nf][0] *= e0; hacc[mf][nf][1] *= e1; hacc[mf][nf][2] *= e2; hacc[mf][nf][3] *= e3;
                us4 o; o[0] = f2bf(hacc[mf][nf][0]); o[1] = f2bf(hacc[mf][nf][1]); o[2] = f2bf(hacc[mf][nf][2]); o[3] = f2bf(hacc[mf][nf][3]);
                *(us4*)(sb + (16 * nf + fr) * 136 + k0) = o; } }
        f32x4 at[4];
#pragma unroll
        for (int nf = 0; nf < 4; ++nf) at[nf] = (f32x4){0.f, 0.f, 0.f, 0.f};
        lds_mma<4, 4>(at, kt, 136, 16 * w, qt, 136, 0, wv_);
        __syncthreads();
        f32x4 oacc[2][4];
#pragma unroll
        for (int mf = 0; mf < 2; ++mf) {
#pragma unroll
            for (int nf = 0; nf < 4; ++nf) oacc[mf][nf] = (f32x4){0.f, 0.f, 0.f, 0.f};
            lds_mma<4, 4>(oacc[mf], sb, 136, 32 * w + 16 * mf, qt, 136, 0, wv_); }
        __syncthreads();
#pragma unroll
        for (int nf = 0; nf < 4; ++nf) { int i = 16 * nf + fr; us4 o;
#pragma unroll
            for (int r = 0; r < 4; ++r) { int j = 16 * w + 4 * fq + r; o[r] = f2bf(j <= i ? at[nf][r] : 0.f); }
            *(us4*)(att + i * 72 + 16 * w + 4 * fq) = o; }
        {   unsigned vu[32];
#pragma unroll
            for (int jj = 0; jj < 32; ++jj) vu[jj] = rawV[(32 * half + jj) * 128 + k];
#pragma unroll
            for (int q4 = 0; q4 < 4; ++q4) { us8 kv, vv;
#pragma unroll
                for (int e = 0; e < 8; ++e) { int jj = q4 * 8 + e; bool valid = (32 * half + jj) < sq.Q; kv[e] = kt[(32 * half + jj) * 136 + k]; vv[e] = valid ? (bf16_t)vu[jj] : (bf16_t)0; }
                *(us8*)(kT + k * 72 + 32 * half + q4 * 8) = kv; *(us8*)(vT + k * 72 + 32 * half + q4 * 8) = vv; } }
        __syncthreads();
        if (!lastc) { const size_t ro = (size_t)(rowc + 64) * NPROJ * 2;
            stage_raw<256>(gf + ro, (size_t)NPROJ * 2, (char*)rawF, tid); stage_raw<256>(gq + ro, (size_t)NPROJ * 2, (char*)rawQ, tid); stage_raw<256>(gv + ro, (size_t)NPROJ * 2, (char*)rawV, tid); }
#pragma unroll
        for (int mf = 0; mf < 2; ++mf) {
            lds_mma<4, 2>(oacc[mf], vT, 72, 32 * w + 16 * mf, att, 72, 0, wv_);
            lds_mma<8, 2>(hacc[mf], kT, 72, 32 * w + 16 * mf, vT, 72, 0, wv_);
            int k0 = 32 * w + 16 * mf + 4 * fq; float e0 = __expf(T1[k0]), e1 = __expf(T1[k0 + 1]), e2 = __expf(T1[k0 + 2]), e3 = __expf(T1[k0 + 3]);
#pragma unroll
            for (int nf = 0; nf < 8; ++nf) { hacc[mf][nf][0] *= e0; hacc[mf][nf][1] *= e1; hacc[mf][nf][2] *= e2; hacc[mf][nf][3] *= e3; } }
#pragma unroll
        for (int nf = 0; nf < 4; ++nf) { float s = 0.f;
#pragma unroll
            for (int mf = 0; mf < 2; ++mf)
#pragma unroll
                for (int r = 0; r < 4; ++r) s += oacc[mf][nf][r] * oacc[mf][nf][r];
            s += shflx(s, 16, lane); s += shflx(s, 32, lane);
            if (fq == 0) atomicAdd(&ssq[16 * nf + fr], s); }
        if (lastc) asm volatile("s_waitcnt vmcnt(0)" ::: "memory"); else asm volatile("s_waitcnt vmcnt(12)" ::: "memory");
        __syncthreads();
#pragma unroll
        for (int nf = 0; nf < 4; ++nf) { int i = 16 * nf + fr; float rs = rsqrtf(ssq[i] * (1.f / 128.f) + 1e-6f);
#pragma unroll
            for (int mf = 0; mf < 2; ++mf) { int v0 = 32 * w + 16 * mf + 4 * fq; us4 gt = *(const us4*)(rawH + i * 128 + v0); f32x4 wv = nwr[mf]; us4 o;
#pragma unroll
                for (int r = 0; r < 4; ++r) o[r] = f2bf(oacc[mf][nf][r] * rs * wv[r] * bf2f(gt[r]));
                if (i < sq.Q) *(us4*)(yhg + (size_t)(rowc + i) * LDK + h * 128 + v0) = o; } }
        __syncthreads();
    }
#pragma unroll
    for (int mf = 0; mf < 2; ++mf)
#pragma unroll
        for (int nf = 0; nf < 8; ++nf)
#pragma unroll
            for (int r = 0; r < 4; ++r) st_out[(32 * w + 16 * mf + 4 * fq + r) * 128 + 16 * nf + fr] = hacc[mf][nf][r];
}

DEVI void rg_unit(const Params& p, int l, Seq sq, int blk, char* lds, int wv_) {
    bf16_t* waT = (bf16_t*)lds; bf16_t* wiT = (bf16_t*)(lds + 9216); bf16_t* xr = (bf16_t*)(lds + 18432);
    float* av = (float*)(lds + 27648); float* uv = (float*)(lds + 44288); float* Pq = (float*)(lds + 60928); float* Hq = Pq + 256; float* carry = Hq + 256;
    const int tid = tidx(wv_), lane = tid & 63, w = tid >> 6, fr = lane & 15, fq = lane >> 4;
    const bf16_t* proj = (const bf16_t*)(p.ws + WS_PROJ); bf16_t* yrg = (bf16_t*)(p.ws + WS_YRG);
    const int cb0 = blk * 64;
    const float* cw = p.in[I_RCW] + (size_t)l * 4 * 1024; const float* cbias = p.in[I_RCB] + l * 1024;
    const float* st_in; float* st_out; const float* hist; float* hist_out;
    if (sq.samp) { st_in = p.in[I_RG] + (size_t)(l * 16 + sq.b) * 1024; st_out = p.out + O_RG_S + (size_t)(l * 16 + sq.b) * 1024;
        hist = p.in[I_RCV] + (size_t)(l * 16 + sq.b) * 3 * 1024; hist_out = p.out + O_RCV_S + (size_t)(l * 16 + sq.b) * 3 * 1024; }
    else { st_out = p.out + O_RG_P + (size_t)(l * 16 + sq.b) * 1024; st_in = sq.seg ? st_out : nullptr;
        hist_out = p.out + O_RCV_P + (size_t)(l * 16 + sq.b) * 3 * 1024; hist = sq.seg ? hist_out : nullptr; }
    float* cwl = (float*)(lds + 63232);
    float* hl = (float*)(lds + 64512);
    float* hl2 = (float*)(lds + 90112);
    for (int idx = tid; idx < 320; idx += 256) { int k = idx >> 6, cc = idx & 63; cwl[idx] = k < 4 ? cw[k * 1024 + cb0 + cc] : cbias[cb0 + cc]; if (idx < 192) hl[idx] = hist ? hist[k * 1024 + cb0 + cc] : 0.f; }
    {   const float* wa = p.in[I_RWA] + ((size_t)l * 16 + blk) * 4096; const float* wi = p.in[I_RWI] + ((size_t)l * 16 + blk) * 4096;
        float wa_[16], wi_[16];
#pragma unroll
        for (int u = 0; u < 16; ++u) { wa_[u] = wa[tid + 256 * u]; wi_[u] = wi[tid + 256 * u]; }
#pragma unroll
        for (int u = 0; u < 16; ++u) { int e = tid + 256 * u, i = e >> 6, j = e & 63; waT[j * 72 + i] = f2bf(wa_[u]); wiT[j * 72 + i] = f2bf(wi_[u]); }
        if (tid < 64) carry[tid] = st_in ? st_in[cb0 + tid] : 0.f; }
    float cba[4], cbi[4], csp[4];
#pragma unroll
    for (int nf = 0; nf < 4; ++nf) { int cc = cb0 + 16 * nf + fr; cba[nf] = p.in[I_RBA][l * 1024 + cc]; cbi[nf] = p.in[I_RBI][l * 1024 + cc]; csp[nf] = softplus(-p.in[I_RLAM][l * 1024 + cc]); }
    bf16_t* rawR = (bf16_t*)(lds + 65536); bf16_t* rawG = (bf16_t*)(lds + 73728);
    const char* gr = (const char*)(proj + PC_RX + cb0); const char* gg = (const char*)(proj + PC_RGATE + cb0);
    asm volatile("s_waitcnt vmcnt(0)" ::: "memory");
    stage_raw<128>(gr + (size_t)sq.row0 * NPROJ * 2, (size_t)NPROJ * 2, (char*)rawR, tid); stage_raw<128>(gg + (size_t)sq.row0 * NPROJ * 2, (size_t)NPROJ * 2, (char*)rawG, tid);
    for (int c = 0; c < sq.nchunk; ++c) {
        const int tid = tidx(wv_), lane = tid & 63, w = tid >> 6, fr = lane & 15, fq = lane >> 4, j = tid & 63, q = tid >> 6;
        const int rowc = sq.row0 + c * 64; const bool lastc = (c == sq.nchunk - 1);
        const float* hlr = (c & 1) ? hl2 : hl; float* hlw = (c & 1) ? hl : hl2;
        asm volatile("s_waitcnt vmcnt(0)" ::: "memory");
        __syncthreads();
#pragma unroll
        for (int i = 0; i < 2; ++i) { int it = tid + 256 * i, t = it >> 3, c8 = (it & 7) * 8; float o[8], raw[8]; int ch = cb0 + c8; const bool tv = t < sq.Q;
            conv_lds(rawR, 64, t, c8, hlr, cwl, 64, c8, o, raw);
            if (t >= 61) {
#pragma unroll
                for (int e = 0; e < 8; ++e) hlw[(t - 61) * 64 + c8 + e] = raw[e]; }
            if (lastc && tv && t >= sq.Q - 3) {
#pragma unroll
                for (int e = 0; e < 8; ++e) hist_out[(t - (sq.Q - 3)) * 1024 + ch + e] = raw[e]; }
            us8 ov;
#pragma unroll
            for (int e = 0; e < 8; ++e) { float ox = tv ? o[e] : 0.f; ov[e] = f2bf(ox); uv[t * 65 + c8 + e] = ox; }
            *(us8*)(xr + t * 72 + c8) = ov; }
        __syncthreads();
        if (!lastc) { const size_t ro = (size_t)(rowc + 64) * NPROJ * 2; stage_raw<128>(gr + ro, (size_t)NPROJ * 2, (char*)rawR, tid); stage_raw<128>(gg + ro, (size_t)NPROJ * 2, (char*)(rawG + ((c + 1) & 1) * 4096), tid); }
        f32x4 ra[4], ri[4];
#pragma unroll
        for (int nf = 0; nf < 4; ++nf) { ra[nf] = (f32x4){0.f, 0.f, 0.f, 0.f}; ri[nf] = (f32x4){0.f, 0.f, 0.f, 0.f}; }
        lds_mma<4, 2>(ra, xr, 72, 16 * w, waT, 72, 0, wv_);
        lds_mma<4, 2>(ri, xr, 72, 16 * w, wiT, 72, 0, wv_);
#pragma unroll
        for (int nf = 0; nf < 4; ++nf) { int jj = 16 * nf + fr; float ba = cba[nf], bi = cbi[nf], sp = csp[nf];
#pragma unroll
            for (int r = 0; r < 4; ++r) { int t = 16 * w + 4 * fq + r; float rr = sigm(ra[nf][r] + ba), ii = sigm(ri[nf][r] + bi); float la = -8.f * sp * rr; float aa = __expf(la);
                float u = __builtin_sqrtf(fmaxf(1.f - aa * aa, 0.f)) * ii * uv[t * 65 + jj];
                if (t >= sq.Q) { aa = 1.f; u = 0.f; }
                av[t * 65 + jj] = aa; uv[t * 65 + jj] = u; } }
        __syncthreads();
        { float P = 1.f, H = 0.f;
#pragma unroll
          for (int tt = 0; tt < 16; ++tt) { int t = 16 * q + tt; float aa = av[t * 65 + j], u = uv[t * 65 + j]; H = aa * H + u; P *= aa; }
          Pq[q * 64 + j] = P; Hq[q * 64 + j] = H; }
        __syncthreads();
        float hcur = carry[j];
        for (int qq = 0; qq < q; ++qq) hcur = Pq[qq * 64 + j] * hcur + Hq[qq * 64 + j];
        const bf16_t* rg_ = rawG + (c & 1) * 4096;
        bf16_t gts[16];
#pragma unroll
        for (int tt = 0; tt < 16; ++tt) gts[tt] = rg_[(16 * q + tt) * 64 + j];
#pragma unroll
        for (int tt = 0; tt < 16; ++tt) { int t = 16 * q + tt; float aa = av[t * 65 + j], u = uv[t * 65 + j]; hcur = aa * hcur + u;
            if (t < sq.Q) yrg[(size_t)(rowc + t) * LDK + cb0 + j] = f2bf(bf2f(gts[tt]) * hcur); }
        __syncthreads();
        if (q == 3) carry[j] = hcur;
        __syncthreads();
    }
    if (tid < 64) st_out[cb0 + tid] = carry[tid];
    __syncthreads();
}

DEVI void phase_mix(const Params& p, int l, int seg, char* lds, int wv_) {
    const int ngrp = seg == 0 ? 2 : 1; const int NU = ngrp * 640;
    unsigned* qctr = (unsigned*)(p.ws + WS_END) + 1 + (seg * 2 + l);
    volatile int* sh = (volatile int*)(lds + 147440);
    for (;;) {
        if (tidx(wv_) == 0) sh[0] = (int)__hip_atomic_fetch_add(qctr, 1u, __ATOMIC_RELAXED, __HIP_MEMORY_SCOPE_AGENT);
        __syncthreads();
        const int u = __builtin_amdgcn_readfirstlane(sh[0]);
        __syncthreads();
        if (u >= NU) break;
        int grp = u / 640, v = u % 640;
        if (v < 128) hgrn_unit(p, l, make_seq(seg, grp * 16 + (v >> 3)), v & 7, lds, wv_);
        else if (v < 384) { v -= 128; ssd_unit(p, l, make_seq(seg, grp * 16 + (v >> 4)), v & 15, lds, wv_); }
        else { v -= 384; rg_unit(p, l, make_seq(seg, grp * 16 + (v >> 4)), v & 15, lds, wv_); }
        __syncthreads();
    }
}

DEVI void gbar(const Params& p, unsigned& epoch_, int wv_) {
    const unsigned epoch = __builtin_amdgcn_readfirstlane(epoch_); epoch_ = epoch + 1u;
    unsigned* bw = (unsigned*)(p.ws + WS_END); asm volatile("" : "+s"(bw));
    asm volatile("s_waitcnt vmcnt(0)" ::: "memory");
    __syncthreads();
    if (tidx(wv_) == 0) {
        if ((wv_ >> 23) & 1) {
            const unsigned x = (wv_ >> 2) & 7, NB = (wv_ >> 14) & 511;
            const unsigned old = __hip_atomic_fetch_add(bw + 32 + x, 1u, __ATOMIC_RELAXED, __HIP_MEMORY_SCOPE_AGENT);
            if (old + 1u == (epoch + 1u) * NB) {
                __builtin_amdgcn_fence(__ATOMIC_RELEASE, "agent");
                asm volatile("s_waitcnt vmcnt(0)" ::: "memory");
                const unsigned og = __hip_atomic_fetch_add(bw + 56, 1u, __ATOMIC_RELAXED, __HIP_MEMORY_SCOPE_AGENT);
                if (og + 1u == (epoch + 1u) * 8u) __hip_atomic_fetch_add(bw + 57, 1u, __ATOMIC_RELAXED, __HIP_MEMORY_SCOPE_AGENT);
                else while (__hip_atomic_load(bw + 57, __ATOMIC_RELAXED, __HIP_MEMORY_SCOPE_AGENT) < epoch + 1u) __builtin_amdgcn_s_sleep(1);
                __builtin_amdgcn_fence(__ATOMIC_ACQUIRE, "agent");
                __hip_atomic_fetch_add(bw + 48 + x, 1u, __ATOMIC_RELAXED, __HIP_MEMORY_SCOPE_AGENT);
                asm volatile("s_waitcnt vmcnt(0)" ::: "memory");
            } else {
                while (__hip_atomic_load(bw + 48 + x, __ATOMIC_RELAXED, __HIP_MEMORY_SCOPE_AGENT) < epoch + 1u) __builtin_amdgcn_s_sleep(1);
                __builtin_amdgcn_fence(__ATOMIC_ACQUIRE, "agent");
                asm volatile("s_waitcnt vmcnt(0)" ::: "memory");
            }
        } else {
            __builtin_amdgcn_fence(__ATOMIC_RELEASE, "agent");
            asm volatile("s_waitcnt vmcnt(0)" ::: "memory");
            __hip_atomic_fetch_add(bw, 1u, __ATOMIC_RELAXED, __HIP_MEMORY_SCOPE_AGENT);
            const unsigned target = (epoch + 1u) * gridDim.x;
            while (__hip_atomic_load(bw, __ATOMIC_RELAXED, __HIP_MEMORY_SCOPE_AGENT) < target) __builtin_amdgcn_s_sleep(1);
            __builtin_amdgcn_fence(__ATOMIC_ACQUIRE, "agent");
            asm volatile("s_waitcnt vmcnt(0)" ::: "memory");
        }
    }
    __syncthreads();
}

__global__ void __launch_bounds__(256) fwd_mega(Params p) {
    extern __shared__ __attribute__((aligned(16))) char lds[];
    int wv_ = __builtin_amdgcn_readfirstlane((int)(__builtin_amdgcn_workitem_id_x() >> 6));
    cg::grid_group grid = cg::this_grid();
    unsigned* xcnt = (unsigned*)(p.ws + WS_END) + 16;
    const int xcc = (int)(__builtin_amdgcn_s_getreg((3 << 11) | 20) & 7u);
    int xrank;
    { int* sh = (int*)lds; if (__builtin_amdgcn_workitem_id_x() == 0) sh[0] = (int)__hip_atomic_fetch_add(xcnt + xcc, 1u, __ATOMIC_RELAXED, __HIP_MEMORY_SCOPE_AGENT); __syncthreads(); xrank = __builtin_amdgcn_readfirstlane(sh[0]); __syncthreads(); }
    unsigned epoch = 0;
    phase_prep(p, lds, wv_);
    grid.sync();
    {   unsigned c[8]; bool ok = true;
#pragma unroll
        for (int i = 0; i < 8; ++i) { c[i] = __hip_atomic_load(xcnt + i, __ATOMIC_RELAXED, __HIP_MEMORY_SCOPE_AGENT); ok = ok && c[i] > 0u && c[i] < 512u; }
        unsigned mine = 0, tot_ = 0;
#pragma unroll
        for (int i = 0; i < 8; ++i) { mine = (i == xcc) ? c[i] : mine; tot_ += c[i]; }
        ok = ok && tot_ == gridDim.x;
        int X = xcc, R = xrank, NB = (int)mine;
        if (!ok) { X = blockIdx.x & 7; R = blockIdx.x >> 3; NB = gridDim.x >> 3; }
        wv_ = __builtin_amdgcn_readfirstlane((wv_ & 3) | (X << 2) | (R << 5) | (NB << 14) | (ok ? (1 << 23) : 0)); }
#pragma unroll 1
    for (int seg = 0; seg < NSEG; ++seg) {
        const int nrows = seg == 0 ? ROWS : ROWS_P, MT = nrows / 256;
#pragma unroll 1
        for (int l = 0; l < 2; ++l) {
            const bf16_t* wl = (const bf16_t*)p.ws + (size_t)l * E_LAYER;
            phase_norm(p, seg, nrows, p.in[I_NMIX] + l * 1024, l == 0, l, lds, wv_);
            gbar(p, epoch, wv_);
            for (int r = 0; r < p.rep[0]; ++r) { phase_proj(p, l, MT, lds, wv_); gbar(p, epoch, wv_); }
            phase_mix(p, l, seg, lds, wv_); gbar(p, epoch, wv_);
            phase_mbnorm(p, l, nrows, wv_);
            gbar(p, epoch, wv_);
            for (int r = 0; r < p.rep[1]; ++r) { phase_merge(p, l, MT, lds, wv_); gbar(p, epoch, wv_); }
            phase_resid(p, seg, MT, (const bf16_t*)(p.ws + WS_MRG), 1024, LDK, wl + E_WIN + E_WBR, l == 0, lds, wv_);
            gbar(p, epoch, wv_);
            phase_norm(p, seg, nrows, p.in[I_NFFN] + l * 1024, false, -1, lds, wv_);
            gbar(p, epoch, wv_);
            for (int r = 0; r < p.rep[2]; ++r) { phase_ffn_in(p, l, MT, lds, wv_); gbar(p, epoch, wv_); }
            phase_resid(p, seg, MT, (const bf16_t*)(p.ws + WS_PROJ), FFH, LDF, wl + E_WIN + E_WBR + E_WOUT + E_WFI, false, lds, wv_);
            gbar(p, epoch, wv_);
        }
        phase_final_norm(p, seg, nrows, wv_);
    }
}

extern "C" void kernel_launch(void* const* d_in, const int* in_sizes, int n_in, void* d_out, int out_size, void* d_ws, size_t ws_size, hipStream_t stream) {
    static int grid_blocks = 0;
    if (!grid_blocks) {
        int dev = 0, cus = 0, per_cu = 0;
        (void)hipGetDevice(&dev);
        (void)hipDeviceGetAttribute(&cus, hipDeviceAttributeMultiprocessorCount, dev);
        (void)hipFuncSetAttribute((const void*)fwd_mega, hipFuncAttributeMaxDynamicSharedMemorySize, LDS_BYTES);
        (void)hipOccupancyMaxActiveBlocksPerMultiprocessor(&per_cu, (const void*)fwd_mega, 256, LDS_BYTES);
        if (per_cu < 1) fprintf(stderr, "occupancy query says %d blocks per CU\n", per_cu);
        grid_blocks = cus;
        if (ws_size < WS_TOTAL) fprintf(stderr, "workspace too small: %zu < %zu\n", ws_size, (size_t)WS_END + 256);
    }
    (void)hipMemsetAsync((char*)d_ws + WS_END, 0, 256, stream);
    Params p{};
    for (int i = 0; i < 30; ++i) p.in[i] = (const float*)d_in[i];
    p.out = (float*)d_out; p.ws = (unsigned char*)d_ws; p.rep[0] = REP0; p.rep[1] = REP1; p.rep[2] = REP2; p.rep[3] = REP3;
    void* args[] = {&p};
    hipError_t e = hipLaunchCooperativeKernel((const void*)fwd_mega, dim3(grid_blocks), dim3(256), args, LDS_BYTES, stream);
    if (e != hipSuccess) fprintf(stderr, "cooperative launch failed: %s (grid %d)\n", hipGetErrorString(e), grid_blocks);
}
```

```cpp
#include <hip/hip_runtime.h>
#include <hip/hip_cooperative_groups.h>
#include <cstdio>
namespace cg = cooperative_groups;

typedef unsigned short bf16_t;
typedef short bf16x8 __attribute__((ext_vector_type(8)));
typedef float f32x4 __attribute__((ext_vector_type(4)));
typedef unsigned short us4 __attribute__((ext_vector_type(4)));
typedef unsigned short us8 __attribute__((ext_vector_type(8)));
#define DEVI __device__ __forceinline__

constexpr int LDK = 1088, LDF = 2880;
constexpr int D = 1024, NPROJ = 12288, SEGT = 512, NSEG = 4, ROWS_P = 8192, ROWS = 8704, FFH = 2816;
constexpr int PC_Z = 0, PC_XBC = 1024, PC_HQ = 3072, PC_HF = 4096, PC_HI = 5120, PC_HGATE = 6144, PC_RGATE = 7168, PC_RX = 8192, PC_MG = 9216, PC_DT = 12288;
constexpr size_t E_WIN = (size_t)NPROJ * LDK, E_WBR = 3u * 1024 * LDK, E_WOUT = 1024u * LDK, E_WFI = 5632u * LDK, E_WFO = 1024u * LDF;
constexpr size_t E_LAYER = E_WIN + E_WBR + E_WOUT + E_WFI + E_WFO;
constexpr size_t WS_PROJ = 2 * E_LAYER * 2;
constexpr size_t WS_DT = WS_PROJ + (size_t)ROWS * NPROJ * 2;
constexpr size_t WS_XB = WS_DT + (size_t)ROWS * 16 * 4;
constexpr size_t WS_YMB = WS_XB + (size_t)ROWS * LDK * 2;
constexpr size_t WS_YHG = WS_YMB + (size_t)ROWS * LDK * 2;
constexpr size_t WS_YRG = WS_YHG + (size_t)ROWS * LDK * 2;
constexpr size_t WS_MRG = WS_YRG + (size_t)ROWS * LDK * 2;
constexpr size_t WS_END = WS_MRG + (size_t)ROWS * LDK * 2;
constexpr size_t WS_HB = WS_END + 256;
constexpr size_t WS_DTW = WS_HB + 2u * 2 * 16 * 3 * 2048 * 4;
constexpr size_t WS_TOTAL = WS_DTW + 2u * 16 * 1024 * 4;
constexpr size_t O_YP = 0, O_YS = 33554432, O_SSM_P = 34078720, O_SCV_P = 38273024, O_HG_P = 38469632, O_RG_P = 42663936, O_RCV_P = 42696704,
                 O_SSM_S = 42795008, O_SCV_S = 46989312, O_HG_S = 47185920, O_RG_S = 51380224, O_RCV_S = 51412992;
constexpr int REP0 = 1, REP1 = 1, REP2 = 1, REP3 = 1;
constexpr int LDS_BYTES = 144 * 1024;

enum { I_XP = 0, I_XS, I_SSM, I_SCV, I_HG, I_RG, I_RCV, I_NMIX, I_WIN, I_MCW, I_MCB, I_DTB, I_ALOG, I_MBD, I_MBNW, I_LBL, I_HGNW, I_RCW, I_RCB, I_RWA, I_RBA, I_RWI, I_RBI, I_RLAM, I_WBR, I_WOUT, I_NFFN, I_WFI, I_WFO, I_NFIN };

struct Params { const float* in[30]; float* out; unsigned char* ws; int rep[4]; };

DEVI int tidx(int wv_) { int t = ((wv_ & 3) << 6) | (int)__builtin_amdgcn_mbcnt_hi(~0u, __builtin_amdgcn_mbcnt_lo(~0u, 0u)); asm volatile("" : "+v"(t)); return t; }
DEVI float shfli(float v, int srcl) { return __int_as_float(__builtin_amdgcn_ds_bpermute(srcl << 2, __float_as_int(v))); }
DEVI float shflx(float v, int m, int lane) { return shfli(v, lane ^ m); }
DEVI bf16_t f2bf(float f) { unsigned r; asm("v_cvt_pk_bf16_f32 %0, %1, %1" : "=v"(r) : "v"(f)); return (bf16_t)r; }
DEVI float bf2f(bf16_t h) { return __uint_as_float(((unsigned)h) << 16); }
DEVI float sigm(float x) { return __builtin_amdgcn_rcpf(1.f + __expf(-x)); }
DEVI float silu(float x) { return x * __builtin_amdgcn_rcpf(1.f + __expf(-x)); }
DEVI float softplus(float x) { return x > 20.f ? x : __logf(1.f + __expf(x)); }
DEVI float gelu_t(float x) { float u = 0.7978845608f * (x + 0.044715f * x * x * x); return x * sigm(2.f * u); }
DEVI float cexp(float x) { return __expf(fminf(x, 80.f)); }

DEVI const float* xrow_in(const Params& p, int seg, int r) {
    if (r < ROWS_P) { int b = r >> 9, tt = r & 511; return p.in[I_XP] + ((size_t)(b * 2048 + seg * SEGT + tt)) * D; }
    return p.in[I_XS] + (size_t)(r - ROWS_P) * D;
}
DEVI float* xrow_out(const Params& p, int seg, int r) {
    if (r < ROWS_P) { int b = r >> 9, tt = r & 511; return p.out + O_YP + ((size_t)(b * 2048 + seg * SEGT + tt)) * D; }
    return p.out + O_YS + (size_t)(r - ROWS_P) * D;
}

DEVI int perm32(int rho) { int n = rho >> 4, i = rho & 15; return 8 * (i >> 2) + 4 * n + (i & 3); }
DEVI int map_win(int n) { n = (n & ~31) + perm32(n & 31); return n < 3072 ? n : n + 16; }
DEVI int map_wfi(int n) { int T = n >> 7, nf = (n >> 4) & 7, i = n & 15, G = nf >> 2, h = (nf >> 1) & 1, s = nf & 1; return s * FFH + 64 * T + 32 * G + 8 * (i >> 2) + 4 * h + (i & 3); }

DEVI void transpose_tile(const float* src, int ldsrc, bf16_t* dst, int K, int k0, int n0, int mode, float* tile  , int wv_) {
    const int tid = tidx(wv_), c = tid & 63, rq = tid >> 6;
    int n = n0 + c, sn = mode == 1 ? map_win(n) : (mode == 2 ? map_wfi(n) : (mode == 3 ? (n & ~31) + perm32(n & 31) : n));
#pragma unroll
    for (int rr = 0; rr < 16; ++rr) { int kl = rr * 4 + rq; tile[kl * 65 + c] = sn >= 0 ? src[(size_t)(k0 + kl) * ldsrc + sn] : 0.f; }
    __syncthreads();
#pragma unroll
    for (int rr = 0; rr < 16; ++rr) { int nl = rr * 4 + rq; dst[(size_t)(n0 + nl) * K + k0 + c] = f2bf(tile[c * 65 + nl]); }
    __syncthreads();
}

DEVI void phase_prep(const Params& p, char* lds, int wv_) {
    float* tile = (float*)lds;
    bf16_t* wsb = (bf16_t*)p.ws;
    constexpr int T_WIN = 16 * 192, T_WBR = 3 * 256, T_WOUT = 256, T_WFI = 16 * 88, T_WFO = 44 * 16, T_L = T_WIN + T_WBR + T_WOUT + T_WFI + T_WFO;
    {   float* dtw = (float*)(p.ws + WS_DTW);
        for (int e = blockIdx.x * 256 + tidx(wv_); e < 32768; e += gridDim.x * 256) { int l = e >> 14, j = (e >> 10) & 15, k = e & 1023; dtw[e] = p.in[I_WIN][(size_t)l * 1024 * 12304 + (size_t)k * 12304 + 3072 + j]; } }
    for (int t = blockIdx.x; t < 2 * T_L; t += gridDim.x) {
        int l = t / T_L, j = t % T_L;
        bf16_t* wl = wsb + (size_t)l * E_LAYER;
        if (j < T_WIN) { int kt = j & 15, nt = j >> 4; transpose_tile(p.in[I_WIN] + (size_t)l * 1024 * 12304, 12304, wl, LDK, kt * 64, nt * 64, 1, tile, wv_); continue; }
        j -= T_WIN;
        if (j < T_WBR) { int k = j >> 8, jj = j & 255, kt = jj & 15, nt = jj >> 4;
            transpose_tile(p.in[I_WBR] + ((size_t)l * 3 + k) * 1024 * 1024, 1024, wl + E_WIN + (size_t)k * 1024 * LDK, LDK, kt * 64, nt * 64, 3, tile, wv_); continue; }
        j -= T_WBR;
        if (j < T_WOUT) { int kt = j & 15, nt = j >> 4; transpose_tile(p.in[I_WOUT] + (size_t)l * 1024 * 1024, 1024, wl + E_WIN + E_WBR, LDK, kt * 64, nt * 64, 0, tile, wv_); continue; }
        j -= T_WOUT;
        if (j < T_WFI) { int kt = j & 15, nt = j >> 4; transpose_tile(p.in[I_WFI] + (size_t)l * 1024 * 5632, 5632, wl + E_WIN + E_WBR + E_WOUT, LDK, kt * 64, nt * 64, 2, tile, wv_); continue; }
        j -= T_WFI;
        { int kt = j % 44, nt = j / 44; transpose_tile(p.in[I_WFO] + (size_t)l * 2816 * 1024, 1024, wl + E_WIN + E_WBR + E_WOUT + E_WFI, LDF, kt * 64, nt * 64, 0, tile, wv_); }
    }
}

DEVI void phase_norm(const Params& p, int seg, int nrows, const float* w, bool from_input, int ldt  , char* lds, int wv_) {
    bf16_t* xb = (bf16_t*)(p.ws + WS_XB); float* dtb = (float*)(p.ws + WS_DT);
    const int lane = tidx(wv_) & 63, wv = tidx(wv_) >> 6;
    float* dw = (float*)lds;
    if (ldt >= 0) { const float* dtw = (const float*)(p.ws + WS_DTW) + ldt * 16384; f32x4 t_[16];
#pragma unroll
        for (int u = 0; u < 16; ++u) t_[u] = *(const f32x4*)(dtw + (tidx(wv_) + 256 * u) * 4);
#pragma unroll
        for (int u = 0; u < 16; ++u) *(f32x4*)(dw + (tidx(wv_) + 256 * u) * 4) = t_[u];
        __syncthreads(); }
    for (int r = blockIdx.x * 4 + wv; r < nrows; r += gridDim.x * 4) {
        const float* x = from_input ? xrow_in(p, seg, r) : xrow_out(p, seg, r);
        f32x4 v[4]; float ss = 0.f;
#pragma unroll
        for (int i = 0; i < 4; ++i) { v[i] = *(const f32x4*)(x + i * 256 + lane * 4); ss += v[i][0] * v[i][0] + v[i][1] * v[i][1] + v[i][2] * v[i][2] + v[i][3] * v[i][3]; }
#pragma unroll
        for (int o = 32; o >= 1; o >>= 1) ss += shflx(ss, o, lane);
        float rs = rsqrtf(ss * (1.f / 1024.f) + 1e-6f);
#pragma unroll
        for (int i = 0; i < 4; ++i) { f32x4 wv4 = *(const f32x4*)(w + i * 256 + lane * 4); us4 o;
            v[i][0] *= rs * wv4[0]; v[i][1] *= rs * wv4[1]; v[i][2] *= rs * wv4[2]; v[i][3] *= rs * wv4[3];
            o[0] = f2bf(v[i][0]); o[1] = f2bf(v[i][1]); o[2] = f2bf(v[i][2]); o[3] = f2bf(v[i][3]);
            *(us4*)(xb + (size_t)r * LDK + i * 256 + lane * 4) = o; }
        if (ldt >= 0) {
            float d[16];
#pragma unroll
            for (int j = 0; j < 16; ++j) { float s = 0.f;
#pragma unroll
                for (int i = 0; i < 4; ++i) { f32x4 ww = *(const f32x4*)(dw + j * 1024 + i * 256 + lane * 4); s += v[i][0] * ww[0] + v[i][1] * ww[1] + v[i][2] * ww[2] + v[i][3] * ww[3]; }
                d[j] = s; }
            { const bool hi = lane & 32;
#pragma unroll
              for (int i = 0; i < 8; ++i) { float send = hi ? d[i] : d[i + 8], keep = hi ? d[i + 8] : d[i]; d[i] = keep + shfli(send, lane ^ 32); } }
            { const bool hi = lane & 16;
#pragma unroll
              for (int i = 0; i < 4; ++i) { float send = hi ? d[i] : d[i + 4], keep = hi ? d[i + 4] : d[i]; d[i] = keep + shfli(send, lane ^ 16); } }
            { const bool hi = lane & 8;
#pragma unroll
              for (int i = 0; i < 2; ++i) { float send = hi ? d[i] : d[i + 2], keep = hi ? d[i + 2] : d[i]; d[i] = keep + shfli(send, lane ^ 8); } }
            { const bool hi = lane & 4; float send = hi ? d[0] : d[1], keep = hi ? d[1] : d[0]; d[0] = keep + shfli(send, lane ^ 4); }
            d[0] += shfli(d[0], lane ^ 2); d[0] += shfli(d[0], lane ^ 1);
            if ((lane & 3) == 0) { int j = lane >> 2; dtb[(size_t)r * 16 + j] = softplus(d[0] + p.in[I_DTB][ldt * 16 + j]); }
        }
    }
    if (ldt >= 0) __syncthreads();
}
DEVI void phase_final_norm(const Params& p, int seg, int nrows, int wv_) {
    const float* w = p.in[I_NFIN];
    const int lane = tidx(wv_) & 63, wv = tidx(wv_) >> 6;
    for (int r = blockIdx.x * 4 + wv; r < nrows; r += gridDim.x * 4) {
        float* x = xrow_out(p, seg, r);
        f32x4 v[4]; float ss = 0.f;
#pragma unroll
        for (int i = 0; i < 4; ++i) { v[i] = *(const f32x4*)(x + i * 256 + lane * 4); ss += v[i][0] * v[i][0] + v[i][1] * v[i][1] + v[i][2] * v[i][2] + v[i][3] * v[i][3]; }
#pragma unroll
        for (int o = 32; o >= 1; o >>= 1) ss += shflx(ss, o, lane);
        float rs = rsqrtf(ss * (1.f / 1024.f) + 1e-6f);
#pragma unroll
        for (int i = 0; i < 4; ++i) { f32x4 wv4 = *(const f32x4*)(w + i * 256 + lane * 4); f32x4 o;
            o[0] = v[i][0] * rs * wv4[0]; o[1] = v[i][1] * rs * wv4[1]; o[2] = v[i][2] * rs * wv4[2]; o[3] = v[i][3] * rs * wv4[3];
            *(f32x4*)(x + i * 256 + lane * 4) = o; }
    }
}
DEVI void phase_mbnorm(const Params& p, int l, int nrows, int wv_) {
    bf16_t* y = (bf16_t*)(p.ws + WS_YMB); const float* w = p.in[I_MBNW] + l * 1024;
    const int lane = tidx(wv_) & 63, wv = tidx(wv_) >> 6;
    for (int it = blockIdx.x * 4 + wv; it < nrows * 4; it += gridDim.x * 4) {
        int r = it >> 2, g = it & 3; bf16_t* yp = y + (size_t)r * LDK + g * 256 + lane * 4;
        us4 v = *(const us4*)yp; float f0 = bf2f(v[0]), f1 = bf2f(v[1]), f2 = bf2f(v[2]), f3 = bf2f(v[3]);
        float ss = f0 * f0 + f1 * f1 + f2 * f2 + f3 * f3;
#pragma unroll
        for (int o = 32; o >= 1; o >>= 1) ss += shflx(ss, o, lane);
        float rs = rsqrtf(ss * (1.f / 256.f) + 1e-6f); f32x4 wv4 = *(const f32x4*)(w + g * 256 + lane * 4);
        us4 o; o[0] = f2bf(f0 * rs * wv4[0]); o[1] = f2bf(f1 * rs * wv4[1]); o[2] = f2bf(f2 * rs * wv4[2]); o[3] = f2bf(f3 * rs * wv4[3]);
        *(us4*)yp = o;
    }
}

#define WAIT_V(n) asm volatile("s_waitcnt vmcnt(" #n ")" ::: "memory")
#define RAW_BAR() do { asm volatile("" ::: "memory"); __builtin_amdgcn_s_barrier(); asm volatile("" ::: "memory"); } while (0)
template <int NF>
DEVI void stage_a(const bf16_t* A, int K, int t, char* st, int tid, size_t soff) {
    const size_t o = soff + (size_t)t * 32;
#pragma unroll
    for (int i = 0; i < 4; ++i) __builtin_amdgcn_global_load_lds((const unsigned*)(A + o + (size_t)i * 64 * K), (unsigned*)(st + tid * 16 + i * 4096), 16, 0, 0);
}
template <int NF>
DEVI void stage_b(const bf16_t* Bt, int K, int t, char* st, int tid, size_t soff) {
    const size_t o = soff + (size_t)t * 32;
#pragma unroll
    for (int i = 0; i < NF / 2; ++i) __builtin_amdgcn_global_load_lds((const unsigned*)(Bt + o + (size_t)i * 64 * K), (unsigned*)(st + 16384 + tid * 16 + i * 4096), 16, 0, 0);
}
template <int NF>
DEVI void gemm_kloop(f32x4 (&acc)[8][NF], const bf16_t* A, const bf16_t* Bt, int K, int ld, char* lds, int wv_) {
    constexpr int STAGE = 16384 + NF * 2048;
    const int tid = tidx(wv_), lane = tid & 63, wid = tid >> 6, wr = wid >> 1, wc = wid & 1, fr = lane & 15, fq = lane >> 4;
    const int fo = fr * 64 + ((fq ^ (0x1320 >> (4 * (fr >> 2)))) & 3) * 16;
    const int aoff = wr * 8192 + fo, boff = 16384 + wc * NF * 1024 + fo;
    const size_t soff = (size_t)(tid >> 2) * ld + ((((tid & 3) ^ (0x1320 >> (4 * ((tid >> 4) & 3)))) & 3) * 8);
    const int nt = K >> 5;
    WAIT_V(0); RAW_BAR();
    stage_a<NF>(A, ld, 0, lds, tid, soff); stage_b<NF>(Bt, ld, 0, lds, tid, soff);
    stage_a<NF>(A, ld, 1, lds + STAGE, tid, soff); stage_b<NF>(Bt, ld, 1, lds + STAGE, tid, soff);
    stage_a<NF>(A, ld, 2, lds + 2 * STAGE, tid, soff); stage_b<NF>(Bt, ld, 2, lds + 2 * STAGE, tid, soff);
    if (NF == 8) WAIT_V(16); else WAIT_V(12);
    RAW_BAR();
    bf16x8 a[8], a01[2][2], b[2][NF];
    a01[0][0] = *(const bf16x8*)(lds + aoff); a01[0][1] = *(const bf16x8*)(lds + aoff + 1024);
#pragma unroll
    for (int n = 0; n < NF; ++n) b[0][n] = *(const bf16x8*)(lds + boff + n * 1024);
#define MMA_1(g_, P_) acc[g_][0] = __builtin_amdgcn_mfma_f32_16x16x32_bf16(b[P_][0], a[g_], acc[g_][0], 0, 0, 0)
#define MMA_R(g_, P_) _Pragma("unroll") for (int n = 1; n < NF; ++n) acc[g_][n] = __builtin_amdgcn_mfma_f32_16x16x32_bf16(b[P_][n], a[g_], acc[g_][n], 0, 0, 0)
#define KBODY(T_, P_, Q_) do { \
        const int T = (T_); const char* st = lds + (T & 3) * STAGE; const char* stn = lds + ((T + 1) & 3) * STAGE; char* st3 = lds + ((T + 3) & 3) * STAGE; \
        a[0] = a01[P_][0]; a[1] = a01[P_][1]; \
        __builtin_amdgcn_sched_barrier(0); MMA_1(0, P_); __builtin_amdgcn_sched_barrier(0); a[2] = *(const bf16x8*)(st + aoff + 2 * 1024); MMA_R(0, P_); \
        __builtin_amdgcn_sched_barrier(0); MMA_1(1, P_); __builtin_amdgcn_sched_barrier(0); a[3] = *(const bf16x8*)(st + aoff + 3 * 1024); MMA_R(1, P_); \
        __builtin_amdgcn_sched_barrier(0); MMA_1(2, P_); __builtin_amdgcn_sched_barrier(0); a[4] = *(const bf16x8*)(st + aoff + 4 * 1024); MMA_R(2, P_); \
        __builtin_amdgcn_sched_barrier(0); MMA_1(3, P_); __builtin_amdgcn_sched_barrier(0); a[5] = *(const bf16x8*)(st + aoff + 5 * 1024); MMA_R(3, P_); \
        __builtin_amdgcn_sched_barrier(0); \
        if (T + 2 < nt) { if (NF == 8) WAIT_V(8); else WAIT_V(6); } else WAIT_V(0); \
        RAW_BAR(); \
        __builtin_amdgcn_sched_barrier(0); MMA_1(4, P_); __builtin_amdgcn_sched_barrier(0); a[6] = *(const bf16x8*)(st + aoff + 6 * 1024); \
        if (T + 3 < nt) stage_a<NF>(A, ld, T + 3, st3, tid, soff); \
        _Pragma("unroll") for (int n = 0; n < NF / 2; ++n) b[Q_][n] = *(const bf16x8*)(stn + boff + n * 1024); \
        MMA_R(4, P_); \
        __builtin_amdgcn_sched_barrier(0); MMA_1(5, P_); __builtin_amdgcn_sched_barrier(0); a[7] = *(const bf16x8*)(st + aoff + 7 * 1024); \
        if (T + 3 < nt) stage_b<NF>(Bt, ld, T + 3, st3, tid, soff); \
        _Pragma("unroll") for (int n = NF / 2; n < NF; ++n) b[Q_][n] = *(const bf16x8*)(stn + boff + n * 1024); \
        MMA_R(5, P_); \
        __builtin_amdgcn_sched_barrier(0); MMA_1(6, P_); __builtin_amdgcn_sched_barrier(0); a01[Q_][0] = *(const bf16x8*)(stn + aoff); MMA_R(6, P_); \
        __builtin_amdgcn_sched_barrier(0); MMA_1(7, P_); __builtin_amdgcn_sched_barrier(0); a01[Q_][1] = *(const bf16x8*)(stn + aoff + 1024); MMA_R(7, P_); \
        __builtin_amdgcn_sched_barrier(0); } while (0)
    for (int t = 0; t < nt; t += 2) { KBODY(t, 0, 1); KBODY(t + 1, 1, 0); }
#undef KBODY
#undef MMA_1
#undef MMA_R
}
DEVI bool next_tile(int it, int MT, int NT, int& mt, int& nt, int wv_) {
    const int x = (wv_ >> 2) & 7, bl = (wv_ >> 5) & 511, G8 = (wv_ >> 14) & 511;
    int j = it * G8 + bl;
    const int nb = 4 * NT;
    if (j < nb) { nt = j >> 2; mt = x + 8 * (j & 3); return true; }
    if (MT == 32) return false;
    j -= nb;
    const int ne = (NT - x + 7) >> 3;
    if (j >= 2 * ne) return false;
    mt = 32 + (j & 1); nt = x + 8 * (j >> 1); return true;
}
#define ZERO_ACC(a, NF_) _Pragma("unroll") for (int m_ = 0; m_ < 8; ++m_) _Pragma("unroll") for (int n_ = 0; n_ < NF_; ++n_) a[m_][n_] = (f32x4){0.f, 0.f, 0.f, 0.f}
#define EPI_IDS const int lane = tidx(wv_) & 63, wid = tidx(wv_) >> 6, wr = wid >> 1, wc = wid & 1, fr = lane & 15, fq = lane >> 4

DEVI void proj_store_row(const f32x4 (&accm)[8], bf16_t* prow, float c1, float c3, bool issig, bool isact) {
#pragma unroll
    for (int q = 0; q < 4; ++q) { __builtin_amdgcn_sched_barrier(0); us8 o;
#pragma unroll
        for (int s = 0; s < 2; ++s)
#pragma unroll
            for (int j = 0; j < 4; ++j) { float x = accm[2 * q + s][j];
                float u = x * (c1 + c3 * x * x); float sg = __builtin_amdgcn_rcpf(1.f + __expf(-u)); float y = sg * (issig ? 1.f : x);
                o[4 * s + j] = f2bf(isact ? y : x); }
        *(us8*)(prow + q * 32) = o; }
}
DEVI void phase_proj(const Params& p, int l, int MT, char* lds, int wv_) {
    const bf16_t* xb = (const bf16_t*)(p.ws + WS_XB); const bf16_t* wt = (const bf16_t*)p.ws + (size_t)l * E_LAYER;
    bf16_t* proj = (bf16_t*)(p.ws + WS_PROJ);
    int mt, nt;
    for (int it = 0; next_tile(it, MT, 48, mt, nt, wv_); ++it) {
        f32x4 acc[8][8]; ZERO_ACC(acc, 8);
        gemm_kloop<8>(acc, xb + (size_t)mt * 256 * LDK, wt + (size_t)nt * 256 * LDK, 1024, LDK, lds, wv_);
        EPI_IDS;
        const int sg = nt >> 2;
        const int ty = (sg == 0 || sg == 3 || sg == 6) ? 1 : (sg == 7 ? 2 : (sg >= 9 ? 3 : 0));
        bf16_t* pbase = proj + (size_t)(mt * 256 + wr * 128 + fr) * NPROJ + nt * 256 + wc * 128 + fq * 8;
        const float c1 = ty == 2 ? 1.5957691216f : 1.f, c3 = ty == 2 ? 0.0713548163f : 0.f;
#pragma unroll
        for (int m = 0; m < 8; ++m) {
#pragma unroll
            for (int n = 0; n < 8; ++n) asm volatile("" : "+v"(acc[m][n]) :: "memory");
            proj_store_row(acc[m], pbase + (size_t)m * 16 * NPROJ, c1, c3, ty == 3, ty != 0); }
    }
}
DEVI void phase_merge(const Params& p, int l, int MT, char* lds, int wv_) {
    const bf16_t* wt = (const bf16_t*)p.ws + (size_t)l * E_LAYER + E_WIN; const bf16_t* proj = (const bf16_t*)(p.ws + WS_PROJ);
    bf16_t* mrg = (bf16_t*)(p.ws + WS_MRG);
    int mt, nt;
    for (int it = 0; next_tile(it, MT, 8, mt, nt, wv_); ++it) {
        f32x4 tot[8][4]; ZERO_ACC(tot, 4);
#pragma unroll 1
        for (int k = 0; k < 3; ++k) {
            const bf16_t* y = (const bf16_t*)(p.ws + WS_YMB + (size_t)k * ROWS * LDK * 2);
            f32x4 acc[8][4]; ZERO_ACC(acc, 4);
            gemm_kloop<4>(acc, y + (size_t)mt * 256 * LDK, wt + (size_t)k * 1024 * LDK + (size_t)nt * 128 * LDK, 1024, LDK, lds, wv_);
            EPI_IDS;
#pragma unroll
            for (int m = 0; m < 8; ++m) { int row = mt * 256 + wr * 128 + m * 16 + fr; asm volatile("" ::: "memory");
#pragma unroll
                for (int q = 0; q < 2; ++q) { int col = nt * 128 + wc * 64 + 32 * q + fq * 8; us8 g = *(const us8*)(proj + (size_t)row * NPROJ + PC_MG + k * 1024 + col);
#pragma unroll
                    for (int s = 0; s < 2; ++s)
#pragma unroll
                        for (int j = 0; j < 4; ++j) tot[m][2 * q + s][j] += acc[m][2 * q + s][j] * bf2f(g[4 * s + j]); } }
        }
        EPI_IDS;
#pragma unroll
        for (int m = 0; m < 8; ++m) { int row = mt * 256 + wr * 128 + m * 16 + fr;
#pragma unroll
            for (int q = 0; q < 2; ++q) { int col = nt * 128 + wc * 64 + 32 * q + fq * 8; us8 o;
#pragma unroll
                for (int s = 0; s < 2; ++s)
#pragma unroll
                    for (int j = 0; j < 4; ++j) o[4 * s + j] = f2bf(tot[m][2 * q + s][j]);
                *(us8*)(mrg + (size_t)row * LDK + col) = o; } }
    }
}
DEVI void phase_resid(const Params& p, int seg, int MT, const bf16_t* A, int K, int ld, const bf16_t* Bt, bool from_input, char* lds, int wv_) {
    int mt, nt;
    for (int it = 0; next_tile(it, MT, 8, mt, nt, wv_); ++it) {
        f32x4 acc[8][4]; ZERO_ACC(acc, 4);
        gemm_kloop<4>(acc, A + (size_t)mt * 256 * ld, Bt + (size_t)nt * 128 * ld, K, ld, lds, wv_);
        EPI_IDS;
#pragma unroll
        for (int m = 0; m < 8; ++m) { int row = mt * 256 + wr * 128 + m * 16 + fr;
            const float* xi = from_input ? xrow_in(p, seg, row) : xrow_out(p, seg, row); float* xo = xrow_out(p, seg, row);
#pragma unroll
            for (int n = 0; n < 4; ++n) { int col = nt * 128 + wc * 64 + n * 16 + fq * 4; f32x4 v = *(const f32x4*)(xi + col); *(f32x4*)(xo + col) = v + acc[m][n]; } }
    }
}
DEVI void phase_ffn_in(const Params& p, int l, int MT, char* lds, int wv_) {
    const bf16_t* xb = (const bf16_t*)(p.ws + WS_XB); const bf16_t* wt = (const bf16_t*)p.ws + (size_t)l * E_LAYER + E_WIN + E_WBR + E_WOUT;
    bf16_t* act = (bf16_t*)(p.ws + WS_PROJ);
    int mt, nt;
    for (int it = 0; next_tile(it, MT, 22, mt, nt, wv_); ++it) {
        f32x4 acc[8][8]; ZERO_ACC(acc, 8);
        gemm_kloop<8>(acc, xb + (size_t)mt * 256 * LDK, wt + (size_t)nt * 256 * LDK, 1024, LDK, lds, wv_);
        EPI_IDS;
#pragma unroll
        for (int m = 0; m < 8; ++m) { int row = mt * 256 + wr * 128 + m * 16 + fr;
#pragma unroll
            for (int n = 0; n < 8; ++n) asm volatile("" : "+v"(acc[m][n]) :: "memory");
#pragma unroll
            for (int G = 0; G < 2; ++G) { int col = (nt * 2 + wc) * 64 + 32 * G + fq * 8; us8 o;
#pragma unroll
                for (int h = 0; h < 2; ++h)
#pragma unroll
                    for (int j = 0; j < 4; ++j) o[4 * h + j] = f2bf(silu(acc[m][4 * G + 2 * h][j]) * acc[m][4 * G + 2 * h + 1][j]);
                *(us8*)(act + (size_t)row * LDF + col) = o; } }
    }
}

struct Seq { int row0, nchunk, Q, b, samp, seg; };
DEVI Seq make_seq(int seg, int sq) { Seq s; s.seg = seg; if (sq < 16) { s.row0 = sq * SEGT; s.nchunk = 8; s.Q = 64; s.b = sq; s.samp = 0; } else { s.b = sq - 16; s.row0 = ROWS_P + s.b * 32; s.nchunk = 1; s.Q = 32; s.samp = 1; } return s; }

template <int NF, int KS>
DEVI void lds_mma(f32x4* acc, const bf16_t* X, int ldx, int m0, const bf16_t* Y, int ldy, int n0, int wv_) {
    const int lane = tidx(wv_) & 63, fr = lane & 15, fq = lane >> 4;
#pragma unroll
    for (int ks = 0; ks < KS; ++ks) {
        bf16x8 a = *(const bf16x8*)(X + (m0 + fr) * ldx + ks * 32 + fq * 8);
#pragma unroll
        for (int nf = 0; nf < NF; ++nf) { bf16x8 b = *(const bf16x8*)(Y + (n0 + nf * 16 + fr) * ldy + ks * 32 + fq * 8); acc[nf] = __builtin_amdgcn_mfma_f32_16x16x32_bf16(a, b, acc[nf], 0, 0, 0); }
    }
}

DEVI void conv_load(uint4 (&r)[4], const bf16_t* proj, int row0, int tq, int pcol) {
#pragma unroll
    for (int k = 0; k < 4; ++k) { int ts = tq - 3 + k; ts = ts < 0 ? 0 : ts; r[k] = *(const uint4*)(proj + (size_t)(row0 + ts) * NPROJ + pcol); }
}
DEVI void touch4(uint4& v) { asm volatile("" : "+v"(v.x), "+v"(v.y), "+v"(v.z), "+v"(v.w)); }
DEVI void conv_compute(const uint4 (&r)[4], int tq, const float* hl, const float* cwl, int HC, int cl, float (&out)[8], float (&raw)[8]) {
    { f32x4 b0 = *(const f32x4*)(cwl + 4 * HC + cl), b1 = *(const f32x4*)(cwl + 4 * HC + cl + 4);
      out[0] = b0[0]; out[1] = b0[1]; out[2] = b0[2]; out[3] = b0[3]; out[4] = b1[0]; out[5] = b1[1]; out[6] = b1[2]; out[7] = b1[3]; }
#pragma unroll
    for (int k = 0; k < 4; ++k) {
        const int ts = tq - 3 + k; float v[8];
        v[0] = __uint_as_float(r[k].x << 16); v[1] = __uint_as_float(r[k].x & 0xffff0000u); v[2] = __uint_as_float(r[k].y << 16); v[3] = __uint_as_float(r[k].y & 0xffff0000u);
        v[4] = __uint_as_float(r[k].z << 16); v[5] = __uint_as_float(r[k].z & 0xffff0000u); v[6] = __uint_as_float(r[k].w << 16); v[7] = __uint_as_float(r[k].w & 0xffff0000u);
        if (k < 3) { int hi = 3 + ts; hi = hi < 0 ? 0 : (hi > 2 ? 2 : hi); const bool uh = ts < 0;
            f32x4 h0 = *(const f32x4*)(hl + hi * HC + cl), h1 = *(const f32x4*)(hl + hi * HC + cl + 4);
            v[0] = uh ? h0[0] : v[0]; v[1] = uh ? h0[1] : v[1]; v[2] = uh ? h0[2] : v[2]; v[3] = uh ? h0[3] : v[3];
            v[4] = uh ? h1[0] : v[4]; v[5] = uh ? h1[1] : v[5]; v[6] = uh ? h1[2] : v[6]; v[7] = uh ? h1[3] : v[7]; }
        f32x4 w0 = *(const f32x4*)(cwl + k * HC + cl), w1 = *(const f32x4*)(cwl + k * HC + cl + 4);
        out[0] += v[0] * w0[0]; out[1] += v[1] * w0[1]; out[2] += v[2] * w0[2]; out[3] += v[3] * w0[3];
        out[4] += v[4] * w1[0]; out[5] += v[5] * w1[1]; out[6] += v[6] * w1[2]; out[7] += v[7] * w1[3];
        if (k == 3) {
#pragma unroll
            for (int e = 0; e < 8; ++e) raw[e] = v[e]; }
    }
}

template <int ROWB>
DEVI void stage_raw(const char* g0, size_t ldgB, char* dst, int tid) {
#pragma unroll
    for (int i = 0; i < ROWB / 64; ++i) { int b = tid * 16 + i * 4096, row = b / ROWB, cb = b % ROWB;
        __builtin_amdgcn_global_load_lds((const unsigned*)(g0 + (size_t)row * ldgB + cb), (unsigned*)(dst + b), 16, 0, 0); }
}
DEVI void conv_lds(const bf16_t* rawt, int RS, int t, int cloc, const float* hl, const float* cwl, int HC, int cl, float (&out)[8], float (&raw)[8]) {
    { f32x4 b0 = *(const f32x4*)(cwl + 4 * HC + cl), b1 = *(const f32x4*)(cwl + 4 * HC + cl + 4);
      out[0] = b0[0]; out[1] = b0[1]; out[2] = b0[2]; out[3] = b0[3]; out[4] = b1[0]; out[5] = b1[1]; out[6] = b1[2]; out[7] = b1[3]; }
#pragma unroll
    for (int k = 0; k < 4; ++k) {
        const int tt = t - 3 + k; const int tc = tt < 0 ? 0 : tt; float v[8];
        const uint4 r = *(const uint4*)(rawt + tc * RS + cloc);
        v[0] = __uint_as_float(r.x << 16); v[1] = __uint_as_float(r.x & 0xffff0000u); v[2] = __uint_as_float(r.y << 16); v[3] = __uint_as_float(r.y & 0xffff0000u);
        v[4] = __uint_as_float(r.z << 16); v[5] = __uint_as_float(r.z & 0xffff0000u); v[6] = __uint_as_float(r.w << 16); v[7] = __uint_as_float(r.w & 0xffff0000u);
        if (k < 3) { int hi = 3 + tt; hi = hi < 0 ? 0 : (hi > 2 ? 2 : hi); const bool uh = tt < 0;
            f32x4 h0 = *(const f32x4*)(hl + hi * HC + cl), h1 = *(const f32x4*)(hl + hi * HC + cl + 4);
            v[0] = uh ? h0[0] : v[0]; v[1] = uh ? h0[1] : v[1]; v[2] = uh ? h0[2] : v[2]; v[3] = uh ? h0[3] : v[3];
            v[4] = uh ? h1[0] : v[4]; v[5] = uh ? h1[1] : v[5]; v[6] = uh ? h1[2] : v[6]; v[7] = uh ? h1[3] : v[7]; }
        f32x4 w0 = *(const f32x4*)(cwl + k * HC + cl), w1 = *(const f32x4*)(cwl + k * HC + cl + 4);
        out[0] += v[0] * w0[0]; out[1] += v[1] * w0[1]; out[2] += v[2] * w0[2]; out[3] += v[3] * w0[3];
        out[4] += v[4] * w1[0]; out[5] += v[5] * w1[1]; out[6] += v[6] * w1[2]; out[7] += v[7] * w1[3];
        if (k == 3) {
#pragma unroll
            for (int e = 0; e < 8; ++e) raw[e] = v[e]; }
    }
}

DEVI void ssd_unit(const Params& p, int l, Seq sq, int hd, char* lds, int wv_) {
    bf16_t* Bm = (bf16_t*)lds;
    bf16_t* R2 = (bf16_t*)(lds + 17408);
    bf16_t* xT = (bf16_t*)(lds + 35840);
    bf16_t* hb = (bf16_t*)(lds + 45056);
    float* fl = (float*)(lds + 62464);
    const int tid = tidx(wv_), lane = tid & 63, w = tid >> 6, fr = lane & 15, fq = lane >> 4;
    const bf16_t* proj = (const bf16_t*)(p.ws + WS_PROJ); const float* dtb = (const float*)(p.ws + WS_DT); bf16_t* ymb = (bf16_t*)(p.ws + WS_YMB);
    const int g = hd >> 2;
    const float a = -__expf(p.in[I_ALOG][l * 16 + hd]), Dv = p.in[I_MBD][l * 16 + hd];
    const float* cw = p.in[I_MCW] + (size_t)l * 4 * 2048; const float* cbias = p.in[I_MCB] + l * 2048;
    float* cwl = (float*)(lds + 63488);
    float* hl = (float*)(lds + 69888);
    const float* st_in; float* st_out; const float* hist; float* hist_out; float* hist_out2 = nullptr;
    float* hbuf = (float*)(p.ws + WS_HB);
    if (sq.samp) { st_in = p.in[I_SSM] + ((size_t)(l * 16 + sq.b) * 16 + hd) * 8192; st_out = p.out + O_SSM_S + ((size_t)(l * 16 + sq.b) * 16 + hd) * 8192;
        hist = p.in[I_SCV] + (size_t)(l * 16 + sq.b) * 3 * 2048; hist_out = p.out + O_SCV_S + (size_t)(l * 16 + sq.b) * 3 * 2048; }
    else { st_out = p.out + O_SSM_P + ((size_t)(l * 16 + sq.b) * 16 + hd) * 8192; st_in = sq.seg ? st_out : nullptr;
        hist_out = hbuf + ((size_t)((sq.seg & 1) * 2 + l) * 16 + sq.b) * 3 * 2048; hist = sq.seg ? hbuf + ((size_t)(((sq.seg + 1) & 1) * 2 + l) * 16 + sq.b) * 3 * 2048 : nullptr;
        if (sq.seg == NSEG - 1) hist_out2 = p.out + O_SCV_P + (size_t)(l * 16 + sq.b) * 3 * 2048; }
    for (int idx = tid; idx < 1600; idx += 256) { int k = idx / 320, cc = idx - k * 320; int ch = cc < 64 ? hd * 64 + cc : (cc < 192 ? 1024 + g * 128 + (cc - 64) : 1536 + g * 128 + (cc - 192));
        cwl[idx] = k < 4 ? cw[k * 2048 + ch] : cbias[ch];
        if (idx < 960) hl[idx] = hist ? hist[k * 2048 + ch] : 0.f; }
    f32x4 hacc[8];
#pragma unroll
    for (int nf = 0; nf < 8; ++nf)
#pragma unroll
        for (int r = 0; r < 4; ++r) { int pp = 16 * w + 4 * fq + r, n = 16 * nf + fr; float v = st_in ? st_in[pp * 128 + n] : 0.f; hacc[nf][r] = v; hb[pp * 136 + n] = f2bf(v); }
    bf16_t* rawX = (bf16_t*)(lds + 77568); bf16_t* rawB = (bf16_t*)(lds + 85760); bf16_t* rawC = (bf16_t*)(lds + 102144); bf16_t* rawZ = (bf16_t*)(lds + 118528); float* rawDt = (float*)(lds + 126720);
    const char* gx = (const char*)(proj + PC_XBC + hd * 64); const char* gb = (const char*)(proj + PC_XBC + 1024 + g * 128); const char* gc = (const char*)(proj + PC_XBC + 1536 + g * 128); const char* gz = (const char*)(proj + PC_Z + hd * 64);
    asm volatile("s_waitcnt vmcnt(0)" ::: "memory");
    {   const size_t ro = (size_t)sq.row0 * NPROJ * 2;
        stage_raw<128>(gx + ro, (size_t)NPROJ * 2, (char*)rawX, tid); stage_raw<256>(gb + ro, (size_t)NPROJ * 2, (char*)rawB, tid); stage_raw<256>(gc + ro, (size_t)NPROJ * 2, (char*)rawC, tid);
        stage_raw<128>(gz + ro, (size_t)NPROJ * 2, (char*)rawZ, tid); stage_raw<64>((const char*)(dtb + (size_t)sq.row0 * 16), 64, (char*)rawDt, tid); }
    for (int c = 0; c < sq.nchunk; ++c) {
        const int tid = tidx(wv_), lane = tid & 63, w = tid >> 6, fr = lane & 15, fq = lane >> 4;
        const int rowc = sq.row0 + c * 64; const bool lastc = (c == sq.nchunk - 1);
        const float* hlr = hl + (c & 1) * 960; float* hlw = hl + ((c + 1) & 1) * 960;
        asm volatile("s_waitcnt vmcnt(0)" ::: "memory");
        __syncthreads();
        if (w == 0) {
            float dt = lane < sq.Q ? rawDt[lane * 16 + hd] : 0.f; float v = dt * a;
#pragma unroll
            for (int o = 1; o < 64; o <<= 1) { float t = shfli(v, lane - o); if (lane >= o) v += t; }
            float last = shfli(v, 63);
            fl[lane] = v; fl[64 + lane] = dt; fl[128 + lane] = __expf(last - v) * dt; fl[192 + lane] = __expf(v);
        }
        __syncthreads();
        const float elast = __expf(fl[63]);
#pragma unroll
        for (int i = 0; i < 2; ++i) { int it = tid + 256 * i, t = it >> 3, c8 = (it & 7) * 8; float o[8], raw[8]; int ch = hd * 64 + c8; const bool tv = t < sq.Q;
            conv_lds(rawX, 64, t, c8, hlr, cwl, 320, c8, o, raw);
#pragma unroll
            for (int e = 0; e < 8; ++e) { float s_ = silu(o[e]); o[e] = tv ? s_ : 0.f; }
            if (t >= 61) {
#pragma unroll
                for (int e = 0; e < 8; ++e) hlw[(t - 61) * 320 + c8 + e] = raw[e]; }
            if (lastc && tv && t >= sq.Q - 3) {
#pragma unroll
                for (int e = 0; e < 8; ++e) { hist_out[(t - (sq.Q - 3)) * 2048 + ch + e] = raw[e]; if (hist_out2) hist_out2[(t - (sq.Q - 3)) * 2048 + ch + e] = raw[e]; } }
#pragma unroll
            for (int e = 0; e < 8; ++e) xT[(c8 + e) * 72 + t] = f2bf(o[e]); }
#pragma unroll
        for (int i = 0; i < 4; ++i) { int it = tid + 256 * i, t = it >> 4, c8 = (it & 15) * 8; float o[8], raw[8]; int ch = 1024 + g * 128 + c8; const bool tv = t < sq.Q;
            conv_lds(rawB, 128, t, c8, hlr, cwl, 320, 64 + c8, o, raw);
#pragma unroll
            for (int e = 0; e < 8; ++e) { float s_ = silu(o[e]); o[e] = tv ? s_ : 0.f; }
            if (t >= 61) {
#pragma unroll
                for (int e = 0; e < 8; ++e) hlw[(t - 61) * 320 + 64 + c8 + e] = raw[e]; }
            if (lastc && tv && (hd & 3) == 0 && t >= sq.Q - 3) {
#pragma unroll
                for (int e = 0; e < 8; ++e) { hist_out[(t - (sq.Q - 3)) * 2048 + ch + e] = raw[e]; if (hist_out2) hist_out2[(t - (sq.Q - 3)) * 2048 + ch + e] = raw[e]; } }
            us8 ov; float we = fl[128 + t];
#pragma unroll
            for (int e = 0; e < 8; ++e) { ov[e] = f2bf(o[e]); R2[(c8 + e) * 72 + t] = f2bf(o[e] * we); }
            *(us8*)(Bm + t * 136 + c8) = ov; }
        __syncthreads();
#pragma unroll
        for (int nf = 0; nf < 8; ++nf) hacc[nf] *= elast;
        lds_mma<8, 2>(hacc, xT, 72, 16 * w, R2, 72, 0, wv_);
        __syncthreads();
#pragma unroll
        for (int i = 0; i < 4; ++i) { int it = tid + 256 * i, t = it >> 4, c8 = (it & 15) * 8; float o[8], raw[8]; int ch = 1536 + g * 128 + c8; const bool tv = t < sq.Q;
            conv_lds(rawC, 128, t, c8, hlr, cwl, 320, 192 + c8, o, raw);
#pragma unroll
            for (int e = 0; e < 8; ++e) { float s_ = silu(o[e]); o[e] = tv ? s_ : 0.f; }
            if (t >= 61) {
#pragma unroll
                for (int e = 0; e < 8; ++e) hlw[(t - 61) * 320 + 192 + c8 + e] = raw[e]; }
            if (lastc && tv && (hd & 3) == 0 && t >= sq.Q - 3) {
#pragma unroll
                for (int e = 0; e < 8; ++e) { hist_out[(t - (sq.Q - 3)) * 2048 + ch + e] = raw[e]; if (hist_out2) hist_out2[(t - (sq.Q - 3)) * 2048 + ch + e] = raw[e]; } }
            us8 ov;
#pragma unroll
            for (int e = 0; e < 8; ++e) ov[e] = f2bf(o[e]);
            *(us8*)(R2 + t * 136 + c8) = ov; }
        us4 zr[4];
#pragma unroll
        for (int nf = 0; nf < 4; ++nf) zr[nf] = *(const us4*)(rawZ + (16 * nf + fr) * 64 + 16 * w + 4 * fq);
        __syncthreads();
        if (!lastc) { const size_t ro = (size_t)(rowc + 64) * NPROJ * 2;
            stage_raw<128>(gx + ro, (size_t)NPROJ * 2, (char*)rawX, tid); stage_raw<256>(gb + ro, (size_t)NPROJ * 2, (char*)rawB, tid); stage_raw<256>(gc + ro, (size_t)NPROJ * 2, (char*)rawC, tid);
            stage_raw<128>(gz + ro, (size_t)NPROJ * 2, (char*)rawZ, tid); stage_raw<64>((const char*)(dtb + (size_t)(rowc + 64) * 16), 64, (char*)rawDt, tid); }
        f32x4 cbv[4];
#pragma unroll
        for (int nf = 0; nf < 4; ++nf) cbv[nf] = (f32x4){0.f, 0.f, 0.f, 0.f};
        lds_mma<4, 4>(cbv, Bm, 136, 16 * w, R2, 136, 0, wv_);
        __syncthreads();
#pragma unroll
        for (int nf = 0; nf < 4; ++nf) { int i = 16 * nf + fr; float ai = fl[i]; us4 o;
#pragma unroll
            for (int r = 0; r < 4; ++r) { int j = 16 * w + 4 * fq + r; float v = (j <= i) ? cbv[nf][r] * __expf(ai - fl[j]) * fl[64 + j] : 0.f; o[r] = f2bf(v); }
            *(us4*)(Bm + i * 72 + 16 * w + 4 * fq) = o; }
        __syncthreads();
        f32x4 ya[4];
#pragma unroll
        for (int nf = 0; nf < 4; ++nf) ya[nf] = (f32x4){0.f, 0.f, 0.f, 0.f};
        lds_mma<4, 4>(ya, hb, 136, 16 * w, R2, 136, 0, wv_);
#pragma unroll
        for (int nf = 0; nf < 4; ++nf) ya[nf] *= fl[192 + 16 * nf + fr];
        lds_mma<4, 2>(ya, xT, 72, 16 * w, Bm, 72, 0, wv_);
#pragma unroll
        for (int nf = 0; nf < 4; ++nf) { int i = 16 * nf + fr, p0 = 16 * w + 4 * fq;
            us4 z = zr[nf];
            if (i < sq.Q) { us4 o;
#pragma unroll
                for (int r = 0; r < 4; ++r) o[r] = f2bf((ya[nf][r] + Dv * bf2f(xT[(p0 + r) * 72 + i])) * bf2f(z[r]));
                *(us4*)(ymb + (size_t)(rowc + i) * LDK + hd * 64 + p0) = o; } }
        __syncthreads();
#pragma unroll
        for (int nf = 0; nf < 8; ++nf)
#pragma unroll
            for (int r = 0; r < 4; ++r) hb[(16 * w + 4 * fq + r) * 136 + 16 * nf + fr] = f2bf(hacc[nf][r]);
    }
#pragma unroll
    for (int nf = 0; nf < 8; ++nf)
#pragma unroll
        for (int r = 0; r < 4; ++r) st_out[(16 * w + 4 * fq + r) * 128 + 16 * nf + fr] = hacc[nf][r];
    __syncthreads();
}

DEVI void hgrn_unit(const Params& p, int l, Seq sq, int h, char* lds, int wv_) {
    bf16_t* sb = (bf16_t*)lds;
    bf16_t* qt = (bf16_t*)(lds + 34816);
    bf16_t* kt = (bf16_t*)(lds + 52224);
    bf16_t* att = (bf16_t*)lds;
    bf16_t* kT = (bf16_t*)(lds + 9216);
    bf16_t* vT = (bf16_t*)(lds + 27648);
    float* T0 = (float*)(lds + 69632); float* T1 = T0 + 128; float* ssq = T0 + 256;
    const int tid = tidx(wv_), lane = tid & 63, w = tid >> 6, fr = lane & 15, fq = lane >> 4;
    const int k = tid & 127, half = tid >> 7;
    const bf16_t* proj = (const bf16_t*)(p.ws + WS_PROJ); bf16_t* yhg = (bf16_t*)(p.ws + WS_YHG);
    float lb = 0.f;
    if (l == 1) { float a0 = p.in[I_LBL][h * 128 + k], a1 = p.in[I_LBL][1024 + h * 128 + k]; lb = 1.f / (1.f + __expf(a0 - a1)); }
    const float* nw = p.in[I_HGNW] + l * 128;
    const float* st_in; float* st_out;
    if (sq.samp) { st_in = p.in[I_HG] + ((size_t)(l * 16 + sq.b) * 8 + h) * 16384; st_out = p.out + O_HG_S + ((size_t)(l * 16 + sq.b) * 8 + h) * 16384; }
    else { st_out = p.out + O_HG_P + ((size_t)(l * 16 + sq.b) * 8 + h) * 16384; st_in = sq.seg ? st_out : nullptr; }
    f32x4 hacc[2][8];
#pragma unroll
    for (int mf = 0; mf < 2; ++mf)
#pragma unroll
        for (int nf = 0; nf < 8; ++nf)
#pragma unroll
            for (int r = 0; r < 4; ++r) hacc[mf][nf][r] = st_in ? st_in[(32 * w + 16 * mf + 4 * fq + r) * 128 + 16 * nf + fr] : 0.f;
    f32x4 nwr[2];
#pragma unroll
    for (int mf = 0; mf < 2; ++mf) nwr[mf] = *(const f32x4*)(nw + 32 * w + 16 * mf + 4 * fq);
    bf16_t* rawF = (bf16_t*)(lds + 71680); bf16_t* rawQ = (bf16_t*)(lds + 88064); bf16_t* rawV = (bf16_t*)(lds + 104448); bf16_t* rawH = (bf16_t*)(lds + 120832);
    const char* gf = (const char*)(proj + PC_HF + h * 128); const char* gq = (const char*)(proj + PC_HQ + h * 128); const char* gv = (const char*)(proj + PC_HI + h * 128); const char* gh = (const char*)(proj + PC_HGATE + h * 128);
    asm volatile("s_waitcnt vmcnt(0)" ::: "memory");
    {   const size_t ro = (size_t)sq.row0 * NPROJ * 2;
        stage_raw<256>(gf + ro, (size_t)NPROJ * 2, (char*)rawF, tid); stage_raw<256>(gq + ro, (size_t)NPROJ * 2, (char*)rawQ, tid); stage_raw<256>(gv + ro, (size_t)NPROJ * 2, (char*)rawV, tid); }
    for (int c = 0; c < sq.nchunk; ++c) {
        const int tid = tidx(wv_), lane = tid & 63, w = tid >> 6, fr = lane & 15, fq = lane >> 4, k = tid & 127, half = tid >> 7;
        const int rowc = sq.row0 + c * 64; const bool lastc = (c == sq.nchunk - 1);
        asm volatile("s_waitcnt vmcnt(0)" ::: "memory");
        __syncthreads();
        stage_raw<256>(gh + (size_t)rowc * NPROJ * 2, (size_t)NPROJ * 2, (char*)rawH, tid);
        {
            unsigned fu[32], qu[32];
#pragma unroll
            for (int jj = 0; jj < 32; ++jj) { fu[jj] = rawF[(32 * half + jj) * 128 + k]; qu[jj] = rawQ[(32 * half + jj) * 128 + k]; }
            if (tid < 64) ssq[tid] = 0.f;
            float run = 0.f;
            if (half == 0) {
#pragma unroll
                for (int jj = 31; jj >= 0; --jj) { bool valid = jj < sq.Q; float f = __uint_as_float(fu[jj] << 16);
                    float sg = __builtin_amdgcn_rcpf(1.f + __expf(-f)); float lg0 = __logf(lb + (1.f - lb) * sg); float lg = valid ? lg0 : 0.f;
                    float kk0 = (1.f - lb) * (1.f - sg); float kk = valid ? kk0 : 0.f; float q0 = __uint_as_float(qu[jj] << 16); float q = valid ? q0 : 0.f;
                    qt[jj * 136 + k] = f2bf(q * cexp(-run)); kt[jj * 136 + k] = f2bf(kk * cexp(run)); run += lg; }
                T0[k] = run;
            } else {
#pragma unroll
                for (int jj = 0; jj < 32; ++jj) { bool valid = (32 + jj) < sq.Q; float f = __uint_as_float(fu[jj] << 16);
                    float sg = __builtin_amdgcn_rcpf(1.f + __expf(-f)); float lg0 = __logf(lb + (1.f - lb) * sg); float lg = valid ? lg0 : 0.f;
                    float kk0 = (1.f - lb) * (1.f - sg); float kk = valid ? kk0 : 0.f; float q0 = __uint_as_float(qu[jj] << 16); float q = valid ? q0 : 0.f;
                    run += lg; qt[(32 + jj) * 136 + k] = f2bf(q * cexp(run)); kt[(32 + jj) * 136 + k] = f2bf(kk * cexp(-run)); }
                T1[k] = run;
            }
        }
        __syncthreads();
#pragma unroll
        for (int mf = 0; mf < 2; ++mf) { int k0 = 32 * w + 16 * mf + 4 * fq; float e0 = __expf(T0[k0]), e1 = __expf(T0[k0 + 1]), e2 = __expf(T0[k0 + 2]), e3 = __expf(T0[k0 + 3]);
#pragma unroll
            for (int nf = 0; nf < 8; ++nf) { hacc[mf][nf][0] *= e0; hacc[mf][nf][1] *= e1; hacc[mf][nf][2] *= e2; hacc[mf][nf][3] *= e3;
                us4 o; o[0] = f2bf(hacc[mf][nf][0]); o[1] = f2bf(hacc[mf][nf][1]); o[2] = f2bf(hacc[mf][nf][2]); o[3] = f2bf(hacc[mf][nf][3]);
                *(us4*)(sb + (16 * nf + fr) * 136 + k0) = o; } }
        f32x4 at[4];
#pragma unroll
        for (int nf = 0; nf < 4; ++nf) at[nf] = (f32x4){0.f, 0.f, 0.f, 0.f};
        lds_mma<4, 4>(at, kt, 136, 16 * w, qt, 136, 0, wv_);
        __syncthreads();
        f32x4 oacc[2][4];
#pragma unroll
        for (int mf = 0; mf < 2; ++mf) {
#pragma unroll
            for (int nf = 0; nf < 4; ++nf) oacc[mf][nf] = (f32x4){0.f, 0.f, 0.f, 0.f};
            lds_mma<4, 4>(oacc[mf], sb, 136, 32 * w + 16 * mf, qt, 136, 0, wv_); }
        __syncthreads();
#pragma unroll
        for (int nf = 0; nf < 4; ++nf) { int i = 16 * nf + fr; us4 o;
#pragma unroll
            for (int r = 0; r < 4; ++r) { int j = 16 * w + 4 * fq + r; o[r] = f2bf(j <= i ? at[nf][r] : 0.f); }
            *(us4*)(att + i * 72 + 16 * w + 4 * fq) = o; }
        {   unsigned vu[32];
#pragma unroll
            for (int jj = 0; jj < 32; ++jj) vu[jj] = rawV[(32 * half + jj) * 128 + k];
#pragma unroll
            for (int q4 = 0; q4 < 4; ++q4) { us8 kv, vv;
#pragma unroll
                for (int e = 0; e < 8; ++e) { int jj = q4 * 8 + e; bool valid = (32 * half + jj) < sq.Q; kv[e] = kt[(32 * half + jj) * 136 + k]; vv[e] = valid ? (bf16_t)vu[jj] : (bf16_t)0; }
                *(us8*)(kT + k * 72 + 32 * half + q4 * 8) = kv; *(us8*)(vT + k * 72 + 32 * half + q4 * 8) = vv; } }
        __syncthreads();
        if (!lastc) { const size_t ro = (size_t)(rowc + 64) * NPROJ * 2;
            stage_raw<256>(gf + ro, (size_t)NPROJ * 2, (char*)rawF, tid); stage_raw<256>(gq + ro, (size_t)NPROJ * 2, (char*)rawQ, tid); stage_raw<256>(gv + ro, (size_t)NPROJ * 2, (char*)rawV, tid); }
#pragma unroll
        for (int mf = 0; mf < 2; ++mf) {
            lds_mma<4, 2>(oacc[mf], vT, 72, 32 * w + 16 * mf, att, 72, 0, wv_);
            lds_mma<8, 2>(hacc[mf], kT, 72, 32 * w + 16 * mf, vT, 72, 0, wv_);
            int k0 = 32 * w + 16 * mf + 4 * fq; float e0 = __expf(T1[k0]), e1 = __expf(T1[k0 + 1]), e2 = __expf(T1[k0 + 2]), e3 = __expf(T1[k0 + 3]);
#pragma unroll
            for (int nf = 0; nf < 8; ++nf) { hacc[mf][nf][0] *= e0; hacc[mf][nf][1] *= e1; hacc[mf][nf][2] *= e2; hacc[mf][nf][3] *= e3; } }
#pragma unroll
        for (int nf = 0; nf < 4; ++nf) { float s = 0.f;
#pragma unroll
            for (int mf = 0; mf < 2; ++mf)
#pragma unroll
                for (int r = 0; r < 4; ++r) s += oacc[mf][nf][r] * oacc[mf][nf][r];
            s += shflx(s, 16, lane); s += shflx(s, 32, lane);
            if (fq == 0) atomicAdd(&ssq[16 * nf + fr], s); }
        if (lastc) asm volatile("s_waitcnt vmcnt(0)" ::: "memory"); else asm volatile("s_waitcnt vmcnt(12)" ::: "memory");
        __syncthreads();
#pragma unroll
        for (int nf = 0; nf < 4; ++nf) { int i = 16 * nf + fr; float rs = rsqrtf(ssq[i] * (1.f / 128.f) + 1e-6f);
#pragma unroll
            for (int mf = 0; mf < 2; ++mf) { int v0 = 32 * w + 16 * mf + 4 * fq; us4 gt = *(const us4*)(rawH + i * 128 + v0); f32x4 wv = nwr[mf]; us4 o;
#pragma unroll
                for (int r = 0; r < 4; ++r) o[r] = f2bf(oacc[mf][nf][r] * rs * wv[r] * bf2f(gt[r]));
                if (i < sq.Q) *(us4*)(yhg + (size_t)(rowc + i) * LDK + h * 128 + v0) = o; } }
        __syncthreads();
    }
#pragma unroll
    for (int mf = 0; mf < 2; ++mf)
#pragma unroll
        for (int nf = 0; nf < 8; ++nf)
#pragma unroll
            for (int r = 0; r < 4; ++r) st_out[(32 * w + 16 * mf + 4 * fq + r) * 128 + 16 * nf + fr] = hacc[mf][nf][r];
}

DEVI void rg_unit(const Params& p, int l, Seq sq, int blk, char* lds, int wv_) {
    bf16_t* waT = (bf16_t*)lds; bf16_t* wiT = (bf16_t*)(lds + 9216); bf16_t* xr = (bf16_t*)(lds + 18432);
    float* av = (float*)(lds + 27648); float* uv = (float*)(lds + 44288); float* Pq = (float*)(lds + 60928); float* Hq = Pq + 256; float* carry = Hq + 256;
    const int tid = tidx(wv_), lane = tid & 63, w = tid >> 6, fr = lane & 15, fq = lane >> 4;
    const bf16_t* proj = (const bf16_t*)(p.ws + WS_PROJ); bf16_t* yrg = (bf16_t*)(p.ws + WS_YRG);
    const int cb0 = blk * 64;
    const float* cw = p.in[I_RCW] + (size_t)l * 4 * 1024; const float* cbias = p.in[I_RCB] + l * 1024;
    const float* st_in; float* st_out; const float* hist; float* hist_out;
    if (sq.samp) { st_in = p.in[I_RG] + (size_t)(l * 16 + sq.b) * 1024; st_out = p.out + O_RG_S + (size_t)(l * 16 + sq.b) * 1024;
        hist = p.in[I_RCV] + (size_t)(l * 16 + sq.b) * 3 * 1024; hist_out = p.out + O_RCV_S + (size_t)(l * 16 + sq.b) * 3 * 1024; }
    else { st_out = p.out + O_RG_P + (size_t)(l * 16 + sq.b) * 1024; st_in = sq.seg ? st_out : nullptr;
        hist_out = p.out + O_RCV_P + (size_t)(l * 16 + sq.b) * 3 * 1024; hist = sq.seg ? hist_out : nullptr; }
    float* cwl = (float*)(lds + 63232);
    float* hl = (float*)(lds + 64512);
    float* hl2 = (float*)(lds + 90112);
    for (int idx = tid; idx < 320; idx += 256) { int k = idx >> 6, cc = idx & 63; cwl[idx] = k < 4 ? cw[k * 1024 + cb0 + cc] : cbias[cb0 + cc]; if (idx < 192) hl[idx] = hist ? hist[k * 1024 + cb0 + cc] : 0.f; }
    {   const float* wa = p.in[I_RWA] + ((size_t)l * 16 + blk) * 4096; const float* wi = p.in[I_RWI] + ((size_t)l * 16 + blk) * 4096;
        float wa_[16], wi_[16];
#pragma unroll
        for (int u = 0; u < 16; ++u) { wa_[u] = wa[tid + 256 * u]; wi_[u] = wi[tid + 256 * u]; }
#pragma unroll
        for (int u = 0; u < 16; ++u) { int e = tid + 256 * u, i = e >> 6, j = e & 63; waT[j * 72 + i] = f2bf(wa_[u]); wiT[j * 72 + i] = f2bf(wi_[u]); }
        if (tid < 64) carry[tid] = st_in ? st_in[cb0 + tid] : 0.f; }
    float cba[4], cbi[4], csp[4];
#pragma unroll
    for (int nf = 0; nf < 4; ++nf) { int cc = cb0 + 16 * nf + fr; cba[nf] = p.in[I_RBA][l * 1024 + cc]; cbi[nf] = p.in[I_RBI][l * 1024 + cc]; csp[nf] = softplus(-p.in[I_RLAM][l * 1024 + cc]); }
    bf16_t* rawR = (bf16_t*)(lds + 65536); bf16_t* rawG = (bf16_t*)(lds + 73728);
    const char* gr = (const char*)(proj + PC_RX + cb0); const char* gg = (const char*)(proj + PC_RGATE + cb0);
    asm volatile("s_waitcnt vmcnt(0)" ::: "memory");
    stage_raw<128>(gr + (size_t)sq.row0 * NPROJ * 2, (size_t)NPROJ * 2, (char*)rawR, tid); stage_raw<128>(gg + (size_t)sq.row0 * NPROJ * 2, (size_t)NPROJ * 2, (char*)rawG, tid);
    for (int c = 0; c < sq.nchunk; ++c) {
        const int tid = tidx(wv_), lane = tid & 63, w = tid >> 6, fr = lane & 15, fq = lane >> 4, j = tid & 63, q = tid >> 6;
        const int rowc = sq.row0 + c * 64; const bool lastc = (c == sq.nchunk - 1);
        const float* hlr = (c & 1) ? hl2 : hl; float* hlw = (c & 1) ? hl : hl2;
        asm volatile("s_waitcnt vmcnt(0)" ::: "memory");
        __syncthreads();
#pragma unroll
        for (int i = 0; i < 2; ++i) { int it = tid + 256 * i, t = it >> 3, c8 = (it & 7) * 8; float o[8], raw[8]; int ch = cb0 + c8; const bool tv = t < sq.Q;
            conv_lds(rawR, 64, t, c8, hlr, cwl, 64, c8, o, raw);
            if (t >= 61) {
#pragma unroll
                for (int e = 0; e < 8; ++e) hlw[(t - 61) * 64 + c8 + e] = raw[e]; }
            if (lastc && tv && t >= sq.Q - 3) {
#pragma unroll
                for (int e = 0; e < 8; ++e) hist_out[(t - (sq.Q - 3)) * 1024 + ch + e] = raw[e]; }
            us8 ov;
#pragma unroll
            for (int e = 0; e < 8; ++e) { float ox = tv ? o[e] : 0.f; ov[e] = f2bf(ox); uv[t * 65 + c8 + e] = ox; }
            *(us8*)(xr + t * 72 + c8) = ov; }
        __syncthreads();
        if (!lastc) { const size_t ro = (size_t)(rowc + 64) * NPROJ * 2; stage_raw<128>(gr + ro, (size_t)NPROJ * 2, (char*)rawR, tid); stage_raw<128>(gg + ro, (size_t)NPROJ * 2, (char*)(rawG + ((c + 1) & 1) * 4096), tid); }
        f32x4 ra[4], ri[4];
#pragma unroll
        for (int nf = 0; nf < 4; ++nf) { ra[nf] = (f32x4){0.f, 0.f, 0.f, 0.f}; ri[nf] = (f32x4){0.f, 0.f, 0.f, 0.f}; }
        lds_mma<4, 2>(ra, xr, 72, 16 * w, waT, 72, 0, wv_);
        lds_mma<4, 2>(ri, xr, 72, 16 * w, wiT, 72, 0, wv_);
#pragma unroll
        for (int nf = 0; nf < 4; ++nf) { int jj = 16 * nf + fr; float ba = cba[nf], bi = cbi[nf], sp = csp[nf];
#pragma unroll
            for (int r = 0; r < 4; ++r) { int t = 16 * w + 4 * fq + r; float rr = sigm(ra[nf][r] + ba), ii = sigm(ri[nf][r] + bi); float la = -8.f * sp * rr; float aa = __expf(la);
                float u = __builtin_sqrtf(fmaxf(1.f - aa * aa, 0.f)) * ii * uv[t * 65 + jj];
                if (t >= sq.Q) { aa = 1.f; u = 0.f; }
                av[t * 65 + jj] = aa; uv[t * 65 + jj] = u; } }
        __syncthreads();
        { float P = 1.f, H = 0.f;
#pragma unroll
          for (int tt = 0; tt < 16; ++tt) { int t = 16 * q + tt; float aa = av[t * 65 + j], u = uv[t * 65 + j]; H = aa * H + u; P *= aa; }
          Pq[q * 64 + j] = P; Hq[q * 64 + j] = H; }
        __syncthreads();
        float hcur = carry[j];
        for (int qq = 0; qq < q; ++qq) hcur = Pq[qq * 64 + j] * hcur + Hq[qq * 64 + j];
        const bf16_t* rg_ = rawG + (c & 1) * 4096;
        bf16_t gts[16];
#pragma unroll
        for (int tt = 0; tt < 16; ++tt) gts[tt] = rg_[(16 * q + tt) * 64 + j];
#pragma unroll
        for (int tt = 0; tt < 16; ++tt) { int t = 16 * q + tt; float aa = av[t * 65 + j], u = uv[t * 65 + j]; hcur = aa * hcur + u;
            if (t < sq.Q) yrg[(size_t)(rowc + t) * LDK + cb0 + j] = f2bf(bf2f(gts[tt]) * hcur); }
        __syncthreads();
        if (q == 3) carry[j] = hcur;
        __syncthreads();
    }
    if (tid < 64) st_out[cb0 + tid] = carry[tid];
    __syncthreads();
}

DEVI void phase_mix(const Params& p, int l, int seg, char* lds, int wv_) {
    const int ngrp = seg == 0 ? 2 : 1; const int NU = ngrp * 640;
    unsigned* qctr = (unsigned*)(p.ws + WS_END) + 1 + (seg * 2 + l);
    volatile int* sh = (volatile int*)(lds + 147440);
    for (;;) {
        if (tidx(wv_) == 0) sh[0] = (int)__hip_atomic_fetch_add(qctr, 1u, __ATOMIC_RELAXED, __HIP_MEMORY_SCOPE_AGENT);
        __syncthreads();
        const int u = __builtin_amdgcn_readfirstlane(sh[0]);
        __syncthreads();
        if (u >= NU) break;
        int grp = u / 640, v = u % 640;
        if (v < 128) hgrn_unit(p, l, make_seq(seg, grp * 16 + (v >> 3)), v & 7, lds, wv_);
        else if (v < 384) { v -= 128; ssd_unit(p, l, make_seq(seg, grp * 16 + (v >> 4)), v & 15, lds, wv_); }
        else { v -= 384; rg_unit(p, l, make_seq(seg, grp * 16 + (v >> 4)), v & 15, lds, wv_); }
        __syncthreads();
    }
}

DEVI void gbar(const Params& p, unsigned& epoch_, int wv_) {
    const unsigned epoch = __builtin_amdgcn_readfirstlane(epoch_); epoch_ = epoch + 1u;
    unsigned* bw = (unsigned*)(p.ws + WS_END); asm volatile("" : "+s"(bw));
    asm volatile("s_waitcnt vmcnt(0)" ::: "memory");
    __syncthreads();
    if (tidx(wv_) == 0) {
        if ((wv_ >> 23) & 1) {
            const unsigned x = (wv_ >> 2) & 7, NB = (wv_ >> 14) & 511;
            const unsigned old = __hip_atomic_fetch_add(bw + 32 + x, 1u, __ATOMIC_RELAXED, __HIP_MEMORY_SCOPE_AGENT);
            if (old + 1u == (epoch + 1u) * NB) {
                __builtin_amdgcn_fence(__ATOMIC_RELEASE, "agent");
                asm volatile("s_waitcnt vmcnt(0)" ::: "memory");
                const unsigned og = __hip_atomic_fetch_add(bw + 56, 1u, __ATOMIC_RELAXED, __HIP_MEMORY_SCOPE_AGENT);
                if (og + 1u == (epoch + 1u) * 8u) __hip_atomic_fetch_add(bw + 57, 1u, __ATOMIC_RELAXED, __HIP_MEMORY_SCOPE_AGENT);
                else while (__hip_atomic_load(bw + 57, __ATOMIC_RELAXED, __HIP_MEMORY_SCOPE_AGENT) < epoch + 1u) __builtin_amdgcn_s_sleep(1);
                __builtin_amdgcn_fence(__ATOMIC_ACQUIRE, "agent");
                __hip_atomic_fetch_add(bw + 48 + x, 1u, __ATOMIC_RELAXED, __HIP_MEMORY_SCOPE_AGENT);
                asm volatile("s_waitcnt vmcnt(0)" ::: "memory");
            } else {
                while (__hip_atomic_load(bw + 48 + x, __ATOMIC_RELAXED, __HIP_MEMORY_SCOPE_AGENT) < epoch + 1u) __builtin_amdgcn_s_sleep(1);
                __builtin_amdgcn_fence(__ATOMIC_ACQUIRE, "agent");
                asm volatile("s_waitcnt vmcnt(0)" ::: "memory");
            }
        } else {
            __builtin_amdgcn_fence(__ATOMIC_RELEASE, "agent");
            asm volatile("s_waitcnt vmcnt(0)" ::: "memory");
            __hip_atomic_fetch_add(bw, 1u, __ATOMIC_RELAXED, __HIP_MEMORY_SCOPE_AGENT);
            const unsigned target = (epoch + 1u) * gridDim.x;
            while (__hip_atomic_load(bw, __ATOMIC_RELAXED, __HIP_MEMORY_SCOPE_AGENT) < target) __builtin_amdgcn_s_sleep(1);
            __builtin_amdgcn_fence(__ATOMIC_ACQUIRE, "agent");
            asm volatile("s_waitcnt vmcnt(0)" ::: "memory");
        }
    }
    __syncthreads();
}

__global__ void __launch_bounds__(256) fwd_mega(Params p) {
    extern __shared__ __attribute__((aligned(16))) char lds[];
    int wv_ = __builtin_amdgcn_readfirstlane((int)(__builtin_amdgcn_workitem_id_x() >> 6));
    cg::grid_group grid = cg::this_grid();
    unsigned* xcnt = (unsigned*)(p.ws + WS_END) + 16;
    const int xcc = (int)(__builtin_amdgcn_s_getreg((3 << 11) | 20) & 7u);
    int xrank;
    { int* sh = (int*)lds; if (__builtin_amdgcn_workitem_id_x() == 0) sh[0] = (int)__hip_atomic_fetch_add(xcnt + xcc, 1u, __ATOMIC_RELAXED, __HIP_MEMORY_SCOPE_AGENT); __syncthreads(); xrank = __builtin_amdgcn_readfirstlane(sh[0]); __syncthreads(); }
    unsigned epoch = 0;
    phase_prep(p, lds, wv_);
    grid.sync();
    {   unsigned c[8]; bool ok = true;
#pragma unroll
        for (int i = 0; i < 8; ++i) { c[i] = __hip_atomic_load(xcnt + i, __ATOMIC_RELAXED, __HIP_MEMORY_SCOPE_AGENT); ok = ok && c[i] > 0u && c[i] < 512u; }
        unsigned mine = 0, tot_ = 0;
#pragma unroll
        for (int i = 0; i < 8; ++i) { mine = (i == xcc) ? c[i] : mine; tot_ += c[i]; }
        ok = ok && tot_ == gridDim.x;
        int X = xcc, R = xrank, NB = (int)mine;
        if (!ok) { X = blockIdx.x & 7; R = blockIdx.x >> 3; NB = gridDim.x >> 3; }
        wv_ = __builtin_amdgcn_readfirstlane((wv_ & 3) | (X << 2) | (R << 5) | (NB << 14) | (ok ? (1 << 23) : 0)); }
#pragma unroll 1
    for (int seg = 0; seg < NSEG; ++seg) {
        const int nrows = seg == 0 ? ROWS : ROWS_P, MT = nrows / 256;
#pragma unroll 1
        for (int l = 0; l < 2; ++l) {
            const bf16_t* wl = (const bf16_t*)p.ws + (size_t)l * E_LAYER;
            phase_norm(p, seg, nrows, p.in[I_NMIX] + l * 1024, l == 0, l, lds, wv_);
            gbar(p, epoch, wv_);
            for (int r = 0; r < p.rep[0]; ++r) { phase_proj(p, l, MT, lds, wv_); gbar(p, epoch, wv_); }
            phase_mix(p, l, seg, lds, wv_); gbar(p, epoch, wv_);
            phase_mbnorm(p, l, nrows, wv_);
            gbar(p, epoch, wv_);
            for (int r = 0; r < p.rep[1]; ++r) { phase_merge(p, l, MT, lds, wv_); gbar(p, epoch, wv_); }
            phase_resid(p, seg, MT, (const bf16_t*)(p.ws + WS_MRG), 1024, LDK, wl + E_WIN + E_WBR, l == 0, lds, wv_);
            gbar(p, epoch, wv_);
            phase_norm(p, seg, nrows, p.in[I_NFFN] + l * 1024, false, -1, lds, wv_);
            gbar(p, epoch, wv_);
            for (int r = 0; r < p.rep[2]; ++r) { phase_ffn_in(p, l, MT, lds, wv_); gbar(p, epoch, wv_); }
            phase_resid(p, seg, MT, (const bf16_t*)(p.ws + WS_PROJ), FFH, LDF, wl + E_WIN + E_WBR + E_WOUT + E_WFI, false, lds, wv_);
            gbar(p, epoch, wv_);
        }
        phase_final_norm(p, seg, nrows, wv_);
    }
}

extern "C" void kernel_launch(void* const* d_in, const int* in_sizes, int n_in, void* d_out, int out_size, void* d_ws, size_t ws_size, hipStream_t stream) {
    static int grid_blocks = 0;
    if (!grid_blocks) {
        int dev = 0, cus = 0, per_cu = 0;
        (void)hipGetDevice(&dev);
        (void)hipDeviceGetAttribute(&cus, hipDeviceAttributeMultiprocessorCount, dev);
        (void)hipFuncSetAttribute((const void*)fwd_mega, hipFuncAttributeMaxDynamicSharedMemorySize, LDS_BYTES);
        (void)hipOccupancyMaxActiveBlocksPerMultiprocessor(&per_cu, (const void*)fwd_mega, 256, LDS_BYTES);
        if (per_cu < 1) fprintf(stderr, "occupancy query says %d blocks per CU\n", per_cu);
        grid_blocks = cus;
        if (ws_size < WS_TOTAL) fprintf(stderr, "workspace too small: %zu < %zu\n", ws_size, (size_t)WS_END + 256);
    }
    (void)hipMemsetAsync((char*)d_ws + WS_END, 0, 256, stream);
    Params p{};
    for (int i = 0; i < 30; ++i) p.in[i] = (const float*)d_in[i];
    p.out = (float*)d_out; p.ws = (unsigned char*)d_ws; p.rep[0] = REP0; p.rep[1] = REP1; p.rep[2] = REP2; p.rep[3] = REP3;
    void* args[] = {&p};
    hipError_t e = hipLaunchCooperativeKernel((const void*)fwd_mega, dim3(grid_blocks), dim3(256), args, LDS_BYTES, stream);
    if (e != hipSuccess) fprintf(stderr, "cooperative launch failed: %s (grid %d)\n", hipGetErrorString(e), grid_blocks);
}
```

```cpp
#include <hip/hip_runtime.h>
#include <hip/hip_cooperative_groups.h>
#include <cstdio>
namespace cg = cooperative_groups;

typedef unsigned short bf16_t;
typedef short bf16x8 __attribute__((ext_vector_type(8)));
typedef float f32x4 __attribute__((ext_vector_type(4)));
typedef unsigned short us4 __attribute__((ext_vector_type(4)));
typedef unsigned short us8 __attribute__((ext_vector_type(8)));
#define DEVI __device__ __forceinline__

constexpr int LDK = 1088, LDF = 2880;
constexpr int D = 1024, NPROJ = 12288, SEGT = 512, NSEG = 4, ROWS_P = 8192, ROWS = 8704, FFH = 2816;
constexpr int PC_Z = 0, PC_XBC = 1024, PC_HQ = 3072, PC_HF = 4096, PC_HI = 5120, PC_HGATE = 6144, PC_RGATE = 7168, PC_RX = 8192, PC_MG = 9216, PC_DT = 12288;
constexpr size_t E_WIN = (size_t)NPROJ * LDK, E_WBR = 3u * 1024 * LDK, E_WOUT = 1024u * LDK, E_WFI = 5632u * LDK, E_WFO = 1024u * LDF;
constexpr size_t E_LAYER = E_WIN + E_WBR + E_WOUT + E_WFI + E_WFO;
constexpr size_t WS_PROJ = 2 * E_LAYER * 2;
constexpr size_t WS_DT = WS_PROJ + (size_t)ROWS * NPROJ * 2;
constexpr size_t WS_XB = WS_DT + (size_t)ROWS * 16 * 4;
constexpr size_t WS_YMB = WS_XB + (size_t)ROWS * LDK * 2;
constexpr size_t WS_YHG = WS_YMB + (size_t)ROWS * LDK * 2;
constexpr size_t WS_YRG = WS_YHG + (size_t)ROWS * LDK * 2;
constexpr size_t WS_MRG = WS_YRG + (size_t)ROWS * LDK * 2;
constexpr size_t WS_END = WS_MRG + (size_t)ROWS * LDK * 2;
constexpr size_t WS_HB = WS_END + 256;
constexpr size_t WS_DTW = WS_HB + 2u * 2 * 16 * 3 * 2048 * 4;
constexpr size_t WS_TOTAL = WS_DTW + 2u * 16 * 1024 * 4;
constexpr size_t O_YP = 0, O_YS = 33554432, O_SSM_P = 34078720, O_SCV_P = 38273024, O_HG_P = 38469632, O_RG_P = 42663936, O_RCV_P = 42696704,
                 O_SSM_S = 42795008, O_SCV_S = 46989312, O_HG_S = 47185920, O_RG_S = 51380224, O_RCV_S = 51412992;
constexpr int REP0 = 1, REP1 = 1, REP2 = 1, REP3 = 1;
constexpr int LDS_BYTES = 144 * 1024;

enum { I_XP = 0, I_XS, I_SSM, I_SCV, I_HG, I_RG, I_RCV, I_NMIX, I_WIN, I_MCW, I_MCB, I_DTB, I_ALOG, I_MBD, I_MBNW, I_LBL, I_HGNW, I_RCW, I_RCB, I_RWA, I_RBA, I_RWI, I_RBI, I_RLAM, I_WBR, I_WOUT, I_NFFN, I_WFI, I_WFO, I_NFIN };

struct Params { const float* in[30]; float* out; unsigned char* ws; int rep[4]; };

DEVI int tidx(int wv_) { int t = ((wv_ & 3) << 6) | (int)__builtin_amdgcn_mbcnt_hi(~0u, __builtin_amdgcn_mbcnt_lo(~0u, 0u)); asm volatile("" : "+v"(t)); return t; }
DEVI float shfli(float v, int srcl) { return __int_as_float(__builtin_amdgcn_ds_bpermute(srcl << 2, __float_as_int(v))); }
DEVI float shflx(float v, int m, int lane) { return shfli(v, lane ^ m); }
DEVI bf16_t f2bf(float f) { unsigned r; asm("v_cvt_pk_bf16_f32 %0, %1, %1" : "=v"(r) : "v"(f)); return (bf16_t)r; }
DEVI float bf2f(bf16_t h) { return __uint_as_float(((unsigned)h) << 16); }
DEVI float sigm(float x) { return __builtin_amdgcn_rcpf(1.f + __expf(-x)); }
DEVI float silu(float x) { return x * __builtin_amdgcn_rcpf(1.f + __expf(-x)); }
DEVI float softplus(float x) { return x > 20.f ? x : __logf(1.f + __expf(x)); }
DEVI float gelu_t(float x) { float u = 0.7978845608f * (x + 0.044715f * x * x * x); return x * sigm(2.f * u); }
DEVI float cexp(float x) { return __expf(fminf(x, 80.f)); }

DEVI const float* xrow_in(const Params& p, int seg, int r) {
    if (r < ROWS_P) { int b = r >> 9, tt = r & 511; return p.in[I_XP] + ((size_t)(b * 2048 + seg * SEGT + tt)) * D; }
    return p.in[I_XS] + (size_t)(r - ROWS_P) * D;
}
DEVI float* xrow_out(const Params& p, int seg, int r) {
    if (r < ROWS_P) { int b = r >> 9, tt = r & 511; return p.out + O_YP + ((size_t)(b * 2048 + seg * SEGT + tt)) * D; }
    return p.out + O_YS + (size_t)(r - ROWS_P) * D;
}

DEVI int perm32(int rho) { int n = rho >> 4, i = rho & 15; return 8 * (i >> 2) + 4 * n + (i & 3); }
DEVI int map_win(int n) { n = (n & ~31) + perm32(n & 31); return n < 3072 ? n : n + 16; }
DEVI int map_wfi(int n) { int T = n >> 7, nf = (n >> 4) & 7, i = n & 15, G = nf >> 2, h = (nf >> 1) & 1, s = nf & 1; return s * FFH + 64 * T + 32 * G + 8 * (i >> 2) + 4 * h + (i & 3); }

DEVI void transpose_tile(const float* src, int ldsrc, bf16_t* dst, int K, int k0, int n0, int mode, float* tile  , int wv_) {
    const int tid = tidx(wv_), c = tid & 63, rq = tid >> 6;
    int n = n0 + c, sn = mode == 1 ? map_win(n) : (mode == 2 ? map_wfi(n) : (mode == 3 ? (n & ~31) + perm32(n & 31) : n));
#pragma unroll
    for (int rr = 0; rr < 16; ++rr) { int kl = rr * 4 + rq; tile[kl * 65 + c] = sn >= 0 ? src[(size_t)(k0 + kl) * ldsrc + sn] : 0.f; }
    __syncthreads();
#pragma unroll
    for (int rr = 0; rr < 16; ++rr) { int nl = rr * 4 + rq; dst[(size_t)(n0 + nl) * K + k0 + c] = f2bf(tile[c * 65 + nl]); }
    __syncthreads();
}

DEVI void phase_prep(const Params& p, char* lds, int wv_) {
    float* tile = (float*)lds;
    bf16_t* wsb = (bf16_t*)p.ws;
    constexpr int T_WIN = 16 * 192, T_WBR = 3 * 256, T_WOUT = 256, T_WFI = 16 * 88, T_WFO = 44 * 16, T_L = T_WIN + T_WBR + T_WOUT + T_WFI + T_WFO;
    {   float* dtw = (float*)(p.ws + WS_DTW);
        for (int e = blockIdx.x * 256 + tidx(wv_); e < 32768; e += gridDim.x * 256) { int l = e >> 14, j = (e >> 10) & 15, k = e & 1023; dtw[e] = p.in[I_WIN][(size_t)l * 1024 * 12304 + (size_t)k * 12304 + 3072 + j]; } }
    for (int t = blockIdx.x; t < 2 * T_L; t += gridDim.x) {
        int l = t / T_L, j = t % T_L;
        bf16_t* wl = wsb + (size_t)l * E_LAYER;
        if (j < T_WIN) { int kt = j & 15, nt = j >> 4; transpose_tile(p.in[I_WIN] + (size_t)l * 1024 * 12304, 12304, wl, LDK, kt * 64, nt * 64, 1, tile, wv_); continue; }
        j -= T_WIN;
        if (j < T_WBR) { int k = j >> 8, jj = j & 255, kt = jj & 15, nt = jj >> 4;
            transpose_tile(p.in[I_WBR] + ((size_t)l * 3 + k) * 1024 * 1024, 1024, wl + E_WIN + (size_t)k * 1024 * LDK, LDK, kt * 64, nt * 64, 3, tile, wv_); continue; }
        j -= T_WBR;
        if (j < T_WOUT) { int kt = j & 15, nt = j >> 4; transpose_tile(p.in[I_WOUT] + (size_t)l * 1024 * 1024, 1024, wl + E_WIN + E_WBR, LDK, kt * 64, nt * 64, 0, tile, wv_); continue; }
        j -= T_WOUT;
        if (j < T_WFI) { int kt = j & 15, nt = j >> 4; transpose_tile(p.in[I_WFI] + (size_t)l * 1024 * 5632, 5632, wl + E_WIN + E_WBR + E_WOUT, LDK, kt * 64, nt * 64, 2, tile, wv_); continue; }
        j -= T_WFI;
        { int kt = j % 44, nt = j / 44; transpose_tile(p.in[I_WFO] + (size_t)l * 2816 * 1024, 1024, wl + E_WIN + E_WBR + E_WOUT + E_WFI, LDF, kt * 64, nt * 64, 0, tile, wv_); }
    }
}

DEVI void phase_norm(const Params& p, int seg, int nrows, const float* w, bool from_input, int ldt  , char* lds, int wv_) {
    bf16_t* xb = (bf16_t*)(p.ws + WS_XB); float* dtb = (float*)(p.ws + WS_DT);
    const int lane = tidx(wv_) & 63, wv = tidx(wv_) >> 6;
    float* dw = (float*)lds;
    if (ldt >= 0) { const float* dtw = (const float*)(p.ws + WS_DTW) + ldt * 16384; f32x4 t_[16];
#pragma unroll
        for (int u = 0; u < 16; ++u) t_[u] = *(const f32x4*)(dtw + (tidx(wv_) + 256 * u) * 4);
#pragma unroll
        for (int u = 0; u < 16; ++u) *(f32x4*)(dw + (tidx(wv_) + 256 * u) * 4) = t_[u];
        __syncthreads(); }
    for (int r = blockIdx.x * 4 + wv; r < nrows; r += gridDim.x * 4) {
        const float* x = from_input ? xrow_in(p, seg, r) : xrow_out(p, seg, r);
        f32x4 v[4]; float ss = 0.f;
#pragma unroll
        for (int i = 0; i < 4; ++i) { v[i] = *(const f32x4*)(x + i * 256 + lane * 4); ss += v[i][0] * v[i][0] + v[i][1] * v[i][1] + v[i][2] * v[i][2] + v[i][3] * v[i][3]; }
#pragma unroll
        for (int o = 32; o >= 1; o >>= 1) ss += shflx(ss, o, lane);
        float rs = rsqrtf(ss * (1.f / 1024.f) + 1e-6f);
#pragma unroll
        for (int i = 0; i < 4; ++i) { f32x4 wv4 = *(const f32x4*)(w + i * 256 + lane * 4); us4 o;
            v[i][0] *= rs * wv4[0]; v[i][1] *= rs * wv4[1]; v[i][2] *= rs * wv4[2]; v[i][3] *= rs * wv4[3];
            o[0] = f2bf(v[i][0]); o[1] = f2bf(v[i][1]); o[2] = f2bf(v[i][2]); o[3] = f2bf(v[i][3]);
            *(us4*)(xb + (size_t)r * LDK + i * 256 + lane * 4) = o; }
        if (ldt >= 0) {
            float d[16];
#pragma unroll
            for (int j = 0; j < 16; ++j) { float s = 0.f;
#pragma unroll
                for (int i = 0; i < 4; ++i) { f32x4 ww = *(const f32x4*)(dw + j * 1024 + i * 256 + lane * 4); s += v[i][0] * ww[0] + v[i][1] * ww[1] + v[i][2] * ww[2] + v[i][3] * ww[3]; }
                d[j] = s; }
            { const bool hi = lane & 32;
#pragma unroll
              for (int i = 0; i < 8; ++i) { float send = hi ? d[i] : d[i + 8], keep = hi ? d[i + 8] : d[i]; d[i] = keep + shfli(send, lane ^ 32); } }
            { const bool hi = lane & 16;
#pragma unroll
              for (int i = 0; i < 4; ++i) { float send = hi ? d[i] : d[i + 4], keep = hi ? d[i + 4] : d[i]; d[i] = keep + shfli(send, lane ^ 16); } }
            { const bool hi = lane & 8;
#pragma unroll
              for (int i = 0; i < 2; ++i) { float send = hi ? d[i] : d[i + 2], keep = hi ? d[i + 2] : d[i]; d[i] = keep + shfli(send, lane ^ 8); } }
            { const bool hi = lane & 4; float send = hi ? d[0] : d[1], keep = hi ? d[1] : d[0]; d[0] = keep + shfli(send, lane ^ 4); }
            d[0] += shfli(d[0], lane ^ 2); d[0] += shfli(d[0], lane ^ 1);
            if ((lane & 3) == 0) { int j = lane >> 2; dtb[(size_t)r * 16 + j] = softplus(d[0] + p.in[I_DTB][ldt * 16 + j]); }
        }
    }
    if (ldt >= 0) __syncthreads();
}
DEVI void phase_final_norm(const Params& p, int seg, int nrows, int wv_) {
    const float* w = p.in[I_NFIN];
    const int lane = tidx(wv_) & 63, wv = tidx(wv_) >> 6;
    for (int r = blockIdx.x * 4 + wv; r < nrows; r += gridDim.x * 4) {
        float* x = xrow_out(p, seg, r);
        f32x4 v[4]; float ss = 0.f;
#pragma unroll
        for (int i = 0; i < 4; ++i) { v[i] = *(const f32x4*)(x + i * 256 + lane * 4); ss += v[i][0] * v[i][0] + v[i][1] * v[i][1] + v[i][2] * v[i][2] + v[i][3] * v[i][3]; }
#pragma unroll
        for (int o = 32; o >= 1; o >>= 1) ss += shflx(ss, o, lane);
        float rs = rsqrtf(ss * (1.f / 1024.f) + 1e-6f);
#pragma unroll
        for (int i = 0; i < 4; ++i) { f32x4 wv4 = *(const f32x4*)(w + i * 256 + lane * 4); f32x4 o;
            o[0] = v[i][0] * rs * wv4[0]; o[1] = v[i][1] * rs * wv4[1]; o[2] = v[i][2] * rs * wv4[2]; o[3] = v[i][3] * rs * wv4[3];
            *(f32x4*)(x + i * 256 + lane * 4) = o; }
    }
}
DEVI void phase_mbnorm(const Params& p, int l, int nrows, int wv_) {
    bf16_t* y = (bf16_t*)(p.ws + WS_YMB); const float* w = p.in[I_MBNW] + l * 1024;
    const int lane = tidx(wv_) & 63, wv = tidx(wv_) >> 6;
    for (int it = blockIdx.x * 4 + wv; it < nrows * 4; it += gridDim.x * 4) {
        int r = it >> 2, g = it & 3; bf16_t* yp = y + (size_t)r * LDK + g * 256 + lane * 4;
        us4 v = *(const us4*)yp; float f0 = bf2f(v[0]), f1 = bf2f(v[1]), f2 = bf2f(v[2]), f3 = bf2f(v[3]);
        float ss = f0 * f0 + f1 * f1 + f2 * f2 + f3 * f3;
#pragma unroll
        for (int o = 32; o >= 1; o >>= 1) ss += shflx(ss, o, lane);
        float rs = rsqrtf(ss * (1.f / 256.f) + 1e-6f); f32x4 wv4 = *(const f32x4*)(w + g * 256 + lane * 4);
        us4 o; o[0] = f2bf(f0 * rs * wv4[0]); o[1] = f2bf(f1 * rs * wv4[1]); o[2] = f2bf(f2 * rs * wv4[2]); o[3] = f2bf(f3 * rs * wv4[3]);
        *(us4*)yp = o;
    }
}

#define WAIT_V(n) asm volatile("s_waitcnt vmcnt(" #n ")" ::: "memory")
#define RAW_BAR() do { asm volatile("" ::: "memory"); __builtin_amdgcn_s_barrier(); asm volatile("" ::: "memory"); } while (0)
template <int NF>
DEVI void stage_a(const bf16_t* A, int K, int t, char* st, int tid, size_t soff) {
    const size_t o = soff + (size_t)t * 32;
#pragma unroll
    for (int i = 0; i < 4; ++i) __builtin_amdgcn_global_load_lds((const unsigned*)(A + o + (size_t)i * 64 * K), (unsigned*)(st + tid * 16 + i * 4096), 16, 0, 0);
}
template <int NF>
DEVI void stage_b(const bf16_t* Bt, int K, int t, char* st, int tid, size_t soff) {
    const size_t o = soff + (size_t)t * 32;
#pragma unroll
    for (int i = 0; i < NF / 2; ++i) __builtin_amdgcn_global_load_lds((const unsigned*)(Bt + o + (size_t)i * 64 * K), (unsigned*)(st + 16384 + tid * 16 + i * 4096), 16, 0, 0);
}
template <int NF>
DEVI void gemm_kloop(f32x4 (&acc)[8][NF], const bf16_t* A, const bf16_t* Bt, int K, int ld, char* lds, int wv_) {
    constexpr int STAGE = 16384 + NF * 2048;
    const int tid = tidx(wv_), lane = tid & 63, wid = tid >> 6, wr = wid >> 1, wc = wid & 1, fr = lane & 15, fq = lane >> 4;
    const int fo = fr * 64 + ((fq ^ (0x1320 >> (4 * (fr >> 2)))) & 3) * 16;
    const int aoff = wr * 8192 + fo, boff = 16384 + wc * NF * 1024 + fo;
    const size_t soff = (size_t)(tid >> 2) * ld + ((((tid & 3) ^ (0x1320 >> (4 * ((tid >> 4) & 3)))) & 3) * 8);
    const int nt = K >> 5;
    WAIT_V(0); RAW_BAR();
    stage_a<NF>(A, ld, 0, lds, tid, soff); stage_b<NF>(Bt, ld, 0, lds, tid, soff);
    stage_a<NF>(A, ld, 1, lds + STAGE, tid, soff); stage_b<NF>(Bt, ld, 1, lds + STAGE, tid, soff);
    stage_a<NF>(A, ld, 2, lds + 2 * STAGE, tid, soff); stage_b<NF>(Bt, ld, 2, lds + 2 * STAGE, tid, soff);
    if (NF == 8) WAIT_V(16); else WAIT_V(12);
    RAW_BAR();
    bf16x8 a[8], a01[2][2], b[2][NF];
    a01[0][0] = *(const bf16x8*)(lds + aoff); a01[0][1] = *(const bf16x8*)(lds + aoff + 1024);
#pragma unroll
    for (int n = 0; n < NF; ++n) b[0][n] = *(const bf16x8*)(lds + boff + n * 1024);
#define MMA_1(g_, P_) acc[g_][0] = __builtin_amdgcn_mfma_f32_16x16x32_bf16(b[P_][0], a[g_], acc[g_][0], 0, 0, 0)
#define MMA_R(g_, P_) _Pragma("unroll") for (int n = 1; n < NF; ++n) acc[g_][n] = __builtin_amdgcn_mfma_f32_16x16x32_bf16(b[P_][n], a[g_], acc[g_][n], 0, 0, 0)
#define KBODY(T_, P_, Q_) do { \
        const int T = (T_); const char* st = lds + (T & 3) * STAGE; const char* stn = lds + ((T + 1) & 3) * STAGE; char* st3 = lds + ((T + 3) & 3) * STAGE; \
        a[0] = a01[P_][0]; a[1] = a01[P_][1]; \
        __builtin_amdgcn_sched_barrier(0); MMA_1(0, P_); __builtin_amdgcn_sched_barrier(0); a[2] = *(const bf16x8*)(st + aoff + 2 * 1024); MMA_R(0, P_); \
        __builtin_amdgcn_sched_barrier(0); MMA_1(1, P_); __builtin_amdgcn_sched_barrier(0); a[3] = *(const bf16x8*)(st + aoff + 3 * 1024); MMA_R(1, P_); \
        __builtin_amdgcn_sched_barrier(0); MMA_1(2, P_); __builtin_amdgcn_sched_barrier(0); a[4] = *(const bf16x8*)(st + aoff + 4 * 1024); MMA_R(2, P_); \
        __builtin_amdgcn_sched_barrier(0); MMA_1(3, P_); __builtin_amdgcn_sched_barrier(0); a[5] = *(const bf16x8*)(st + aoff + 5 * 1024); MMA_R(3, P_); \
        __builtin_amdgcn_sched_barrier(0); \
        if (T + 2 < nt) { if (NF == 8) WAIT_V(8); else WAIT_V(6); } else WAIT_V(0); \
        RAW_BAR(); \
        __builtin_amdgcn_sched_barrier(0); MMA_1(4, P_); __builtin_amdgcn_sched_barrier(0); a[6] = *(const bf16x8*)(st + aoff + 6 * 1024); \
        if (T + 3 < nt) stage_a<NF>(A, ld, T + 3, st3, tid, soff); \
        _Pragma("unroll") for (int n = 0; n < NF / 2; ++n) b[Q_][n] = *(const bf16x8*)(stn + boff + n * 1024); \
        MMA_R(4, P_); \
        __builtin_amdgcn_sched_barrier(0); MMA_1(5, P_); __builtin_amdgcn_sched_barrier(0); a[7] = *(const bf16x8*)(st + aoff + 7 * 1024); \
        if (T + 3 < nt) stage_b<NF>(Bt, ld, T + 3, st3, tid, soff); \
        _Pragma("unroll") for (int n = NF / 2; n < NF; ++n) b[Q_][n] = *(const bf16x8*)(stn + boff + n * 1024); \
        MMA_R(5, P_); \
        __builtin_amdgcn_sched_barrier(0); MMA_1(6, P_); __builtin_amdgcn_sched_barrier(0); a01[Q_][0] = *(const bf16x8*)(stn + aoff); MMA_R(6, P_); \
        __builtin_amdgcn_sched_barrier(0); MMA_1(7, P_); __builtin_amdgcn_sched_barrier(0); a01[Q_][1] = *(const bf16x8*)(stn + aoff + 1024); MMA_R(7, P_); \
        __builtin_amdgcn_sched_barrier(0); } while (0)
    for (int t = 0; t < nt; t += 2) { KBODY(t, 0, 1); KBODY(t + 1, 1, 0); }
#undef KBODY
#undef MMA_1
#undef MMA_R
}
DEVI void gemm_kloop8s(f32x4 (&acc)[8][8], const bf16_t* A, const bf16_t* Bt, int K, int ld, char* lds, int wv_) {
    constexpr int NF = 8, STAGE = 32768;
    const int tid = tidx(wv_), lane = tid & 63, wid = tid >> 6, wr = wid >> 1, wc = wid & 1, fr = lane & 15, fq = lane >> 4;
    const int fo = fr * 64 + ((fq ^ (0x1320 >> (4 * (fr >> 2)))) & 3) * 16;
    const int aoff = wr * 8192 + fo, boff = 16384 + wc * NF * 1024 + fo;
    const size_t soff = (size_t)(tid >> 2) * ld + ((((tid & 3) ^ (0x1320 >> (4 * ((tid >> 4) & 3)))) & 3) * 8);
    const int nt = K >> 5;
    WAIT_V(0); RAW_BAR();
#pragma unroll
    for (int s = 0; s < 3; ++s) { stage_a<NF>(A, ld, s, lds + s * STAGE, tid, soff); stage_b<NF>(Bt, ld, s, lds + s * STAGE, tid, soff); }
    for (int t = 0; t < nt; ++t) {
        if (t + 2 < nt) WAIT_V(16); else if (t + 1 < nt) WAIT_V(8); else WAIT_V(0);
        RAW_BAR();
        if (t + 3 < nt) { stage_a<NF>(A, ld, t + 3, lds + ((t + 3) & 3) * STAGE, tid, soff); stage_b<NF>(Bt, ld, t + 3, lds + ((t + 3) & 3) * STAGE, tid, soff); }
        const char* st = lds + (t & 3) * STAGE;
        bf16x8 af[8], bfr[NF];
        af[0] = *(const bf16x8*)(st + aoff);
#pragma unroll
        for (int n = 0; n < NF; ++n) bfr[n] = *(const bf16x8*)(st + boff + n * 1024);
        af[1] = *(const bf16x8*)(st + aoff + 1024);
#pragma unroll
        for (int g = 0; g < 8; ++g) {
            __builtin_amdgcn_sched_barrier(0);
            if (g < 6) af[g + 2] = *(const bf16x8*)(st + aoff + (g + 2) * 1024);
#pragma unroll
            for (int n = 0; n < NF; ++n) acc[g][n] = __builtin_amdgcn_mfma_f32_16x16x32_bf16(bfr[n], af[g], acc[g][n], 0, 0, 0);
        }
        __builtin_amdgcn_sched_barrier(0);
    }
}
DEVI bool next_tile(int it, int MT, int NT, int& mt, int& nt, int wv_) {
    const int x = (wv_ >> 2) & 7, bl = (wv_ >> 5) & 511, G8 = (wv_ >> 14) & 511;
    int j = it * G8 + bl;
    const int nb = 4 * NT;
    if (j < nb) { nt = j >> 2; mt = x + 8 * (j & 3); return true; }
    if (MT == 32) return false;
    j -= nb;
    const int ne = (NT - x + 7) >> 3;
    if (j >= 2 * ne) return false;
    mt = 32 + (j & 1); nt = x + 8 * (j >> 1); return true;
}
#define ZERO_ACC(a, NF_) _Pragma("unroll") for (int m_ = 0; m_ < 8; ++m_) _Pragma("unroll") for (int n_ = 0; n_ < NF_; ++n_) a[m_][n_] = (f32x4){0.f, 0.f, 0.f, 0.f}
#define EPI_IDS const int lane = tidx(wv_) & 63, wid = tidx(wv_) >> 6, wr = wid >> 1, wc = wid & 1, fr = lane & 15, fq = lane >> 4

DEVI void proj_store_row(const f32x4 (&accm)[8], bf16_t* prow, float c1, float c3, bool issig, bool isact) {
#pragma unroll
    for (int q = 0; q < 4; ++q) { __builtin_amdgcn_sched_barrier(0); us8 o;
#pragma unroll
        for (int s = 0; s < 2; ++s)
#pragma unroll
            for (int j = 0; j < 4; ++j) { float x = accm[2 * q + s][j];
                float u = x * (c1 + c3 * x * x); float sg = __builtin_amdgcn_rcpf(1.f + __expf(-u)); float y = sg * (issig ? 1.f : x);
                o[4 * s + j] = f2bf(isact ? y : x); }
        *(us8*)(prow + q * 32) = o; }
}
DEVI void phase_proj(const Params& p, int l, int MT, char* lds, int wv_) {
    const bf16_t* xb = (const bf16_t*)(p.ws + WS_XB); const bf16_t* wt = (const bf16_t*)p.ws + (size_t)l * E_LAYER;
    bf16_t* proj = (bf16_t*)(p.ws + WS_PROJ);
    int mt, nt;
    for (int it = 0; next_tile(it, MT, 48, mt, nt, wv_); ++it) {
        f32x4 acc[8][8]; ZERO_ACC(acc, 8);
        gemm_kloop8s(acc, xb + (size_t)mt * 256 * LDK, wt + (size_t)nt * 256 * LDK, 1024, LDK, lds, wv_);
        EPI_IDS;
        const int sg = nt >> 2;
        const int ty = (sg == 0 || sg == 3 || sg == 6) ? 1 : (sg == 7 ? 2 : (sg >= 9 ? 3 : 0));
        bf16_t* pbase = proj + (size_t)(mt * 256 + wr * 128 + fr) * NPROJ + nt * 256 + wc * 128 + fq * 8;
        const float c1 = ty == 2 ? 1.5957691216f : 1.f, c3 = ty == 2 ? 0.0713548163f : 0.f;
#pragma unroll
        for (int m = 0; m < 8; ++m) { asm volatile("" ::: "memory"); proj_store_row(acc[m], pbase + (size_t)m * 16 * NPROJ, c1, c3, ty == 3, ty != 0); }
    }
}
DEVI void phase_merge(const Params& p, int l, int MT, char* lds, int wv_) {
    const bf16_t* wt = (const bf16_t*)p.ws + (size_t)l * E_LAYER + E_WIN; const bf16_t* proj = (const bf16_t*)(p.ws + WS_PROJ);
    bf16_t* mrg = (bf16_t*)(p.ws + WS_MRG);
    int mt, nt;
    for (int it = 0; next_tile(it, MT, 8, mt, nt, wv_); ++it) {
        f32x4 tot[8][4]; ZERO_ACC(tot, 4);
#pragma unroll 1
        for (int k = 0; k < 3; ++k) {
            const bf16_t* y = (const bf16_t*)(p.ws + WS_YMB + (size_t)k * ROWS * LDK * 2);
            f32x4 acc[8][4]; ZERO_ACC(acc, 4);
            gemm_kloop<4>(acc, y + (size_t)mt * 256 * LDK, wt + (size_t)k * 1024 * LDK + (size_t)nt * 128 * LDK, 1024, LDK, lds, wv_);
            EPI_IDS;
#pragma unroll
            for (int m = 0; m < 8; ++m) { int row = mt * 256 + wr * 128 + m * 16 + fr; asm volatile("" ::: "memory");
#pragma unroll
                for (int q = 0; q < 2; ++q) { int col = nt * 128 + wc * 64 + 32 * q + fq * 8; us8 g = *(const us8*)(proj + (size_t)row * NPROJ + PC_MG + k * 1024 + col);
#pragma unroll
                    for (int s = 0; s < 2; ++s)
#pragma unroll
                        for (int j = 0; j < 4; ++j) tot[m][2 * q + s][j] += acc[m][2 * q + s][j] * bf2f(g[4 * s + j]); } }
        }
        EPI_IDS;
#pragma unroll
        for (int m = 0; m < 8; ++m) { int row = mt * 256 + wr * 128 + m * 16 + fr;
#pragma unroll
            for (int q = 0; q < 2; ++q) { int col = nt * 128 + wc * 64 + 32 * q + fq * 8; us8 o;
#pragma unroll
                for (int s = 0; s < 2; ++s)
#pragma unroll
                    for (int j = 0; j < 4; ++j) o[4 * s + j] = f2bf(tot[m][2 * q + s][j]);
                *(us8*)(mrg + (size_t)row * LDK + col) = o; } }
    }
}
DEVI void phase_resid(const Params& p, int seg, int MT, const bf16_t* A, int K, int ld, const bf16_t* Bt, bool from_input, char* lds, int wv_) {
    int mt, nt;
    for (int it = 0; next_tile(it, MT, 8, mt, nt, wv_); ++it) {
        f32x4 acc[8][4]; ZERO_ACC(acc, 4);
        gemm_kloop<4>(acc, A + (size_t)mt * 256 * ld, Bt + (size_t)nt * 128 * ld, K, ld, lds, wv_);
        EPI_IDS;
#pragma unroll
        for (int m = 0; m < 8; ++m) { int row = mt * 256 + wr * 128 + m * 16 + fr;
            const float* xi = from_input ? xrow_in(p, seg, row) : xrow_out(p, seg, row); float* xo = xrow_out(p, seg, row);
#pragma unroll
            for (int n = 0; n < 4; ++n) { int col = nt * 128 + wc * 64 + n * 16 + fq * 4; f32x4 v = *(const f32x4*)(xi + col); *(f32x4*)(xo + col) = v + acc[m][n]; } }
    }
}
DEVI void phase_ffn_in(const Params& p, int l, int MT, char* lds, int wv_) {
    const bf16_t* xb = (const bf16_t*)(p.ws + WS_XB); const bf16_t* wt = (const bf16_t*)p.ws + (size_t)l * E_LAYER + E_WIN + E_WBR + E_WOUT;
    bf16_t* act = (bf16_t*)(p.ws + WS_PROJ);
    int mt, nt;
    for (int it = 0; next_tile(it, MT, 22, mt, nt, wv_); ++it) {
        f32x4 acc[8][8]; ZERO_ACC(acc, 8);
        gemm_kloop8s(acc, xb + (size_t)mt * 256 * LDK, wt + (size_t)nt * 256 * LDK, 1024, LDK, lds, wv_);
        EPI_IDS;
#pragma unroll
        for (int m = 0; m < 8; ++m) { int row = mt * 256 + wr * 128 + m * 16 + fr;
            asm volatile("" ::: "memory");
#pragma unroll
            for (int G = 0; G < 2; ++G) { int col = (nt * 2 + wc) * 64 + 32 * G + fq * 8; us8 o;
#pragma unroll
                for (int h = 0; h < 2; ++h)
#pragma unroll
                    for (int j = 0; j < 4; ++j) o[4 * h + j] = f2bf(silu(acc[m][4 * G + 2 * h][j]) * acc[m][4 * G + 2 * h + 1][j]);
                *(us8*)(act + (size_t)row * LDF + col) = o; } }
    }
}

struct Seq { int row0, nchunk, Q, b, samp, seg; };
DEVI Seq make_seq(int seg, int sq) { Seq s; s.seg = seg; if (sq < 16) { s.row0 = sq * SEGT; s.nchunk = 8; s.Q = 64; s.b = sq; s.samp = 0; } else { s.b = sq - 16; s.row0 = ROWS_P + s.b * 32; s.nchunk = 1; s.Q = 32; s.samp = 1; } return s; }

template <int NF, int KS>
DEVI void lds_mma(f32x4* acc, const bf16_t* X, int ldx, int m0, const bf16_t* Y, int ldy, int n0, int wv_) {
    const int lane = tidx(wv_) & 63, fr = lane & 15, fq = lane >> 4;
#pragma unroll
    for (int ks = 0; ks < KS; ++ks) {
        bf16x8 a = *(const bf16x8*)(X + (m0 + fr) * ldx + ks * 32 + fq * 8);
#pragma unroll
        for (int nf = 0; nf < NF; ++nf) { bf16x8 b = *(const bf16x8*)(Y + (n0 + nf * 16 + fr) * ldy + ks * 32 + fq * 8); acc[nf] = __builtin_amdgcn_mfma_f32_16x16x32_bf16(a, b, acc[nf], 0, 0, 0); }
    }
}

DEVI void conv_load(uint4 (&r)[4], const bf16_t* proj, int row0, int tq, int pcol) {
#pragma unroll
    for (int k = 0; k < 4; ++k) { int ts = tq - 3 + k; ts = ts < 0 ? 0 : ts; r[k] = *(const uint4*)(proj + (size_t)(row0 + ts) * NPROJ + pcol); }
}
DEVI void touch4(uint4& v) { asm volatile("" : "+v"(v.x), "+v"(v.y), "+v"(v.z), "+v"(v.w)); }
DEVI void conv_compute(const uint4 (&r)[4], int tq, const float* hl, const float* cwl, int HC, int cl, float (&out)[8], float (&raw)[8]) {
    { f32x4 b0 = *(const f32x4*)(cwl + 4 * HC + cl), b1 = *(const f32x4*)(cwl + 4 * HC + cl + 4);
      out[0] = b0[0]; out[1] = b0[1]; out[2] = b0[2]; out[3] = b0[3]; out[4] = b1[0]; out[5] = b1[1]; out[6] = b1[2]; out[7] = b1[3]; }
#pragma unroll
    for (int k = 0; k < 4; ++k) {
        const int ts = tq - 3 + k; float v[8];
        v[0] = __uint_as_float(r[k].x << 16); v[1] = __uint_as_float(r[k].x & 0xffff0000u); v[2] = __uint_as_float(r[k].y << 16); v[3] = __uint_as_float(r[k].y & 0xffff0000u);
        v[4] = __uint_as_float(r[k].z << 16); v[5] = __uint_as_float(r[k].z & 0xffff0000u); v[6] = __uint_as_float(r[k].w << 16); v[7] = __uint_as_float(r[k].w & 0xffff0000u);
        if (k < 3) { int hi = 3 + ts; hi = hi < 0 ? 0 : (hi > 2 ? 2 : hi); const bool uh = ts < 0;
            f32x4 h0 = *(const f32x4*)(hl + hi * HC + cl), h1 = *(const f32x4*)(hl + hi * HC + cl + 4);
            v[0] = uh ? h0[0] : v[0]; v[1] = uh ? h0[1] : v[1]; v[2] = uh ? h0[2] : v[2]; v[3] = uh ? h0[3] : v[3];
            v[4] = uh ? h1[0] : v[4]; v[5] = uh ? h1[1] : v[5]; v[6] = uh ? h1[2] : v[6]; v[7] = uh ? h1[3] : v[7]; }
        f32x4 w0 = *(const f32x4*)(cwl + k * HC + cl), w1 = *(const f32x4*)(cwl + k * HC + cl + 4);
        out[0] += v[0] * w0[0]; out[1] += v[1] * w0[1]; out[2] += v[2] * w0[2]; out[3] += v[3] * w0[3];
        out[4] += v[4] * w1[0]; out[5] += v[5] * w1[1]; out[6] += v[6] * w1[2]; out[7] += v[7] * w1[3];
        if (k == 3) {
#pragma unroll
            for (int e = 0; e < 8; ++e) raw[e] = v[e]; }
    }
}

template <int ROWB>
DEVI void stage_raw(const char* g0, size_t ldgB, char* dst, int tid) {
#pragma unroll
    for (int i = 0; i < ROWB / 64; ++i) { int b = tid * 16 + i * 4096, row = b / ROWB, cb = b % ROWB;
        __builtin_amdgcn_global_load_lds((const unsigned*)(g0 + (size_t)row * ldgB + cb), (unsigned*)(dst + b), 16, 0, 0); }
}
DEVI void conv_lds(const bf16_t* rawt, int RS, int t, int cloc, const float* hl, const float* cwl, int HC, int cl, float (&out)[8], float (&raw)[8]) {
    { f32x4 b0 = *(const f32x4*)(cwl + 4 * HC + cl), b1 = *(const f32x4*)(cwl + 4 * HC + cl + 4);
      out[0] = b0[0]; out[1] = b0[1]; out[2] = b0[2]; out[3] = b0[3]; out[4] = b1[0]; out[5] = b1[1]; out[6] = b1[2]; out[7] = b1[3]; }
#pragma unroll
    for (int k = 0; k < 4; ++k) {
        const int tt = t - 3 + k; const int tc = tt < 0 ? 0 : tt; float v[8];
        const uint4 r = *(const uint4*)(rawt + tc * RS + cloc);
        v[0] = __uint_as_float(r.x << 16); v[1] = __uint_as_float(r.x & 0xffff0000u); v[2] = __uint_as_float(r.y << 16); v[3] = __uint_as_float(r.y & 0xffff0000u);
        v[4] = __uint_as_float(r.z << 16); v[5] = __uint_as_float(r.z & 0xffff0000u); v[6] = __uint_as_float(r.w << 16); v[7] = __uint_as_float(r.w & 0xffff0000u);
        if (k < 3) { int hi = 3 + tt; hi = hi < 0 ? 0 : (hi > 2 ? 2 : hi); const bool uh = tt < 0;
            f32x4 h0 = *(const f32x4*)(hl + hi * HC + cl), h1 = *(const f32x4*)(hl + hi * HC + cl + 4);
            v[0] = uh ? h0[0] : v[0]; v[1] = uh ? h0[1] : v[1]; v[2] = uh ? h0[2] : v[2]; v[3] = uh ? h0[3] : v[3];
            v[4] = uh ? h1[0] : v[4]; v[5] = uh ? h1[1] : v[5]; v[6] = uh ? h1[2] : v[6]; v[7] = uh ? h1[3] : v[7]; }
        f32x4 w0 = *(const f32x4*)(cwl + k * HC + cl), w1 = *(const f32x4*)(cwl + k * HC + cl + 4);
        out[0] += v[0] * w0[0]; out[1] += v[1] * w0[1]; out[2] += v[2] * w0[2]; out[3] += v[3] * w0[3];
        out[4] += v[4] * w1[0]; out[5] += v[5] * w1[1]; out[6] += v[6] * w1[2]; out[7] += v[7] * w1[3];
        if (k == 3) {
#pragma unroll
            for (int e = 0; e < 8; ++e) raw[e] = v[e]; }
    }
}

DEVI void ssd_unit(const Params& p, int l, Seq sq, int hd, char* lds, int wv_) {
    bf16_t* Bm = (bf16_t*)lds;
    bf16_t* R2 = (bf16_t*)(lds + 17408);
    bf16_t* xT = (bf16_t*)(lds + 35840);
    bf16_t* hb = (bf16_t*)(lds + 45056);
    float* fl = (float*)(lds + 62464);
    const int tid = tidx(wv_), lane = tid & 63, w = tid >> 6, fr = lane & 15, fq = lane >> 4;
    const bf16_t* proj = (const bf16_t*)(p.ws + WS_PROJ); const float* dtb = (const float*)(p.ws + WS_DT); bf16_t* ymb = (bf16_t*)(p.ws + WS_YMB);
    const int g = hd >> 2;
    const float a = -__expf(p.in[I_ALOG][l * 16 + hd]), Dv = p.in[I_MBD][l * 16 + hd];
    const float* cw = p.in[I_MCW] + (size_t)l * 4 * 2048; const float* cbias = p.in[I_MCB] + l * 2048;
    float* cwl = (float*)(lds + 63488);
    float* hl = (float*)(lds + 69888);
    const float* st_in; float* st_out; const float* hist; float* hist_out; float* hist_out2 = nullptr;
    float* hbuf = (float*)(p.ws + WS_HB);
    if (sq.samp) { st_in = p.in[I_SSM] + ((size_t)(l * 16 + sq.b) * 16 + hd) * 8192; st_out = p.out + O_SSM_S + ((size_t)(l * 16 + sq.b) * 16 + hd) * 8192;
        hist = p.in[I_SCV] + (size_t)(l * 16 + sq.b) * 3 * 2048; hist_out = p.out + O_SCV_S + (size_t)(l * 16 + sq.b) * 3 * 2048; }
    else { st_out = p.out + O_SSM_P + ((size_t)(l * 16 + sq.b) * 16 + hd) * 8192; st_in = sq.seg ? st_out : nullptr;
        hist_out = hbuf + ((size_t)((sq.seg & 1) * 2 + l) * 16 + sq.b) * 3 * 2048; hist = sq.seg ? hbuf + ((size_t)(((sq.seg + 1) & 1) * 2 + l) * 16 + sq.b) * 3 * 2048 : nullptr;
        if (sq.seg == NSEG - 1) hist_out2 = p.out + O_SCV_P + (size_t)(l * 16 + sq.b) * 3 * 2048; }
    for (int idx = tid; idx < 1600; idx += 256) { int k = idx / 320, cc = idx - k * 320; int ch = cc < 64 ? hd * 64 + cc : (cc < 192 ? 1024 + g * 128 + (cc - 64) : 1536 + g * 128 + (cc - 192));
        cwl[idx] = k < 4 ? cw[k * 2048 + ch] : cbias[ch];
        if (idx < 960) hl[idx] = hist ? hist[k * 2048 + ch] : 0.f; }
    f32x4 hacc[8];
#pragma unroll
    for (int nf = 0; nf < 8; ++nf)
#pragma unroll
        for (int r = 0; r < 4; ++r) { int pp = 16 * w + 4 * fq + r, n = 16 * nf + fr; float v = st_in ? st_in[pp * 128 + n] : 0.f; hacc[nf][r] = v; hb[pp * 136 + n] = f2bf(v); }
    bf16_t* rawX = (bf16_t*)(lds + 77568); bf16_t* rawB = (bf16_t*)(lds + 85760); bf16_t* rawC = (bf16_t*)(lds + 102144); bf16_t* rawZ = (bf16_t*)(lds + 118528); float* rawDt = (float*)(lds + 126720);
    const char* gx = (const char*)(proj + PC_XBC + hd * 64); const char* gb = (const char*)(proj + PC_XBC + 1024 + g * 128); const char* gc = (const char*)(proj + PC_XBC + 1536 + g * 128); const char* gz = (const char*)(proj + PC_Z + hd * 64);
    asm volatile("s_waitcnt vmcnt(0)" ::: "memory");
    {   const size_t ro = (size_t)sq.row0 * NPROJ * 2;
        stage_raw<128>(gx + ro, (size_t)NPROJ * 2, (char*)rawX, tid); stage_raw<256>(gb + ro, (size_t)NPROJ * 2, (char*)rawB, tid); stage_raw<256>(gc + ro, (size_t)NPROJ * 2, (char*)rawC, tid);
        stage_raw<128>(gz + ro, (size_t)NPROJ * 2, (char*)rawZ, tid); stage_raw<64>((const char*)(dtb + (size_t)sq.row0 * 16), 64, (char*)rawDt, tid); }
    for (int c = 0; c < sq.nchunk; ++c) {
        const int tid = tidx(wv_), lane = tid & 63, w = tid >> 6, fr = lane & 15, fq = lane >> 4;
        const int rowc = sq.row0 + c * 64; const bool lastc = (c == sq.nchunk - 1);
        const float* hlr = hl + (c & 1) * 960; float* hlw = hl + ((c + 1) & 1) * 960;
        asm volatile("s_waitcnt vmcnt(0)" ::: "memory");
        __syncthreads();
        if (w == 0) {
            float dt = lane < sq.Q ? rawDt[lane * 16 + hd] : 0.f; float v = dt * a;
#pragma unroll
            for (int o = 1; o < 64; o <<= 1) { float t = shfli(v, lane - o); if (lane >= o) v += t; }
            float last = shfli(v, 63);
            fl[lane] = v; fl[64 + lane] = dt; fl[128 + lane] = __expf(last - v) * dt; fl[192 + lane] = __expf(v);
        }
        __syncthreads();
        const float elast = __expf(fl[63]);
#pragma unroll
        for (int i = 0; i < 2; ++i) { int it = tid + 256 * i, t = it >> 3, c8 = (it & 7) * 8; float o[8], raw[8]; int ch = hd * 64 + c8; const bool tv = t < sq.Q;
            conv_lds(rawX, 64, t, c8, hlr, cwl, 320, c8, o, raw);
#pragma unroll
            for (int e = 0; e < 8; ++e) { float s_ = silu(o[e]); o[e] = tv ? s_ : 0.f; }
            if (t >= 61) {
#pragma unroll
                for (int e = 0; e < 8; ++e) hlw[(t - 61) * 320 + c8 + e] = raw[e]; }
            if (lastc && tv && t >= sq.Q - 3) {
#pragma unroll
                for (int e = 0; e < 8; ++e) { hist_out[(t - (sq.Q - 3)) * 2048 + ch + e] = raw[e]; if (hist_out2) hist_out2[(t - (sq.Q - 3)) * 2048 + ch + e] = raw[e]; } }
#pragma unroll
            for (int e = 0; e < 8; ++e) xT[(c8 + e) * 72 + t] = f2bf(o[e]); }
#pragma unroll
        for (int i = 0; i < 4; ++i) { int it = tid + 256 * i, t = it >> 4, c8 = (it & 15) * 8; float o[8], raw[8]; int ch = 1024 + g * 128 + c8; const bool tv = t < sq.Q;
            conv_lds(rawB, 128, t, c8, hlr, cwl, 320, 64 + c8, o, raw);
#pragma unroll
            for (int e = 0; e < 8; ++e) { float s_ = silu(o[e]); o[e] = tv ? s_ : 0.f; }
            if (t >= 61) {
#pragma unroll
                for (int e = 0; e < 8; ++e) hlw[(t - 61) * 320 + 64 + c8 + e] = raw[e]; }
            if (lastc && tv && (hd & 3) == 0 && t >= sq.Q - 3) {
#pragma unroll
                for (int e = 0; e < 8; ++e) { hist_out[(t - (sq.Q - 3)) * 2048 + ch + e] = raw[e]; if (hist_out2) hist_out2[(t - (sq.Q - 3)) * 2048 + ch + e] = raw[e]; } }
            us8 ov; float we = fl[128 + t];
#pragma unroll
            for (int e = 0; e < 8; ++e) { ov[e] = f2bf(o[e]); R2[(c8 + e) * 72 + t] = f2bf(o[e] * we); }
            *(us8*)(Bm + t * 136 + c8) = ov; }
        __syncthreads();
#pragma unroll
        for (int nf = 0; nf < 8; ++nf) hacc[nf] *= elast;
        lds_mma<8, 2>(hacc, xT, 72, 16 * w, R2, 72, 0, wv_);
        __syncthreads();
#pragma unroll
        for (int i = 0; i < 4; ++i) { int it = tid + 256 * i, t = it >> 4, c8 = (it & 15) * 8; float o[8], raw[8]; int ch = 1536 + g * 128 + c8; const bool tv = t < sq.Q;
            conv_lds(rawC, 128, t, c8, hlr, cwl, 320, 192 + c8, o, raw);
#pragma unroll
            for (int e = 0; e < 8; ++e) { float s_ = silu(o[e]); o[e] = tv ? s_ : 0.f; }
            if (t >= 61) {
#pragma unroll
                for (int e = 0; e < 8; ++e) hlw[(t - 61) * 320 + 192 + c8 + e] = raw[e]; }
            if (lastc && tv && (hd & 3) == 0 && t >= sq.Q - 3) {
#pragma unroll
                for (int e = 0; e < 8; ++e) { hist_out[(t - (sq.Q - 3)) * 2048 + ch + e] = raw[e]; if (hist_out2) hist_out2[(t - (sq.Q - 3)) * 2048 + ch + e] = raw[e]; } }
            us8 ov;
#pragma unroll
            for (int e = 0; e < 8; ++e) ov[e] = f2bf(o[e]);
            *(us8*)(R2 + t * 136 + c8) = ov; }
        us4 zr[4];
#pragma unroll
        for (int nf = 0; nf < 4; ++nf) zr[nf] = *(const us4*)(rawZ + (16 * nf + fr) * 64 + 16 * w + 4 * fq);
        __syncthreads();
        if (!lastc) { const size_t ro = (size_t)(rowc + 64) * NPROJ * 2;
            stage_raw<128>(gx + ro, (size_t)NPROJ * 2, (char*)rawX, tid); stage_raw<256>(gb + ro, (size_t)NPROJ * 2, (char*)rawB, tid); stage_raw<256>(gc + ro, (size_t)NPROJ * 2, (char*)rawC, tid);
            stage_raw<128>(gz + ro, (size_t)NPROJ * 2, (char*)rawZ, tid); stage_raw<64>((const char*)(dtb + (size_t)(rowc + 64) * 16), 64, (char*)rawDt, tid); }
        f32x4 cbv[4];
#pragma unroll
        for (int nf = 0; nf < 4; ++nf) cbv[nf] = (f32x4){0.f, 0.f, 0.f, 0.f};
        lds_mma<4, 4>(cbv, Bm, 136, 16 * w, R2, 136, 0, wv_);
        __syncthreads();
#pragma unroll
        for (int nf = 0; nf < 4; ++nf) { int i = 16 * nf + fr; float ai = fl[i]; us4 o;
#pragma unroll
            for (int r = 0; r < 4; ++r) { int j = 16 * w + 4 * fq + r; float v = (j <= i) ? cbv[nf][r] * __expf(ai - fl[j]) * fl[64 + j] : 0.f; o[r] = f2bf(v); }
            *(us4*)(Bm + i * 72 + 16 * w + 4 * fq) = o; }
        __syncthreads();
        f32x4 ya[4];
#pragma unroll
        for (int nf = 0; nf < 4; ++nf) ya[nf] = (f32x4){0.f, 0.f, 0.f, 0.f};
        lds_mma<4, 4>(ya, hb, 136, 16 * w, R2, 136, 0, wv_);
#pragma unroll
        for (int nf = 0; nf < 4; ++nf) ya[nf] *= fl[192 + 16 * nf + fr];
        lds_mma<4, 2>(ya, xT, 72, 16 * w, Bm, 72, 0, wv_);
#pragma unroll
        for (int nf = 0; nf < 4; ++nf) { int i = 16 * nf + fr, p0 = 16 * w + 4 * fq;
            us4 z = zr[nf];
            if (i < sq.Q) { us4 o;
#pragma unroll
                for (int r = 0; r < 4; ++r) o[r] = f2bf((ya[nf][r] + Dv * bf2f(xT[(p0 + r) * 72 + i])) * bf2f(z[r]));
                *(us4*)(ymb + (size_t)(rowc + i) * LDK + hd * 64 + p0) = o; } }
        __syncthreads();
#pragma unroll
        for (int nf = 0; nf < 8; ++nf)
#pragma unroll
            for (int r = 0; r < 4; ++r) hb[(16 * w + 4 * fq + r) * 136 + 16 * nf + fr] = f2bf(hacc[nf][r]);
    }
#pragma unroll
    for (int nf = 0; nf < 8; ++nf)
#pragma unroll
        for (int r = 0; r < 4; ++r) st_out[(16 * w + 4 * fq + r) * 128 + 16 * nf + fr] = hacc[nf][r];
    __syncthreads();
}

DEVI void hgrn_unit(const Params& p, int l, Seq sq, int h, char* lds, int wv_) {
    bf16_t* sb = (bf16_t*)lds;
    bf16_t* qt = (bf16_t*)(lds + 34816);
    bf16_t* kt = (bf16_t*)(lds + 52224);
    bf16_t* att = (bf16_t*)lds;
    bf16_t* kT = (bf16_t*)(lds + 9216);
    bf16_t* vT = (bf16_t*)(lds + 27648);
    float* T0 = (float*)(lds + 69632); float* T1 = T0 + 128; float* ssq = T0 + 256;
    const int tid = tidx(wv_), lane = tid & 63, w = tid >> 6, fr = lane & 15, fq = lane >> 4;
    const int k = tid & 127, half = tid >> 7;
    const bf16_t* proj = (const bf16_t*)(p.ws + WS_PROJ); bf16_t* yhg = (bf16_t*)(p.ws + WS_YHG);
    float lb = 0.f;
    if (l == 1) { float a0 = p.in[I_LBL][h * 128 + k], a1 = p.in[I_LBL][1024 + h * 128 + k]; lb = 1.f / (1.f + __expf(a0 - a1)); }
    const float* nw = p.in[I_HGNW] + l * 128;
    const float* st_in; float* st_out;
    if (sq.samp) { st_in = p.in[I_HG] + ((size_t)(l * 16 + sq.b) * 8 + h) * 16384; st_out = p.out + O_HG_S + ((size_t)(l * 16 + sq.b) * 8 + h) * 16384; }
    else { st_out = p.out + O_HG_P + ((size_t)(l * 16 + sq.b) * 8 + h) * 16384; st_in = sq.seg ? st_out : nullptr; }
    f32x4 hacc[2][8];
#pragma unroll
    for (int mf = 0; mf < 2; ++mf)
#pragma unroll
        for (int nf = 0; nf < 8; ++nf)
#pragma unroll
            for (int r = 0; r < 4; ++r) hacc[mf][nf][r] = st_in ? st_in[(32 * w + 16 * mf + 4 * fq + r) * 128 + 16 * nf + fr] : 0.f;
    f32x4 nwr[2];
#pragma unroll
    for (int mf = 0; mf < 2; ++mf) nwr[mf] = *(const f32x4*)(nw + 32 * w + 16 * mf + 4 * fq);
    bf16_t* rawF = (bf16_t*)(lds + 71680); bf16_t* rawQ = (bf16_t*)(lds + 88064); bf16_t* rawV = (bf16_t*)(lds + 104448); bf16_t* rawH = (bf16_t*)(lds + 120832);
    const char* gf = (const char*)(proj + PC_HF + h * 128); const char* gq = (const char*)(proj + PC_HQ + h * 128); const char* gv = (const char*)(proj + PC_HI + h * 128); const char* gh = (const char*)(proj + PC_HGATE + h * 128);
    asm volatile("s_waitcnt vmcnt(0)" ::: "memory");
    {   const size_t ro = (size_t)sq.row0 * NPROJ * 2;
        stage_raw<256>(gf + ro, (size_t)NPROJ * 2, (char*)rawF, tid); stage_raw<256>(gq + ro, (size_t)NPROJ * 2, (char*)rawQ, tid); stage_raw<256>(gv + ro, (size_t)NPROJ * 2, (char*)rawV, tid); }
    for (int c = 0; c < sq.nchunk; ++c) {
        const int tid = tidx(wv_), lane = tid & 63, w = tid >> 6, fr = lane & 15, fq = lane >> 4, k = tid & 127, half = tid >> 7;
        const int rowc = sq.row0 + c * 64; const bool lastc = (c == sq.nchunk - 1);
        asm volatile("s_waitcnt vmcnt(0)" ::: "memory");
        __syncthreads();
        stage_raw<256>(gh + (size_t)rowc * NPROJ * 2, (size_t)NPROJ * 2, (char*)rawH, tid);
        {
            unsigned fu[32], qu[32];
#pragma unroll
            for (int jj = 0; jj < 32; ++jj) { fu[jj] = rawF[(32 * half + jj) * 128 + k]; qu[jj] = rawQ[(32 * half + jj) * 128 + k]; }
            if (tid < 64) ssq[tid] = 0.f;
            float run = 0.f;
            if (half == 0) {
#pragma unroll
                for (int jj = 31; jj >= 0; --jj) { bool valid = jj < sq.Q; float f = __uint_as_float(fu[jj] << 16);
                    float sg = __builtin_amdgcn_rcpf(1.f + __expf(-f)); float lg0 = __logf(lb + (1.f - lb) * sg); float lg = valid ? lg0 : 0.f;
                    float kk0 = (1.f - lb) * (1.f - sg); float kk = valid ? kk0 : 0.f; float q0 = __uint_as_float(qu[jj] << 16); float q = valid ? q0 : 0.f;
                    qt[jj * 136 + k] = f2bf(q * cexp(-run)); kt[jj * 136 + k] = f2bf(kk * cexp(run)); run += lg; }
                T0[k] = run;
            } else {
#pragma unroll
                for (int jj = 0; jj < 32; ++jj) { bool valid = (32 + jj) < sq.Q; float f = __uint_as_float(fu[jj] << 16);
                    float sg = __builtin_amdgcn_rcpf(1.f + __expf(-f)); float lg0 = __logf(lb + (1.f - lb) * sg); float lg = valid ? lg0 : 0.f;
                    float kk0 = (1.f - lb) * (1.f - sg); float kk = valid ? kk0 : 0.f; float q0 = __uint_as_float(qu[jj] << 16); float q = valid ? q0 : 0.f;
                    run += lg; qt[(32 + jj) * 136 + k] = f2bf(q * cexp(run)); kt[(32 + jj) * 136 + k] = f2bf(kk * cexp(-run)); }
                T1[k] = run;
            }
        }
        __syncthreads();
#pragma unroll
        for (int mf = 0; mf < 2; ++mf) { int k0 = 32 * w + 16 * mf + 4 * fq; float e0 = __expf(T0[k0]), e1 = __expf(T0[k0 + 1]), e2 = __expf(T0[k0 + 2]), e3 = __expf(T0[k0 + 3]);
#pragma unroll
            for (int nf = 0; nf < 8; ++nf) { hacc[mf][nf][0] *= e0; hacc[mf][nf][1] *= e1; hacc[mf][nf][2] *= e2; hacc[mf][nf][3] *= e3;
                us4 o; o[0] = f2bf(hacc[mf][nf][0]); o[1] = f2bf(hacc[mf][nf][1]); o[2] = f2bf(hacc[mf][nf][2]); o[3] = f2bf(hacc[mf][nf][3]);
                *(us4*)(sb + (16 * nf + fr) * 136 + k0) = o; } }
        f32x4 at[4];
#pragma unroll
        for (int nf = 0; nf < 4; ++nf) at[nf] = (f32x4){0.f, 0.f, 0.f, 0.f};
        lds_mma<4, 4>(at, kt, 136, 16 * w, qt, 136, 0, wv_);
        __syncthreads();
        f32x4 oacc[2][4];
#pragma unroll
        for (int mf = 0; mf < 2; ++mf) {
#pragma unroll
            for (int nf = 0; nf < 4; ++nf) oacc[mf][nf] = (f32x4){0.f, 0.f, 0.f, 0.f};
            lds_mma<4, 4>(oacc[mf], sb, 136, 32 * w + 16 * mf, qt, 136, 0, wv_); }
        __syncthreads();
#pragma unroll
        for (int nf = 0; nf < 4; ++nf) { int i = 16 * nf + fr; us4 o;
#pragma unroll
            for (int r = 0; r < 4; ++r) { int j = 16 * w + 4 * fq + r; o[r] = f2bf(j <= i ? at[nf][r] : 0.f); }
            *(us4*)(att + i * 72 + 16 * w + 4 * fq) = o; }
        {   unsigned vu[32];
#pragma unroll
            for (int jj = 0; jj < 32; ++jj) vu[jj] = rawV[(32 * half + jj) * 128 + k];
#pragma unroll
            for (int q4 = 0; q4 < 4; ++q4) { us8 kv, vv;
#pragma unroll
                for (int e = 0; e < 8; ++e) { int jj = q4 * 8 + e; bool valid = (32 * half + jj) < sq.Q; kv[e] = kt[(32 * half + jj) * 136 + k]; vv[e] = valid ? (bf16_t)vu[jj] : (bf16_t)0; }
                *(us8*)(kT + k * 72 + 32 * half + q4 * 8) = kv; *(us8*)(vT + k * 72 + 32 * half + q4 * 8) = vv; } }
        __syncthreads();
        if (!lastc) { const size_t ro = (size_t)(rowc + 64) * NPROJ * 2;
            stage_raw<256>(gf + ro, (size_t)NPROJ * 2, (char*)rawF, tid); stage_raw<256>(gq + ro, (size_t)NPROJ * 2, (char*)rawQ, tid); stage_raw<256>(gv + ro, (size_t)NPROJ * 2, (char*)rawV, tid); }
#pragma unroll
        for (int mf = 0; mf < 2; ++mf) {
            lds_mma<4, 2>(oacc[mf], vT, 72, 32 * w + 16 * mf, att, 72, 0, wv_);
            lds_mma<8, 2>(hacc[mf], kT, 72, 32 * w + 16 * mf, vT, 72, 0, wv_);
            int k0 = 32 * w + 16 * mf + 4 * fq; float e0 = __expf(T1[k0]), e1 = __expf(T1[k0 + 1]), e2 = __expf(T1[k0 + 2]), e3 = __expf(T1[k0 + 3]);
#pragma unroll
            for (int nf = 0; nf < 8; ++nf) { hacc[mf][nf][0] *= e0; hacc[mf][nf][1] *= e1; hacc[mf][nf][2] *= e2; hacc[mf][nf][3] *= e3; } }
#pragma unroll
        for (int nf = 0; nf < 4; ++nf) { float s = 0.f;
#pragma unroll
            for (int mf = 0; mf < 2; ++mf)
#pragma unroll
                for (int r = 0; r < 4; ++r) s += oacc[mf][nf][r] * oacc[mf][nf][r];
            s += shflx(s, 16, lane); s += shflx(s, 32, lane);
            if (fq == 0) atomicAdd(&ssq[16 * nf + fr], s); }
        if (lastc) asm volatile("s_waitcnt vmcnt(0)" ::: "memory"); else asm volatile("s_waitcnt vmcnt(12)" ::: "memory");
        __syncthreads();
#pragma unroll
        for (int nf = 0; nf < 4; ++nf) { int i = 16 * nf + fr; float rs = rsqrtf(ssq[i] * (1.f / 128.f) + 1e-6f);
#pragma unroll
            for (int mf = 0; mf < 2; ++mf) { int v0 = 32 * w + 16 * mf + 4 * fq; us4 gt = *(const us4*)(rawH + i * 128 + v0); f32x4 wv = nwr[mf]; us4 o;
#pragma unroll
                for (int r = 0; r < 4; ++r) o[r] = f2bf(oacc[mf][nf][r] * rs * wv[r] * bf2f(gt[r]));
                if (i < sq.Q) *(us4*)(yhg + (size_t)(rowc + i) * LDK + h * 128 + v0) = o; } }
        __syncthreads();
    }
#pragma unroll
    for (int mf = 0; mf < 2; ++mf)
#pragma unroll
        for (int nf = 0; nf < 8; ++nf)
#pragma unroll
            for (int r = 0; r < 4; ++r) st_out[(32 * w + 16 * mf + 4 * fq + r) * 128 + 16 * nf + fr] = hacc[mf][nf][r];
}

DEVI void rg_unit(const Params& p, int l, Seq sq, int blk, char* lds, int wv_) {
    bf16_t* waT = (bf16_t*)lds; bf16_t* wiT = (bf16_t*)(lds + 9216); bf16_t* xr = (bf16_t*)(lds + 18432);
    float* av = (float*)(lds + 27648); float* uv = (float*)(lds + 44288); float* Pq = (float*)(lds + 60928); float* Hq = Pq + 256; float* carry = Hq + 256;
    const int tid = tidx(wv_), lane = tid & 63, w = tid >> 6, fr = lane & 15, fq = lane >> 4;
    const bf16_t* proj = (const bf16_t*)(p.ws + WS_PROJ); bf16_t* yrg = (bf16_t*)(p.ws + WS_YRG);
    const int cb0 = blk * 64;
    const float* cw = p.in[I_RCW] + (size_t)l * 4 * 1024; const float* cbias = p.in[I_RCB] + l * 1024;
    const float* st_in; float* st_out; const float* hist; float* hist_out;
    if (sq.samp) { st_in = p.in[I_RG] + (size_t)(l * 16 + sq.b) * 1024; st_out = p.out + O_RG_S + (size_t)(l * 16 + sq.b) * 1024;
        hist = p.in[I_RCV] + (size_t)(l * 16 + sq.b) * 3 * 1024; hist_out = p.out + O_RCV_S + (size_t)(l * 16 + sq.b) * 3 * 1024; }
    else { st_out = p.out + O_RG_P + (size_t)(l * 16 + sq.b) * 1024; st_in = sq.seg ? st_out : nullptr;
        hist_out = p.out + O_RCV_P + (size_t)(l * 16 + sq.b) * 3 * 1024; hist = sq.seg ? hist_out : nullptr; }
    float* cwl = (float*)(lds + 63232);
    float* hl = (float*)(lds + 64512);
    float* hl2 = (float*)(lds + 90112);
    for (int idx = tid; idx < 320; idx += 256) { int k = idx >> 6, cc = idx & 63; cwl[idx] = k < 4 ? cw[k * 1024 + cb0 + cc] : cbias[cb0 + cc]; if (idx < 192) hl[idx] = hist ? hist[k * 1024 + cb0 + cc] : 0.f; }
    {   const float* wa = p.in[I_RWA] + ((size_t)l * 16 + blk) * 4096; const float* wi = p.in[I_RWI] + ((size_t)l * 16 + blk) * 4096;
        float wa_[16], wi_[16];
#pragma unroll
        for (int u = 0; u < 16; ++u) { wa_[u] = wa[tid + 256 * u]; wi_[u] = wi[tid + 256 * u]; }
#pragma unroll
        for (int u = 0; u < 16; ++u) { int e = tid + 256 * u, i = e >> 6, j = e & 63; waT[j * 72 + i] = f2bf(wa_[u]); wiT[j * 72 + i] = f2bf(wi_[u]); }
        if (tid < 64) carry[tid] = st_in ? st_in[cb0 + tid] : 0.f; }
    float cba[4], cbi[4], csp[4];
#pragma unroll
    for (int nf = 0; nf < 4; ++nf) { int cc = cb0 + 16 * nf + fr; cba[nf] = p.in[I_RBA][l * 1024 + cc]; cbi[nf] = p.in[I_RBI][l * 1024 + cc]; csp[nf] = softplus(-p.in[I_RLAM][l * 1024 + cc]); }
    bf16_t* rawR = (bf16_t*)(lds + 65536); bf16_t* rawG = (bf16_t*)(lds + 73728);
    const char* gr = (const char*)(proj + PC_RX + cb0); const char* gg = (const char*)(proj + PC_RGATE + cb0);
    asm volatile("s_waitcnt vmcnt(0)" ::: "memory");
    stage_raw<128>(gr + (size_t)sq.row0 * NPROJ * 2, (size_t)NPROJ * 2, (char*)rawR, tid); stage_raw<128>(gg + (size_t)sq.row0 * NPROJ * 2, (size_t)NPROJ * 2, (char*)rawG, tid);
    for (int c = 0; c < sq.nchunk; ++c) {
        const int tid = tidx(wv_), lane = tid & 63, w = tid >> 6, fr = lane & 15, fq = lane >> 4, j = tid & 63, q = tid >> 6;
        const int rowc = sq.row0 + c * 64; const bool lastc = (c == sq.nchunk - 1);
        const float* hlr = (c & 1) ? hl2 : hl; float* hlw = (c & 1) ? hl : hl2;
        asm volatile("s_waitcnt vmcnt(0)" ::: "memory");
        __syncthreads();
#pragma unroll
        for (int i = 0; i < 2; ++i) { int it = tid + 256 * i, t = it >> 3, c8 = (it & 7) * 8; float o[8], raw[8]; int ch = cb0 + c8; const bool tv = t < sq.Q;
            conv_lds(rawR, 64, t, c8, hlr, cwl, 64, c8, o, raw);
            if (t >= 61) {
#pragma unroll
                for (int e = 0; e < 8; ++e) hlw[(t - 61) * 64 + c8 + e] = raw[e]; }
            if (lastc && tv && t >= sq.Q - 3) {
#pragma unroll
                for (int e = 0; e < 8; ++e) hist_out[(t - (sq.Q - 3)) * 1024 + ch + e] = raw[e]; }
            us8 ov;
#pragma unroll
            for (int e = 0; e < 8; ++e) { float ox = tv ? o[e] : 0.f; ov[e] = f2bf(ox); uv[t * 65 + c8 + e] = ox; }
            *(us8*)(xr + t * 72 + c8) = ov; }
        __syncthreads();
        if (!lastc) { const size_t ro = (size_t)(rowc + 64) * NPROJ * 2; stage_raw<128>(gr + ro, (size_t)NPROJ * 2, (char*)rawR, tid); stage_raw<128>(gg + ro, (size_t)NPROJ * 2, (char*)(rawG + ((c + 1) & 1) * 4096), tid); }
        f32x4 ra[4], ri[4];
#pragma unroll
        for (int nf = 0; nf < 4; ++nf) { ra[nf] = (f32x4){0.f, 0.f, 0.f, 0.f}; ri[nf] = (f32x4){0.f, 0.f, 0.f, 0.f}; }
        lds_mma<4, 2>(ra, xr, 72, 16 * w, waT, 72, 0, wv_);
        lds_mma<4, 2>(ri, xr, 72, 16 * w, wiT, 72, 0, wv_);
#pragma unroll
        for (int nf = 0; nf < 4; ++nf) { int jj = 16 * nf + fr; float ba = cba[nf], bi = cbi[nf], sp = csp[nf];
#pragma unroll
            for (int r = 0; r < 4; ++r) { int t = 16 * w + 4 * fq + r; float rr = sigm(ra[nf][r] + ba), ii = sigm(ri[nf][r] + bi); float la = -8.f * sp * rr; float aa = __expf(la);
                float u = __builtin_sqrtf(fmaxf(1.f - aa * aa, 0.f)) * ii * uv[t * 65 + jj];
                if (t >= sq.Q) { aa = 1.f; u = 0.f; }
                av[t * 65 + jj] = aa; uv[t * 65 + jj] = u; } }
        __syncthreads();
        { float P = 1.f, H = 0.f;
#pragma unroll
          for (int tt = 0; tt < 16; ++tt) { int t = 16 * q + tt; float aa = av[t * 65 + j], u = uv[t * 65 + j]; H = aa * H + u; P *= aa; }
          Pq[q * 64 + j] = P; Hq[q * 64 + j] = H; }
        __syncthreads();
        float hcur = carry[j];
        for (int qq = 0; qq < q; ++qq) hcur = Pq[qq * 64 + j] * hcur + Hq[qq * 64 + j];
        const bf16_t* rg_ = rawG + (c & 1) * 4096;
        bf16_t gts[16];
#pragma unroll
        for (int tt = 0; tt < 16; ++tt) gts[tt] = rg_[(16 * q + tt) * 64 + j];
#pragma unroll
        for (int tt = 0; tt < 16; ++tt) { int t = 16 * q + tt; float aa = av[t * 65 + j], u = uv[t * 65 + j]; hcur = aa * hcur + u;
            if (t < sq.Q) yrg[(size_t)(rowc + t) * LDK + cb0 + j] = f2bf(bf2f(gts[tt]) * hcur); }
        __syncthreads();
        if (q == 3) carry[j] = hcur;
        __syncthreads();
    }
    if (tid < 64) st_out[cb0 + tid] = carry[tid];
    __syncthreads();
}

DEVI void phase_mix(const Params& p, int l, int seg, char* lds, int wv_) {
    const int ngrp = seg == 0 ? 2 : 1; const int NU = ngrp * 640;
    unsigned* qctr = (unsigned*)(p.ws + WS_END) + 1 + (seg * 2 + l);
    volatile int* sh = (volatile int*)(lds + 147440);
    for (;;) {
        if (tidx(wv_) == 0) sh[0] = (int)__hip_atomic_fetch_add(qctr, 1u, __ATOMIC_RELAXED, __HIP_MEMORY_SCOPE_AGENT);
        __syncthreads();
        const int u = __builtin_amdgcn_readfirstlane(sh[0]);
        __syncthreads();
        if (u >= NU) break;
        int grp = u / 640, v = u % 640;
        if (v < 128) hgrn_unit(p, l, make_seq(seg, grp * 16 + (v >> 3)), v & 7, lds, wv_);
        else if (v < 384) { v -= 128; ssd_unit(p, l, make_seq(seg, grp * 16 + (v >> 4)), v & 15, lds, wv_); }
        else { v -= 384; rg_unit(p, l, make_seq(seg, grp * 16 + (v >> 4)), v & 15, lds, wv_); }
        __syncthreads();
    }
}

DEVI void gbar(const Params& p, unsigned& epoch_, int wv_) {
    const unsigned epoch = __builtin_amdgcn_readfirstlane(epoch_); epoch_ = epoch + 1u;
    unsigned* bw = (unsigned*)(p.ws + WS_END); asm volatile("" : "+s"(bw));
    asm volatile("s_waitcnt vmcnt(0)" ::: "memory");
    __syncthreads();
    if (tidx(wv_) == 0) {
        if ((wv_ >> 23) & 1) {
            const unsigned x = (wv_ >> 2) & 7, NB = (wv_ >> 14) & 511;
            const unsigned old = __hip_atomic_fetch_add(bw + 32 + x, 1u, __ATOMIC_RELAXED, __HIP_MEMORY_SCOPE_AGENT);
            if (old + 1u == (epoch + 1u) * NB) {
                __builtin_amdgcn_fence(__ATOMIC_RELEASE, "agent");
                asm volatile("s_waitcnt vmcnt(0)" ::: "memory");
                const unsigned og = __hip_atomic_fetch_add(bw + 56, 1u, __ATOMIC_RELAXED, __HIP_MEMORY_SCOPE_AGENT);
                if (og + 1u == (epoch + 1u) * 8u) __hip_atomic_fetch_add(bw + 57, 1u, __ATOMIC_RELAXED, __HIP_MEMORY_SCOPE_AGENT);
                else while (__hip_atomic_load(bw + 57, __ATOMIC_RELAXED, __HIP_MEMORY_SCOPE_AGENT) < epoch + 1u) __builtin_amdgcn_s_sleep(1);
                __builtin_amdgcn_fence(__ATOMIC_ACQUIRE, "agent");
                __hip_atomic_fetch_add(bw + 48 + x, 1u, __ATOMIC_RELAXED, __HIP_MEMORY_SCOPE_AGENT);
                asm volatile("s_waitcnt vmcnt(0)" ::: "memory");
            } else {
                while (__hip_atomic_load(bw + 48 + x, __ATOMIC_RELAXED, __HIP_MEMORY_SCOPE_AGENT) < epoch + 1u) __builtin_amdgcn_s_sleep(1);
                __builtin_amdgcn_fence(__ATOMIC_ACQUIRE, "agent");
                asm volatile("s_waitcnt vmcnt(0)" ::: "memory");
            }
        } else {
            __builtin_amdgcn_fence(__ATOMIC_RELEASE, "agent");
            asm volatile("s_waitcnt vmcnt(0)" ::: "memory");
            __hip_atomic_fetch_add(bw, 1u, __ATOMIC_RELAXED, __HIP_MEMORY_SCOPE_AGENT);
            const unsigned target = (epoch + 1u) * gridDim.x;
            while (__hip_atomic_load(bw, __ATOMIC_RELAXED, __HIP_MEMORY_SCOPE_AGENT) < target) __builtin_amdgcn_s_sleep(1);
            __builtin_amdgcn_fence(__ATOMIC_ACQUIRE, "agent");
            asm volatile("s_waitcnt vmcnt(0)" ::: "memory");
        }
    }
    __syncthreads();
}

__global__ void __launch_bounds__(256) fwd_mega(Params p) {
    extern __shared__ __attribute__((aligned(16))) char lds[];
    int wv_ = __builtin_amdgcn_readfirstlane((int)(__builtin_amdgcn_workitem_id_x() >> 6));
    cg::grid_group grid = cg::this_grid();
    unsigned* xcnt = (unsigned*)(p.ws + WS_END) + 16;
    const int xcc = (int)(__builtin_amdgcn_s_getreg((3 << 11) | 20) & 7u);
    int xrank;
    { int* sh = (int*)lds; if (__builtin_amdgcn_workitem_id_x() == 0) sh[0] = (int)__hip_atomic_fetch_add(xcnt + xcc, 1u, __ATOMIC_RELAXED, __HIP_MEMORY_SCOPE_AGENT); __syncthreads(); xrank = __builtin_amdgcn_readfirstlane(sh[0]); __syncthreads(); }
    unsigned epoch = 0;
    phase_prep(p, lds, wv_);
    grid.sync();
    {   unsigned c[8]; bool ok = true;
#pragma unroll
        for (int i = 0; i < 8; ++i) { c[i] = __hip_atomic_load(xcnt + i, __ATOMIC_RELAXED, __HIP_MEMORY_SCOPE_AGENT); ok = ok && c[i] > 0u && c[i] < 512u; }
        unsigned mine = 0, tot_ = 0;
#pragma unroll
        for (int i = 0; i < 8; ++i) { mine = (i == xcc) ? c[i] : mine; tot_ += c[i]; }
        ok = ok && tot_ == gridDim.x;
        int X = xcc, R = xrank, NB = (int)mine;
        if (!ok) { X = blockIdx.x & 7; R = blockIdx.x >> 3; NB = gridDim.x >> 3; }
        wv_ = __builtin_amdgcn_readfirstlane((wv_ & 3) | (X << 2) | (R << 5) | (NB << 14) | (ok ? (1 << 23) : 0)); }
#pragma unroll 1
    for (int seg = 0; seg < NSEG; ++seg) {
        const int nrows = seg == 0 ? ROWS : ROWS_P, MT = nrows / 256;
#pragma unroll 1
        for (int l = 0; l < 2; ++l) {
            const bf16_t* wl = (const bf16_t*)p.ws + (size_t)l * E_LAYER;
            phase_norm(p, seg, nrows, p.in[I_NMIX] + l * 1024, l == 0, l, lds, wv_);
            gbar(p, epoch, wv_);
            for (int r = 0; r < p.rep[0]; ++r) { phase_proj(p, l, MT, lds, wv_); gbar(p, epoch, wv_); }
            phase_mix(p, l, seg, lds, wv_); gbar(p, epoch, wv_);
            phase_mbnorm(p, l, nrows, wv_);
            gbar(p, epoch, wv_);
            for (int r = 0; r < p.rep[1]; ++r) { phase_merge(p, l, MT, lds, wv_); gbar(p, epoch, wv_); }
            phase_resid(p, seg, MT, (const bf16_t*)(p.ws + WS_MRG), 1024, LDK, wl + E_WIN + E_WBR, l == 0, lds, wv_);
            gbar(p, epoch, wv_);
            phase_norm(p, seg, nrows, p.in[I_NFFN] + l * 1024, false, -1, lds, wv_);
            gbar(p, epoch, wv_);
            for (int r = 0; r < p.rep[2]; ++r) { phase_ffn_in(p, l, MT, lds, wv_); gbar(p, epoch, wv_); }
            phase_resid(p, seg, MT, (const bf16_t*)(p.ws + WS_PROJ), FFH, LDF, wl + E_WIN + E_WBR + E_WOUT + E_WFI, false, lds, wv_);
            gbar(p, epoch, wv_);
        }
        phase_final_norm(p, seg, nrows, wv_);
    }
}

extern "C" void kernel_launch(void* const* d_in, const int* in_sizes, int n_in, void* d_out, int out_size, void* d_ws, size_t ws_size, hipStream_t stream) {
    static int grid_blocks = 0;
    if (!grid_blocks) {
        int dev = 0, cus = 0, per_cu = 0;
        (void)hipGetDevice(&dev);
        (void)hipDeviceGetAttribute(&cus, hipDeviceAttributeMultiprocessorCount, dev);
        (void)hipFuncSetAttribute((const void*)fwd_mega, hipFuncAttributeMaxDynamicSharedMemorySize, LDS_BYTES);
        (void)hipOccupancyMaxActiveBlocksPerMultiprocessor(&per_cu, (const void*)fwd_mega, 256, LDS_BYTES);
        if (per_cu < 1) fprintf(stderr, "occupancy query says %d blocks per CU\n", per_cu);
        grid_blocks = cus;
        if (ws_size < WS_TOTAL) fprintf(stderr, "workspace too small: %zu < %zu\n", ws_size, (size_t)WS_END + 256);
    }
    (void)hipMemsetAsync((char*)d_ws + WS_END, 0, 256, stream);
    Params p{};
    for (int i = 0; i < 30; ++i) p.in[i] = (const float*)d_in[i];
    p.out = (float*)d_out; p.ws = (unsigned char*)d_ws; p.rep[0] = REP0; p.rep[1] = REP1; p.rep[2] = REP2; p.rep[3] = REP3;
    void* args[] = {&p};
    hipError_t e = hipLaunchCooperativeKernel((const void*)fwd_mega, dim3(grid_blocks), dim3(256), args, LDS_BYTES, stream);
    if (e != hipSuccess) fprintf(stderr, "cooperative launch failed: %s (grid %d)\n", hipGetErrorString(e), grid_blocks);
}
```
